# Optimizing an MI355X kernel written in HIP

```python
import jax, jax.numpy as jnp
from jax import lax
import numpy as np

D_MODEL = 1024
BATCH = 2
SEQ = 8192
DEPTH = 1

SWA_HEADS = 8
SWA_KV_HEADS = 2
SWA_HEAD_DIM = 64
WINDOW = 128
ATTN_BLOCK = 128
MLA_HEADS = 8
MLA_Q_RANK = 384
MLA_KV_RANK = 256
MLA_NOPE_DIM = 64
MLA_ROPE_DIM = 32
MLA_V_DIM = 64
ROPE_THETA = 10000.0
N_EXPERTS = 32
TOP_K = 4
D_EXPERT = 1024
SWIGLU_LIMIT = 7.0
SWIGLU_ALPHA = 1.702
MOE_BLOCK = 128
NORM_EPS = 1e-6

SWA_Q_DIM = SWA_HEADS * SWA_HEAD_DIM
SWA_KV_DIM = SWA_KV_HEADS * SWA_HEAD_DIM
MLA_QK_DIM = MLA_NOPE_DIM + MLA_ROPE_DIM
MLA_OUT_DIM = MLA_HEADS * MLA_V_DIM
IN_WIDTHS = (SWA_Q_DIM, SWA_KV_DIM, SWA_KV_DIM, MLA_Q_RANK, MLA_KV_RANK, MLA_ROPE_DIM, D_MODEL, D_MODEL)
IN_DIM = 3488

kernel_name = 'hybrid_swa_mla_moe_adaln_block'


def rmsnorm(x, g):
    x32 = x.astype(jnp.float32)
    r = x32 * lax.rsqrt(jnp.mean(x32 * x32, axis=-1, keepdims=True) + NORM_EPS)
    return (r * g.astype(jnp.float32)).astype(x.dtype)


def alibi_slopes(n_heads):
    return jnp.asarray(np.exp2(-8.0 * np.arange(1, n_heads + 1) / n_heads), dtype=jnp.float32)


def rope(t, cos, sin):
    half = t.shape[-1] // 2
    t1, t2 = t[..., :half], t[..., half:]
    return jnp.concatenate([t1 * cos - t2 * sin, t2 * cos + t1 * sin], axis=-1)


def sliding_window_attention(q, k, v, sinks):
    B, S = q.shape[:2]
    nb = S // ATTN_BLOCK
    G = SWA_HEADS // SWA_KV_HEADS
    qb = q.reshape(B, nb, ATTN_BLOCK, SWA_KV_HEADS, G, SWA_HEAD_DIM)

    def band(t):
        tp = jnp.pad(t, ((0, 0), (ATTN_BLOCK, 0), (0, 0), (0, 0)))
        tp = tp.reshape(B, nb + 1, ATTN_BLOCK, SWA_KV_HEADS, SWA_HEAD_DIM)
        return jnp.concatenate([tp[:, :-1], tp[:, 1:]], axis=2)

    kw, vw = band(k), band(v)
    scores = jnp.einsum('bnqhgd,bnkhd->bnhgqk', qb, kw).astype(jnp.float32) * (SWA_HEAD_DIM ** -0.5)
    qi = jnp.arange(ATTN_BLOCK)[:, None]
    kj = jnp.arange(2 * ATTN_BLOCK)[None, :]
    dist = qi - kj + ATTN_BLOCK
    key_abs = jnp.arange(nb)[:, None, None] * ATTN_BLOCK - ATTN_BLOCK + kj[None]
    valid = (dist >= 0) & (dist < WINDOW) & (key_abs >= 0)
    slopes = alibi_slopes(SWA_HEADS).reshape(SWA_KV_HEADS, G)
    scores = scores - slopes[:, :, None, None] * dist.astype(jnp.float32)
    scores = jnp.where(valid[None, :, None, None], scores, -jnp.inf)
    sink = jnp.broadcast_to(sinks.astype(jnp.float32).reshape(SWA_KV_HEADS, G)[:, :, None, None],
                            scores.shape[:-1] + (1,))
    probs = jax.nn.softmax(jnp.concatenate([scores, sink], axis=-1), axis=-1)[..., :-1]
    out = jnp.einsum('bnhgqk,bnkhd->bnqhgd', probs.astype(v.dtype), vw)
    return out.reshape(B, S, SWA_Q_DIM)


def mla_attention(q_nope, q_rope, k_nope, k_rope, v):
    B, S = q_nope.shape[:2]
    nb = S // ATTN_BLOCK
    scale = MLA_QK_DIM ** -0.5
    key_pos = jnp.arange(S)

    def blocks(t):
        return jnp.moveaxis(t.reshape((B, nb, ATTN_BLOCK) + t.shape[2:]), 1, 0)

    def attend(args):
        qn, qr, n = args
        s = (jnp.einsum('bqhd,bkhd->bhqk', qn, k_nope).astype(jnp.float32)
             + jnp.einsum('bqhd,bkd->bhqk', qr, k_rope).astype(jnp.float32)) * scale
        q_pos = n * ATTN_BLOCK + jnp.arange(ATTN_BLOCK)
        s = jnp.where(key_pos[None, :] <= q_pos[:, None], s, -jnp.inf)
        p = jax.nn.softmax(s, axis=-1)
        return jnp.einsum('bhqk,bkhd->bqhd', p.astype(v.dtype), v)

    out = lax.map(attend, (blocks(q_nope), blocks(q_rope), jnp.arange(nb)))
    return jnp.moveaxis(out, 0, 1).reshape(B, S, MLA_OUT_DIM)


def clamped_swiglu(hb):
    x_glu = jnp.minimum(hb[..., :D_EXPERT], SWIGLU_LIMIT)
    x_lin = jnp.clip(hb[..., D_EXPERT:], -SWIGLU_LIMIT, SWIGLU_LIMIT)
    return x_glu * jax.nn.sigmoid(SWIGLU_ALPHA * x_glu) * (x_lin + 1.0)


def moe(h, w_router, b_router, w1, b1, w2, b2):
    B, S, D = h.shape
    xt = h.reshape(-1, D)
    N = xt.shape[0]
    logits = (xt @ w_router + b_router).astype(jnp.float32)
    top_vals, top_idx = lax.top_k(logits, TOP_K)
    top_w = jax.nn.softmax(top_vals, axis=-1)
    NK = N * TOP_K
    flat_e = top_idx.reshape(-1)
    flat_tok = jnp.repeat(jnp.arange(N, dtype=jnp.int32), TOP_K)
    flat_w = top_w.reshape(-1)
    order = jnp.argsort(flat_e)
    sorted_e = flat_e[order]
    counts = jnp.bincount(flat_e, length=N_EXPERTS)
    padded = ((counts + MOE_BLOCK - 1) // MOE_BLOCK) * MOE_BLOCK
    starts = jnp.cumsum(counts) - counts
    pends = jnp.cumsum(padded)
    pstarts = pends - padded
    dest = pstarts[sorted_e] + (jnp.arange(NK) - starts[sorted_e])
    P = NK + N_EXPERTS * MOE_BLOCK
    n_blocks = P // MOE_BLOCK
    tok_buf = jnp.zeros((P,), jnp.int32).at[dest].set(flat_tok[order])
    w_buf = jnp.zeros((P,), h.dtype).at[dest].set(flat_w[order].astype(h.dtype))
    block_e = jnp.minimum(jnp.searchsorted(pends, jnp.arange(n_blocks) * MOE_BLOCK, side='right'),
                          N_EXPERTS - 1)

    def expert_block(args):
        e, toks = args
        xb = xt[toks]
        hb = clamped_swiglu(xb @ w1[e] + b1[e])
        return hb @ w2[e] + b2[e]

    ys = lax.map(expert_block, (block_e, tok_buf.reshape(n_blocks, MOE_BLOCK)))
    y = jnp.zeros_like(xt).at[tok_buf].add(ys.reshape(P, D) * w_buf[:, None])
    return y.reshape(B, S, D)


def setup_inputs(seed: int = 0) -> dict:
    key = jax.random.key(seed)
    ks = jax.random.split(key, 26)
    f32 = jnp.float32

    def nrm(k, shape, fan_in, mult=1.0):
        return jax.random.normal(k, shape, f32) * (mult * fan_in ** -0.5)

    L, D, E, F = DEPTH, D_MODEL, N_EXPERTS, D_EXPERT
    return {
        'x': jax.random.normal(ks[0], (BATCH, SEQ, D), f32),
        'c': jax.random.normal(ks[1], (BATCH, D), f32),
        'positions': jax.random.randint(ks[2], (BATCH, 1), 0, 1024, jnp.int32)
                     + jnp.arange(SEQ, dtype=jnp.int32)[None, :],
        'w_ada': nrm(ks[3], (L, D, 6 * D), D, 0.5),
        'b_ada': 0.01 * jax.random.normal(ks[4], (L, 6 * D), f32),
        'norm_mix': 1.0 + 0.05 * jax.random.normal(ks[5], (L, D), f32),
        'norm_ffn': 1.0 + 0.05 * jax.random.normal(ks[6], (L, D), f32),
        'w_in': nrm(ks[7], (L, D, IN_DIM), D),
        'sinks': 0.5 * jax.random.normal(ks[8], (L, SWA_HEADS), f32),
        'q_norm': 1.0 + 0.05 * jax.random.normal(ks[9], (L, MLA_Q_RANK), f32),
        'kv_norm': 1.0 + 0.05 * jax.random.normal(ks[10], (L, MLA_KV_RANK), f32),
        'w_uq': nrm(ks[11], (L, MLA_Q_RANK, MLA_HEADS * MLA_QK_DIM), MLA_Q_RANK),
        'w_uk': nrm(ks[12], (L, MLA_KV_RANK, MLA_HEADS * MLA_NOPE_DIM), MLA_KV_RANK),
        'w_uv': nrm(ks[13], (L, MLA_KV_RANK, MLA_OUT_DIM), MLA_KV_RANK),
        'w_branch_a': nrm(ks[14], (L, SWA_Q_DIM, D), SWA_Q_DIM),
        'w_branch_b': nrm(ks[15], (L, MLA_OUT_DIM, D), MLA_OUT_DIM),
        'w_out': nrm(ks[16], (L, D, D), D),
        'w_router': nrm(ks[17], (L, D, E), D),
        'b_router': 0.01 * jax.random.normal(ks[18], (L, E), f32),
        'w_moe1': nrm(ks[19], (L, E, D, 2 * F), D),
        'b_moe1': 0.01 * jax.random.normal(ks[20], (L, E, 2 * F), f32),
        'w_moe2': nrm(ks[21], (L, E, F, D), F),
        'b_moe2': 0.01 * jax.random.normal(ks[22], (L, E, D), f32),
        'final_norm': 1.0 + 0.05 * jax.random.normal(ks[23], (D,), f32),
    }


def reference(x, c, positions, w_ada, b_ada, norm_mix, norm_ffn, w_in, sinks, q_norm, kv_norm,
              w_uq, w_uk, w_uv, w_branch_a, w_branch_b, w_out, w_router, b_router,
              w_moe1, b_moe1, w_moe2, b_moe2, final_norm):
    B, S, D = x.shape
    freqs = ROPE_THETA ** (-jnp.arange(0, MLA_ROPE_DIM, 2, dtype=jnp.float32) / MLA_ROPE_DIM)
    ang = positions.astype(jnp.float32)[..., None] * freqs
    cos, sin = jnp.cos(ang).astype(x.dtype), jnp.sin(ang).astype(x.dtype)
    split_at = list(np.cumsum(IN_WIDTHS)[:-1])
    c_act = jax.nn.silu(c)

    for l in range(DEPTH):
        mod = c_act @ w_ada[l] + b_ada[l]
        sh1, sc1, g1, sh2, sc2, g2 = [m[:, None, :] for m in jnp.split(mod, 6, axis=-1)]

        h = rmsnorm(x, norm_mix[l]) * (1.0 + sc1) + sh1
        proj = h @ w_in[l]
        qa, ka, va, cq, ckv, kr, gate_a, gate_b = jnp.split(proj, split_at, axis=-1)

        ya = sliding_window_attention(qa.reshape(B, S, SWA_HEADS, SWA_HEAD_DIM),
                                      ka.reshape(B, S, SWA_KV_HEADS, SWA_HEAD_DIM),
                                      va.reshape(B, S, SWA_KV_HEADS, SWA_HEAD_DIM),
                                      sinks[l])
        ya = ya @ w_branch_a[l]

        q = (rmsnorm(cq, q_norm[l]) @ w_uq[l]).reshape(B, S, MLA_HEADS, MLA_QK_DIM)
        q_nope = q[..., :MLA_NOPE_DIM]
        q_rope = rope(q[..., MLA_NOPE_DIM:], cos[:, :, None, :], sin[:, :, None, :])
        ckv_n = rmsnorm(ckv, kv_norm[l])
        k_nope = (ckv_n @ w_uk[l]).reshape(B, S, MLA_HEADS, MLA_NOPE_DIM)
        v_b = (ckv_n @ w_uv[l]).reshape(B, S, MLA_HEADS, MLA_V_DIM)
        k_rope = rope(kr, cos, sin)
        yb = mla_attention(q_nope, q_rope, k_nope, k_rope, v_b) @ w_branch_b[l]

        mixed = jax.nn.sigmoid(gate_a) * ya + jax.nn.sigmoid(gate_b) * yb
        x = x + g1 * (mixed @ w_out[l])

        h2 = rmsnorm(x, norm_ffn[l]) * (1.0 + sc2) + sh2
        x = x + g2 * moe(h2, w_router[l], b_router[l], w_moe1[l], b_moe1[l], w_moe2[l], b_moe2[l])

    return rmsnorm(x, final_norm)
```

```cpp
#include <hip/hip_runtime.h>
#include <cstdio>
#include <cstdint>

typedef unsigned short bf16_t;
typedef short bf16x8 __attribute__((ext_vector_type(8)));
typedef float f32x4 __attribute__((ext_vector_type(4)));
typedef unsigned u32x4 __attribute__((ext_vector_type(4)));
typedef unsigned u32x2 __attribute__((ext_vector_type(2)));

constexpr int NTHREADS = 512;
constexpr int LDS_BYTES = 147456;
constexpr int BATCH = 2, SEQ = 8192, DM = 1024, MTOK = BATCH * SEQ;
constexpr int NEXP = 32, LISTCAP = 16384;
constexpr float EPS = 1e-6f;
constexpr float LOG2E = 1.4426950408889634f;

constexpr size_t MiB = 1u << 20;
constexpr size_t WS_CTL = 0;
constexpr size_t WS_MOD = 1 * MiB;
constexpr size_t WS_WT_IN = 2 * MiB;
constexpr size_t WS_WT_UQ = 9 * MiB;
constexpr size_t WS_WT_UKV = 10 * MiB;
constexpr size_t WS_WT_A = 11 * MiB;
constexpr size_t WS_WT_B = 12 * MiB;
constexpr size_t WS_WT_OUT = 13 * MiB;
constexpr size_t WS_WRT = 1 * MiB + 524288;
constexpr size_t WS_COS = 15 * MiB;
constexpr size_t WS_SIN = 16 * MiB;
constexpr size_t WS_SSQ = 17 * MiB;
constexpr size_t WS_LIST = 18 * MiB;
constexpr size_t WS_TOPW = 1835008;
constexpr size_t WS_LISTW = 809 * MiB;
constexpr size_t WS_WT_M1 = 20 * MiB;
constexpr size_t WS_WT_M2 = 148 * MiB;
constexpr size_t WS_XN = 212 * MiB;
constexpr size_t WS_QA = 244 * MiB;
constexpr size_t WS_KA = 260 * MiB;
constexpr size_t WS_VA = 264 * MiB;
constexpr size_t WS_CQ = 268 * MiB;
constexpr size_t WS_CKV = 280 * MiB;
constexpr size_t WS_KR = 288 * MiB;
constexpr size_t WS_GA = 289 * MiB;
constexpr size_t WS_GB = 321 * MiB;
constexpr size_t WS_QN = 353 * MiB;
constexpr size_t WS_QR = 369 * MiB;
constexpr size_t WS_KN = 377 * MiB;
constexpr size_t WS_VB = 393 * MiB;
constexpr size_t WS_AO = 409 * MiB;
constexpr size_t WS_BO = 425 * MiB;
constexpr size_t WS_MIX = 441 * MiB;
constexpr size_t WS_X1 = 473 * MiB;
constexpr size_t WS_HID = 537 * MiB;
constexpr size_t WS_Y = 681 * MiB;
constexpr size_t WS_XN8 = 811 * MiB;
constexpr size_t WS_WT_G8 = 827 * MiB;
constexpr size_t WS_END = 829 * MiB;

struct P {
    const float *x, *c; const int* pos;
    const float *w_ada, *b_ada, *norm_mix, *norm_ffn, *w_in, *sinks, *q_norm, *kv_norm, *w_uq, *w_uk, *w_uv, *w_a, *w_b, *w_out,
        *w_router, *b_router, *w_m1, *b_m1, *w_m2, *b_m2, *fnorm;
    float* out; unsigned char* ws;
};

__device__ __forceinline__ unsigned f2bf(float f) { unsigned u = __float_as_uint(f); return (u + 0x7fffu + ((u >> 16) & 1u)) >> 16; }
__device__ __forceinline__ unsigned pk2(float lo, float hi) { return f2bf(lo) | (f2bf(hi) << 16); }
__device__ __forceinline__ float bf2f(unsigned h) { return __uint_as_float(h << 16); }
__device__ __forceinline__ unsigned pk4_fp8(float a, float b, float c, float d) { int r = __builtin_amdgcn_cvt_pk_fp8_f32(a, b, 0, false); r = __builtin_amdgcn_cvt_pk_fp8_f32(c, d, r, true); return (unsigned)r; }
constexpr float W8_SCALE = 32.f, W8_INV = 0.03125f;
constexpr float MIX8_SCALE = 8.f, OUT8_INV = 1.f / (8.f * 32.f);
__device__ __forceinline__ float wave_sum(float v) {
#pragma unroll
    for (int o = 1; o < 64; o <<= 1) v += __shfl_xor(v, o);
    return v;
}
__device__ __forceinline__ float sigmoidf_(float v) { return __builtin_amdgcn_rcpf(1.f + __builtin_amdgcn_exp2f(-LOG2E * v)); }

__device__ __forceinline__ void ph_mod(const P& p, unsigned char* lds) {
    const int tid = threadIdx.x, lane = tid & 63, wave = tid >> 6;
    float* red = (float*)lds;
    float* mod = (float*)(p.ws + WS_MOD);
    for (int item = blockIdx.x; item < 192; item += gridDim.x) {
        const int n0 = item * 32, cn = lane & 31, kq = lane >> 5;
        float a0 = 0.f, a1 = 0.f;
#pragma unroll 1
        for (int i0 = 0; i0 < 64; i0 += 16) {
            float wv[16];
#pragma unroll
            for (int i = 0; i < 16; ++i) wv[i] = __builtin_nontemporal_load(p.w_ada + (size_t)(wave * 128 + 2 * (i0 + i) + kq) * 6144 + n0 + cn);
#pragma unroll
            for (int i = 0; i < 16; ++i) { const int k = wave * 128 + 2 * (i0 + i) + kq; const float c0 = p.c[k], c1 = p.c[1024 + k];
                a0 += c0 * sigmoidf_(c0) * wv[i]; a1 += c1 * sigmoidf_(c1) * wv[i]; }
        }
        a0 += __shfl_xor(a0, 32); a1 += __shfl_xor(a1, 32);
        if (lane < 32) { red[(wave * 2 + 0) * 32 + cn] = a0; red[(wave * 2 + 1) * 32 + cn] = a1; }
        __syncthreads();
        if (tid < 64) { const int b = tid >> 5, cc = tid & 31; float s = 0.f;
            for (int w = 0; w < 8; ++w) s += red[(w * 2 + b) * 32 + cc];
            mod[b * 6144 + n0 + cc] = s + p.b_ada[n0 + cc]; }
        __syncthreads();
    }
}
__device__ __forceinline__ int ropeperm(int d) { return d < 16 ? 8 * (d >> 2) + (d & 3) : 8 * ((d - 16) >> 2) + 4 + (d & 3); }
__device__ __forceinline__ void transpose_item(const float* W, int N, int K, bf16_t* WT, int k0, int n0, int dst_row0, const float* kscale, float* scr, int lane, bool rperm = false) {
    float tv[32];
#pragma unroll
    for (int i = 0; i < 32; ++i) tv[i] = W[(size_t)(k0 + 2 * i + (lane >> 5)) * N + n0 + (lane & 31)];
#pragma unroll
    for (int i = 0; i < 32; ++i) { const int kk = 2 * i + (lane >> 5); float v = tv[i]; if (kscale) v *= kscale[k0 + kk]; scr[kk * 33 + (lane & 31)] = v; }
    __builtin_amdgcn_s_waitcnt(0); __builtin_amdgcn_wave_barrier();
    const int c = lane & 7;
#pragma unroll
    for (int j = 0; j < 4; ++j) { const int n = (lane >> 3) + 8 * j; const float* s = scr + (8 * c) * 33 + n;
        u32x4 o; o.x = pk2(s[0 * 33], s[1 * 33]); o.y = pk2(s[2 * 33], s[3 * 33]); o.z = pk2(s[4 * 33], s[5 * 33]); o.w = pk2(s[6 * 33], s[7 * 33]);
        *(u32x4*)(WT + (size_t)(dst_row0 + (rperm ? ropeperm(n) : n)) * K + k0 + 8 * c) = o; }
    __builtin_amdgcn_s_waitcnt(0); __builtin_amdgcn_wave_barrier();
}
__device__ __forceinline__ void transpose_item_fp8(const float* W, int N, int K, unsigned char* WT, int k0, int n0, int dst_row0, float* scr, int lane) {
    float tv[32];
#pragma unroll
    for (int i = 0; i < 32; ++i) tv[i] = W[(size_t)(k0 + 2 * i + (lane >> 5)) * N + n0 + (lane & 31)];
#pragma unroll
    for (int i = 0; i < 32; ++i) { const int kk = 2 * i + (lane >> 5); scr[kk * 33 + (lane & 31)] = tv[i] * W8_SCALE; }
    __builtin_amdgcn_s_waitcnt(0); __builtin_amdgcn_wave_barrier();
    const int c = lane & 3;
#pragma unroll
    for (int j = 0; j < 2; ++j) { const int n = (lane >> 2) + 16 * j; const float* sp = scr + (16 * c) * 33 + n;
        u32x4 o; o.x = pk4_fp8(sp[0 * 33], sp[1 * 33], sp[2 * 33], sp[3 * 33]); o.y = pk4_fp8(sp[4 * 33], sp[5 * 33], sp[6 * 33], sp[7 * 33]);
        o.z = pk4_fp8(sp[8 * 33], sp[9 * 33], sp[10 * 33], sp[11 * 33]); o.w = pk4_fp8(sp[12 * 33], sp[13 * 33], sp[14 * 33], sp[15 * 33]);
        *(u32x4*)(WT + (size_t)(dst_row0 + n) * K + k0 + 16 * c) = o; }
    __builtin_amdgcn_s_waitcnt(0); __builtin_amdgcn_wave_barrier();
}
__device__ __forceinline__ int in_colmap(int s) {
    if (s < 768) return s;
    if (s < 1152) return 1024 + (s - 768);
    if (s < 1408) return 768 + (s - 1152);
    if (s < 1440) return s;
    if (s < 2464) return 1536 + (s - 1440);
    return 2560 + (s - 2464);
}
#ifndef BG_CONV
#define BG_CONV 1
#endif
constexpr int BG_I_M1 = 32 * 16 * 64, BG_I_M2 = 32 * 16 * 32, BG_TOTAL = BG_I_M1 + BG_I_M2;
struct BgConv { float r[32]; int item, it, ngw; bool pend; };
__device__ __forceinline__ void bg_decode(const P& p, int item, const float*& W, int& N, unsigned char*& WT, int& k0, int& n0, int& dst) {
    if (item < BG_I_M1) { const int e = item >> 10, q = item & 1023, kb = q >> 6, nb = q & 63; n0 = nb * 32; const int j = n0 & 1023, lin = n0 >> 10;
        dst = (j >> 7) * 256 + lin * 128 + (j & 127); W = p.w_m1 + (size_t)e * 1024 * 2048; N = 2048; WT = p.ws + WS_WT_M1 + (size_t)e * 2048 * 1024; k0 = kb * 64; }
    else { const int r = item - BG_I_M1, e = r >> 9, q = r & 511, kb = q >> 5, nb = q & 31; n0 = nb * 32; dst = n0;
        W = p.w_m2 + (size_t)e * 1024 * 1024; N = 1024; WT = p.ws + WS_WT_M2 + (size_t)e * 1024 * 1024; k0 = kb * 64; }
}
__device__ __forceinline__ void bg_issue(const P& p, BgConv& g, int lane) {
    const float* W; int N, k0, n0, dst; unsigned char* WT; bg_decode(p, g.item, W, N, WT, k0, n0, dst);
    const float* src = W + (size_t)(k0 + (lane >> 5)) * N + n0 + (lane & 31);
#pragma unroll
    for (int i = 0; i < 32; ++i) g.r[i] = __builtin_nontemporal_load(src + (size_t)(2 * i) * N);
}
__device__ __forceinline__ void bg_finish(const P& p, BgConv& g, float* scr, int lane) {
    const float* W; int N, k0, n0, dst; unsigned char* WT; bg_decode(p, g.item, W, N, WT, k0, n0, dst);
    unsigned w[8];
#pragma unroll
    for (int i = 0; i < 16; i += 2) {
        const auto s0 = __builtin_amdgcn_permlane32_swap(__float_as_uint(g.r[i] * W8_SCALE), __float_as_uint(g.r[i + 16] * W8_SCALE), false, false);
        const auto s1 = __builtin_amdgcn_permlane32_swap(__float_as_uint(g.r[i + 1] * W8_SCALE), __float_as_uint(g.r[i + 17] * W8_SCALE), false, false);
        w[i >> 1] = pk4_fp8(__uint_as_float(s0[0]), __uint_as_float(s0[1]), __uint_as_float(s1[0]), __uint_as_float(s1[1]));
    }
    unsigned char* o = WT + (size_t)(dst + (lane & 31)) * 1024 + k0 + 32 * (lane >> 5);
    __builtin_nontemporal_store((u32x4){w[0], w[1], w[2], w[3]}, (u32x4*)o); __builtin_nontemporal_store((u32x4){w[4], w[5], w[6], w[7]}, (u32x4*)(o + 16));
}
__device__ __forceinline__ void bg_step(const P& p, BgConv& g, float* scr, int lane) {
    if ((g.it & 3) == 2 && g.pend) { bg_finish(p, g, scr, lane); g.item += g.ngw; g.pend = false; }
    if ((g.it & 3) == 0 && g.item < BG_TOTAL) { bg_issue(p, g, lane); g.pend = true; }
    ++g.it;
}
__device__ __forceinline__ void bg_step_fin(const P& p, BgConv& g, int lane) { if ((g.it & 3) == 2 && g.pend) { bg_finish(p, g, nullptr, lane); g.item += g.ngw; g.pend = false; } }
__device__ __forceinline__ void bg_step_iss(const P& p, BgConv& g, int lane) { if ((g.it & 3) == 0 && g.item < BG_TOTAL) { bg_issue(p, g, lane); g.pend = true; } ++g.it; }
__device__ __forceinline__ void bg_drain(const P& p, BgConv& g, float* scr, int lane) {
    if (g.pend) { bg_finish(p, g, scr, lane); g.item += g.ngw; g.pend = false; }
    while (g.item < BG_TOTAL) { bg_issue(p, g, lane); bg_finish(p, g, scr, lane); g.item += g.ngw; }
}
__device__ __forceinline__ void ph_convert(const P& p, unsigned char* lds) {
    const int tid = threadIdx.x, lane = tid & 63, wave = tid >> 6;
    const int gw = blockIdx.x * 8 + wave, NGW = gridDim.x * 8;
    float* scr = (float*)(lds + wave * 8704);
    bf16_t* WT_IN = (bf16_t*)(p.ws + WS_WT_IN); bf16_t* WT_UQ = (bf16_t*)(p.ws + WS_WT_UQ); bf16_t* WT_UKV = (bf16_t*)(p.ws + WS_WT_UKV);
    bf16_t* WT_A = (bf16_t*)(p.ws + WS_WT_A); bf16_t* WT_B = (bf16_t*)(p.ws + WS_WT_B); bf16_t* WT_OUT = (bf16_t*)(p.ws + WS_WT_OUT);
    bf16_t* WT_M1 = (bf16_t*)(p.ws + WS_WT_M1); bf16_t* WT_M2 = (bf16_t*)(p.ws + WS_WT_M2);
    constexpr int I_IN = 16 * 109, I_UQ = 6 * 24, I_UK = 4 * 16, I_A = 8 * 32, I_OUT = 16 * 32, I_M1 = 32 * 16 * 64, I_M2 = 32 * 16 * 32;
    constexpr int TOTAL = I_IN + I_UQ + 2 * I_UK + 2 * I_A + I_OUT + (BG_CONV ? 0 : I_M1 + I_M2);
    for (int it = gw; it < TOTAL; it += NGW) {
        int r = it;
        if (r < I_IN) { const int kb = r / 109, nb = r % 109;
            if (nb * 32 < 1440) transpose_item(p.w_in, 3488, 1024, WT_IN, kb * 64, nb * 32, in_colmap(nb * 32), nullptr, scr, lane, nb * 32 == 1408);
            else transpose_item_fp8(p.w_in, 3488, 1024, p.ws + WS_WT_G8, kb * 64, nb * 32, nb * 32 - 1440, scr, lane);
            continue; } r -= I_IN;
        if (r < I_UQ) { const int kb = r / 24, nb = r % 24; const int n0 = nb * 32, hh = n0 / 96, d = n0 % 96;
            const int dst = d < 64 ? hh * 64 + d : 512 + hh * 32; transpose_item(p.w_uq, 768, 384, WT_UQ, kb * 64, n0, dst, p.q_norm, scr, lane, d >= 64); continue; } r -= I_UQ;
        if (r < I_UK) { const int kb = r / 16, nb = r % 16; transpose_item(p.w_uk, 512, 256, WT_UKV, kb * 64, nb * 32, nb * 32, p.kv_norm, scr, lane); continue; } r -= I_UK;
        if (r < I_UK) { const int kb = r / 16, nb = r % 16; transpose_item(p.w_uv, 512, 256, WT_UKV, kb * 64, nb * 32, 512 + nb * 32, p.kv_norm, scr, lane); continue; } r -= I_UK;
        if (r < I_A) { const int kb = r / 32, nb = r % 32; transpose_item(p.w_a, 1024, 1024, WT_A, kb * 64, nb * 32, nb * 32, nullptr, scr, lane); continue; } r -= I_A;
        if (r < I_A) { const int kb = r / 32, nb = r % 32; transpose_item(p.w_b, 1024, 1024, WT_A + 512, kb * 64, nb * 32, nb * 32, nullptr, scr, lane); continue; } r -= I_A;
        if (r < I_OUT) { const int kb = r / 32, nb = r % 32; transpose_item_fp8(p.w_out, 1024, 1024, (unsigned char*)WT_OUT, kb * 64, nb * 32, nb * 32, scr, lane); continue; } r -= I_OUT;
        if (r < I_M1) { const int e = r / 1024, q = r % 1024, kb = q / 64, nb = q % 64; const int n0 = nb * 32, j = n0 & 1023, lin = n0 >> 10;
            const int dst = (j >> 7) * 256 + lin * 128 + (j & 127);
            transpose_item_fp8(p.w_m1 + (size_t)e * 1024 * 2048, 2048, 1024, (unsigned char*)WT_M1 + (size_t)e * 2048 * 1024, kb * 64, n0, dst, scr, lane); continue; } r -= I_M1;
        { const int e = r / 512, q = r % 512, kb = q / 32, nb = q % 32;
            transpose_item_fp8(p.w_m2 + (size_t)e * 1024 * 1024, 1024, 1024, (unsigned char*)WT_M2 + (size_t)e * 1024 * 1024, kb * 64, nb * 32, nb * 32, scr, lane); }
    }
    for (int i = blockIdx.x * NTHREADS + tid; i < 1024 * 32; i += gridDim.x * NTHREADS) { const int k = i >> 5, e = i & 31; ((float*)(p.ws + WS_WRT))[e * 1028 + k] = p.w_router[i]; }
    for (int i = blockIdx.x * NTHREADS + tid; i < 96 * 128; i += gridDim.x * NTHREADS) ((u32x4*)(WT_IN + (size_t)1440 * 1024))[i] = (u32x4){0u, 0u, 0u, 0u};
}

__device__ __forceinline__ void ph_xn(const P& p) {
    const int tid = threadIdx.x, lane = tid & 63, wave = tid >> 6;
    const int gw = blockIdx.x * 8 + wave, NGW = gridDim.x * 8;
    const float* mod = (const float*)(p.ws + WS_MOD);
    bf16_t* XN = (bf16_t*)(p.ws + WS_XN); float* COS = (float*)(p.ws + WS_COS); float* SIN = (float*)(p.ws + WS_SIN);
    for (int m = gw; m < MTOK; m += NGW) {
        const int b = m >> 13;
        const f32x4* xr = (const f32x4*)(p.x + (size_t)m * DM);
        f32x4 v[4]; float s = 0.f;
#pragma unroll
        for (int j = 0; j < 4; ++j) { v[j] = xr[lane + 64 * j]; s += v[j].x * v[j].x + v[j].y * v[j].y + v[j].z * v[j].z + v[j].w * v[j].w; }
        s = wave_sum(s);
        const float rstd = rsqrtf(s * (1.f / DM) + EPS);
#pragma unroll
        for (int j = 0; j < 4; ++j) { const int col = 4 * lane + 256 * j;
            const f32x4 g = *(const f32x4*)(p.norm_mix + col), sc = *(const f32x4*)(mod + b * 6144 + 1024 + col), sh = *(const f32x4*)(mod + b * 6144 + col);
            const f32x4 h = v[j] * rstd * g * (sc + 1.0f) + sh;
            u32x2 o; o.x = pk2(h.x, h.y); o.y = pk2(h.z, h.w); *(u32x2*)(XN + (size_t)m * DM + col) = o;
            *(unsigned*)(p.ws + WS_XN8 + (size_t)m * DM + col) = pk4_fp8(h.x, h.y, h.z, h.w); }
        if (lane < 16) {
            const float freq = exp2f(-(float)lane * 0.8304820237218406f);
            const float ang = (float)p.pos[m] * freq;
            double t = (double)ang * 0.15915494309189535; t -= rint(t);
            const float fr = (float)t;
            COS[m * 16 + lane] = __builtin_amdgcn_cosf(fr); SIN[m * 16 + lane] = __builtin_amdgcn_sinf(fr);
        }
    }
}

namespace pg8 {
#define PG8_LAS __attribute__((address_space(3)))
constexpr int BM = 256, BK = 64, HALF = 128, HTB = HALF * BK * 2, STAGE_BYTES = 8 * HTB, NXCD = 8, WGM = 8;
__device__ __forceinline__ int lds_byte(int r, int c) { const int st = (r >> 4) * 2 + (c >> 5), rr = r & 15, cc = c & 31, ob = rr * 64 + cc * 2; return st * 1024 + (ob ^ (((ob >> 9) & 1) << 5)); }
__device__ __forceinline__ void stage_rc(int b, int& R, int& C) { const int st = b / 1024, sb = b % 1024, swz = sb ^ (((sb >> 9) & 1) << 5); R = (st >> 1) * 16 + swz / 64; C = (st & 1) * 32 + (swz % 64) / 2; }
__device__ __forceinline__ int perm32(int rho) { const int n = rho >> 4, i = rho & 15; return 8 * (i >> 2) + 4 * n + (i & 3); }
struct GUnit { const char* a; const char* b; int pm, pn, e, cnt, tile, pad_; };
typedef float f32x2_t __attribute__((ext_vector_type(2))); typedef __bf16 bf16x2_t __attribute__((ext_vector_type(2)));
__device__ __forceinline__ unsigned cvt_pk_bf16(float lo, float hi) { f32x2_t v = {lo, hi}; bf16x2_t b = __builtin_convertvector(v, bf16x2_t); return __builtin_bit_cast(unsigned, b); }

struct DenseOrder {
    const char* A; const char* Bt; int K, nM, nN, nwg, G, c;
    __device__ void init(const void* A_, const void* Bt_, int M, int N, int K_, int G_, int c_) { A = (const char*)A_; Bt = (const char*)Bt_; K = K_; nM = M / BM; nN = N / BM; nwg = nM * nN; G = G_; c = c_; }
    __device__ bool next(int i, GUnit& u) const {
        const long L = (long)i * G + c; if (L >= nwg) return false;
        int wgid = (int)L; { const int q = nwg / NXCD, r = nwg % NXCD, xcd = wgid % NXCD, off = wgid / NXCD; wgid = (xcd < r ? xcd * (q + 1) : r * (q + 1) + (xcd - r) * q) + off; }
        const int nig = WGM * nN, gid = wgid / nig, fm = gid * WGM, gsz = (nM - fm) < WGM ? (nM - fm) : WGM;
        u.pm = fm + ((wgid % nig) % gsz); u.pn = (wgid % nig) / gsz; u.e = 0; u.cnt = 0; u.tile = 0; u.pad_ = 0;
        u.a = A + (size_t)u.pm * BM * K * 2; u.b = Bt + (size_t)u.pn * BM * K * 2; return true;
    }
    __device__ __forceinline__ unsigned a_rowoff(const GUnit&, int) const { return 0u; }
};

typedef int v8i32 __attribute__((ext_vector_type(8)));
typedef int v4i32 __attribute__((ext_vector_type(4)));
template <class Epi, class Sched, bool ALIGN_EPI, bool GATHER, bool FP8 = false>
__device__ __forceinline__ void gemm_phase(PG8_LAS unsigned char* lds, const int K, const Sched& S, const Epi& E) {
    int tid_ = threadIdx.x; asm volatile("" : "+v"(tid_));
    const int tid = tid_, wid = __builtin_amdgcn_readfirstlane(tid >> 6), lane = tid & 63, wr = wid >> 2, wc = wid & 3, fr = lane & 15, fq = lane >> 4;
    const int nt = K / BK;
    int RA[2]; unsigned CA[2], voffB[2];
#pragma unroll
    for (int i = 0; i < 2; ++i) { int R, C; stage_rc(tid * 16 + i * 8192, R, C); const int Rb = Epi::PERM ? ((R & ~31) + perm32(R & 31)) : R;
        RA[i] = R; CA[i] = (unsigned)C * 2u; voffB[i] = (unsigned)(Rb * K + C) * 2u; }
    const size_t kstep = (size_t)(BK * 2);
    const size_t hstep = (size_t)HALF * K * 2;
    const unsigned ldsw = (unsigned)wid * 1024u;
    const int aoff = lds_byte(wr * 64 + fr, FP8 ? fq * 16 : fq * 8), boff = lds_byte(wc * 32 + fr, FP8 ? fq * 16 : fq * 8);
#define PG8_SA(b, h) (((b) * 2 + (h)) * HTB)
#define PG8_SB(b, h) ((4 + (b) * 2 + (h)) * HTB)
#define PG8_STAGE(bufoff, gbase, voff) do { _Pragma("unroll") for (int _i = 0; _i < 2; ++_i) { unsigned o_ = (voff)[_i]; asm volatile("" : "+v"(o_));     \
        __builtin_amdgcn_global_load_lds((const unsigned*)((const char*)(gbase) + o_), (PG8_LAS unsigned*)(lds + (bufoff) + ldsw + _i * 8192), 16, 0, 0); } } while (0)
#define PG8_LD16(p) (*(const PG8_LAS v4i32*)(p))
#define PG8_LDA(dst, b, h) do { if constexpr (FP8) { _Pragma("unroll") for (int m = 0; m < 4; ++m) { const PG8_LAS unsigned char* p_ = lds + PG8_SA(b, h) + aoff + m * 2048; \
            dst##8[m] = __builtin_shufflevector(PG8_LD16(p_), PG8_LD16(p_ + 16), 0, 1, 2, 3, 4, 5, 6, 7); } } \
        else { _Pragma("unroll") for (int m = 0; m < 4; ++m) _Pragma("unroll") for (int k = 0; k < 2; ++k) dst[m][k] = *(const PG8_LAS bf16x8*)(lds + PG8_SA(b, h) + aoff + m * 2048 + k * 1024); } } while (0)
#define PG8_LDB(dst, b, h) do { if constexpr (FP8) { _Pragma("unroll") for (int n = 0; n < 2; ++n) { const PG8_LAS unsigned char* p_ = lds + PG8_SB(b, h) + boff + n * 2048; \
            dst##8[n] = __builtin_shufflevector(PG8_LD16(p_), PG8_LD16(p_ + 16), 0, 1, 2, 3, 4, 5, 6, 7); } } \
        else { _Pragma("unroll") for (int n = 0; n < 2; ++n) _Pragma("unroll") for (int k = 0; k < 2; ++k) dst[n][k] = *(const PG8_LAS bf16x8*)(lds + PG8_SB(b, h) + boff + n * 2048 + k * 1024); } } while (0)
#define PG8_MMA(ai, bj, At, Bt) do { __builtin_amdgcn_s_setprio(1); \
        if constexpr (FP8) { _Pragma("unroll") for (int m = 0; m < 4; ++m) _Pragma("unroll") for (int n = 0; n < 2; ++n) \
                asm volatile("v_mfma_scale_f32_16x16x128_f8f6f4 %0, %1, %2, %0, %3, %3 op_sel_hi:[0,0,0]" : "+v"(acc[ai][bj][m][n]) : "v"(Bt##8[n]), "v"(At##8[m]), "v"(scl8)); } \
        else { _Pragma("unroll") for (int m = 0; m < 4; ++m) _Pragma("unroll") for (int n = 0; n < 2; ++n) _Pragma("unroll") for (int k = 0; k < 2; ++k) \
                acc[ai][bj][m][n] = __builtin_amdgcn_mfma_f32_16x16x32_bf16(Bt[n][k], At[m][k], acc[ai][bj][m][n], 0, 0, 0); } \
        __builtin_amdgcn_s_setprio(0); } while (0)
#define PG8_WAIT_V(n) asm volatile("s_waitcnt vmcnt(" #n ")" ::: "memory")
#define PG8_WAIT_L(n) asm volatile("s_waitcnt lgkmcnt(" #n ")" ::: "memory")
#define PG8_BAR __builtin_amdgcn_s_barrier()
#define PG8_SCHED __builtin_amdgcn_sched_barrier(0)
#define PG8_VOFF(u, v) do { _Pragma("unroll") for (int _i = 0; _i < 2; ++_i) { int r_ = RA[_i]; if (GATHER) asm volatile("" : "+v"(r_));     \
        _Pragma("unroll") for (int _h = 0; _h < 2; ++_h) v[_h][_i] = GATHER ? (S.a_rowoff(u, _h * HALF + r_) + CA[_i]) : ((unsigned)((_h * HALF + r_) * K) * 2u + CA[_i]); } } while (0)
    GUnit cur, nxt; int ui = 0;
    if (!S.next(0, cur)) return;
    f32x4 acc[2][2][4][2];
#pragma unroll
    for (int a = 0; a < 2; ++a)
#pragma unroll
        for (int b = 0; b < 2; ++b)
#pragma unroll
            for (int m = 0; m < 4; ++m)
#pragma unroll
                for (int n = 0; n < 2; ++n) acc[a][b][m][n] = (f32x4){0.f, 0.f, 0.f, 0.f};
    bf16x8 At[4][2], B0[2][2], B1[2][2];
    v8i32 At8[4], B08[2], B18[2];
    const int scl8 = 0x7f7f7f7f;
    unsigned vAc[2][2], vAn[2][2];
    PG8_VOFF(cur, vAc);
    if (GATHER) { asm volatile("s_waitcnt vmcnt(0)" : "+v"(vAc[0][0]), "+v"(vAc[0][1]), "+v"(vAc[1][0]), "+v"(vAc[1][1]) :: "memory"); }
    const char* cA = cur.a; const char* cB = cur.b;
    PG8_STAGE(PG8_SB(0, 0), cB, voffB); PG8_STAGE(PG8_SB(0, 1), cB + hstep, voffB); PG8_STAGE(PG8_SA(0, 0), cA, vAc[0]); PG8_STAGE(PG8_SA(0, 1), cA, vAc[1]);
    if (wr == 1) PG8_BAR;
    PG8_WAIT_V(2); PG8_BAR;
    PG8_STAGE(PG8_SB(1, 0), cB + kstep, voffB); PG8_STAGE(PG8_SA(1, 0), cA + kstep, vAc[0]); PG8_STAGE(PG8_SB(1, 1), cB + hstep + kstep, voffB);
    PG8_WAIT_V(6); PG8_BAR;
    for (;;) {
        const bool has_next = S.next(ui + 1, nxt);
        const char* nA = has_next ? nxt.a : cA; const char* nB = has_next ? nxt.b : cB;
        if (GATHER) {
            if (has_next) { PG8_VOFF(nxt, vAn); }
            else {
#pragma unroll
                for (int h = 0; h < 2; ++h)
#pragma unroll
                    for (int i = 0; i < 2; ++i) vAn[h][i] = vAc[h][i]; }
            asm volatile("s_waitcnt vmcnt(0)" : "+v"(vAn[0][0]), "+v"(vAn[0][1]), "+v"(vAn[1][0]), "+v"(vAn[1][1]) :: "memory");
        }
#pragma unroll 1
        for (int t = 0; t < nt; t += 2) {
            const bool last = (t == nt - 2);
            if constexpr (Epi::HAS_MID) { if (t == (nt >> 1)) { int t_ = threadIdx.x; asm volatile("" : "+v"(t_)); E.mid(acc, cur, wr, wc, t_ & 15, (t_ >> 4) & 3); } }
            const char* a1 = cA + (size_t)(t + 1) * kstep;
            const char* a2 = last ? nA : cA + (size_t)(t + 2) * kstep; const char* b2 = last ? nB : cB + (size_t)(t + 2) * kstep;
            const char* a3 = a2 + kstep; const char* b3 = b2 + kstep;
            unsigned v2[2][2];
#pragma unroll
            for (int h = 0; h < 2; ++h)
#pragma unroll
                for (int i = 0; i < 2; ++i) v2[h][i] = (GATHER && last) ? vAn[h][i] : vAc[h][i];
            PG8_LDB(B0, 0, 0); PG8_LDB(B1, 0, 1); PG8_SCHED; PG8_LDA(At, 0, 0); PG8_STAGE(PG8_SA(1, 1), a1, vAc[1]);
            PG8_WAIT_V(8); PG8_WAIT_L(0); PG8_BAR; PG8_MMA(0, 0, At, B0); PG8_MMA(0, 1, At, B1); PG8_BAR; PG8_SCHED;
            PG8_LDA(At, 0, 1); PG8_STAGE(PG8_SB(0, 0), b2, voffB); PG8_STAGE(PG8_SB(0, 1), b2 + hstep, voffB); PG8_STAGE(PG8_SA(0, 0), a2, v2[0]);
            PG8_WAIT_V(8); PG8_WAIT_L(0); PG8_BAR; PG8_MMA(1, 0, At, B0); PG8_MMA(1, 1, At, B1); PG8_BAR; PG8_SCHED;
            PG8_LDB(B0, 1, 0); PG8_LDB(B1, 1, 1); PG8_SCHED; PG8_LDA(At, 1, 0); PG8_STAGE(PG8_SA(0, 1), a2, v2[1]);
            PG8_WAIT_V(8); PG8_WAIT_L(0); PG8_BAR; PG8_MMA(0, 0, At, B0); PG8_MMA(0, 1, At, B1); PG8_BAR; PG8_SCHED;
            PG8_LDA(At, 1, 1); PG8_STAGE(PG8_SB(1, 0), b3, voffB); PG8_STAGE(PG8_SB(1, 1), b3 + hstep, voffB); PG8_STAGE(PG8_SA(1, 0), a3, v2[0]);
            PG8_WAIT_V(8); PG8_WAIT_L(0); PG8_BAR; PG8_MMA(1, 0, At, B0); PG8_MMA(1, 1, At, B1); PG8_BAR; PG8_SCHED;
        }
        if constexpr (FP8) {
            asm volatile("s_nop 15\n\ts_nop 15" ::: "memory");
#pragma unroll
            for (int a = 0; a < 2; ++a)
#pragma unroll
                for (int b = 0; b < 2; ++b)
#pragma unroll
                    for (int m = 0; m < 4; ++m) asm volatile("" : "+v"(acc[a][b][m][0]), "+v"(acc[a][b][m][1]));
        }
        if constexpr (ALIGN_EPI) { if (wr == 0) PG8_BAR; }
        { int t_ = threadIdx.x; asm volatile("" : "+v"(t_));
          E(acc, cur, wr, wc, t_ & 15, (t_ >> 4) & 3); }
        if (!has_next) break;
#pragma unroll
        for (int a = 0; a < 2; ++a)
#pragma unroll
            for (int b = 0; b < 2; ++b)
#pragma unroll
                for (int m = 0; m < 4; ++m)
#pragma unroll
                    for (int n = 0; n < 2; ++n) acc[a][b][m][n] = (f32x4){0.f, 0.f, 0.f, 0.f};
        cur = nxt; cA = nA; cB = nB; ++ui;
#pragma unroll
        for (int h = 0; h < 2; ++h)
#pragma unroll
            for (int i = 0; i < 2; ++i) vAc[h][i] = vAn[h][i];
        if constexpr (ALIGN_EPI) { if (wr == 1) PG8_BAR; }
    }
    PG8_WAIT_V(0);
    if constexpr (!ALIGN_EPI) { if (wr == 0) PG8_BAR; }
    PG8_BAR;
#undef PG8_SA
#undef PG8_SB
#undef PG8_STAGE
#undef PG8_LDA
#undef PG8_LDB
#undef PG8_MMA
#undef PG8_LD16
#undef PG8_WAIT_V
#undef PG8_WAIT_L
#undef PG8_BAR
#undef PG8_SCHED
#undef PG8_VOFF
}
}
#define LAS __attribute__((address_space(3)))
__device__ __forceinline__ u32x4 pack8(const f32x4& v0, const f32x4& v1) { u32x4 w; w.x = pg8::cvt_pk_bf16(v0[0], v0[1]); w.y = pg8::cvt_pk_bf16(v0[2], v0[3]); w.z = pg8::cvt_pk_bf16(v1[0], v1[1]); w.w = pg8::cvt_pk_bf16(v1[2], v1[3]); return w; }
__device__ __forceinline__ void unpack8(const u32x4& w, f32x4& v0, f32x4& v1) { v0 = (f32x4){bf2f(w.x & 0xffffu), bf2f(w.x >> 16), bf2f(w.y & 0xffffu), bf2f(w.y >> 16)}; v1 = (f32x4){bf2f(w.z & 0xffffu), bf2f(w.z >> 16), bf2f(w.w & 0xffffu), bf2f(w.w >> 16)}; }
__device__ __forceinline__ float sigs_(float a) { return __builtin_amdgcn_rcpf(1.f + __builtin_amdgcn_exp2f(a * (-LOG2E * W8_INV))); }
__device__ __forceinline__ f32x4 sig4s(const f32x4& v) { return (f32x4){sigs_(v[0]), sigs_(v[1]), sigs_(v[2]), sigs_(v[3])}; }
__device__ __forceinline__ f32x4 sig4(const f32x4& v) { return (f32x4){sigmoidf_(v[0]), sigmoidf_(v[1]), sigmoidf_(v[2]), sigmoidf_(v[3])}; }

struct EpiProj {
    static constexpr bool PERM = true, HAS_MID = false;
    unsigned char* ws;
    __device__ __forceinline__ void operator()(const f32x4 (&acc)[2][2][4][2], const pg8::GUnit& u, int wr, int wc, int fr, int fq) const {
        const int row0 = u.pm * 256 + wr * 64 + fr;
#pragma unroll
        for (int bj = 0; bj < 2; ++bj) {
            const int cl = bj * 128 + wc * 32 + 8 * fq;
            bf16_t* base; int ld, c; float sc = 1.f; bool sg = false;
            const int pn = u.pn;
            if (pn < 2) { base = (bf16_t*)(ws + WS_QA); ld = 512; c = pn * 256 + cl; sc = 0.125f * LOG2E; }
            else if (pn == 2) { base = (bf16_t*)(ws + (bj == 0 ? WS_KA : WS_VA)); ld = 128; c = wc * 32 + 8 * fq; }
            else if (pn == 3) { base = (bf16_t*)(ws + WS_CKV); ld = 256; c = cl; }
            else if (pn == 4) { base = (bf16_t*)(ws + WS_CQ); ld = 384; c = cl; }
            else if (pn == 5) { if (bj == 0) { base = (bf16_t*)(ws + WS_CQ); ld = 384; c = 256 + wc * 32 + 8 * fq; } else { if (wc != 0) continue; base = (bf16_t*)(ws + WS_KR); ld = 32; c = 8 * fq; } }
            else if (pn < 10) { base = (bf16_t*)(ws + WS_GA); ld = 1024; c = (pn - 6) * 256 + cl; sg = true; }
            else { base = (bf16_t*)(ws + WS_GB); ld = 1024; c = (pn - 10) * 256 + cl; sg = true; }
            const bool is_kr = pn == 5 && bj == 1;
#pragma unroll
            for (int ai = 0; ai < 2; ++ai)
#pragma unroll
                for (int m = 0; m < 4; ++m) { f32x4 v0 = acc[ai][bj][m][0], v1 = acc[ai][bj][m][1]; const int row = row0 + ai * 128 + m * 16;
                    if (is_kr) { const f32x4 cs = *(const f32x4*)((const float*)(ws + WS_COS) + row * 16 + 4 * fq), sn = *(const f32x4*)((const float*)(ws + WS_SIN) + row * 16 + 4 * fq);
                        const f32x4 o1 = v0 * cs - v1 * sn, o2 = v1 * cs + v0 * sn; v0 = o1; v1 = o2; }
                    else if (sg) { v0 = sig4(v0); v1 = sig4(v1); } else { v0 = v0 * sc; v1 = v1 * sc; }
                    *(u32x4*)(base + (size_t)row * ld + c) = pack8(v0, v1); }
        }
        if (u.pn >= 3 && u.pn <= 5) {
            float* SSQ = (float*)(ws + WS_SSQ);
#pragma unroll
            for (int ai = 0; ai < 2; ++ai)
#pragma unroll
                for (int m = 0; m < 4; ++m) { float q = 0.f;
#pragma unroll
                    for (int bj = 0; bj < 2; ++bj) { if (u.pn == 5 && bj == 1) continue;
#pragma unroll
                        for (int n = 0; n < 2; ++n) { const f32x4 v = acc[ai][bj][m][n]; q += (v[0] * v[0] + v[1] * v[1]) + (v[2] * v[2] + v[3] * v[3]); } }
                    q += __shfl_xor(q, 16); q += __shfl_xor(q, 32);
                    const int slot = u.pn == 3 ? 8 + wc : u.pn == 4 ? wc : 4 + wc;
                    if (fq == 0) SSQ[slot * MTOK + row0 + ai * 128 + m * 16] = q; }
        }
    }
};
struct EpiUpQ {
    static constexpr bool PERM = true, HAS_MID = false;
    unsigned char* ws;
    __device__ __forceinline__ void operator()(const f32x4 (&acc)[2][2][4][2], const pg8::GUnit& u, int wr, int wc, int fr, int fq) const {
        const float qs0 = 0.10206207261596577f * LOG2E;
        const int row0 = u.pm * 256 + wr * 64 + fr;
        const float* COS = (const float*)(ws + WS_COS); const float* SIN = (const float*)(ws + WS_SIN); const float* SSQ = (const float*)(ws + WS_SSQ);
        float rq[2][4];
#pragma unroll
        for (int ai = 0; ai < 2; ++ai)
#pragma unroll
            for (int m = 0; m < 4; ++m) { const int row = row0 + ai * 128 + m * 16; float q = 0.f;
#pragma unroll
                for (int sl = 0; sl < 8; ++sl) q += SSQ[sl * MTOK + row];
                rq[ai][m] = rsqrtf(q * (1.f / 384.f) + EPS); }
#pragma unroll
        for (int bj = 0; bj < 2; ++bj) { const int cl = bj * 128 + wc * 32 + 8 * fq;
#pragma unroll
            for (int ai = 0; ai < 2; ++ai)
#pragma unroll
                for (int m = 0; m < 4; ++m) { const int row = row0 + ai * 128 + m * 16; f32x4 v0 = acc[ai][bj][m][0], v1 = acc[ai][bj][m][1];
                    const float qs = qs0 * rq[ai][m];
                    if (u.pn < 2) { *(u32x4*)((bf16_t*)(ws + WS_QN) + (size_t)row * 512 + u.pn * 256 + cl) = pack8(v0 * qs, v1 * qs); }
                    else { const f32x4 cs = *(const f32x4*)(COS + row * 16 + 4 * fq), sn = *(const f32x4*)(SIN + row * 16 + 4 * fq);
                        const f32x4 o1 = (v0 * cs - v1 * sn) * qs, o2 = (v1 * cs + v0 * sn) * qs;
                        *(u32x4*)((bf16_t*)(ws + WS_QR) + (size_t)row * 256 + cl) = pack8(o1, o2); }
                    asm volatile("" ::: "memory"); }
        }
    }
};
struct EpiUpKV {
    static constexpr bool PERM = true, HAS_MID = false;
    unsigned char* ws;
    __device__ __forceinline__ void operator()(const f32x4 (&acc)[2][2][4][2], const pg8::GUnit& u, int wr, int wc, int fr, int fq) const {
        const int row0 = u.pm * 256 + wr * 64 + fr;
        bf16_t* base = (bf16_t*)(ws + (u.pn < 2 ? WS_KN : WS_VB)); const float* SSQ = (const float*)(ws + WS_SSQ);
        float rk[2][4];
#pragma unroll
        for (int ai = 0; ai < 2; ++ai)
#pragma unroll
            for (int m = 0; m < 4; ++m) { const int row = row0 + ai * 128 + m * 16;
                const float q = (SSQ[8 * MTOK + row] + SSQ[9 * MTOK + row]) + (SSQ[10 * MTOK + row] + SSQ[11 * MTOK + row]);
                rk[ai][m] = rsqrtf(q * (1.f / 256.f) + EPS); }
#pragma unroll
        for (int bj = 0; bj < 2; ++bj) { const int c = (u.pn & 1) * 256 + bj * 128 + wc * 32 + 8 * fq;
#pragma unroll
            for (int ai = 0; ai < 2; ++ai)
#pragma unroll
                for (int m = 0; m < 4; ++m) *(u32x4*)(base + (size_t)(row0 + ai * 128 + m * 16) * 512 + c) = pack8(acc[ai][bj][m][0] * rk[ai][m], acc[ai][bj][m][1] * rk[ai][m]); }
    }
};
struct EpiMixF {
    static constexpr bool PERM = true, HAS_MID = true;
    unsigned char* ws;
    __device__ __forceinline__ void mid(f32x4 (&acc)[2][2][4][2], const pg8::GUnit& u, int wr, int wc, int fr, int fq) const {
        const int row0 = u.pm * 256 + wr * 64 + fr;
        const bf16_t* GA = (const bf16_t*)(ws + WS_GA); const bf16_t* GB = (const bf16_t*)(ws + WS_GB);
#pragma unroll
        for (int bj = 0; bj < 2; ++bj) { const int c = u.pn * 256 + bj * 128 + wc * 32 + 8 * fq;
#pragma unroll
            for (int ai = 0; ai < 2; ++ai)
#pragma unroll
                for (int m = 0; m < 4; ++m) { const size_t idx = (size_t)(row0 + ai * 128 + m * 16) * 1024 + c;
                    f32x4 a0, a1, b0, b1; unpack8(*(const u32x4*)(GA + idx), a0, a1); unpack8(*(const u32x4*)(GB + idx), b0, b1);
#pragma unroll
                    for (int i = 0; i < 4; ++i) { acc[ai][bj][m][0][i] *= a0[i] * __builtin_amdgcn_rcpf(fmaxf(b0[i], 1e-30f)); acc[ai][bj][m][1][i] *= a1[i] * __builtin_amdgcn_rcpf(fmaxf(b1[i], 1e-30f)); }
                    if (m == 3) asm volatile("" ::: "memory"); } }
    }
    __device__ __forceinline__ void operator()(const f32x4 (&acc)[2][2][4][2], const pg8::GUnit& u, int wr, int wc, int fr, int fq) const {
        const int row0 = u.pm * 256 + wr * 64 + fr;
        const bf16_t* GB = (const bf16_t*)(ws + WS_GB); bf16_t* MIX = (bf16_t*)(ws + WS_MIX);
#pragma unroll
        for (int bj = 0; bj < 2; ++bj) { const int c = u.pn * 256 + bj * 128 + wc * 32 + 8 * fq;
#pragma unroll
            for (int ai = 0; ai < 2; ++ai)
#pragma unroll
                for (int m = 0; m < 4; ++m) { const size_t idx = (size_t)(row0 + ai * 128 + m * 16) * 1024 + c;
                    f32x4 g0, g1; unpack8(*(const u32x4*)(GB + idx), g0, g1);
                    const f32x4 y0 = g0 * acc[ai][bj][m][0] * MIX8_SCALE, y1 = g1 * acc[ai][bj][m][1] * MIX8_SCALE;
                    u32x2 o8; o8.x = pk4_fp8(y0[0], y0[1], y0[2], y0[3]); o8.y = pk4_fp8(y1[0], y1[1], y1[2], y1[3]);
                    *(u32x2*)((unsigned char*)MIX + idx) = o8; if (m & 1) asm volatile("" ::: "memory"); } }
    }
};
struct EpiOut {
    static constexpr bool PERM = true, HAS_MID = false;
    unsigned char* ws; const float* x;
    __device__ __forceinline__ void operator()(const f32x4 (&acc)[2][2][4][2], const pg8::GUnit& u, int wr, int wc, int fr, int fq) const {
        const int row0 = u.pm * 256 + wr * 64 + fr; const int b = (u.pm * 256) >> 13;
        const float* mod = (const float*)(ws + WS_MOD); bf16_t* X1 = (bf16_t*)(ws + WS_X1);
#pragma unroll
        for (int bj = 0; bj < 2; ++bj) { const int c = u.pn * 256 + bj * 128 + wc * 32 + 8 * fq;
            const f32x4 g0 = *(const f32x4*)(mod + b * 6144 + 2048 + c) * OUT8_INV, g1 = *(const f32x4*)(mod + b * 6144 + 2048 + c + 4) * OUT8_INV;
#pragma unroll
            for (int ai = 0; ai < 2; ++ai)
#pragma unroll
                for (int m = 0; m < 4; ++m) { const size_t idx = (size_t)(row0 + ai * 128 + m * 16) * 1024 + c;
                    const f32x4 x0 = *(const f32x4*)(x + idx), x1 = *(const f32x4*)(x + idx + 4);
                    *(u32x4*)(X1 + idx) = pack8(x0 + g0 * acc[ai][bj][m][0], x1 + g1 * acc[ai][bj][m][1]); if (m & 1) asm volatile("" ::: "memory"); } }
    }
};

constexpr int RT_LD = 1028;
__device__ __forceinline__ void ph_route(const P& p, unsigned char* lds, bool commit = true) {
    const int tid = threadIdx.x, lane = tid & 63, wave = tid >> 6, e = lane & 31, hf = lane >> 5;
    const int RPW = MTOK / gridDim.x;
    float* h2s = (float*)lds;
    unsigned* lcnt = (unsigned*)(lds + 132096); unsigned* lbase = lcnt + 32; unsigned* lent = lcnt + 64; float* lw = (float*)(lcnt + 64 + 256);
    float* lg = (float*)(lcnt + 64 + 512) + wave * 128 + hf * 64;
    if (tid < NEXP) lcnt[tid] = 0u;
    const float* mod = (const float*)(p.ws + WS_MOD); const bf16_t* X1 = (const bf16_t*)(p.ws + WS_X1); unsigned char* H2 = p.ws + WS_XN;
    unsigned* cnt = (unsigned*)(p.ws + WS_CTL); unsigned* LIST = (unsigned*)(p.ws + WS_LIST); float* LISTW = (float*)(p.ws + WS_LISTW);
    float wreg[64];
#pragma unroll
    for (int kk = 0; kk < 64; ++kk) wreg[kk] = p.w_router[(size_t)(128 * wave + 2 * kk + hf) * 32 + e];
    const float brt = p.b_router[e];
    for (int pass = 0; pass * 32 < RPW; ++pass) {
        u32x2 xw[4][4];
#pragma unroll
        for (int rr = 0; rr < 4; ++rr) { const u32x2* xr = (const u32x2*)(X1 + (size_t)(blockIdx.x * RPW + pass * 32 + 4 * wave + rr) * DM);
#pragma unroll
            for (int j = 0; j < 4; ++j) xw[rr][j] = xr[lane + 64 * j]; }
#pragma unroll
        for (int rr = 0; rr < 4; ++rr) {
            const int rl = 4 * wave + rr, m = blockIdx.x * RPW + pass * 32 + rl, b = m >> 13;
            f32x4 v[4]; float s = 0.f;
#pragma unroll
            for (int j = 0; j < 4; ++j) { const u32x2 w = xw[rr][j]; v[j] = (f32x4){bf2f(w.x & 0xffffu), bf2f(w.x >> 16), bf2f(w.y & 0xffffu), bf2f(w.y >> 16)};
                s += v[j].x * v[j].x + v[j].y * v[j].y + v[j].z * v[j].z + v[j].w * v[j].w; }
            s = wave_sum(s);
            const float rstd = rsqrtf(s * (1.f / DM) + EPS);
#pragma unroll
            for (int j = 0; j < 4; ++j) { const int col = 4 * lane + 256 * j;
                const f32x4 g = *(const f32x4*)(p.norm_ffn + col), sc = *(const f32x4*)(mod + b * 6144 + 4096 + col), sh = *(const f32x4*)(mod + b * 6144 + 3072 + col);
                v[j] = v[j] * rstd * g * (sc + 1.0f) + sh;
                *(unsigned*)(H2 + (size_t)m * DM + col) = pk4_fp8(v[j].x, v[j].y, v[j].z, v[j].w);
                *(f32x4*)(h2s + rl * RT_LD + col) = v[j]; }
        }
        __syncthreads();
        typedef float f32x16r __attribute__((ext_vector_type(16)));
        f32x16r acc;
#pragma unroll
        for (int r = 0; r < 16; ++r) acc[r] = 0.f;
        const float* ap = h2s + e * RT_LD + 128 * wave + hf;
#pragma unroll
        for (int kk = 0; kk < 64; ++kk) acc = __builtin_amdgcn_mfma_f32_32x32x2f32(ap[2 * kk], wreg[kk], acc, 0, 0, 0);
        __syncthreads();
#pragma unroll
        for (int r = 0; r < 16; ++r) h2s[(wave * 32 + ((r & 3) + 8 * (r >> 2) + 4 * hf)) * 32 + e] = acc[r];
        __syncthreads();
#pragma unroll 1
        for (int it = 0; it < 2; ++it) {
            const int rl = 4 * wave + 2 * it + hf, ri = pass * 32 + rl;
            float val = brt;
#pragma unroll
            for (int w8 = 0; w8 < 8; ++w8) val += h2s[(w8 * 32 + rl) * 32 + e];
            lg[e] = val;
            int rank = 0;
#pragma unroll
            for (int e4 = 0; e4 < 8; ++e4) { const f32x4 o = *(const f32x4*)(lg + 4 * e4);
#pragma unroll
                for (int i = 0; i < 4; ++i) { const int ee = 4 * e4 + i; rank += (o[i] > val || (o[i] == val && ee < e)) ? 1 : 0; } }
            if (rank < 4) { lg[32 + rank] = val; lg[36 + rank] = __int_as_float(e); }
            const f32x4 tvv = *(const f32x4*)(lg + 32), tiv = *(const f32x4*)(lg + 36);
            const float e1 = __expf(tvv[1] - tvv[0]), e2 = __expf(tvv[2] - tvv[0]), e3 = __expf(tvv[3] - tvv[0]);
            const float inv = 1.f / (1.f + e1 + e2 + e3);
            if (e < 4) {
                const int ex = __float_as_int(e == 0 ? tiv[0] : e == 1 ? tiv[1] : e == 2 ? tiv[2] : tiv[3]);
                const float w = (e == 0 ? 1.f : e == 1 ? e1 : e == 2 ? e2 : e3) * inv;
                const unsigned lr = atomicAdd(&lcnt[ex], 1u);
                lent[ri * 4 + e] = (unsigned)ex | (lr << 8); lw[ri * 4 + e] = w;
            }
        }
        __syncthreads();
    }
    if (!commit) return;
    if (tid < NEXP) lbase[tid] = atomicAdd(&cnt[tid * 64], lcnt[tid]);
    __syncthreads();
    for (int a = tid; a < RPW * 4; a += NTHREADS) {
        const unsigned en = lent[a]; const int ex = (int)(en & 255u); const unsigned pos = lbase[ex] + (en >> 8);
        LIST[(size_t)ex * LISTCAP + pos] = (unsigned)((blockIdx.x * RPW + (a >> 2)) * 4 + (a & 3));
        ((float*)(p.ws + WS_TOPW))[(size_t)blockIdx.x * RPW * 4 + a] = lw[a];
    }
}
__device__ __forceinline__ void ph_final(const P& p) {
    const int tid = threadIdx.x, lane = tid & 63, wave = tid >> 6;
    const int gw = blockIdx.x * 8 + wave, NGW = gridDim.x * 8;
    const float* mod = (const float*)(p.ws + WS_MOD); const bf16_t* X1 = (const bf16_t*)(p.ws + WS_X1); const unsigned char* Y = (const unsigned char*)(p.ws + WS_Y);
    for (int m = gw; m < MTOK; m += NGW) {
        const int b = m >> 13;
        const u32x2* xr = (const u32x2*)(X1 + (size_t)m * DM);
        f32x4 v[4]; float s = 0.f;
        const f32x4 tw = *(const f32x4*)((const float*)(p.ws + WS_TOPW) + (size_t)m * 4);
#pragma unroll
        for (int j = 0; j < 4; ++j) { const int col = 4 * lane + 256 * j;
            f32x4 y = (f32x4){0.f, 0.f, 0.f, 0.f};
#pragma unroll
            for (int k = 0; k < 4; ++k) { const int w = (int)__builtin_nontemporal_load((const unsigned*)(Y + ((size_t)m * 4 + k) * 1024 + col));
                y.x += tw[k] * __builtin_amdgcn_cvt_f32_fp8(w, 0); y.y += tw[k] * __builtin_amdgcn_cvt_f32_fp8(w, 1); y.z += tw[k] * __builtin_amdgcn_cvt_f32_fp8(w, 2); y.w += tw[k] * __builtin_amdgcn_cvt_f32_fp8(w, 3); }
            const f32x4 g2 = *(const f32x4*)(mod + b * 6144 + 5120 + col);
            const u32x2 xw = xr[lane + 64 * j];
            v[j] = (f32x4){bf2f(xw.x & 0xffffu), bf2f(xw.x >> 16), bf2f(xw.y & 0xffffu), bf2f(xw.y >> 16)} + g2 * y;
            s += v[j].x * v[j].x + v[j].y * v[j].y + v[j].z * v[j].z + v[j].w * v[j].w; }
        s = wave_sum(s);
        const float rstd = rsqrtf(s * (1.f / DM) + EPS);
#pragma unroll
        for (int j = 0; j < 4; ++j) { const int col = 4 * lane + 256 * j; const f32x4 g = *(const f32x4*)(p.fnorm + col);
            *(f32x4*)(p.out + (size_t)m * DM + col) = v[j] * rstd * g; }
    }
}


struct EpiGate {
    static constexpr bool PERM = true, HAS_MID = false;
    unsigned char* ws;
    __device__ __forceinline__ void operator()(const f32x4 (&acc)[2][2][4][2], const pg8::GUnit& u, int wr, int wc, int fr, int fq) const {
        const int row0 = u.pm * 256 + wr * 64 + fr;
        bf16_t* base = (bf16_t*)(ws + (u.pn < 4 ? WS_GA : WS_GB));
#pragma unroll
        for (int bj = 0; bj < 2; ++bj) { const int c = (u.pn & 3) * 256 + bj * 128 + wc * 32 + 8 * fq;
#pragma unroll
            for (int ai = 0; ai < 2; ++ai)
#pragma unroll
                for (int m = 0; m < 4; ++m) *(u32x4*)(base + (size_t)(row0 + ai * 128 + m * 16) * 1024 + c) = pack8(sig4s(acc[ai][bj][m][0]), sig4s(acc[ai][bj][m][1])); }
    }
};
struct GateOrder {
    const char* A; const char* Bt; int G, c;
    __device__ __forceinline__ bool next(int i, pg8::GUnit& u) const {
        int un;
        if (G == 256) { if (c < 128) { if (i > 0) return false; un = c; } else { if (i > 2) return false; un = 128 + 3 * (c - 128) + i; } }
        else { un = i * G + c; if (un >= 512) return false; }
        u.pm = un >> 3; u.pn = un & 7; u.e = 0; u.cnt = 0; u.tile = 0; u.pad_ = 0;
        u.a = A + (size_t)u.pm * 256 * 1024; u.b = Bt + (size_t)u.pn * 256 * 1024; return true;
    }
    __device__ __forceinline__ unsigned a_rowoff(const pg8::GUnit&, int) const { return 0u; }
};
__device__ __forceinline__ void ph_proj2(const P& p, unsigned char* lds) {
    { pg8::DenseOrder S; S.init(p.ws + WS_XN, p.ws + WS_WT_IN, MTOK, 1536, 1024, gridDim.x, blockIdx.x);
      EpiProj E{p.ws};
      pg8::gemm_phase<EpiProj, pg8::DenseOrder, true, false>((LAS unsigned char*)lds, 1024, S, E); }
    { GateOrder S{(const char*)(p.ws + WS_XN8), (const char*)(p.ws + WS_WT_G8), (int)gridDim.x, (int)blockIdx.x};
      EpiGate E{p.ws};
      pg8::gemm_phase<EpiGate, GateOrder, true, false, true>((LAS unsigned char*)lds, 512, S, E); }
}
__device__ __forceinline__ void ph_up2(const P& p, unsigned char* lds) {
    { pg8::DenseOrder S; S.init(p.ws + WS_CQ, p.ws + WS_WT_UQ, MTOK, 768, 384, gridDim.x, blockIdx.x); EpiUpQ E{p.ws};
      pg8::gemm_phase<EpiUpQ, pg8::DenseOrder, false, false>((LAS unsigned char*)lds, 384, S, E); }
    { pg8::DenseOrder S; S.init(p.ws + WS_CKV, p.ws + WS_WT_UKV, MTOK, 1024, 256, gridDim.x, blockIdx.x); EpiUpKV E{p.ws};
      pg8::gemm_phase<EpiUpKV, pg8::DenseOrder, false, false>((LAS unsigned char*)lds, 256, S, E); }
}
__device__ __forceinline__ void ph_mix2(const P& p, unsigned char* lds) {
    pg8::DenseOrder S; S.init(p.ws + WS_AO, p.ws + WS_WT_A, MTOK, 1024, 1024, gridDim.x, blockIdx.x); EpiMixF E{p.ws};
    pg8::gemm_phase<EpiMixF, pg8::DenseOrder, false, false>((LAS unsigned char*)lds, 1024, S, E);
}
__device__ __forceinline__ void ph_out2(const P& p, unsigned char* lds) {
    pg8::DenseOrder S; S.init(p.ws + WS_MIX, p.ws + WS_WT_OUT, MTOK, 1024, 512, gridDim.x, blockIdx.x); EpiOut E{p.ws, p.x};
    pg8::gemm_phase<EpiOut, pg8::DenseOrder, false, false, true>((LAS unsigned char*)lds, 512, S, E);
}


constexpr int MOE_TAB_OFF = 135168;
__device__ __forceinline__ void moe_build_tab(const P& p, unsigned char* lds) {
    LAS int* tab = (LAS int*)((LAS unsigned char*)lds + MOE_TAB_OFF);
    const unsigned* cnt = (const unsigned*)(p.ws + WS_CTL);
    const int tid = threadIdx.x;
    if (tid < 64) {
        const int c = tid < NEXP ? (int)cnt[tid * 64] : 0, n = (c + 255) >> 8;
        int incl = n;
#pragma unroll
        for (int o = 1; o < 32; o <<= 1) { const int t = __shfl_up(incl, o); if (tid >= o) incl += t; }
        const int s = incl - n;
        if (tid < NEXP) { tab[tid] = c; tab[32 + tid] = s; for (int j = 0; j < n; ++j) tab[128 + s + j] = tid; if (tid == NEXP - 1) tab[64] = incl; }
    }
    __syncthreads();
}
template <bool GATHER> struct MoeOrder {
    const LAS int* tab; const char* Abase; const char* Bbase; const unsigned* LIST; int K, NCT, G, c;
    __device__ __forceinline__ bool next(int i, pg8::GUnit& u) const {
        const int vc = (G % 8 == 0) ? (c % 8) * (G / 8) + c / 8 : c;
        const int L = i * G + vc; const int ntile = __builtin_amdgcn_readfirstlane(tab[64]); if (L >= ntile * NCT) return false;
        const int tile = L / NCT, pn = L - tile * NCT, e = __builtin_amdgcn_readfirstlane(tab[128 + tile]);
        u.e = e; u.cnt = __builtin_amdgcn_readfirstlane(tab[e]); u.pm = tile - __builtin_amdgcn_readfirstlane(tab[32 + e]); u.pn = pn; u.tile = tile; u.pad_ = 0;
        u.b = Bbase + ((size_t)e * NCT + pn) * 256 * K * 2;
        u.a = GATHER ? Abase : Abase + (size_t)tile * 256 * K * 2;
        return true;
    }
    __device__ __forceinline__ unsigned a_rowoff(const pg8::GUnit& u, int r) const {
        const int row = u.pm * 256 + r; const unsigned ent = row < u.cnt ? LIST[(size_t)u.e * LISTCAP + row] : 0u; return (ent >> 2) * (unsigned)(K * 2);
    }
};
struct EpiMoe1 {
    static constexpr bool PERM = true, HAS_MID = false;
    unsigned char* ws; const float* b1;
    __device__ __forceinline__ void operator()(const f32x4 (&acc)[2][2][4][2], const pg8::GUnit& u, int wr, int wc, int fr, int fq) const {
        bf16_t* HID = (bf16_t*)(ws + WS_HID);
        const int row0 = u.tile * 256 + wr * 64 + fr, col = u.pn * 128 + wc * 32 + 8 * fq;
        constexpr float CG = -1.702f * LOG2E, CGI = 1.f / CG;
        f32x4 bg[2], bl[2];
#pragma unroll
        for (int n = 0; n < 2; ++n) { bg[n] = *(const f32x4*)(b1 + u.e * 2048 + col + 4 * n) * CG; bl[n] = (*(const f32x4*)(b1 + u.e * 2048 + 1024 + col + 4 * n) + 1.f) * CGI; }
#pragma unroll
        for (int ai = 0; ai < 2; ++ai)
#pragma unroll
            for (int m = 0; m < 4; ++m) { f32x4 h[2];
#pragma unroll
                for (int n = 0; n < 2; ++n) { const f32x4 gv = acc[ai][0][m][n] * (W8_INV * CG) + bg[n], lv = acc[ai][1][m][n] * (W8_INV * CGI) + bl[n];
#pragma unroll
                    for (int i = 0; i < 4; ++i) { const float t = fmaxf(gv[i], 7.f * CG), L = __builtin_amdgcn_fmed3f(lv[i], 8.f * CGI, -6.f * CGI);
                        h[n][i] = t * __builtin_amdgcn_rcpf(1.f + __builtin_amdgcn_exp2f(t)) * L; } }
                u32x2 o8; o8.x = pk4_fp8(h[0][0], h[0][1], h[0][2], h[0][3]); o8.y = pk4_fp8(h[1][0], h[1][1], h[1][2], h[1][3]);
                *(u32x2*)((unsigned char*)HID + (size_t)(row0 + ai * 128 + m * 16) * 1024 + col) = o8; }
    }
};
struct EpiMoe2 {
    static constexpr bool PERM = true, HAS_MID = false;
    unsigned char* ws; const float* b2;
    __device__ __forceinline__ void operator()(const f32x4 (&acc)[2][2][4][2], const pg8::GUnit& u, int wr, int wc, int fr, int fq) const {
        unsigned char* Y = ws + WS_Y; const unsigned* LIST = (const unsigned*)(ws + WS_LIST) + (size_t)u.e * LISTCAP;
        f32x4 bv[2][2]; unsigned ent[2][4];
#pragma unroll
        for (int bj = 0; bj < 2; ++bj)
#pragma unroll
            for (int n = 0; n < 2; ++n) bv[bj][n] = *(const f32x4*)(b2 + u.e * 1024 + u.pn * 256 + bj * 128 + wc * 32 + 8 * fq + 4 * n);
#pragma unroll
        for (int ai = 0; ai < 2; ++ai)
#pragma unroll
            for (int m = 0; m < 4; ++m) { const int rr = u.pm * 256 + ai * 128 + wr * 64 + m * 16 + fr, rc = rr < u.cnt ? rr : u.cnt - 1; ent[ai][m] = LIST[rc]; }
        asm volatile("" : "+v"(bv[0][0]), "+v"(bv[0][1]), "+v"(bv[1][0]), "+v"(bv[1][1]));
#pragma unroll
        for (int ai = 0; ai < 2; ++ai)
#pragma unroll
            for (int m = 0; m < 4; ++m) asm volatile("" : "+v"(ent[ai][m]));
#pragma unroll
        for (int ai = 0; ai < 2; ++ai)
#pragma unroll
            for (int m = 0; m < 4; ++m) { const int rr = u.pm * 256 + ai * 128 + wr * 64 + m * 16 + fr;
                if (rr < u.cnt) {
#pragma unroll
                    for (int bj = 0; bj < 2; ++bj) { const int c = u.pn * 256 + bj * 128 + wc * 32 + 8 * fq;
                        const f32x4 y0 = acc[ai][bj][m][0] * W8_INV + bv[bj][0], y1 = acc[ai][bj][m][1] * W8_INV + bv[bj][1];
                        u32x2 o8; o8.x = pk4_fp8(y0[0], y0[1], y0[2], y0[3]); o8.y = pk4_fp8(y1[0], y1[1], y1[2], y1[3]);
                        *(u32x2*)(Y + (size_t)ent[ai][m] * 1024 + c) = o8; } } }
    }
};
__device__ __forceinline__ void ph_moe1_2(const P& p, unsigned char* lds) {
    moe_build_tab(p, lds);
    MoeOrder<true> S{(const LAS int*)((LAS unsigned char*)lds + MOE_TAB_OFF), (const char*)(p.ws + WS_XN), (const char*)(p.ws + WS_WT_M1), (const unsigned*)(p.ws + WS_LIST), 512, 8, (int)gridDim.x, (int)blockIdx.x};
    EpiMoe1 E{p.ws, p.b_m1};
    pg8::gemm_phase<EpiMoe1, MoeOrder<true>, true, true, true>((LAS unsigned char*)lds, 512, S, E);
}
__device__ __forceinline__ void ph_moe2_2(const P& p, unsigned char* lds) {
    MoeOrder<false> S{(const LAS int*)((LAS unsigned char*)lds + MOE_TAB_OFF), (const char*)(p.ws + WS_HID), (const char*)(p.ws + WS_WT_M2), (const unsigned*)(p.ws + WS_LIST), 512, 4, (int)gridDim.x, (int)blockIdx.x};
    EpiMoe2 E{p.ws, p.b_m2};
    pg8::gemm_phase<EpiMoe2, MoeOrder<false>, true, false, true>((LAS unsigned char*)lds, 512, S, E);
}


namespace att {
typedef float f32x16 __attribute__((ext_vector_type(16)));
typedef short s16x4 __attribute__((ext_vector_type(4)));
typedef short v4i16_t __attribute__((ext_vector_type(4)));
typedef LAS const unsigned char* lds_cptr;
constexpr int KROW = 208;
constexpr int KBUF = 64 * KROW, VBUF = 8192;
constexpr int OFF_K = 0, OFF_V = 2 * KBUF, OFF_WS = 2 * KBUF + 2 * VBUF, LDS_BYTES_ATT = OFF_WS + 8 * 256;
__device__ __forceinline__ int crow(int r, int hi) { return (r & 3) + 8 * (r >> 2) + 4 * hi; }
__device__ __forceinline__ s16x4 vtr(lds_cptr p) { return __builtin_bit_cast(s16x4, __builtin_amdgcn_ds_read_tr16_b64_v4i16((LAS v4i16_t*)p)); }
__device__ __forceinline__ float half_swap_max(float m) { auto rr = __builtin_amdgcn_permlane32_swap(__float_as_uint(m), __float_as_uint(m), false, false); return fmaxf(__uint_as_float(rr[0]), __uint_as_float(rr[1])); }
__device__ __forceinline__ float half_swap_sum(float m) { auto rr = __builtin_amdgcn_permlane32_swap(__float_as_uint(m), __float_as_uint(m), false, false); return __uint_as_float(rr[0]) + __uint_as_float(rr[1]); }

constexpr int BG_SCR_OFF = 49152;
#define ATT_BARRIER() asm volatile("s_waitcnt lgkmcnt(0)\n\ts_barrier" ::: "memory")
template <bool MLA>
__device__ __forceinline__ void attn_unit(const P& p, LAS unsigned char* lds, int b, int hk, int q0, BgConv& bg, float* bgscr) {
    int tid_ = threadIdx.x; asm volatile("" : "+v"(tid_));
    const int tid = tid_, lane = tid & 63, r32 = lane & 31, hi = lane >> 5, wid = __builtin_amdgcn_readfirstlane(tid >> 6);
    constexpr int NKS = MLA ? 6 : 4;
    const int head = MLA ? hk : hk * 4 + (wid >> 1);
    const int qw0 = MLA ? q0 + 32 * wid : q0 + 32 * (wid & 1);
    const size_t rb = (size_t)b * SEQ;
    bf16x8 qf[NKS];
    if (MLA) {
        const bf16_t* qn = (const bf16_t*)(p.ws + WS_QN) + (rb + qw0 + r32) * 512 + head * 64 + 8 * hi;
        const bf16_t* qr = (const bf16_t*)(p.ws + WS_QR) + (rb + qw0 + r32) * 256 + head * 32 + 8 * hi;
#pragma unroll
        for (int ks = 0; ks < 4; ++ks) qf[ks] = *(const bf16x8*)(qn + 16 * ks);
#pragma unroll
        for (int ks = 4; ks < NKS; ++ks) qf[ks] = *(const bf16x8*)(qr + 16 * (ks - 4));
    } else {
        const bf16_t* qa = (const bf16_t*)(p.ws + WS_QA) + (rb + qw0 + r32) * 512 + head * 64 + 8 * hi;
#pragma unroll
        for (int ks = 0; ks < NKS; ++ks) qf[ks] = *(const bf16x8*)(qa + 16 * ks);
    }
    const int t_lo = MLA ? 0 : (q0 >= 128 ? (q0 - 128) >> 6 : 0), t_hi = MLA ? ((q0 + 256) >> 6) - 1 : (q0 >> 6);
    const int skey = tid >> 3, sc = tid & 7;
    const bf16_t* kg; const bf16_t* vg; const bf16_t* rg = nullptr;
    if (MLA) { kg = (const bf16_t*)(p.ws + WS_KN) + (rb + skey) * 512 + hk * 64 + 8 * sc; vg = (const bf16_t*)(p.ws + WS_VB) + (rb + skey) * 512 + hk * 64 + 8 * sc;
               rg = (const bf16_t*)(p.ws + WS_KR) + (rb + (tid >> 2)) * 32 + 8 * (tid & 3); }
    else { kg = (const bf16_t*)(p.ws + WS_KA) + (rb + skey) * 128 + hk * 64 + 8 * sc; vg = (const bf16_t*)(p.ws + WS_VA) + (rb + skey) * 128 + hk * 64 + 8 * sc; }
    const int kpitch = MLA ? 512 : 128;
    const int kst = skey * KROW + sc * 16;
    const int rst = (tid >> 2) * KROW + 128 + (tid & 3) * 16;
    const int vst = ((8 * sc) >> 5) * 4096 + (skey >> 4) * 1024 + (skey & 15) * 64 + ((8 * sc) & 31) * 2;
    u32x4 kreg, vreg, rreg = (u32x4){0u, 0u, 0u, 0u};
#define ATT_LOAD(t) do { kreg = *(const u32x4*)(kg + (size_t)(t) * 64 * kpitch); vreg = *(const u32x4*)(vg + (size_t)(t) * 64 * kpitch); \
        if (MLA && tid < 256) rreg = *(const u32x4*)(rg + (size_t)(t) * 64 * 32); } while (0)
#define ATT_WRITE(buf) do { *(LAS u32x4*)(lds + OFF_K + (buf) * KBUF + kst) = kreg; *(LAS u32x4*)(lds + OFF_V + (buf) * VBUF + vst) = vreg; \
        if (MLA && tid < 256) *(LAS u32x4*)(lds + OFF_K + (buf) * KBUF + rst) = rreg; } while (0)
    LAS float* wsf = (LAS float*)(lds + OFF_WS) + wid * 64;
    float m, l; f32x16 o[2];
#pragma unroll
    for (int r = 0; r < 16; ++r) { o[0][r] = 0.f; o[1][r] = 0.f; }
    float slope2 = 0.f;
    if (MLA) { m = -INFINITY; l = 0.f; }
    else { m = p.sinks[head] * LOG2E; l = hi == 0 ? 1.f : 0.f; slope2 = exp2f(-(float)(head + 1)) * LOG2E; }
    const lds_cptr kp0 = (lds_cptr)lds + OFF_K + r32 * KROW + hi * 16;
    const lds_cptr vp0 = (lds_cptr)lds + OFF_V + ((lane >> 4) & 1) * 32 + (lane & 3) * 8 + (4 * hi + ((lane & 15) >> 2)) * 64;
    ATT_LOAD(t_lo); ATT_WRITE(0);
    ATT_BARRIER();
    for (int t = t_lo; t <= t_hi; ++t) {
        const int cur = (t - t_lo) & 1, s0 = t * 64;
        if (t < t_hi) ATT_LOAD(t + 1);
        if (BG_CONV) bg_step(p, bg, bgscr, lane);
        const bool active = MLA ? (s0 <= qw0 + 31) : (s0 <= qw0 + 31 && s0 + 63 >= qw0 - 127);
        if (active) {
            f32x16 p0, p1;
#pragma unroll
            for (int r = 0; r < 16; ++r) { p0[r] = 0.f; p1[r] = 0.f; }
            const lds_cptr kp = kp0 + cur * KBUF;
#pragma unroll
            for (int ks = 0; ks < NKS; ++ks) {
                const bf16x8 a0 = *(const LAS bf16x8*)(kp + ks * 32), a1 = *(const LAS bf16x8*)(kp + 32 * KROW + ks * 32);
                p0 = __builtin_amdgcn_mfma_f32_32x32x16_bf16(a0, qf[ks], p0, 0, 0, 0);
                p1 = __builtin_amdgcn_mfma_f32_32x32x16_bf16(a1, qf[ks], p1, 0, 0, 0);
            }
            const int q = qw0 + r32;
            if (MLA) {
                if (s0 + 63 > qw0) {
#pragma unroll
                    for (int r = 0; r < 16; ++r) { const int key = s0 + crow(r, hi); if (key > q) p0[r] = -INFINITY; if (key + 32 > q) p1[r] = -INFINITY; }
                }
            } else {
#pragma unroll
                for (int r = 0; r < 16; ++r) { const int d0 = q - (s0 + crow(r, hi)), d1 = d0 - 32;
                    p0[r] = (d0 >= 0 && d0 < 128) ? p0[r] - slope2 * (float)d0 : -INFINITY;
                    p1[r] = (d1 >= 0 && d1 < 128) ? p1[r] - slope2 * (float)d1 : -INFINITY; }
            }
            float mx = fmaxf(p0[0], p1[0]);
#pragma unroll
            for (int r = 1; r < 16; ++r) mx = fmaxf(mx, fmaxf(p0[r], p1[r]));
            mx = half_swap_max(mx);
            if (__any(mx > m + 8.f)) {
                const float mn = fmaxf(m, mx), alpha = __builtin_amdgcn_exp2f(m - mn);
                m = mn; l *= alpha;
                if (hi == 0) wsf[r32] = alpha;
#pragma unroll
                for (int r = 0; r < 16; ++r) { const float a = wsf[crow(r, hi)]; o[0][r] *= a; o[1][r] *= a; }
            }
            float ps = 0.f;
#pragma unroll
            for (int r = 0; r < 16; ++r) { p0[r] = __builtin_amdgcn_exp2f(p0[r] - m); p1[r] = __builtin_amdgcn_exp2f(p1[r] - m); ps += p0[r] + p1[r]; }
            l += ps;
            u32x4 pw[4];
#pragma unroll
            for (int i = 0; i < 4; ++i) { pw[0][i] = pg8::cvt_pk_bf16(p0[2 * i], p0[2 * i + 1]); pw[1][i] = pg8::cvt_pk_bf16(p0[8 + 2 * i], p0[8 + 2 * i + 1]);
                                          pw[2][i] = pg8::cvt_pk_bf16(p1[2 * i], p1[2 * i + 1]); pw[3][i] = pg8::cvt_pk_bf16(p1[8 + 2 * i], p1[8 + 2 * i + 1]); }
            const lds_cptr vp = vp0 + cur * VBUF;
#pragma unroll
            for (int d0 = 0; d0 < 2; ++d0)
#pragma unroll
                for (int ks = 0; ks < 4; ++ks) {
                    const s16x4 lo = vtr(vp + d0 * 4096 + ks * 1024), hh = vtr(vp + d0 * 4096 + ks * 1024 + 512);
                    const bf16x8 vf = (bf16x8){lo[0], lo[1], lo[2], lo[3], hh[0], hh[1], hh[2], hh[3]};
                    o[d0] = __builtin_amdgcn_mfma_f32_32x32x16_bf16(__builtin_bit_cast(bf16x8, pw[ks]), vf, o[d0], 0, 0, 0);
                }
        }
        if (t < t_hi) ATT_WRITE(cur ^ 1);
        ATT_BARRIER();
    }
    l = half_swap_sum(l);
    if (hi == 0) wsf[32 + r32] = 1.f / l;
    bf16_t* Ob = (bf16_t*)(p.ws + WS_AO) + (rb + qw0) * 1024 + (MLA ? 512 : 0) + head * 64 + r32;
#pragma unroll
    for (int r = 0; r < 16; ++r) { const int qr = crow(r, hi); const float rl = wsf[32 + qr];
        Ob[(size_t)qr * 1024] = (bf16_t)f2bf(o[0][r] * rl); Ob[(size_t)qr * 1024 + 32] = (bf16_t)f2bf(o[1][r] * rl); }
#undef ATT_LOAD
#undef ATT_WRITE
}
constexpr int PP_AHEAD = 4;
constexpr int PP_OFF_V = 3 * KBUF, PP_OFF_WS = 3 * KBUF + 3 * VBUF;
#define ATT_PBAR() do { __builtin_amdgcn_sched_barrier(0); asm volatile("s_waitcnt lgkmcnt(0)\n\ts_barrier" ::: "memory"); __builtin_amdgcn_sched_barrier(0); } while (0)
template <bool MLA>
__device__ __forceinline__ void attn_unit_pp(const P& p, LAS unsigned char* lds, int b, int hk, int q0, BgConv& bg) {
    int tid_ = threadIdx.x; asm volatile("" : "+v"(tid_));
    const int tid = tid_, lane = tid & 63, r32 = lane & 31, hi = lane >> 5, wid = __builtin_amdgcn_readfirstlane(tid >> 6);
    const int grp = wid >> 2;
    constexpr int NKS = MLA ? 6 : 4;
    const int head = MLA ? hk : hk * 4 + (wid >> 1);
    const int qw0 = MLA ? q0 + 32 * wid : q0 + 32 * (wid & 1);
    const size_t rb = (size_t)b * SEQ;
    bf16x8 qf[NKS];
    if (MLA) {
        const bf16_t* qn = (const bf16_t*)(p.ws + WS_QN) + (rb + qw0 + r32) * 512 + head * 64 + 8 * hi;
        const bf16_t* qr = (const bf16_t*)(p.ws + WS_QR) + (rb + qw0 + r32) * 256 + head * 32 + 8 * hi;
#pragma unroll
        for (int ks = 0; ks < 4; ++ks) qf[ks] = *(const bf16x8*)(qn + 16 * ks);
#pragma unroll
        for (int ks = 4; ks < NKS; ++ks) qf[ks] = *(const bf16x8*)(qr + 16 * (ks - 4));
    } else {
        const bf16_t* qa = (const bf16_t*)(p.ws + WS_QA) + (rb + qw0 + r32) * 512 + head * 64 + 8 * hi;
#pragma unroll
        for (int ks = 0; ks < NKS; ++ks) qf[ks] = *(const bf16x8*)(qa + 16 * ks);
    }
    const int t_lo = MLA ? 0 : (q0 >= 128 ? (q0 - 128) >> 6 : 0), t_hi = MLA ? ((q0 + 256) >> 6) - 1 : (q0 >> 6);
    const int skey = tid >> 3, sc = tid & 7;
    const bf16_t* kg; const bf16_t* vg; const bf16_t* rg = nullptr;
    if (MLA) { kg = (const bf16_t*)(p.ws + WS_KN) + (rb + skey) * 512 + hk * 64 + 8 * sc; vg = (const bf16_t*)(p.ws + WS_VB) + (rb + skey) * 512 + hk * 64 + 8 * sc;
               rg = (const bf16_t*)(p.ws + WS_KR) + (rb + (tid >> 2)) * 32 + 8 * (tid & 3); }
    else { kg = (const bf16_t*)(p.ws + WS_KA) + (rb + skey) * 128 + hk * 64 + 8 * sc; vg = (const bf16_t*)(p.ws + WS_VA) + (rb + skey) * 128 + hk * 64 + 8 * sc; }
    const int kpitch = MLA ? 512 : 128;
    const int kst = skey * KROW + sc * 16;
    const int rst = (tid >> 2) * KROW + 128 + (tid & 3) * 16;
    const int vst = ((8 * sc) >> 5) * 4096 + (skey >> 4) * 1024 + (skey & 15) * 64 + ((8 * sc) & 31) * 2;
    u32x4 kreg, vreg, rreg = (u32x4){0u, 0u, 0u, 0u};
#define PP_LOAD(t) do { kreg = *(const u32x4*)(kg + (size_t)(t) * 64 * kpitch); vreg = *(const u32x4*)(vg + (size_t)(t) * 64 * kpitch); \
        if (MLA && tid < 256) rreg = *(const u32x4*)(rg + (size_t)(t) * 64 * 32); } while (0)
#define PP_WRITE(kb, vb) do { *(LAS u32x4*)(lds + (kb) + kst) = kreg; *(LAS u32x4*)(lds + PP_OFF_V + (vb) + vst) = vreg; \
        if (MLA && tid < 256) *(LAS u32x4*)(lds + (kb) + rst) = rreg; } while (0)
    LAS float* wsf = (LAS float*)(lds + PP_OFF_WS) + wid * 64;
    float m, l; f32x16 o[2];
#pragma unroll
    for (int r = 0; r < 16; ++r) { o[0][r] = 0.f; o[1][r] = 0.f; }
    float slope2 = 0.f;
    if (MLA) { m = -INFINITY; l = 0.f; }
    else { m = p.sinks[head] * LOG2E; l = hi == 0 ? 1.f : 0.f; slope2 = exp2f(-(float)(head + 1)) * LOG2E; }
    const lds_cptr kp0 = (lds_cptr)lds + r32 * KROW + hi * 16;
    const lds_cptr vp0 = (lds_cptr)lds + PP_OFF_V + ((lane >> 4) & 1) * 32 + (lane & 3) * 8 + (4 * hi + ((lane & 15) >> 2)) * 64;
    int kbP = 2 * KBUF, kbC = 0, kbN = KBUF, vbP = 2 * VBUF, vbC = 0, vbN = VBUF;
    PP_LOAD(t_lo); PP_WRITE(kbC, vbC);
    if (t_lo < t_hi) PP_LOAD(t_lo + 1);
    ATT_PBAR();
    if (grp) ATT_PBAR();
    u32x4 pw[4];
#pragma unroll
    for (int i = 0; i < 4; ++i) pw[i] = (u32x4){0u, 0u, 0u, 0u};
    f32x16 p0, p1;
#pragma unroll
    for (int r = 0; r < 16; ++r) { p0[r] = 0.f; p1[r] = 0.f; }
    bool act_prev = false;
    for (int t = t_lo; t <= t_hi + 1; ++t) {
        const int s0 = t * 64;
        const bool active = t <= t_hi && (MLA ? (s0 <= qw0 + 31) : (s0 <= qw0 + 31 && s0 + 63 >= qw0 - 127));
        if (active) {
#pragma unroll
            for (int r = 0; r < 16; ++r) { p0[r] = 0.f; p1[r] = 0.f; }
            const lds_cptr kp = kp0 + kbC;
            bf16x8 ka[2 * NKS];
#pragma unroll
            for (int ks = 0; ks < NKS; ++ks) { ka[2 * ks] = *(const LAS bf16x8*)(kp + ks * 32); ka[2 * ks + 1] = *(const LAS bf16x8*)(kp + 32 * KROW + ks * 32); }
#pragma unroll
            for (int ks = 0; ks < NKS; ++ks) {
                p0 = __builtin_amdgcn_mfma_f32_32x32x16_bf16(ka[2 * ks], qf[ks], p0, 0, 0, 0);
                p1 = __builtin_amdgcn_mfma_f32_32x32x16_bf16(ka[2 * ks + 1], qf[ks], p1, 0, 0, 0);
            }
            __builtin_amdgcn_sched_group_barrier(0x100, PP_AHEAD, 0);
#pragma unroll
            for (int i = 0; i < 2 * NKS - PP_AHEAD; ++i) { __builtin_amdgcn_sched_group_barrier(0x008, 1, 0); __builtin_amdgcn_sched_group_barrier(0x100, 1, 0); }
            __builtin_amdgcn_sched_group_barrier(0x008, PP_AHEAD, 0);
        }
        __builtin_amdgcn_sched_barrier(0);
        if (act_prev) {
            const lds_cptr vp = vp0 + vbP;
            bf16x8 vf[8];
#pragma unroll
            for (int ks = 0; ks < 4; ++ks)
#pragma unroll
                for (int d0 = 0; d0 < 2; ++d0) {
                    const s16x4 lo = vtr(vp + d0 * 4096 + ks * 1024), hh = vtr(vp + d0 * 4096 + ks * 1024 + 512);
                    vf[2 * ks + d0] = (bf16x8){lo[0], lo[1], lo[2], lo[3], hh[0], hh[1], hh[2], hh[3]};
                }
#pragma unroll
            for (int ks = 0; ks < 4; ++ks) {
                o[0] = __builtin_amdgcn_mfma_f32_32x32x16_bf16(__builtin_bit_cast(bf16x8, pw[ks]), vf[2 * ks], o[0], 0, 0, 0);
                o[1] = __builtin_amdgcn_mfma_f32_32x32x16_bf16(__builtin_bit_cast(bf16x8, pw[ks]), vf[2 * ks + 1], o[1], 0, 0, 0);
            }
            __builtin_amdgcn_sched_group_barrier(0x100, 6, 0);
#pragma unroll
            for (int i = 0; i < 5; ++i) { __builtin_amdgcn_sched_group_barrier(0x008, 1, 0); __builtin_amdgcn_sched_group_barrier(0x100, 2, 0); }
            __builtin_amdgcn_sched_group_barrier(0x008, 3, 0);
        }
        __builtin_amdgcn_sched_barrier(0);
        if (t < t_hi) PP_WRITE(kbN, vbN);
        if (BG_CONV) bg_step_fin(p, bg, lane);
        if (t + 1 < t_hi) PP_LOAD(t + 2);
        if (BG_CONV) bg_step_iss(p, bg, lane);
        ATT_PBAR();
        if (active) {
            const int q = qw0 + r32;
            if (MLA) {
                if (s0 + 63 > qw0) {
#pragma unroll
                    for (int r = 0; r < 16; ++r) { const int key = s0 + crow(r, hi); if (key > q) p0[r] = -INFINITY; if (key + 32 > q) p1[r] = -INFINITY; }
                }
            } else {
#pragma unroll
                for (int r = 0; r < 16; ++r) { const int d0 = q - (s0 + crow(r, hi)), d1 = d0 - 32;
                    p0[r] = (d0 >= 0 && d0 < 128) ? p0[r] - slope2 * (float)d0 : -INFINITY;
                    p1[r] = (d1 >= 0 && d1 < 128) ? p1[r] - slope2 * (float)d1 : -INFINITY; }
            }
            float mx = fmaxf(p0[0], p1[0]);
#pragma unroll
            for (int r = 1; r < 16; ++r) mx = fmaxf(mx, fmaxf(p0[r], p1[r]));
            mx = half_swap_max(mx);
            if (__any(mx > m + 8.f)) {
                const float mn = fmaxf(m, mx), alpha = __builtin_amdgcn_exp2f(m - mn);
                m = mn; l *= alpha;
                if (hi == 0) wsf[r32] = alpha;
#pragma unroll
                for (int r = 0; r < 16; ++r) { const float a = wsf[crow(r, hi)]; o[0][r] *= a; o[1][r] *= a; }
            }
            float ps = 0.f;
#pragma unroll
            for (int r = 0; r < 16; ++r) { p0[r] = __builtin_amdgcn_exp2f(p0[r] - m); p1[r] = __builtin_amdgcn_exp2f(p1[r] - m); ps += p0[r] + p1[r]; }
            l += ps;
#pragma unroll
            for (int i = 0; i < 4; ++i) { pw[0][i] = pg8::cvt_pk_bf16(p0[2 * i], p0[2 * i + 1]); pw[1][i] = pg8::cvt_pk_bf16(p0[8 + 2 * i], p0[8 + 2 * i + 1]);
                                          pw[2][i] = pg8::cvt_pk_bf16(p1[2 * i], p1[2 * i + 1]); pw[3][i] = pg8::cvt_pk_bf16(p1[8 + 2 * i], p1[8 + 2 * i + 1]); }
        }
        act_prev = active;
        ATT_PBAR();
        { const int tk = kbP; kbP = kbC; kbC = kbN; kbN = tk; const int tv = vbP; vbP = vbC; vbC = vbN; vbN = tv; }
    }
    if (!grp) ATT_PBAR();
    l = half_swap_sum(l);
    if (hi == 0) wsf[32 + r32] = 1.f / l;
    bf16_t* Ob = (bf16_t*)(p.ws + WS_AO) + (rb + qw0) * 1024 + (MLA ? 512 : 0) + head * 64 + r32;
#pragma unroll
    for (int r = 0; r < 16; ++r) { const int qr = crow(r, hi); const float rl = wsf[32 + qr];
        Ob[(size_t)qr * 1024] = (bf16_t)f2bf(o[0][r] * rl); Ob[(size_t)qr * 1024 + 32] = (bf16_t)f2bf(o[1][r] * rl); }
#undef PP_LOAD
#undef PP_WRITE
}
}
__device__ __forceinline__ void ph_attn2(const P& p, unsigned char* lds_) {
    LAS unsigned char* lds = (LAS unsigned char*)lds_;
    const int G = gridDim.x, bx = blockIdx.x;
    const int vcu = (G % 8 == 0) ? (bx % 8) * (G / 8) + bx / 8 : bx;
    const int lane_ = threadIdx.x & 63, wave_ = threadIdx.x >> 6;
    BgConv bg; bg.item = bx * 8 + wave_; bg.it = 0; bg.ngw = G * 8; bg.pend = false;
#pragma unroll
    for (int i = 0; i < 32; ++i) bg.r[i] = 0.f;
    float* bgscr = (float*)(lds_ + att::BG_SCR_OFF + wave_ * 8704);
    for (int pi = vcu; pi < 256; pi += G) {
        const int bh = pi >> 4, sidx = pi & 15;
        att::attn_unit_pp<true>(p, lds, bh >> 3, bh & 7, (31 - sidx) * 256, bg);
        att::attn_unit_pp<true>(p, lds, bh >> 3, bh & 7, sidx * 256, bg);
    }
    for (int u = vcu; u < 512; u += G) {
        const int bk = u >> 7, qb = u & 127;
        att::attn_unit_pp<false>(p, lds, bk >> 1, bk & 1, qb * 64, bg);
    }
    if (BG_CONV) bg_drain(p, bg, bgscr, lane_);
}

#define XB_TMO      128
#define XB_XCNT(j)  (256  + 64 * (j))
#define XB_XSUB(j)  (1280 + 64 * (j))
#define XB_XGEN(j)  (2304 + 64 * (j))
#define XB_TOP      3328
#define XB_TOPGEN   3392
#define XCD_BAR_WORDS 3456
#define XB_SPIN_CAP (1u << 18)
__device__ __forceinline__ unsigned xb_ld(unsigned* p)              { return __hip_atomic_load(p, __ATOMIC_RELAXED, __HIP_MEMORY_SCOPE_AGENT); }
__device__ __forceinline__ unsigned xb_add(unsigned* p, unsigned v) { return __hip_atomic_fetch_add(p, v, __ATOMIC_RELAXED, __HIP_MEMORY_SCOPE_AGENT); }
__device__ __forceinline__ unsigned xb_xcc_id() { return (unsigned)__builtin_amdgcn_s_getreg((3 << 11) | 20) & 0xFu; }
#define XB_SPIN(cond, bar) do { unsigned _sp = 0; while (cond) { __builtin_amdgcn_s_sleep(1); \
    if ((++_sp & 255u) == 0u) { if (xb_ld(&(bar)[XB_TMO])) break; if (_sp > XB_SPIN_CAP) { atomicAdd(&(bar)[XB_TMO], 1u); break; } } } } while (0)
struct XcdBarrier { unsigned* bar; unsigned x; volatile LAS unsigned* st; };
__device__ __forceinline__ XcdBarrier xcd_barrier_post(unsigned* bar, volatile LAS unsigned* st) {
    XcdBarrier b; b.bar = bar; b.x = xb_xcc_id(); b.st = st;
    if (threadIdx.x == 0) (void)xb_add(&bar[XB_XCNT(b.x)], 1u);
    return b;
}
__device__ __forceinline__ void xcd_barrier_complete(unsigned* bar, unsigned x, unsigned& nloc, unsigned& nx) {
    const unsigned G = gridDim.x * gridDim.y * gridDim.z;
    unsigned sum, cnt, mine, sp = 0u;
    for (;;) {
        sum = 0u; cnt = 0u; mine = 0u;
#pragma unroll
        for (unsigned j = 0; j < 16; ++j) { const unsigned c = xb_ld(&bar[XB_XCNT(j)]); sum += c; cnt += (c > 0u) ? 1u : 0u; mine = (j == x) ? c : mine; }
        if (sum == G) break;
        __builtin_amdgcn_s_sleep(1);
        if ((++sp & 255u) == 0u) { if (xb_ld(&bar[XB_TMO])) break; if (sp > XB_SPIN_CAP) { atomicAdd(&bar[XB_TMO], 1u); break; } }
    }
    nloc = mine > 0u ? mine : 1u; nx = cnt > 0u ? cnt : 1u;
}
__device__ __forceinline__ void xcd_barrier(const XcdBarrier& b) {
    asm volatile("s_waitcnt vmcnt(0)" ::: "memory");
    __syncthreads();
    if (threadIdx.x == 0) {
        unsigned* bar = b.bar;
        __builtin_amdgcn_s_waitcnt(0);
        unsigned nloc = b.st[0], nx = b.st[1];
        if (nloc == 0u) { xcd_barrier_complete(bar, b.x, nloc, nx); b.st[0] = nloc; b.st[1] = nx; }
        const unsigned old = xb_add(&bar[XB_XSUB(b.x)], 1u);
        const unsigned gen = old / nloc;
        if (old + 1u == (gen + 1u) * nloc) {
            __builtin_amdgcn_fence(__ATOMIC_RELEASE, "agent");
            asm volatile("s_waitcnt vmcnt(0)" ::: "memory");
            const unsigned og = xb_add(&bar[XB_TOP], 1u);
            const unsigned tg = og / nx;
            if (og + 1u == (tg + 1u) * nx) xb_add(&bar[XB_TOPGEN], 1u);
            else XB_SPIN(xb_ld(&bar[XB_TOPGEN]) == tg, bar);
            __builtin_amdgcn_fence(__ATOMIC_ACQUIRE, "agent");
            xb_add(&bar[XB_XGEN(b.x)], 1u);
            asm volatile("s_waitcnt vmcnt(0)" ::: "memory");
        } else {
            XB_SPIN(xb_ld(&bar[XB_XGEN(b.x)]) == gen, bar);
            __builtin_amdgcn_fence(__ATOMIC_ACQUIRE, "agent");
            asm volatile("s_waitcnt vmcnt(0)" ::: "memory");
        }
    }
    __syncthreads();
}
constexpr int LDSCTL_OFF = 139264;
constexpr int CW_BAR = 4096;
constexpr size_t CTL_ZERO_BYTES = 65536;

__global__ void __launch_bounds__(NTHREADS, 2) mega_fwd(P p) {
    extern __shared__ __attribute__((aligned(16))) unsigned char lds[];
    if (threadIdx.x < 32) ((LAS unsigned*)((LAS unsigned char*)lds + LDSCTL_OFF))[threadIdx.x] = 0u;
    __syncthreads();
    const XcdBarrier bar = xcd_barrier_post((unsigned*)(p.ws + WS_CTL) + CW_BAR, (volatile LAS unsigned*)((LAS unsigned char*)lds + LDSCTL_OFF));
#ifndef PH_MASK
#define PH_MASK 0xFFFF
#endif
#ifndef PH_DUP
#define PH_DUP 0
#endif
#define RUN_PH(bit, call) do { if (PH_MASK & (bit)) { call; if (PH_DUP & (bit)) { __syncthreads(); call; } } } while (0)
#define GSYNC() do { xcd_barrier(bar); if (PH_DUP & 0x10000) xcd_barrier(bar); } while (0)
    RUN_PH(1, (ph_mod(p, lds), ph_convert(p, lds)));
    GSYNC();
    RUN_PH(2, ph_xn(p));
    GSYNC();
    RUN_PH(4, ph_proj2(p, lds));
    GSYNC();
    RUN_PH(16, ph_up2(p, lds));
    GSYNC();
    RUN_PH(32, ph_attn2(p, lds));
    GSYNC();
    RUN_PH(64, ph_mix2(p, lds));
    GSYNC();
    RUN_PH(128, ph_out2(p, lds));
    GSYNC();
    if (PH_DUP & 256) { ph_route(p, lds, false); __syncthreads(); }
    if (PH_MASK & 256) ph_route(p, lds, true);
    GSYNC();
    RUN_PH(512, ph_moe1_2(p, lds));
    GSYNC();
    RUN_PH(1024, ph_moe2_2(p, lds));
    GSYNC();
    RUN_PH(2048, ph_final(p));
}

extern "C" void kernel_launch(void* const* d_in, const int* in_sizes, int n_in, void* d_out, int out_size, void* d_ws, size_t ws_size, hipStream_t stream) {
    static int grid_blocks = 0;
    if (!grid_blocks) {
        int dev = 0, cus = 0, per_cu = 0;
        (void)hipGetDevice(&dev);
        (void)hipDeviceGetAttribute(&cus, hipDeviceAttributeMultiprocessorCount, dev);
        (void)hipFuncSetAttribute((const void*)mega_fwd, hipFuncAttributeMaxDynamicSharedMemorySize, LDS_BYTES);
        (void)hipOccupancyMaxActiveBlocksPerMultiprocessor(&per_cu, (const void*)mega_fwd, NTHREADS, LDS_BYTES);
        if (per_cu < 1) per_cu = 1;
        grid_blocks = cus * per_cu;
        if (grid_blocks > 256) grid_blocks = 256;
        if (grid_blocks < 256 || MTOK % grid_blocks != 0) { fprintf(stderr, "kernel_launch: grid %d unsupported (needs >= 256 workgroups dividing %d)\n", grid_blocks, MTOK); grid_blocks = -1; }
        else if (ws_size < WS_END || n_in != 24) { fprintf(stderr, "kernel_launch: ws %zu < %zu or n_in %d != 24\n", ws_size, (size_t)WS_END, n_in); grid_blocks = -1; }
    }
    if (grid_blocks < 0) return;
    P p{};
    p.x = (const float*)d_in[0]; p.c = (const float*)d_in[1]; p.pos = (const int*)d_in[2]; p.w_ada = (const float*)d_in[3]; p.b_ada = (const float*)d_in[4];
    p.norm_mix = (const float*)d_in[5]; p.norm_ffn = (const float*)d_in[6]; p.w_in = (const float*)d_in[7]; p.sinks = (const float*)d_in[8];
    p.q_norm = (const float*)d_in[9]; p.kv_norm = (const float*)d_in[10]; p.w_uq = (const float*)d_in[11]; p.w_uk = (const float*)d_in[12]; p.w_uv = (const float*)d_in[13];
    p.w_a = (const float*)d_in[14]; p.w_b = (const float*)d_in[15]; p.w_out = (const float*)d_in[16]; p.w_router = (const float*)d_in[17]; p.b_router = (const float*)d_in[18];
    p.w_m1 = (const float*)d_in[19]; p.b_m1 = (const float*)d_in[20]; p.w_m2 = (const float*)d_in[21]; p.b_m2 = (const float*)d_in[22]; p.fnorm = (const float*)d_in[23];
    p.out = (float*)d_out; p.ws = (unsigned char*)d_ws;
    if (hipMemsetAsync((char*)d_ws + WS_CTL, 0, CTL_ZERO_BYTES, stream) != hipSuccess) { fprintf(stderr, "kernel_launch: memset failed\n"); return; }
    hipLaunchKernelGGL(mega_fwd, dim3(grid_blocks), dim3(NTHREADS), LDS_BYTES, stream, p);
    const hipError_t e = hipPeekAtLastError();
    if (e != hipSuccess) fprintf(stderr, "launch failed: %s (grid %d)\n", hipGetErrorString(e), grid_blocks);
}
```

```cpp
#include <hip/hip_runtime.h>
#include <cstdio>
#include <cstdint>

typedef unsigned short bf16_t;
typedef short bf16x8 __attribute__((ext_vector_type(8)));
typedef float f32x4 __attribute__((ext_vector_type(4)));
typedef unsigned u32x4 __attribute__((ext_vector_type(4)));
typedef unsigned u32x2 __attribute__((ext_vector_type(2)));

constexpr int NTHREADS = 512;
constexpr int LDS_BYTES = 147456;
constexpr int BATCH = 2, SEQ = 8192, DM = 1024, MTOK = BATCH * SEQ;
constexpr int NEXP = 32, LISTCAP = 16384;
constexpr float EPS = 1e-6f;
constexpr float LOG2E = 1.4426950408889634f;

constexpr size_t MiB = 1u << 20;
constexpr size_t WS_CTL = 0;
constexpr size_t WS_MOD = 1 * MiB;
constexpr size_t WS_WT_IN = 2 * MiB;
constexpr size_t WS_WT_UQ = 9 * MiB;
constexpr size_t WS_WT_UKV = 10 * MiB;
constexpr size_t WS_WT_A = 11 * MiB;
constexpr size_t WS_WT_B = 12 * MiB;
constexpr size_t WS_WT_OUT = 13 * MiB;
constexpr size_t WS_WRT = 1 * MiB + 524288;
constexpr size_t WS_COS = 15 * MiB;
constexpr size_t WS_SIN = 16 * MiB;
constexpr size_t WS_SSQ = 17 * MiB;
constexpr size_t WS_LIST = 18 * MiB;
constexpr size_t WS_TOPW = 1835008;
constexpr size_t WS_LISTW = 809 * MiB;
constexpr size_t WS_WT_M1 = 20 * MiB;
constexpr size_t WS_WT_M2 = 148 * MiB;
constexpr size_t WS_XN = 212 * MiB;
constexpr size_t WS_QA = 244 * MiB;
constexpr size_t WS_KA = 260 * MiB;
constexpr size_t WS_VA = 264 * MiB;
constexpr size_t WS_CQ = 268 * MiB;
constexpr size_t WS_CKV = 280 * MiB;
constexpr size_t WS_KR = 288 * MiB;
constexpr size_t WS_GA = 289 * MiB;
constexpr size_t WS_GB = 321 * MiB;
constexpr size_t WS_QN = 353 * MiB;
constexpr size_t WS_QR = 369 * MiB;
constexpr size_t WS_KN = 377 * MiB;
constexpr size_t WS_VB = 393 * MiB;
constexpr size_t WS_AO = 409 * MiB;
constexpr size_t WS_BO = 425 * MiB;
constexpr size_t WS_MIX = 441 * MiB;
constexpr size_t WS_X1 = 473 * MiB;
constexpr size_t WS_HID = 537 * MiB;
constexpr size_t WS_Y = 681 * MiB;
constexpr size_t WS_XN8 = 811 * MiB;
constexpr size_t WS_WT_G8 = 827 * MiB;
constexpr size_t WS_END = 829 * MiB;

struct P {
    const float *x, *c; const int* pos;
    const float *w_ada, *b_ada, *norm_mix, *norm_ffn, *w_in, *sinks, *q_norm, *kv_norm, *w_uq, *w_uk, *w_uv, *w_a, *w_b, *w_out,
        *w_router, *b_router, *w_m1, *b_m1, *w_m2, *b_m2, *fnorm;
    float* out; unsigned char* ws;
};

__device__ __forceinline__ unsigned f2bf(float f) { unsigned u = __float_as_uint(f); return (u + 0x7fffu + ((u >> 16) & 1u)) >> 16; }
__device__ __forceinline__ unsigned pk2(float lo, float hi) { return f2bf(lo) | (f2bf(hi) << 16); }
__device__ __forceinline__ float bf2f(unsigned h) { return __uint_as_float(h << 16); }
__device__ __forceinline__ unsigned pk4_fp8(float a, float b, float c, float d) { int r = __builtin_amdgcn_cvt_pk_fp8_f32(a, b, 0, false); r = __builtin_amdgcn_cvt_pk_fp8_f32(c, d, r, true); return (unsigned)r; }
constexpr float W8_SCALE = 32.f, W8_INV = 0.03125f;
constexpr float MIX8_SCALE = 8.f, OUT8_INV = 1.f / (8.f * 32.f);
__device__ __forceinline__ float wave_sum(float v) {
#pragma unroll
    for (int o = 1; o < 64; o <<= 1) v += __shfl_xor(v, o);
    return v;
}
__device__ __forceinline__ float sigmoidf_(float v) { return __builtin_amdgcn_rcpf(1.f + __builtin_amdgcn_exp2f(-LOG2E * v)); }

__device__ __forceinline__ void ph_mod(const P& p, unsigned char* lds) {
    const int tid = threadIdx.x, lane = tid & 63, wave = tid >> 6;
    float* red = (float*)lds;
    float* mod = (float*)(p.ws + WS_MOD);
    for (int item = blockIdx.x; item < 192; item += gridDim.x) {
        const int n0 = item * 32, cn = lane & 31, kq = lane >> 5;
        float a0 = 0.f, a1 = 0.f;
#pragma unroll 1
        for (int i0 = 0; i0 < 64; i0 += 16) {
            float wv[16];
#pragma unroll
            for (int i = 0; i < 16; ++i) wv[i] = __builtin_nontemporal_load(p.w_ada + (size_t)(wave * 128 + 2 * (i0 + i) + kq) * 6144 + n0 + cn);
#pragma unroll
            for (int i = 0; i < 16; ++i) { const int k = wave * 128 + 2 * (i0 + i) + kq; const float c0 = p.c[k], c1 = p.c[1024 + k];
                a0 += c0 * sigmoidf_(c0) * wv[i]; a1 += c1 * sigmoidf_(c1) * wv[i]; }
        }
        a0 += __shfl_xor(a0, 32); a1 += __shfl_xor(a1, 32);
        if (lane < 32) { red[(wave * 2 + 0) * 32 + cn] = a0; red[(wave * 2 + 1) * 32 + cn] = a1; }
        __syncthreads();
        if (tid < 64) { const int b = tid >> 5, cc = tid & 31; float s = 0.f;
            for (int w = 0; w < 8; ++w) s += red[(w * 2 + b) * 32 + cc];
            mod[b * 6144 + n0 + cc] = s + p.b_ada[n0 + cc]; }
        __syncthreads();
    }
}
__device__ __forceinline__ int ropeperm(int d) { return d < 16 ? 8 * (d >> 2) + (d & 3) : 8 * ((d - 16) >> 2) + 4 + (d & 3); }
__device__ __forceinline__ void transpose_item(const float* W, int N, int K, bf16_t* WT, int k0, int n0, int dst_row0, const float* kscale, float* scr, int lane, bool rperm = false) {
    float tv[32];
#pragma unroll
    for (int i = 0; i < 32; ++i) tv[i] = W[(size_t)(k0 + 2 * i + (lane >> 5)) * N + n0 + (lane & 31)];
#pragma unroll
    for (int i = 0; i < 32; ++i) { const int kk = 2 * i + (lane >> 5); float v = tv[i]; if (kscale) v *= kscale[k0 + kk]; scr[kk * 33 + (lane & 31)] = v; }
    __builtin_amdgcn_s_waitcnt(0); __builtin_amdgcn_wave_barrier();
    const int c = lane & 7;
#pragma unroll
    for (int j = 0; j < 4; ++j) { const int n = (lane >> 3) + 8 * j; const float* s = scr + (8 * c) * 33 + n;
        u32x4 o; o.x = pk2(s[0 * 33], s[1 * 33]); o.y = pk2(s[2 * 33], s[3 * 33]); o.z = pk2(s[4 * 33], s[5 * 33]); o.w = pk2(s[6 * 33], s[7 * 33]);
        *(u32x4*)(WT + (size_t)(dst_row0 + (rperm ? ropeperm(n) : n)) * K + k0 + 8 * c) = o; }
    __builtin_amdgcn_s_waitcnt(0); __builtin_amdgcn_wave_barrier();
}
__device__ __forceinline__ void transpose_item_fp8(const float* W, int N, int K, unsigned char* WT, int k0, int n0, int dst_row0, float* scr, int lane) {
    float tv[32];
#pragma unroll
    for (int i = 0; i < 32; ++i) tv[i] = W[(size_t)(k0 + 2 * i + (lane >> 5)) * N + n0 + (lane & 31)];
#pragma unroll
    for (int i = 0; i < 32; ++i) { const int kk = 2 * i + (lane >> 5); scr[kk * 33 + (lane & 31)] = tv[i] * W8_SCALE; }
    __builtin_amdgcn_s_waitcnt(0); __builtin_amdgcn_wave_barrier();
    const int c = lane & 3;
#pragma unroll
    for (int j = 0; j < 2; ++j) { const int n = (lane >> 2) + 16 * j; const float* sp = scr + (16 * c) * 33 + n;
        u32x4 o; o.x = pk4_fp8(sp[0 * 33], sp[1 * 33], sp[2 * 33], sp[3 * 33]); o.y = pk4_fp8(sp[4 * 33], sp[5 * 33], sp[6 * 33], sp[7 * 33]);
        o.z = pk4_fp8(sp[8 * 33], sp[9 * 33], sp[10 * 33], sp[11 * 33]); o.w = pk4_fp8(sp[12 * 33], sp[13 * 33], sp[14 * 33], sp[15 * 33]);
        *(u32x4*)(WT + (size_t)(dst_row0 + n) * K + k0 + 16 * c) = o; }
    __builtin_amdgcn_s_waitcnt(0); __builtin_amdgcn_wave_barrier();
}
__device__ __forceinline__ int in_colmap(int s) {
    if (s < 768) return s;
    if (s < 1152) return 1024 + (s - 768);
    if (s < 1408) return 768 + (s - 1152);
    if (s < 1440) return s;
    if (s < 2464) return 1536 + (s - 1440);
    return 2560 + (s - 2464);
}
#ifndef BG_CONV
#define BG_CONV 1
#endif
constexpr int BG_I_M1 = 32 * 16 * 64, BG_I_M2 = 32 * 16 * 32, BG_TOTAL = BG_I_M1 + BG_I_M2;
struct BgConv { float r[32]; int item, it, ngw; bool pend; };
__device__ __forceinline__ void bg_decode(const P& p, int item, const float*& W, int& N, unsigned char*& WT, int& k0, int& n0, int& dst) {
    if (item < BG_I_M1) { const int e = item >> 10, q = item & 1023, kb = q >> 6, nb = q & 63; n0 = nb * 32; const int j = n0 & 1023, lin = n0 >> 10;
        dst = (j >> 7) * 256 + lin * 128 + (j & 127); W = p.w_m1 + (size_t)e * 1024 * 2048; N = 2048; WT = p.ws + WS_WT_M1 + (size_t)e * 2048 * 1024; k0 = kb * 64; }
    else { const int r = item - BG_I_M1, e = r >> 9, q = r & 511, kb = q >> 5, nb = q & 31; n0 = nb * 32; dst = n0;
        W = p.w_m2 + (size_t)e * 1024 * 1024; N = 1024; WT = p.ws + WS_WT_M2 + (size_t)e * 1024 * 1024; k0 = kb * 64; }
}
__device__ __forceinline__ void bg_issue(const P& p, BgConv& g, int lane) {
    const float* W; int N, k0, n0, dst; unsigned char* WT; bg_decode(p, g.item, W, N, WT, k0, n0, dst);
    const float* src = W + (size_t)(k0 + (lane >> 5)) * N + n0 + (lane & 31);
#pragma unroll
    for (int i = 0; i < 32; ++i) g.r[i] = __builtin_nontemporal_load(src + (size_t)(2 * i) * N);
}
__device__ __forceinline__ void bg_finish(const P& p, BgConv& g, float* scr, int lane) {
    const float* W; int N, k0, n0, dst; unsigned char* WT; bg_decode(p, g.item, W, N, WT, k0, n0, dst);
    unsigned w[8];
#pragma unroll
    for (int i = 0; i < 16; i += 2) {
        const auto s0 = __builtin_amdgcn_permlane32_swap(__float_as_uint(g.r[i] * W8_SCALE), __float_as_uint(g.r[i + 16] * W8_SCALE), false, false);
        const auto s1 = __builtin_amdgcn_permlane32_swap(__float_as_uint(g.r[i + 1] * W8_SCALE), __float_as_uint(g.r[i + 17] * W8_SCALE), false, false);
        w[i >> 1] = pk4_fp8(__uint_as_float(s0[0]), __uint_as_float(s0[1]), __uint_as_float(s1[0]), __uint_as_float(s1[1]));
    }
    unsigned char* o = WT + (size_t)(dst + (lane & 31)) * 1024 + k0 + 32 * (lane >> 5);
    __builtin_nontemporal_store((u32x4){w[0], w[1], w[2], w[3]}, (u32x4*)o); __builtin_nontemporal_store((u32x4){w[4], w[5], w[6], w[7]}, (u32x4*)(o + 16));
}
__device__ __forceinline__ void bg_step(const P& p, BgConv& g, float* scr, int lane) {
    if ((g.it & 3) == 2 && g.pend) { bg_finish(p, g, scr, lane); g.item += g.ngw; g.pend = false; }
    if ((g.it & 3) == 0 && g.item < BG_TOTAL) { bg_issue(p, g, lane); g.pend = true; }
    ++g.it;
}
__device__ __forceinline__ void bg_step_fin(const P& p, BgConv& g, int lane) { if ((g.it & 3) == 2 && g.pend) { bg_finish(p, g, nullptr, lane); g.item += g.ngw; g.pend = false; } }
__device__ __forceinline__ void bg_step_iss(const P& p, BgConv& g, int lane) { if ((g.it & 3) == 0 && g.item < BG_TOTAL) { bg_issue(p, g, lane); g.pend = true; } ++g.it; }
__device__ __forceinline__ void bg_drain(const P& p, BgConv& g, float* scr, int lane) {
    if (g.pend) { bg_finish(p, g, scr, lane); g.item += g.ngw; g.pend = false; }
    while (g.item < BG_TOTAL) { bg_issue(p, g, lane); bg_finish(p, g, scr, lane); g.item += g.ngw; }
}
__device__ __forceinline__ void ph_convert(const P& p, unsigned char* lds) {
    const int tid = threadIdx.x, lane = tid & 63, wave = tid >> 6;
    const int gw = blockIdx.x * 8 + wave, NGW = gridDim.x * 8;
    float* scr = (float*)(lds + wave * 8704);
    bf16_t* WT_IN = (bf16_t*)(p.ws + WS_WT_IN); bf16_t* WT_UQ = (bf16_t*)(p.ws + WS_WT_UQ); bf16_t* WT_UKV = (bf16_t*)(p.ws + WS_WT_UKV);
    bf16_t* WT_A = (bf16_t*)(p.ws + WS_WT_A); bf16_t* WT_B = (bf16_t*)(p.ws + WS_WT_B); bf16_t* WT_OUT = (bf16_t*)(p.ws + WS_WT_OUT);
    bf16_t* WT_M1 = (bf16_t*)(p.ws + WS_WT_M1); bf16_t* WT_M2 = (bf16_t*)(p.ws + WS_WT_M2);
    constexpr int I_IN = 16 * 109, I_UQ = 6 * 24, I_UK = 4 * 16, I_A = 8 * 32, I_OUT = 16 * 32, I_M1 = 32 * 16 * 64, I_M2 = 32 * 16 * 32;
    constexpr int TOTAL = I_IN + I_UQ + 2 * I_UK + 2 * I_A + I_OUT + (BG_CONV ? 0 : I_M1 + I_M2);
    for (int it = gw; it < TOTAL; it += NGW) {
        int r = it;
        if (r < I_IN) { const int kb = r / 109, nb = r % 109;
            if (nb * 32 < 1440) transpose_item(p.w_in, 3488, 1024, WT_IN, kb * 64, nb * 32, in_colmap(nb * 32), nullptr, scr, lane, nb * 32 == 1408);
            else transpose_item_fp8(p.w_in, 3488, 1024, p.ws + WS_WT_G8, kb * 64, nb * 32, nb * 32 - 1440, scr, lane);
            continue; } r -= I_IN;
        if (r < I_UQ) { const int kb = r / 24, nb = r % 24; const int n0 = nb * 32, hh = n0 / 96, d = n0 % 96;
            const int dst = d < 64 ? hh * 64 + d : 512 + hh * 32; transpose_item(p.w_uq, 768, 384, WT_UQ, kb * 64, n0, dst, p.q_norm, scr, lane, d >= 64); continue; } r -= I_UQ;
        if (r < I_UK) { const int kb = r / 16, nb = r % 16; transpose_item(p.w_uk, 512, 256, WT_UKV, kb * 64, nb * 32, nb * 32, p.kv_norm, scr, lane); continue; } r -= I_UK;
        if (r < I_UK) { const int kb = r / 16, nb = r % 16; transpose_item(p.w_uv, 512, 256, WT_UKV, kb * 64, nb * 32, 512 + nb * 32, p.kv_norm, scr, lane); continue; } r -= I_UK;
        if (r < I_A) { const int kb = r / 32, nb = r % 32; transpose_item(p.w_a, 1024, 1024, WT_A, kb * 64, nb * 32, nb * 32, nullptr, scr, lane); continue; } r -= I_A;
        if (r < I_A) { const int kb = r / 32, nb = r % 32; transpose_item(p.w_b, 1024, 1024, WT_A + 512, kb * 64, nb * 32, nb * 32, nullptr, scr, lane); continue; } r -= I_A;
        if (r < I_OUT) { const int kb = r / 32, nb = r % 32; transpose_item_fp8(p.w_out, 1024, 1024, (unsigned char*)WT_OUT, kb * 64, nb * 32, nb * 32, scr, lane); continue; } r -= I_OUT;
        if (r < I_M1) { const int e = r / 1024, q = r % 1024, kb = q / 64, nb = q % 64; const int n0 = nb * 32, j = n0 & 1023, lin = n0 >> 10;
            const int dst = (j >> 7) * 256 + lin * 128 + (j & 127);
            transpose_item_fp8(p.w_m1 + (size_t)e * 1024 * 2048, 2048, 1024, (unsigned char*)WT_M1 + (size_t)e * 2048 * 1024, kb * 64, n0, dst, scr, lane); continue; } r -= I_M1;
        { const int e = r / 512, q = r % 512, kb = q / 32, nb = q % 32;
            transpose_item_fp8(p.w_m2 + (size_t)e * 1024 * 1024, 1024, 1024, (unsigned char*)WT_M2 + (size_t)e * 1024 * 1024, kb * 64, nb * 32, nb * 32, scr, lane); }
    }
    for (int i = blockIdx.x * NTHREADS + tid; i < 1024 * 32; i += gridDim.x * NTHREADS) { const int k = i >> 5, e = i & 31; ((float*)(p.ws + WS_WRT))[e * 1028 + k] = p.w_router[i]; }
    for (int i = blockIdx.x * NTHREADS + tid; i < 96 * 128; i += gridDim.x * NTHREADS) ((u32x4*)(WT_IN + (size_t)1440 * 1024))[i] = (u32x4){0u, 0u, 0u, 0u};
}

__device__ __forceinline__ void ph_xn(const P& p) {
    const int tid = threadIdx.x, lane = tid & 63, wave = tid >> 6;
    const int gw = blockIdx.x * 8 + wave, NGW = gridDim.x * 8;
    const float* mod = (const float*)(p.ws + WS_MOD);
    bf16_t* XN = (bf16_t*)(p.ws + WS_XN); float* COS = (float*)(p.ws + WS_COS); float* SIN = (float*)(p.ws + WS_SIN);
    for (int m = gw; m < MTOK; m += NGW) {
        const int b = m >> 13;
        const f32x4* xr = (const f32x4*)(p.x + (size_t)m * DM);
        f32x4 v[4]; float s = 0.f;
#pragma unroll
        for (int j = 0; j < 4; ++j) { v[j] = xr[lane + 64 * j]; s += v[j].x * v[j].x + v[j].y * v[j].y + v[j].z * v[j].z + v[j].w * v[j].w; }
        s = wave_sum(s);
        const float rstd = rsqrtf(s * (1.f / DM) + EPS);
#pragma unroll
        for (int j = 0; j < 4; ++j) { const int col = 4 * lane + 256 * j;
            const f32x4 g = *(const f32x4*)(p.norm_mix + col), sc = *(const f32x4*)(mod + b * 6144 + 1024 + col), sh = *(const f32x4*)(mod + b * 6144 + col);
            const f32x4 h = v[j] * rstd * g * (sc + 1.0f) + sh;
            u32x2 o; o.x = pk2(h.x, h.y); o.y = pk2(h.z, h.w); *(u32x2*)(XN + (size_t)m * DM + col) = o;
            *(unsigned*)(p.ws + WS_XN8 + (size_t)m * DM + col) = pk4_fp8(h.x, h.y, h.z, h.w); }
        if (lane < 16) {
            const float freq = exp2f(-(float)lane * 0.8304820237218406f);
            const float ang = (float)p.pos[m] * freq;
            double t = (double)ang * 0.15915494309189535; t -= rint(t);
            const float fr = (float)t;
            COS[m * 16 + lane] = __builtin_amdgcn_cosf(fr); SIN[m * 16 + lane] = __builtin_amdgcn_sinf(fr);
        }
    }
}

namespace pg8 {
#define PG8_LAS __attribute__((address_space(3)))
constexpr int BM = 256, BK = 64, HALF = 128, HTB = HALF * BK * 2, STAGE_BYTES = 8 * HTB, NXCD = 8, WGM = 8;
__device__ __forceinline__ int lds_byte(int r, int c) { const int st = (r >> 4) * 2 + (c >> 5), rr = r & 15, cc = c & 31, ob = rr * 64 + cc * 2; return st * 1024 + (ob ^ (((ob >> 9) & 1) << 5)); }
__device__ __forceinline__ void stage_rc(int b, int& R, int& C) { const int st = b / 1024, sb = b % 1024, swz = sb ^ (((sb >> 9) & 1) << 5); R = (st >> 1) * 16 + swz / 64; C = (st & 1) * 32 + (swz % 64) / 2; }
__device__ __forceinline__ int perm32(int rho) { const int n = rho >> 4, i = rho & 15; return 8 * (i >> 2) + 4 * n + (i & 3); }
struct GUnit { const char* a; const char* b; int pm, pn, e, cnt, tile, pad_; };
typedef float f32x2_t __attribute__((ext_vector_type(2))); typedef __bf16 bf16x2_t __attribute__((ext_vector_type(2)));
__device__ __forceinline__ unsigned cvt_pk_bf16(float lo, float hi) { f32x2_t v = {lo, hi}; bf16x2_t b = __builtin_convertvector(v, bf16x2_t); return __builtin_bit_cast(unsigned, b); }

struct DenseOrder {
    const char* A; const char* Bt; int K, nM, nN, nwg, G, c;
    __device__ void init(const void* A_, const void* Bt_, int M, int N, int K_, int G_, int c_) { A = (const char*)A_; Bt = (const char*)Bt_; K = K_; nM = M / BM; nN = N / BM; nwg = nM * nN; G = G_; c = c_; }
    __device__ bool next(int i, GUnit& u) const {
        const long L = (long)i * G + c; if (L >= nwg) return false;
        int wgid = (int)L; { const int q = nwg / NXCD, r = nwg % NXCD, xcd = wgid % NXCD, off = wgid / NXCD; wgid = (xcd < r ? xcd * (q + 1) : r * (q + 1) + (xcd - r) * q) + off; }
        const int nig = WGM * nN, gid = wgid / nig, fm = gid * WGM, gsz = (nM - fm) < WGM ? (nM - fm) : WGM;
        u.pm = fm + ((wgid % nig) % gsz); u.pn = (wgid % nig) / gsz; u.e = 0; u.cnt = 0; u.tile = 0; u.pad_ = 0;
        u.a = A + (size_t)u.pm * BM * K * 2; u.b = Bt + (size_t)u.pn * BM * K * 2; return true;
    }
    __device__ __forceinline__ unsigned a_rowoff(const GUnit&, int) const { return 0u; }
};

typedef int v8i32 __attribute__((ext_vector_type(8)));
typedef int v4i32 __attribute__((ext_vector_type(4)));
template <class Epi, class Sched, bool ALIGN_EPI, bool GATHER, bool FP8 = false>
__device__ __forceinline__ void gemm_phase(PG8_LAS unsigned char* lds, const int K, const Sched& S, const Epi& E) {
    int tid_ = threadIdx.x; asm volatile("" : "+v"(tid_));
    const int tid = tid_, wid = __builtin_amdgcn_readfirstlane(tid >> 6), lane = tid & 63, wr = wid >> 2, wc = wid & 3, fr = lane & 15, fq = lane >> 4;
    const int nt = K / BK;
    int RA[2]; unsigned CA[2], voffB[2];
#pragma unroll
    for (int i = 0; i < 2; ++i) { int R, C; stage_rc(tid * 16 + i * 8192, R, C); const int Rb = Epi::PERM ? ((R & ~31) + perm32(R & 31)) : R;
        RA[i] = R; CA[i] = (unsigned)C * 2u; voffB[i] = (unsigned)(Rb * K + C) * 2u; }
    const size_t kstep = (size_t)(BK * 2);
    const size_t hstep = (size_t)HALF * K * 2;
    const unsigned ldsw = (unsigned)wid * 1024u;
    const int aoff = lds_byte(wr * 64 + fr, FP8 ? fq * 16 : fq * 8), boff = lds_byte(wc * 32 + fr, FP8 ? fq * 16 : fq * 8);
#define PG8_SA(b, h) (((b) * 2 + (h)) * HTB)
#define PG8_SB(b, h) ((4 + (b) * 2 + (h)) * HTB)
#define PG8_STAGE(bufoff, gbase, voff) do { _Pragma("unroll") for (int _i = 0; _i < 2; ++_i) { unsigned o_ = (voff)[_i]; asm volatile("" : "+v"(o_));     \
        __builtin_amdgcn_global_load_lds((const unsigned*)((const char*)(gbase) + o_), (PG8_LAS unsigned*)(lds + (bufoff) + ldsw + _i * 8192), 16, 0, 0); } } while (0)
#define PG8_LD16(p) (*(const PG8_LAS v4i32*)(p))
#define PG8_LDA(dst, b, h) do { if constexpr (FP8) { _Pragma("unroll") for (int m = 0; m < 4; ++m) { const PG8_LAS unsigned char* p_ = lds + PG8_SA(b, h) + aoff + m * 2048; \
            dst##8[m] = __builtin_shufflevector(PG8_LD16(p_), PG8_LD16(p_ + 16), 0, 1, 2, 3, 4, 5, 6, 7); } } \
        else { _Pragma("unroll") for (int m = 0; m < 4; ++m) _Pragma("unroll") for (int k = 0; k < 2; ++k) dst[m][k] = *(const PG8_LAS bf16x8*)(lds + PG8_SA(b, h) + aoff + m * 2048 + k * 1024); } } while (0)
#define PG8_LDB(dst, b, h) do { if constexpr (FP8) { _Pragma("unroll") for (int n = 0; n < 2; ++n) { const PG8_LAS unsigned char* p_ = lds + PG8_SB(b, h) + boff + n * 2048; \
            dst##8[n] = __builtin_shufflevector(PG8_LD16(p_), PG8_LD16(p_ + 16), 0, 1, 2, 3, 4, 5, 6, 7); } } \
        else { _Pragma("unroll") for (int n = 0; n < 2; ++n) _Pragma("unroll") for (int k = 0; k < 2; ++k) dst[n][k] = *(const PG8_LAS bf16x8*)(lds + PG8_SB(b, h) + boff + n * 2048 + k * 1024); } } while (0)
#define PG8_MMA(ai, bj, At, Bt) do { __builtin_amdgcn_s_setprio(1); \
        if constexpr (FP8) { _Pragma("unroll") for (int m = 0; m < 4; ++m) _Pragma("unroll") for (int n = 0; n < 2; ++n) \
                asm volatile("v_mfma_scale_f32_16x16x128_f8f6f4 %0, %1, %2, %0, %3, %3 op_sel_hi:[0,0,0]" : "+v"(acc[ai][bj][m][n]) : "v"(Bt##8[n]), "v"(At##8[m]), "v"(scl8)); } \
        else { _Pragma("unroll") for (int m = 0; m < 4; ++m) _Pragma("unroll") for (int n = 0; n < 2; ++n) _Pragma("unroll") for (int k = 0; k < 2; ++k) \
                acc[ai][bj][m][n] = __builtin_amdgcn_mfma_f32_16x16x32_bf16(Bt[n][k], At[m][k], acc[ai][bj][m][n], 0, 0, 0); } \
        __builtin_amdgcn_s_setprio(0); } while (0)
#define PG8_WAIT_V(n) asm volatile("s_waitcnt vmcnt(" #n ")" ::: "memory")
#define PG8_WAIT_L(n) asm volatile("s_waitcnt lgkmcnt(" #n ")" ::: "memory")
#define PG8_BAR __builtin_amdgcn_s_barrier()
#define PG8_SCHED __builtin_amdgcn_sched_barrier(0)
#define PG8_VOFF(u, v) do { _Pragma("unroll") for (int _i = 0; _i < 2; ++_i) { int r_ = RA[_i]; if (GATHER) asm volatile("" : "+v"(r_));     \
        _Pragma("unroll") for (int _h = 0; _h < 2; ++_h) v[_h][_i] = GATHER ? (S.a_rowoff(u, _h * HALF + r_) + CA[_i]) : ((unsigned)((_h * HALF + r_) * K) * 2u + CA[_i]); } } while (0)
    GUnit cur, nxt; int ui = 0;
    if (!S.next(0, cur)) return;
    f32x4 acc[2][2][4][2];
#pragma unroll
    for (int a = 0; a < 2; ++a)
#pragma unroll
        for (int b = 0; b < 2; ++b)
#pragma unroll
            for (int m = 0; m < 4; ++m)
#pragma unroll
                for (int n = 0; n < 2; ++n) acc[a][b][m][n] = (f32x4){0.f, 0.f, 0.f, 0.f};
    bf16x8 At[4][2], B0[2][2], B1[2][2];
    v8i32 At8[4], B08[2], B18[2];
    const int scl8 = 0x7f7f7f7f;
    unsigned vAc[2][2], vAn[2][2];
    PG8_VOFF(cur, vAc);
    if (GATHER) { asm volatile("s_waitcnt vmcnt(0)" : "+v"(vAc[0][0]), "+v"(vAc[0][1]), "+v"(vAc[1][0]), "+v"(vAc[1][1]) :: "memory"); }
    const char* cA = cur.a; const char* cB = cur.b;
    PG8_STAGE(PG8_SB(0, 0), cB, voffB); PG8_STAGE(PG8_SB(0, 1), cB + hstep, voffB); PG8_STAGE(PG8_SA(0, 0), cA, vAc[0]); PG8_STAGE(PG8_SA(0, 1), cA, vAc[1]);
    if (wr == 1) PG8_BAR;
    PG8_WAIT_V(2); PG8_BAR;
    PG8_STAGE(PG8_SB(1, 0), cB + kstep, voffB); PG8_STAGE(PG8_SA(1, 0), cA + kstep, vAc[0]); PG8_STAGE(PG8_SB(1, 1), cB + hstep + kstep, voffB);
    PG8_WAIT_V(6); PG8_BAR;
    for (;;) {
        const bool has_next = S.next(ui + 1, nxt);
        const char* nA = has_next ? nxt.a : cA; const char* nB = has_next ? nxt.b : cB;
        if (GATHER) {
            if (has_next) { PG8_VOFF(nxt, vAn); }
            else {
#pragma unroll
                for (int h = 0; h < 2; ++h)
#pragma unroll
                    for (int i = 0; i < 2; ++i) vAn[h][i] = vAc[h][i]; }
            asm volatile("s_waitcnt vmcnt(0)" : "+v"(vAn[0][0]), "+v"(vAn[0][1]), "+v"(vAn[1][0]), "+v"(vAn[1][1]) :: "memory");
        }
#pragma unroll 1
        for (int t = 0; t < nt; t += 2) {
            const bool last = (t == nt - 2);
            if constexpr (Epi::HAS_MID) { if (t == (nt >> 1)) { int t_ = threadIdx.x; asm volatile("" : "+v"(t_)); E.mid(acc, cur, wr, wc, t_ & 15, (t_ >> 4) & 3); } }
            const char* a1 = cA + (size_t)(t + 1) * kstep;
            const char* a2 = last ? nA : cA + (size_t)(t + 2) * kstep; const char* b2 = last ? nB : cB + (size_t)(t + 2) * kstep;
            const char* a3 = a2 + kstep; const char* b3 = b2 + kstep;
            unsigned v2[2][2];
#pragma unroll
            for (int h = 0; h < 2; ++h)
#pragma unroll
                for (int i = 0; i < 2; ++i) v2[h][i] = (GATHER && last) ? vAn[h][i] : vAc[h][i];
            PG8_LDB(B0, 0, 0); PG8_LDB(B1, 0, 1); PG8_SCHED; PG8_LDA(At, 0, 0); PG8_STAGE(PG8_SA(1, 1), a1, vAc[1]);
            PG8_WAIT_V(8); PG8_WAIT_L(0); PG8_BAR; PG8_MMA(0, 0, At, B0); PG8_MMA(0, 1, At, B1); PG8_BAR; PG8_SCHED;
            PG8_LDA(At, 0, 1); PG8_STAGE(PG8_SB(0, 0), b2, voffB); PG8_STAGE(PG8_SB(0, 1), b2 + hstep, voffB); PG8_STAGE(PG8_SA(0, 0), a2, v2[0]);
            PG8_WAIT_V(8); PG8_WAIT_L(0); PG8_BAR; PG8_MMA(1, 0, At, B0); PG8_MMA(1, 1, At, B1); PG8_BAR; PG8_SCHED;
            PG8_LDB(B0, 1, 0); PG8_LDB(B1, 1, 1); PG8_SCHED; PG8_LDA(At, 1, 0); PG8_STAGE(PG8_SA(0, 1), a2, v2[1]);
            PG8_WAIT_V(8); PG8_WAIT_L(0); PG8_BAR; PG8_MMA(0, 0, At, B0); PG8_MMA(0, 1, At, B1); PG8_BAR; PG8_SCHED;
            PG8_LDA(At, 1, 1); PG8_STAGE(PG8_SB(1, 0), b3, voffB); PG8_STAGE(PG8_SB(1, 1), b3 + hstep, voffB); PG8_STAGE(PG8_SA(1, 0), a3, v2[0]);
            PG8_WAIT_V(8); PG8_WAIT_L(0); PG8_BAR; PG8_MMA(1, 0, At, B0); PG8_MMA(1, 1, At, B1); PG8_BAR; PG8_SCHED;
        }
        if constexpr (FP8) {
            asm volatile("s_nop 15\n\ts_nop 15" ::: "memory");
#pragma unroll
            for (int a = 0; a < 2; ++a)
#pragma unroll
                for (int b = 0; b < 2; ++b)
#pragma unroll
                    for (int m = 0; m < 4; ++m) asm volatile("" : "+v"(acc[a][b][m][0]), "+v"(acc[a][b][m][1]));
        }
        if constexpr (ALIGN_EPI) { if (wr == 0) PG8_BAR; }
        { int t_ = threadIdx.x; asm volatile("" : "+v"(t_));
          E(acc, cur, wr, wc, t_ & 15, (t_ >> 4) & 3); }
        if (!has_next) break;
#pragma unroll
        for (int a = 0; a < 2; ++a)
#pragma unroll
            for (int b = 0; b < 2; ++b)
#pragma unroll
                for (int m = 0; m < 4; ++m)
#pragma unroll
                    for (int n = 0; n < 2; ++n) acc[a][b][m][n] = (f32x4){0.f, 0.f, 0.f, 0.f};
        cur = nxt; cA = nA; cB = nB; ++ui;
#pragma unroll
        for (int h = 0; h < 2; ++h)
#pragma unroll
            for (int i = 0; i < 2; ++i) vAc[h][i] = vAn[h][i];
        if constexpr (ALIGN_EPI) { if (wr == 1) PG8_BAR; }
    }
    PG8_WAIT_V(0);
    if constexpr (!ALIGN_EPI) { if (wr == 0) PG8_BAR; }
    PG8_BAR;
#undef PG8_SA
#undef PG8_SB
#undef PG8_STAGE
#undef PG8_LDA
#undef PG8_LDB
#undef PG8_MMA
#undef PG8_LD16
#undef PG8_WAIT_V
#undef PG8_WAIT_L
#undef PG8_BAR
#undef PG8_SCHED
#undef PG8_VOFF
}
}
#define LAS __attribute__((address_space(3)))
__device__ __forceinline__ u32x4 pack8(const f32x4& v0, const f32x4& v1) { u32x4 w; w.x = pg8::cvt_pk_bf16(v0[0], v0[1]); w.y = pg8::cvt_pk_bf16(v0[2], v0[3]); w.z = pg8::cvt_pk_bf16(v1[0], v1[1]); w.w = pg8::cvt_pk_bf16(v1[2], v1[3]); return w; }
__device__ __forceinline__ void unpack8(const u32x4& w, f32x4& v0, f32x4& v1) { v0 = (f32x4){bf2f(w.x & 0xffffu), bf2f(w.x >> 16), bf2f(w.y & 0xffffu), bf2f(w.y >> 16)}; v1 = (f32x4){bf2f(w.z & 0xffffu), bf2f(w.z >> 16), bf2f(w.w & 0xffffu), bf2f(w.w >> 16)}; }
__device__ __forceinline__ float sigs_(float a) { return __builtin_amdgcn_rcpf(1.f + __builtin_amdgcn_exp2f(a * (-LOG2E * W8_INV))); }
__device__ __forceinline__ f32x4 sig4s(const f32x4& v) { return (f32x4){sigs_(v[0]), sigs_(v[1]), sigs_(v[2]), sigs_(v[3])}; }
__device__ __forceinline__ f32x4 sig4(const f32x4& v) { return (f32x4){sigmoidf_(v[0]), sigmoidf_(v[1]), sigmoidf_(v[2]), sigmoidf_(v[3])}; }

struct EpiProj {
    static constexpr bool PERM = true, HAS_MID = false;
    unsigned char* ws;
    __device__ __forceinline__ void operator()(const f32x4 (&acc)[2][2][4][2], const pg8::GUnit& u, int wr, int wc, int fr, int fq) const {
        const int row0 = u.pm * 256 + wr * 64 + fr;
#pragma unroll
        for (int bj = 0; bj < 2; ++bj) {
            const int cl = bj * 128 + wc * 32 + 8 * fq;
            bf16_t* base; int ld, c; float sc = 1.f; bool sg = false;
            const int pn = u.pn;
            if (pn < 2) { base = (bf16_t*)(ws + WS_QA); ld = 512; c = pn * 256 + cl; sc = 0.125f * LOG2E; }
            else if (pn == 2) { base = (bf16_t*)(ws + (bj == 0 ? WS_KA : WS_VA)); ld = 128; c = wc * 32 + 8 * fq; }
            else if (pn == 3) { base = (bf16_t*)(ws + WS_CKV); ld = 256; c = cl; }
            else if (pn == 4) { base = (bf16_t*)(ws + WS_CQ); ld = 384; c = cl; }
            else if (pn == 5) { if (bj == 0) { base = (bf16_t*)(ws + WS_CQ); ld = 384; c = 256 + wc * 32 + 8 * fq; } else { if (wc != 0) continue; base = (bf16_t*)(ws + WS_KR); ld = 32; c = 8 * fq; } }
            else if (pn < 10) { base = (bf16_t*)(ws + WS_GA); ld = 1024; c = (pn - 6) * 256 + cl; sg = true; }
            else { base = (bf16_t*)(ws + WS_GB); ld = 1024; c = (pn - 10) * 256 + cl; sg = true; }
            const bool is_kr = pn == 5 && bj == 1;
#pragma unroll
            for (int ai = 0; ai < 2; ++ai)
#pragma unroll
                for (int m = 0; m < 4; ++m) { f32x4 v0 = acc[ai][bj][m][0], v1 = acc[ai][bj][m][1]; const int row = row0 + ai * 128 + m * 16;
                    if (is_kr) { const f32x4 cs = *(const f32x4*)((const float*)(ws + WS_COS) + row * 16 + 4 * fq), sn = *(const f32x4*)((const float*)(ws + WS_SIN) + row * 16 + 4 * fq);
                        const f32x4 o1 = v0 * cs - v1 * sn, o2 = v1 * cs + v0 * sn; v0 = o1; v1 = o2; }
                    else if (sg) { v0 = sig4(v0); v1 = sig4(v1); } else { v0 = v0 * sc; v1 = v1 * sc; }
                    *(u32x4*)(base + (size_t)row * ld + c) = pack8(v0, v1); }
        }
        if (u.pn >= 3 && u.pn <= 5) {
            float* SSQ = (float*)(ws + WS_SSQ);
#pragma unroll
            for (int ai = 0; ai < 2; ++ai)
#pragma unroll
                for (int m = 0; m < 4; ++m) { float q = 0.f;
#pragma unroll
                    for (int bj = 0; bj < 2; ++bj) { if (u.pn == 5 && bj == 1) continue;
#pragma unroll
                        for (int n = 0; n < 2; ++n) { const f32x4 v = acc[ai][bj][m][n]; q += (v[0] * v[0] + v[1] * v[1]) + (v[2] * v[2] + v[3] * v[3]); } }
                    q += __shfl_xor(q, 16); q += __shfl_xor(q, 32);
                    const int slot = u.pn == 3 ? 8 + wc : u.pn == 4 ? wc : 4 + wc;
                    if (fq == 0) SSQ[slot * MTOK + row0 + ai * 128 + m * 16] = q; }
        }
    }
};
struct EpiUpQ {
    static constexpr bool PERM = true, HAS_MID = false;
    unsigned char* ws;
    __device__ __forceinline__ void operator()(const f32x4 (&acc)[2][2][4][2], const pg8::GUnit& u, int wr, int wc, int fr, int fq) const {
        const float qs0 = 0.10206207261596577f * LOG2E;
        const int row0 = u.pm * 256 + wr * 64 + fr;
        const float* COS = (const float*)(ws + WS_COS); const float* SIN = (const float*)(ws + WS_SIN); const float* SSQ = (const float*)(ws + WS_SSQ);
        float rq[2][4];
#pragma unroll
        for (int ai = 0; ai < 2; ++ai)
#pragma unroll
            for (int m = 0; m < 4; ++m) { const int row = row0 + ai * 128 + m * 16; float q = 0.f;
#pragma unroll
                for (int sl = 0; sl < 8; ++sl) q += SSQ[sl * MTOK + row];
                rq[ai][m] = rsqrtf(q * (1.f / 384.f) + EPS); }
#pragma unroll
        for (int bj = 0; bj < 2; ++bj) { const int cl = bj * 128 + wc * 32 + 8 * fq;
#pragma unroll
            for (int ai = 0; ai < 2; ++ai)
#pragma unroll
                for (int m = 0; m < 4; ++m) { const int row = row0 + ai * 128 + m * 16; f32x4 v0 = acc[ai][bj][m][0], v1 = acc[ai][bj][m][1];
                    const float qs = qs0 * rq[ai][m];
                    if (u.pn < 2) { *(u32x4*)((bf16_t*)(ws + WS_QN) + (size_t)row * 512 + u.pn * 256 + cl) = pack8(v0 * qs, v1 * qs); }
                    else { const f32x4 cs = *(const f32x4*)(COS + row * 16 + 4 * fq), sn = *(const f32x4*)(SIN + row * 16 + 4 * fq);
                        const f32x4 o1 = (v0 * cs - v1 * sn) * qs, o2 = (v1 * cs + v0 * sn) * qs;
                        *(u32x4*)((bf16_t*)(ws + WS_QR) + (size_t)row * 256 + cl) = pack8(o1, o2); }
                    asm volatile("" ::: "memory"); }
        }
    }
};
struct EpiUpKV {
    static constexpr bool PERM = true, HAS_MID = false;
    unsigned char* ws;
    __device__ __forceinline__ void operator()(const f32x4 (&acc)[2][2][4][2], const pg8::GUnit& u, int wr, int wc, int fr, int fq) const {
        const int row0 = u.pm * 256 + wr * 64 + fr;
        bf16_t* base = (bf16_t*)(ws + (u.pn < 2 ? WS_KN : WS_VB)); const float* SSQ = (const float*)(ws + WS_SSQ);
        float rk[2][4];
#pragma unroll
        for (int ai = 0; ai < 2; ++ai)
#pragma unroll
            for (int m = 0; m < 4; ++m) { const int row = row0 + ai * 128 + m * 16;
                const float q = (SSQ[8 * MTOK + row] + SSQ[9 * MTOK + row]) + (SSQ[10 * MTOK + row] + SSQ[11 * MTOK + row]);
                rk[ai][m] = rsqrtf(q * (1.f / 256.f) + EPS); }
#pragma unroll
        for (int bj = 0; bj < 2; ++bj) { const int c = (u.pn & 1) * 256 + bj * 128 + wc * 32 + 8 * fq;
#pragma unroll
            for (int ai = 0; ai < 2; ++ai)
#pragma unroll
                for (int m = 0; m < 4; ++m) *(u32x4*)(base + (size_t)(row0 + ai * 128 + m * 16) * 512 + c) = pack8(acc[ai][bj][m][0] * rk[ai][m], acc[ai][bj][m][1] * rk[ai][m]); }
    }
};
struct EpiMixF {
    static constexpr bool PERM = true, HAS_MID = true;
    unsigned char* ws;
    __device__ __forceinline__ void mid(f32x4 (&acc)[2][2][4][2], const pg8::GUnit& u, int wr, int wc, int fr, int fq) const {
        const int row0 = u.pm * 256 + wr * 64 + fr;
        const bf16_t* GA = (const bf16_t*)(ws + WS_GA); const bf16_t* GB = (const bf16_t*)(ws + WS_GB);
#pragma unroll
        for (int bj = 0; bj < 2; ++bj) { const int c = u.pn * 256 + bj * 128 + wc * 32 + 8 * fq;
#pragma unroll
            for (int ai = 0; ai < 2; ++ai)
#pragma unroll
                for (int m = 0; m < 4; ++m) { const size_t idx = (size_t)(row0 + ai * 128 + m * 16) * 1024 + c;
                    f32x4 a0, a1, b0, b1; unpack8(*(const u32x4*)(GA + idx), a0, a1); unpack8(*(const u32x4*)(GB + idx), b0, b1);
#pragma unroll
                    for (int i = 0; i < 4; ++i) { acc[ai][bj][m][0][i] *= a0[i] * __builtin_amdgcn_rcpf(fmaxf(b0[i], 1e-30f)); acc[ai][bj][m][1][i] *= a1[i] * __builtin_amdgcn_rcpf(fmaxf(b1[i], 1e-30f)); }
                    if (m == 3) asm volatile("" ::: "memory"); } }
    }
    __device__ __forceinline__ void operator()(const f32x4 (&acc)[2][2][4][2], const pg8::GUnit& u, int wr, int wc, int fr, int fq) const {
        const int row0 = u.pm * 256 + wr * 64 + fr;
        const bf16_t* GB = (const bf16_t*)(ws + WS_GB); bf16_t* MIX = (bf16_t*)(ws + WS_MIX);
#pragma unroll
        for (int bj = 0; bj < 2; ++bj) { const int c = u.pn * 256 + bj * 128 + wc * 32 + 8 * fq;
#pragma unroll
            for (int ai = 0; ai < 2; ++ai)
#pragma unroll
                for (int m = 0; m < 4; ++m) { const size_t idx = (size_t)(row0 + ai * 128 + m * 16) * 1024 + c;
                    f32x4 g0, g1; unpack8(*(const u32x4*)(GB + idx), g0, g1);
                    const f32x4 y0 = g0 * acc[ai][bj][m][0] * MIX8_SCALE, y1 = g1 * acc[ai][bj][m][1] * MIX8_SCALE;
                    u32x2 o8; o8.x = pk4_fp8(y0[0], y0[1], y0[2], y0[3]); o8.y = pk4_fp8(y1[0], y1[1], y1[2], y1[3]);
                    *(u32x2*)((unsigned char*)MIX + idx) = o8; if (m & 1) asm volatile("" ::: "memory"); } }
    }
};
struct EpiOut {
    static constexpr bool PERM = true, HAS_MID = false;
    unsigned char* ws; const float* x;
    __device__ __forceinline__ void operator()(const f32x4 (&acc)[2][2][4][2], const pg8::GUnit& u, int wr, int wc, int fr, int fq) const {
        const int row0 = u.pm * 256 + wr * 64 + fr; const int b = (u.pm * 256) >> 13;
        const float* mod = (const float*)(ws + WS_MOD); bf16_t* X1 = (bf16_t*)(ws + WS_X1);
#pragma unroll
        for (int bj = 0; bj < 2; ++bj) { const int c = u.pn * 256 + bj * 128 + wc * 32 + 8 * fq;
            const f32x4 g0 = *(const f32x4*)(mod + b * 6144 + 2048 + c) * OUT8_INV, g1 = *(const f32x4*)(mod + b * 6144 + 2048 + c + 4) * OUT8_INV;
#pragma unroll
            for (int ai = 0; ai < 2; ++ai)
#pragma unroll
                for (int m = 0; m < 4; ++m) { const size_t idx = (size_t)(row0 + ai * 128 + m * 16) * 1024 + c;
                    const f32x4 x0 = *(const f32x4*)(x + idx), x1 = *(const f32x4*)(x + idx + 4);
                    *(u32x4*)(X1 + idx) = pack8(x0 + g0 * acc[ai][bj][m][0], x1 + g1 * acc[ai][bj][m][1]); if (m & 1) asm volatile("" ::: "memory"); } }
    }
};

constexpr int RT_LD = 1028;
__device__ __forceinline__ void ph_route(const P& p, unsigned char* lds, bool commit = true) {
    const int tid = threadIdx.x, lane = tid & 63, wave = tid >> 6, e = lane & 31, hf = lane >> 5;
    const int RPW = MTOK / gridDim.x;
    float* h2s = (float*)lds;
    unsigned* lcnt = (unsigned*)(lds + 132096); unsigned* lbase = lcnt + 32; unsigned* lent = lcnt + 64; float* lw = (float*)(lcnt + 64 + 256);
    float* lg = (float*)(lcnt + 64 + 512) + wave * 128 + hf * 64;
    if (tid < NEXP) lcnt[tid] = 0u;
    const float* mod = (const float*)(p.ws + WS_MOD); const bf16_t* X1 = (const bf16_t*)(p.ws + WS_X1); unsigned char* H2 = p.ws + WS_XN;
    unsigned* cnt = (unsigned*)(p.ws + WS_CTL); unsigned* LIST = (unsigned*)(p.ws + WS_LIST); float* LISTW = (float*)(p.ws + WS_LISTW);
    float wreg[64];
#pragma unroll
    for (int kk = 0; kk < 64; ++kk) wreg[kk] = p.w_router[(size_t)(128 * wave + 2 * kk + hf) * 32 + e];
    const float brt = p.b_router[e];
    for (int pass = 0; pass * 32 < RPW; ++pass) {
        u32x2 xw[4][4];
#pragma unroll
        for (int rr = 0; rr < 4; ++rr) { const u32x2* xr = (const u32x2*)(X1 + (size_t)(blockIdx.x * RPW + pass * 32 + 4 * wave + rr) * DM);
#pragma unroll
            for (int j = 0; j < 4; ++j) xw[rr][j] = xr[lane + 64 * j]; }
#pragma unroll
        for (int rr = 0; rr < 4; ++rr) {
            const int rl = 4 * wave + rr, m = blockIdx.x * RPW + pass * 32 + rl, b = m >> 13;
            f32x4 v[4]; float s = 0.f;
#pragma unroll
            for (int j = 0; j < 4; ++j) { const u32x2 w = xw[rr][j]; v[j] = (f32x4){bf2f(w.x & 0xffffu), bf2f(w.x >> 16), bf2f(w.y & 0xffffu), bf2f(w.y >> 16)};
                s += v[j].x * v[j].x + v[j].y * v[j].y + v[j].z * v[j].z + v[j].w * v[j].w; }
            s = wave_sum(s);
            const float rstd = rsqrtf(s * (1.f / DM) + EPS);
#pragma unroll
            for (int j = 0; j < 4; ++j) { const int col = 4 * lane + 256 * j;
                const f32x4 g = *(const f32x4*)(p.norm_ffn + col), sc = *(const f32x4*)(mod + b * 6144 + 4096 + col), sh = *(const f32x4*)(mod + b * 6144 + 3072 + col);
                v[j] = v[j] * rstd * g * (sc + 1.0f) + sh;
                *(unsigned*)(H2 + (size_t)m * DM + col) = pk4_fp8(v[j].x, v[j].y, v[j].z, v[j].w);
                *(f32x4*)(h2s + rl * RT_LD + col) = v[j]; }
        }
        __syncthreads();
        typedef float f32x16r __attribute__((ext_vector_type(16)));
        f32x16r acc;
#pragma unroll
        for (int r = 0; r < 16; ++r) acc[r] = 0.f;
        const float* ap = h2s + e * RT_LD + 128 * wave + hf;
#pragma unroll
        for (int kk = 0; kk < 64; ++kk) acc = __builtin_amdgcn_mfma_f32_32x32x2f32(ap[2 * kk], wreg[kk], acc, 0, 0, 0);
        __syncthreads();
#pragma unroll
        for (int r = 0; r < 16; ++r) h2s[(wave * 32 + ((r & 3) + 8 * (r >> 2) + 4 * hf)) * 32 + e] = acc[r];
        __syncthreads();
#pragma unroll 1
        for (int it = 0; it < 2; ++it) {
            const int rl = 4 * wave + 2 * it + hf, ri = pass * 32 + rl;
            float val = brt;
#pragma unroll
            for (int w8 = 0; w8 < 8; ++w8) val += h2s[(w8 * 32 + rl) * 32 + e];
            lg[e] = val;
            int rank = 0;
#pragma unroll
            for (int e4 = 0; e4 < 8; ++e4) { const f32x4 o = *(const f32x4*)(lg + 4 * e4);
#pragma unroll
                for (int i = 0; i < 4; ++i) { const int ee = 4 * e4 + i; rank += (o[i] > val || (o[i] == val && ee < e)) ? 1 : 0; } }
            if (rank < 4) { lg[32 + rank] = val; lg[36 + rank] = __int_as_float(e); }
            const f32x4 tvv = *(const f32x4*)(lg + 32), tiv = *(const f32x4*)(lg + 36);
            const float e1 = __expf(tvv[1] - tvv[0]), e2 = __expf(tvv[2] - tvv[0]), e3 = __expf(tvv[3] - tvv[0]);
            const float inv = 1.f / (1.f + e1 + e2 + e3);
            if (e < 4) {
                const int ex = __float_as_int(e == 0 ? tiv[0] : e == 1 ? tiv[1] : e == 2 ? tiv[2] : tiv[3]);
                const float w = (e == 0 ? 1.f : e == 1 ? e1 : e == 2 ? e2 : e3) * inv;
                const unsigned lr = atomicAdd(&lcnt[ex], 1u);
                lent[ri * 4 + e] = (unsigned)ex | (lr << 8); lw[ri * 4 + e] = w;
            }
        }
        __syncthreads();
    }
    if (!commit) return;
    if (tid < NEXP) lbase[tid] = atomicAdd(&cnt[tid * 64], lcnt[tid]);
    __syncthreads();
    for (int a = tid; a < RPW * 4; a += NTHREADS) {
        const unsigned en = lent[a]; const int ex = (int)(en & 255u); const unsigned pos = lbase[ex] + (en >> 8);
        LIST[(size_t)ex * LISTCAP + pos] = (unsigned)((blockIdx.x * RPW + (a >> 2)) * 4 + (a & 3));
        ((float*)(p.ws + WS_TOPW))[(size_t)blockIdx.x * RPW * 4 + a] = lw[a];
    }
}
__device__ __forceinline__ void ph_final(const P& p) {
    const int tid = threadIdx.x, lane = tid & 63, wave = tid >> 6;
    const int gw = blockIdx.x * 8 + wave, NGW = gridDim.x * 8;
    const float* mod = (const float*)(p.ws + WS_MOD); const bf16_t* X1 = (const bf16_t*)(p.ws + WS_X1); const unsigned char* Y = (const unsigned char*)(p.ws + WS_Y);
    for (int m = gw; m < MTOK; m += NGW) {
        const int b = m >> 13;
        const u32x2* xr = (const u32x2*)(X1 + (size_t)m * DM);
        f32x4 v[4]; float s = 0.f;
        const f32x4 tw = *(const f32x4*)((const float*)(p.ws + WS_TOPW) + (size_t)m * 4);
#pragma unroll
        for (int j = 0; j < 4; ++j) { const int col = 4 * lane + 256 * j;
            f32x4 y = (f32x4){0.f, 0.f, 0.f, 0.f};
#pragma unroll
            for (int k = 0; k < 4; ++k) { const int w = (int)__builtin_nontemporal_load((const unsigned*)(Y + ((size_t)m * 4 + k) * 1024 + col));
                y.x += tw[k] * __builtin_amdgcn_cvt_f32_fp8(w, 0); y.y += tw[k] * __builtin_amdgcn_cvt_f32_fp8(w, 1); y.z += tw[k] * __builtin_amdgcn_cvt_f32_fp8(w, 2); y.w += tw[k] * __builtin_amdgcn_cvt_f32_fp8(w, 3); }
            const f32x4 g2 = *(const f32x4*)(mod + b * 6144 + 5120 + col);
            const u32x2 xw = xr[lane + 64 * j];
            v[j] = (f32x4){bf2f(xw.x & 0xffffu), bf2f(xw.x >> 16), bf2f(xw.y & 0xffffu), bf2f(xw.y >> 16)} + g2 * y;
            s += v[j].x * v[j].x + v[j].y * v[j].y + v[j].z * v[j].z + v[j].w * v[j].w; }
        s = wave_sum(s);
        const float rstd = rsqrtf(s * (1.f / DM) + EPS);
#pragma unroll
        for (int j = 0; j < 4; ++j) { const int col = 4 * lane + 256 * j; const f32x4 g = *(const f32x4*)(p.fnorm + col);
            *(f32x4*)(p.out + (size_t)m * DM + col) = v[j] * rstd * g; }
    }
}


struct EpiGate {
    static constexpr bool PERM = true, HAS_MID = false;
    unsigned char* ws;
    __device__ __forceinline__ void operator()(const f32x4 (&acc)[2][2][4][2], const pg8::GUnit& u, int wr, int wc, int fr, int fq) const {
        const int row0 = u.pm * 256 + wr * 64 + fr;
        bf16_t* base = (bf16_t*)(ws + (u.pn < 4 ? WS_GA : WS_GB));
#pragma unroll
        for (int bj = 0; bj < 2; ++bj) { const int c = (u.pn & 3) * 256 + bj * 128 + wc * 32 + 8 * fq;
#pragma unroll
            for (int ai = 0; ai < 2; ++ai)
#pragma unroll
                for (int m = 0; m < 4; ++m) *(u32x4*)(base + (size_t)(row0 + ai * 128 + m * 16) * 1024 + c) = pack8(sig4s(acc[ai][bj][m][0]), sig4s(acc[ai][bj][m][1])); }
    }
};
struct GateOrder {
    const char* A; const char* Bt; int G, c;
    __device__ __forceinline__ bool next(int i, pg8::GUnit& u) const {
        int un;
        if (G == 256) { if (c < 128) { if (i > 0) return false; un = c; } else { if (i > 2) return false; un = 128 + 3 * (c - 128) + i; } }
        else { un = i * G + c; if (un >= 512) return false; }
        u.pm = un >> 3; u.pn = un & 7; u.e = 0; u.cnt = 0; u.tile = 0; u.pad_ = 0;
        u.a = A + (size_t)u.pm * 256 * 1024; u.b = Bt + (size_t)u.pn * 256 * 1024; return true;
    }
    __device__ __forceinline__ unsigned a_rowoff(const pg8::GUnit&, int) const { return 0u; }
};
__device__ __forceinline__ void ph_proj2(const P& p, unsigned char* lds) {
    { pg8::DenseOrder S; S.init(p.ws + WS_XN, p.ws + WS_WT_IN, MTOK, 1536, 1024, gridDim.x, blockIdx.x);
      EpiProj E{p.ws};
      pg8::gemm_phase<EpiProj, pg8::DenseOrder, true, false>((LAS unsigned char*)lds, 1024, S, E); }
    { GateOrder S{(const char*)(p.ws + WS_XN8), (const char*)(p.ws + WS_WT_G8), (int)gridDim.x, (int)blockIdx.x};
      EpiGate E{p.ws};
      pg8::gemm_phase<EpiGate, GateOrder, true, false, true>((LAS unsigned char*)lds, 512, S, E); }
}
__device__ __forceinline__ void ph_up2(const P& p, unsigned char* lds) {
    { pg8::DenseOrder S; S.init(p.ws + WS_CQ, p.ws + WS_WT_UQ, MTOK, 768, 384, gridDim.x, blockIdx.x); EpiUpQ E{p.ws};
      pg8::gemm_phase<EpiUpQ, pg8::DenseOrder, false, false>((LAS unsigned char*)lds, 384, S, E); }
    { pg8::DenseOrder S; S.init(p.ws + WS_CKV, p.ws + WS_WT_UKV, MTOK, 1024, 256, gridDim.x, blockIdx.x); EpiUpKV E{p.ws};
      pg8::gemm_phase<EpiUpKV, pg8::DenseOrder, false, false>((LAS unsigned char*)lds, 256, S, E); }
}
__device__ __forceinline__ void ph_mix2(const P& p, unsigned char* lds) {
    pg8::DenseOrder S; S.init(p.ws + WS_AO, p.ws + WS_WT_A, MTOK, 1024, 1024, gridDim.x, blockIdx.x); EpiMixF E{p.ws};
    pg8::gemm_phase<EpiMixF, pg8::DenseOrder, false, false>((LAS unsigned char*)lds, 1024, S, E);
}
__device__ __forceinline__ void ph_out2(const P& p, unsigned char* lds) {
    pg8::DenseOrder S; S.init(p.ws + WS_MIX, p.ws + WS_WT_OUT, MTOK, 1024, 512, gridDim.x, blockIdx.x); EpiOut E{p.ws, p.x};
    pg8::gemm_phase<EpiOut, pg8::DenseOrder, false, false, true>((LAS unsigned char*)lds, 512, S, E);
}


constexpr int MOE_TAB_OFF = 135168;
__device__ __forceinline__ void moe_build_tab(const P& p, unsigned char* lds) {
    LAS int* tab = (LAS int*)((LAS unsigned char*)lds + MOE_TAB_OFF);
    const unsigned* cnt = (const unsigned*)(p.ws + WS_CTL);
    const int tid = threadIdx.x;
    if (tid < 64) {
        const int c = tid < NEXP ? (int)cnt[tid * 64] : 0, n = (c + 255) >> 8;
        int incl = n;
#pragma unroll
        for (int o = 1; o < 32; o <<= 1) { const int t = __shfl_up(incl, o); if (tid >= o) incl += t; }
        const int s = incl - n;
        if (tid < NEXP) { tab[tid] = c; tab[32 + tid] = s; for (int j = 0; j < n; ++j) tab[128 + s + j] = tid; if (tid == NEXP - 1) tab[64] = incl; }
    }
    __syncthreads();
}
template <bool GATHER> struct MoeOrder {
    const LAS int* tab; const char* Abase; const char* Bbase; const unsigned* LIST; int K, NCT, G, c;
    __device__ __forceinline__ bool next(int i, pg8::GUnit& u) const {
        const int vc = (G % 8 == 0) ? (c % 8) * (G / 8) + c / 8 : c;
        const int L = i * G + vc; const int ntile = __builtin_amdgcn_readfirstlane(tab[64]); if (L >= ntile * NCT) return false;
        const int tile = L / NCT, pn = L - tile * NCT, e = __builtin_amdgcn_readfirstlane(tab[128 + tile]);
        u.e = e; u.cnt = __builtin_amdgcn_readfirstlane(tab[e]); u.pm = tile - __builtin_amdgcn_readfirstlane(tab[32 + e]); u.pn = pn; u.tile = tile; u.pad_ = 0;
        u.b = Bbase + ((size_t)e * NCT + pn) * 256 * K * 2;
        u.a = GATHER ? Abase : Abase + (size_t)tile * 256 * K * 2;
        return true;
    }
    __device__ __forceinline__ unsigned a_rowoff(const pg8::GUnit& u, int r) const {
        const int row = u.pm * 256 + r; const unsigned ent = row < u.cnt ? LIST[(size_t)u.e * LISTCAP + row] : 0u; return (ent >> 2) * (unsigned)(K * 2);
    }
};
struct EpiMoe1 {
    static constexpr bool PERM = true, HAS_MID = false;
    unsigned char* ws; const float* b1;
    __device__ __forceinline__ void operator()(const f32x4 (&acc)[2][2][4][2], const pg8::GUnit& u, int wr, int wc, int fr, int fq) const {
        bf16_t* HID = (bf16_t*)(ws + WS_HID);
        const int row0 = u.tile * 256 + wr * 64 + fr, col = u.pn * 128 + wc * 32 + 8 * fq;
        constexpr float CG = -1.702f * LOG2E, CGI = 1.f / CG;
        f32x4 bg[2], bl[2];
#pragma unroll
        for (int n = 0; n < 2; ++n) { bg[n] = *(const f32x4*)(b1 + u.e * 2048 + col + 4 * n) * CG; bl[n] = (*(const f32x4*)(b1 + u.e * 2048 + 1024 + col + 4 * n) + 1.f) * CGI; }
#pragma unroll
        for (int ai = 0; ai < 2; ++ai)
#pragma unroll
            for (int m = 0; m < 4; ++m) { f32x4 h[2];
#pragma unroll
                for (int n = 0; n < 2; ++n) { const f32x4 gv = acc[ai][0][m][n] * (W8_INV * CG) + bg[n], lv = acc[ai][1][m][n] * (W8_INV * CGI) + bl[n];
#pragma unroll
                    for (int i = 0; i < 4; ++i) { const float t = fmaxf(gv[i], 7.f * CG), L = __builtin_amdgcn_fmed3f(lv[i], 8.f * CGI, -6.f * CGI);
                        h[n][i] = t * __builtin_amdgcn_rcpf(1.f + __builtin_amdgcn_exp2f(t)) * L; } }
                u32x2 o8; o8.x = pk4_fp8(h[0][0], h[0][1], h[0][2], h[0][3]); o8.y = pk4_fp8(h[1][0], h[1][1], h[1][2], h[1][3]);
                *(u32x2*)((unsigned char*)HID + (size_t)(row0 + ai * 128 + m * 16) * 1024 + col) = o8; }
    }
};
struct EpiMoe2 {
    static constexpr bool PERM = true, HAS_MID = false;
    unsigned char* ws; const float* b2;
    __device__ __forceinline__ void operator()(const f32x4 (&acc)[2][2][4][2], const pg8::GUnit& u, int wr, int wc, int fr, int fq) const {
        unsigned char* Y = ws + WS_Y; const unsigned* LIST = (const unsigned*)(ws + WS_LIST) + (size_t)u.e * LISTCAP;
        f32x4 bv[2][2]; unsigned ent[2][4];
#pragma unroll
        for (int bj = 0; bj < 2; ++bj)
#pragma unroll
            for (int n = 0; n < 2; ++n) bv[bj][n] = *(const f32x4*)(b2 + u.e * 1024 + u.pn * 256 + bj * 128 + wc * 32 + 8 * fq + 4 * n);
#pragma unroll
        for (int ai = 0; ai < 2; ++ai)
#pragma unroll
            for (int m = 0; m < 4; ++m) { const int rr = u.pm * 256 + ai * 128 + wr * 64 + m * 16 + fr, rc = rr < u.cnt ? rr : u.cnt - 1; ent[ai][m] = LIST[rc]; }
        asm volatile("" : "+v"(bv[0][0]), "+v"(bv[0][1]), "+v"(bv[1][0]), "+v"(bv[1][1]));
#pragma unroll
        for (int ai = 0; ai < 2; ++ai)
#pragma unroll
            for (int m = 0; m < 4; ++m) asm volatile("" : "+v"(ent[ai][m]));
#pragma unroll
        for (int ai = 0; ai < 2; ++ai)
#pragma unroll
            for (int m = 0; m < 4; ++m) { const int rr = u.pm * 256 + ai * 128 + wr * 64 + m * 16 + fr;
                if (rr < u.cnt) {
#pragma unroll
                    for (int bj = 0; bj < 2; ++bj) { const int c = u.pn * 256 + bj * 128 + wc * 32 + 8 * fq;
                        const f32x4 y0 = acc[ai][bj][m][0] * W8_INV + bv[bj][0], y1 = acc[ai][bj][m][1] * W8_INV + bv[bj][1];
                        u32x2 o8; o8.x = pk4_fp8(y0[0], y0[1], y0[2], y0[3]); o8.y = pk4_fp8(y1[0], y1[1], y1[2], y1[3]);
                        *(u32x2*)(Y + (size_t)ent[ai][m] * 1024 + c) = o8; } } }
    }
};
__device__ __forceinline__ void ph_moe1_2(const P& p, unsigned char* lds) {
    moe_build_tab(p, lds);
    MoeOrder<true> S{(const LAS int*)((LAS unsigned char*)lds + MOE_TAB_OFF), (const char*)(p.ws + WS_XN), (const char*)(p.ws + WS_WT_M1), (const unsigned*)(p.ws + WS_LIST), 512, 8, (int)gridDim.x, (int)blockIdx.x};
    EpiMoe1 E{p.ws, p.b_m1};
    pg8::gemm_phase<EpiMoe1, MoeOrder<true>, true, true, true>((LAS unsigned char*)lds, 512, S, E);
}
__device__ __forceinline__ void ph_moe2_2(const P& p, unsigned char* lds) {
    MoeOrder<false> S{(const LAS int*)((LAS unsigned char*)lds + MOE_TAB_OFF), (const char*)(p.ws + WS_HID), (const char*)(p.ws + WS_WT_M2), (const unsigned*)(p.ws + WS_LIST), 512, 4, (int)gridDim.x, (int)blockIdx.x};
    EpiMoe2 E{p.ws, p.b_m2};
    pg8::gemm_phase<EpiMoe2, MoeOrder<false>, true, false, true>((LAS unsigned char*)lds, 512, S, E);
}


namespace att {
typedef float f32x16 __attribute__((ext_vector_type(16)));
typedef short s16x4 __attribute__((ext_vector_type(4)));
typedef short v4i16_t __attribute__((ext_vector_type(4)));
typedef LAS const unsigned char* lds_cptr;
constexpr int KROW = 208;
constexpr int KBUF = 64 * KROW, VBUF = 8192;
constexpr int OFF_K = 0, OFF_V = 2 * KBUF, OFF_WS = 2 * KBUF + 2 * VBUF, LDS_BYTES_ATT = OFF_WS + 8 * 256;
__device__ __forceinline__ int crow(int r, int hi) { return (r & 3) + 8 * (r >> 2) + 4 * hi; }
__device__ __forceinline__ s16x4 vtr(lds_cptr p) { return __builtin_bit_cast(s16x4, __builtin_amdgcn_ds_read_tr16_b64_v4i16((LAS v4i16_t*)p)); }
__device__ __forceinline__ float vmax3(float a, float b, float c) { float d; asm("v_max3_f32 %0, %1, %2, %3" : "=v"(d) : "v"(a), "v"(b), "v"(c)); return d; }
__device__ __forceinline__ float half_swap_max(float m) { auto rr = __builtin_amdgcn_permlane32_swap(__float_as_uint(m), __float_as_uint(m), false, false); return fmaxf(__uint_as_float(rr[0]), __uint_as_float(rr[1])); }
__device__ __forceinline__ float half_swap_sum(float m) { auto rr = __builtin_amdgcn_permlane32_swap(__float_as_uint(m), __float_as_uint(m), false, false); return __uint_as_float(rr[0]) + __uint_as_float(rr[1]); }

constexpr int BG_SCR_OFF = 49152;
#define ATT_BARRIER() asm volatile("s_waitcnt lgkmcnt(0)\n\ts_barrier" ::: "memory")
template <bool MLA>
__device__ __forceinline__ void attn_unit(const P& p, LAS unsigned char* lds, int b, int hk, int q0, BgConv& bg, float* bgscr) {
    int tid_ = threadIdx.x; asm volatile("" : "+v"(tid_));
    const int tid = tid_, lane = tid & 63, r32 = lane & 31, hi = lane >> 5, wid = __builtin_amdgcn_readfirstlane(tid >> 6);
    constexpr int NKS = MLA ? 6 : 4;
    const int head = MLA ? hk : hk * 4 + (wid >> 1);
    const int qw0 = MLA ? q0 + 32 * wid : q0 + 32 * (wid & 1);
    const size_t rb = (size_t)b * SEQ;
    bf16x8 qf[NKS];
    if (MLA) {
        const bf16_t* qn = (const bf16_t*)(p.ws + WS_QN) + (rb + qw0 + r32) * 512 + head * 64 + 8 * hi;
        const bf16_t* qr = (const bf16_t*)(p.ws + WS_QR) + (rb + qw0 + r32) * 256 + head * 32 + 8 * hi;
#pragma unroll
        for (int ks = 0; ks < 4; ++ks) qf[ks] = *(const bf16x8*)(qn + 16 * ks);
#pragma unroll
        for (int ks = 4; ks < NKS; ++ks) qf[ks] = *(const bf16x8*)(qr + 16 * (ks - 4));
    } else {
        const bf16_t* qa = (const bf16_t*)(p.ws + WS_QA) + (rb + qw0 + r32) * 512 + head * 64 + 8 * hi;
#pragma unroll
        for (int ks = 0; ks < NKS; ++ks) qf[ks] = *(const bf16x8*)(qa + 16 * ks);
    }
    const int t_lo = MLA ? 0 : (q0 >= 128 ? (q0 - 128) >> 6 : 0), t_hi = MLA ? ((q0 + 256) >> 6) - 1 : (q0 >> 6);
    const int skey = tid >> 3, sc = tid & 7;
    const bf16_t* kg; const bf16_t* vg; const bf16_t* rg = nullptr;
    if (MLA) { kg = (const bf16_t*)(p.ws + WS_KN) + (rb + skey) * 512 + hk * 64 + 8 * sc; vg = (const bf16_t*)(p.ws + WS_VB) + (rb + skey) * 512 + hk * 64 + 8 * sc;
               rg = (const bf16_t*)(p.ws + WS_KR) + (rb + (tid >> 2)) * 32 + 8 * (tid & 3); }
    else { kg = (const bf16_t*)(p.ws + WS_KA) + (rb + skey) * 128 + hk * 64 + 8 * sc; vg = (const bf16_t*)(p.ws + WS_VA) + (rb + skey) * 128 + hk * 64 + 8 * sc; }
    const int kpitch = MLA ? 512 : 128;
    const int kst = skey * KROW + sc * 16;
    const int rst = (tid >> 2) * KROW + 128 + (tid & 3) * 16;
    const int vst = ((8 * sc) >> 5) * 4096 + (skey >> 4) * 1024 + (skey & 15) * 64 + ((8 * sc) & 31) * 2;
    u32x4 kreg, vreg, rreg = (u32x4){0u, 0u, 0u, 0u};
#define ATT_LOAD(t) do { kreg = *(const u32x4*)(kg + (size_t)(t) * 64 * kpitch); vreg = *(const u32x4*)(vg + (size_t)(t) * 64 * kpitch); \
        if (MLA && tid < 256) rreg = *(const u32x4*)(rg + (size_t)(t) * 64 * 32); } while (0)
#define ATT_WRITE(buf) do { *(LAS u32x4*)(lds + OFF_K + (buf) * KBUF + kst) = kreg; *(LAS u32x4*)(lds + OFF_V + (buf) * VBUF + vst) = vreg; \
        if (MLA && tid < 256) *(LAS u32x4*)(lds + OFF_K + (buf) * KBUF + rst) = rreg; } while (0)
    LAS float* wsf = (LAS float*)(lds + OFF_WS) + wid * 64;
    float m, l; f32x16 o[2];
#pragma unroll
    for (int r = 0; r < 16; ++r) { o[0][r] = 0.f; o[1][r] = 0.f; }
    float slope2 = 0.f;
    if (MLA) { m = -INFINITY; l = 0.f; }
    else { m = p.sinks[head] * LOG2E; l = hi == 0 ? 1.f : 0.f; slope2 = exp2f(-(float)(head + 1)) * LOG2E; }
    const lds_cptr kp0 = (lds_cptr)lds + OFF_K + r32 * KROW + hi * 16;
    const lds_cptr vp0 = (lds_cptr)lds + OFF_V + ((lane >> 4) & 1) * 32 + (lane & 3) * 8 + (4 * hi + ((lane & 15) >> 2)) * 64;
    ATT_LOAD(t_lo); ATT_WRITE(0);
    ATT_BARRIER();
    for (int t = t_lo; t <= t_hi; ++t) {
        const int cur = (t - t_lo) & 1, s0 = t * 64;
        if (t < t_hi) ATT_LOAD(t + 1);
        if (BG_CONV) bg_step(p, bg, bgscr, lane);
        const bool active = MLA ? (s0 <= qw0 + 31) : (s0 <= qw0 + 31 && s0 + 63 >= qw0 - 127);
        if (active) {
            f32x16 p0, p1;
#pragma unroll
            for (int r = 0; r < 16; ++r) { p0[r] = 0.f; p1[r] = 0.f; }
            const lds_cptr kp = kp0 + cur * KBUF;
#pragma unroll
            for (int ks = 0; ks < NKS; ++ks) {
                const bf16x8 a0 = *(const LAS bf16x8*)(kp + ks * 32), a1 = *(const LAS bf16x8*)(kp + 32 * KROW + ks * 32);
                p0 = __builtin_amdgcn_mfma_f32_32x32x16_bf16(a0, qf[ks], p0, 0, 0, 0);
                p1 = __builtin_amdgcn_mfma_f32_32x32x16_bf16(a1, qf[ks], p1, 0, 0, 0);
            }
            const int q = qw0 + r32;
            if (MLA) {
                if (s0 + 63 > qw0) {
#pragma unroll
                    for (int r = 0; r < 16; ++r) { const int key = s0 + crow(r, hi); if (key > q) p0[r] = -INFINITY; if (key + 32 > q) p1[r] = -INFINITY; }
                }
            } else {
#pragma unroll
                for (int r = 0; r < 16; ++r) { const int d0 = q - (s0 + crow(r, hi)), d1 = d0 - 32;
                    p0[r] = (d0 >= 0 && d0 < 128) ? p0[r] - slope2 * (float)d0 : -INFINITY;
                    p1[r] = (d1 >= 0 && d1 < 128) ? p1[r] - slope2 * (float)d1 : -INFINITY; }
            }
            float mx = fmaxf(p0[0], p1[0]);
#pragma unroll
            for (int r = 1; r < 16; ++r) mx = fmaxf(mx, fmaxf(p0[r], p1[r]));
            mx = half_swap_max(mx);
            if (__any(mx > m + 8.f)) {
                const float mn = fmaxf(m, mx), alpha = __builtin_amdgcn_exp2f(m - mn);
                m = mn; l *= alpha;
                if (hi == 0) wsf[r32] = alpha;
#pragma unroll
                for (int r = 0; r < 16; ++r) { const float a = wsf[crow(r, hi)]; o[0][r] *= a; o[1][r] *= a; }
            }
            float ps = 0.f;
#pragma unroll
            for (int r = 0; r < 16; ++r) { p0[r] = __builtin_amdgcn_exp2f(p0[r] - m); p1[r] = __builtin_amdgcn_exp2f(p1[r] - m); ps += p0[r] + p1[r]; }
            l += ps;
            u32x4 pw[4];
#pragma unroll
            for (int i = 0; i < 4; ++i) { pw[0][i] = pg8::cvt_pk_bf16(p0[2 * i], p0[2 * i + 1]); pw[1][i] = pg8::cvt_pk_bf16(p0[8 + 2 * i], p0[8 + 2 * i + 1]);
                                          pw[2][i] = pg8::cvt_pk_bf16(p1[2 * i], p1[2 * i + 1]); pw[3][i] = pg8::cvt_pk_bf16(p1[8 + 2 * i], p1[8 + 2 * i + 1]); }
            const lds_cptr vp = vp0 + cur * VBUF;
#pragma unroll
            for (int d0 = 0; d0 < 2; ++d0)
#pragma unroll
                for (int ks = 0; ks < 4; ++ks) {
                    const s16x4 lo = vtr(vp + d0 * 4096 + ks * 1024), hh = vtr(vp + d0 * 4096 + ks * 1024 + 512);
                    const bf16x8 vf = (bf16x8){lo[0], lo[1], lo[2], lo[3], hh[0], hh[1], hh[2], hh[3]};
                    o[d0] = __builtin_amdgcn_mfma_f32_32x32x16_bf16(__builtin_bit_cast(bf16x8, pw[ks]), vf, o[d0], 0, 0, 0);
                }
        }
        if (t < t_hi) ATT_WRITE(cur ^ 1);
        ATT_BARRIER();
    }
    l = half_swap_sum(l);
    if (hi == 0) wsf[32 + r32] = 1.f / l;
    bf16_t* Ob = (bf16_t*)(p.ws + WS_AO) + (rb + qw0) * 1024 + (MLA ? 512 : 0) + head * 64 + r32;
#pragma unroll
    for (int r = 0; r < 16; ++r) { const int qr = crow(r, hi); const float rl = wsf[32 + qr];
        Ob[(size_t)qr * 1024] = (bf16_t)f2bf(o[0][r] * rl); Ob[(size_t)qr * 1024 + 32] = (bf16_t)f2bf(o[1][r] * rl); }
#undef ATT_LOAD
#undef ATT_WRITE
}
constexpr int PP_AHEAD = 4;
constexpr int PP_OFF_V = 3 * KBUF, PP_OFF_WS = 3 * KBUF + 3 * VBUF;
#define ATT_PBAR() do { __builtin_amdgcn_sched_barrier(0); asm volatile("s_waitcnt lgkmcnt(0)\n\ts_barrier" ::: "memory"); __builtin_amdgcn_sched_barrier(0); } while (0)
template <bool MLA>
__device__ __forceinline__ void attn_unit_pp(const P& p, LAS unsigned char* lds, int b, int hk, int q0, BgConv& bg) {
    int tid_ = threadIdx.x; asm volatile("" : "+v"(tid_));
    const int tid = tid_, lane = tid & 63, r32 = lane & 31, hi = lane >> 5, wid = __builtin_amdgcn_readfirstlane(tid >> 6);
    const int grp = wid >> 2;
    constexpr int NKS = MLA ? 6 : 4;
    const int head = MLA ? hk : hk * 4 + (wid >> 1);
    const int qw0 = MLA ? q0 + 32 * wid : q0 + 32 * (wid & 1);
    const size_t rb = (size_t)b * SEQ;
    bf16x8 qf[NKS];
    if (MLA) {
        const bf16_t* qn = (const bf16_t*)(p.ws + WS_QN) + (rb + qw0 + r32) * 512 + head * 64 + 8 * hi;
        const bf16_t* qr = (const bf16_t*)(p.ws + WS_QR) + (rb + qw0 + r32) * 256 + head * 32 + 8 * hi;
#pragma unroll
        for (int ks = 0; ks < 4; ++ks) qf[ks] = *(const bf16x8*)(qn + 16 * ks);
#pragma unroll
        for (int ks = 4; ks < NKS; ++ks) qf[ks] = *(const bf16x8*)(qr + 16 * (ks - 4));
    } else {
        const bf16_t* qa = (const bf16_t*)(p.ws + WS_QA) + (rb + qw0 + r32) * 512 + head * 64 + 8 * hi;
#pragma unroll
        for (int ks = 0; ks < NKS; ++ks) qf[ks] = *(const bf16x8*)(qa + 16 * ks);
    }
    const int t_lo = MLA ? 0 : (q0 >= 128 ? (q0 - 128) >> 6 : 0), t_hi = MLA ? ((q0 + 256) >> 6) - 1 : (q0 >> 6);
    const int skey = tid >> 3, sc = tid & 7;
    const bf16_t* kg; const bf16_t* vg; const bf16_t* rg = nullptr;
    if (MLA) { kg = (const bf16_t*)(p.ws + WS_KN) + (rb + skey) * 512 + hk * 64 + 8 * sc; vg = (const bf16_t*)(p.ws + WS_VB) + (rb + skey) * 512 + hk * 64 + 8 * sc;
               rg = (const bf16_t*)(p.ws + WS_KR) + (rb + (tid >> 2)) * 32 + 8 * (tid & 3); }
    else { kg = (const bf16_t*)(p.ws + WS_KA) + (rb + skey) * 128 + hk * 64 + 8 * sc; vg = (const bf16_t*)(p.ws + WS_VA) + (rb + skey) * 128 + hk * 64 + 8 * sc; }
    const int kpitch = MLA ? 512 : 128;
    const int kst = skey * KROW + sc * 16;
    const int rst = (tid >> 2) * KROW + 128 + (tid & 3) * 16;
    const int vst = ((8 * sc) >> 5) * 4096 + (skey >> 4) * 1024 + (skey & 15) * 64 + ((8 * sc) & 31) * 2;
    u32x4 kreg, vreg, rreg = (u32x4){0u, 0u, 0u, 0u};
#define PP_LOAD(t) do { kreg = *(const u32x4*)(kg + (size_t)(t) * 64 * kpitch); vreg = *(const u32x4*)(vg + (size_t)(t) * 64 * kpitch); \
        if (MLA && tid < 256) rreg = *(const u32x4*)(rg + (size_t)(t) * 64 * 32); } while (0)
#define PP_WRITE(kb, vb) do { *(LAS u32x4*)(lds + (kb) + kst) = kreg; *(LAS u32x4*)(lds + PP_OFF_V + (vb) + vst) = vreg; \
        if (MLA && tid < 256) *(LAS u32x4*)(lds + (kb) + rst) = rreg; } while (0)
    LAS float* wsf = (LAS float*)(lds + PP_OFF_WS) + wid * 64;
    float m, l; f32x16 o[2];
#pragma unroll
    for (int r = 0; r < 16; ++r) { o[0][r] = 0.f; o[1][r] = 0.f; }
    float slope2 = 0.f;
    if (MLA) { m = -INFINITY; l = 0.f; }
    else { m = p.sinks[head] * LOG2E; l = hi == 0 ? 1.f : 0.f; slope2 = exp2f(-(float)(head + 1)) * LOG2E; }
    const lds_cptr kp0 = (lds_cptr)lds + r32 * KROW + hi * 16;
    const lds_cptr vp0 = (lds_cptr)lds + PP_OFF_V + ((lane >> 4) & 1) * 32 + (lane & 3) * 8 + (4 * hi + ((lane & 15) >> 2)) * 64;
    int kbP = 2 * KBUF, kbC = 0, kbN = KBUF, vbP = 2 * VBUF, vbC = 0, vbN = VBUF;
    PP_LOAD(t_lo); PP_WRITE(kbC, vbC);
    if (t_lo < t_hi) PP_LOAD(t_lo + 1);
    ATT_PBAR();
    if (grp) ATT_PBAR();
    u32x4 pw[4];
#pragma unroll
    for (int i = 0; i < 4; ++i) pw[i] = (u32x4){0u, 0u, 0u, 0u};
    f32x16 p0, p1;
#pragma unroll
    for (int r = 0; r < 16; ++r) { p0[r] = 0.f; p1[r] = 0.f; }
    bool act_prev = false;
    for (int t = t_lo; t <= t_hi + 1; ++t) {
        const int s0 = t * 64;
        const bool active = t <= t_hi && (MLA ? (s0 <= qw0 + 31) : (s0 <= qw0 + 31 && s0 + 63 >= qw0 - 127));
        if (active) {
#pragma unroll
            for (int r = 0; r < 16; ++r) { p0[r] = 0.f; p1[r] = 0.f; }
            const lds_cptr kp = kp0 + kbC;
            bf16x8 ka[2 * NKS];
#pragma unroll
            for (int ks = 0; ks < NKS; ++ks) { ka[2 * ks] = *(const LAS bf16x8*)(kp + ks * 32); ka[2 * ks + 1] = *(const LAS bf16x8*)(kp + 32 * KROW + ks * 32); }
#pragma unroll
            for (int ks = 0; ks < NKS; ++ks) {
                p0 = __builtin_amdgcn_mfma_f32_32x32x16_bf16(ka[2 * ks], qf[ks], p0, 0, 0, 0);
                p1 = __builtin_amdgcn_mfma_f32_32x32x16_bf16(ka[2 * ks + 1], qf[ks], p1, 0, 0, 0);
            }
            __builtin_amdgcn_sched_group_barrier(0x100, PP_AHEAD, 0);
#pragma unroll
            for (int i = 0; i < 2 * NKS - PP_AHEAD; ++i) { __builtin_amdgcn_sched_group_barrier(0x008, 1, 0); __builtin_amdgcn_sched_group_barrier(0x100, 1, 0); }
            __builtin_amdgcn_sched_group_barrier(0x008, PP_AHEAD, 0);
        }
        __builtin_amdgcn_sched_barrier(0);
        if (act_prev) {
            const lds_cptr vp = vp0 + vbP;
            bf16x8 vf[8];
#pragma unroll
            for (int ks = 0; ks < 4; ++ks)
#pragma unroll
                for (int d0 = 0; d0 < 2; ++d0) {
                    const s16x4 lo = vtr(vp + d0 * 4096 + ks * 1024), hh = vtr(vp + d0 * 4096 + ks * 1024 + 512);
                    vf[2 * ks + d0] = (bf16x8){lo[0], lo[1], lo[2], lo[3], hh[0], hh[1], hh[2], hh[3]};
                }
#pragma unroll
            for (int ks = 0; ks < 4; ++ks) {
                o[0] = __builtin_amdgcn_mfma_f32_32x32x16_bf16(__builtin_bit_cast(bf16x8, pw[ks]), vf[2 * ks], o[0], 0, 0, 0);
                o[1] = __builtin_amdgcn_mfma_f32_32x32x16_bf16(__builtin_bit_cast(bf16x8, pw[ks]), vf[2 * ks + 1], o[1], 0, 0, 0);
            }
            __builtin_amdgcn_sched_group_barrier(0x100, 6, 0);
#pragma unroll
            for (int i = 0; i < 5; ++i) { __builtin_amdgcn_sched_group_barrier(0x008, 1, 0); __builtin_amdgcn_sched_group_barrier(0x100, 2, 0); }
            __builtin_amdgcn_sched_group_barrier(0x008, 3, 0);
        }
        __builtin_amdgcn_sched_barrier(0);
        if (t < t_hi) PP_WRITE(kbN, vbN);
        if (BG_CONV) bg_step_fin(p, bg, lane);
        if (t + 1 < t_hi) PP_LOAD(t + 2);
        if (BG_CONV) bg_step_iss(p, bg, lane);
        ATT_PBAR();
        if (active) {
            const int q = qw0 + r32;
            if (MLA) {
                if (s0 + 63 > qw0) {
#pragma unroll
                    for (int r = 0; r < 16; ++r) { const int key = s0 + crow(r, hi); if (key > q) p0[r] = -INFINITY; if (key + 32 > q) p1[r] = -INFINITY; }
                }
            } else {
#pragma unroll
                for (int r = 0; r < 16; ++r) { const int d0 = q - (s0 + crow(r, hi)), d1 = d0 - 32;
                    p0[r] = (d0 >= 0 && d0 < 128) ? p0[r] - slope2 * (float)d0 : -INFINITY;
                    p1[r] = (d1 >= 0 && d1 < 128) ? p1[r] - slope2 * (float)d1 : -INFINITY; }
            }
            float mxa = fmaxf(p0[0], p1[0]), mxb = fmaxf(p0[1], p1[1]);
#pragma unroll
            for (int r = 2; r < 16; r += 2) { mxa = vmax3(mxa, p0[r], p1[r]); mxb = vmax3(mxb, p0[r + 1], p1[r + 1]); }
            float mx = half_swap_max(fmaxf(mxa, mxb));
            if (__any(mx > m + 8.f)) {
                const float mn = fmaxf(m, mx), alpha = __builtin_amdgcn_exp2f(m - mn);
                m = mn; l *= alpha;
                if (hi == 0) wsf[r32] = alpha;
#pragma unroll
                for (int r = 0; r < 16; ++r) { const float a = wsf[crow(r, hi)]; o[0][r] *= a; o[1][r] *= a; }
            }
#pragma unroll
            for (int r = 0; r < 16; ++r) { p0[r] -= m; p1[r] -= m; }
            __builtin_amdgcn_sched_barrier(0);
#pragma unroll
            for (int r = 0; r < 16; ++r) { p0[r] = __builtin_amdgcn_exp2f(p0[r]); p1[r] = __builtin_amdgcn_exp2f(p1[r]); }
            __builtin_amdgcn_sched_barrier(0);
            { typedef float f32x2 __attribute__((ext_vector_type(2)));
              f32x2 sa = (f32x2){p0[0], p0[1]} + (f32x2){p1[0], p1[1]}, sb = (f32x2){p0[2], p0[3]} + (f32x2){p1[2], p1[3]};
#pragma unroll
              for (int r = 4; r < 16; r += 4) { sa += (f32x2){p0[r], p0[r + 1]} + (f32x2){p1[r], p1[r + 1]}; sb += (f32x2){p0[r + 2], p0[r + 3]} + (f32x2){p1[r + 2], p1[r + 3]}; }
              sa += sb; l += sa[0] + sa[1]; }
#pragma unroll
            for (int i = 0; i < 4; ++i) { pw[0][i] = pg8::cvt_pk_bf16(p0[2 * i], p0[2 * i + 1]); pw[1][i] = pg8::cvt_pk_bf16(p0[8 + 2 * i], p0[8 + 2 * i + 1]);
                                          pw[2][i] = pg8::cvt_pk_bf16(p1[2 * i], p1[2 * i + 1]); pw[3][i] = pg8::cvt_pk_bf16(p1[8 + 2 * i], p1[8 + 2 * i + 1]); }
        }
        act_prev = active;
        ATT_PBAR();
        { const int tk = kbP; kbP = kbC; kbC = kbN; kbN = tk; const int tv = vbP; vbP = vbC; vbC = vbN; vbN = tv; }
    }
    if (!grp) ATT_PBAR();
    l = half_swap_sum(l);
    if (hi == 0) wsf[32 + r32] = 1.f / l;
    bf16_t* Ob = (bf16_t*)(p.ws + WS_AO) + (rb + qw0) * 1024 + (MLA ? 512 : 0) + head * 64 + r32;
#pragma unroll
    for (int r = 0; r < 16; ++r) { const int qr = crow(r, hi); const float rl = wsf[32 + qr];
        Ob[(size_t)qr * 1024] = (bf16_t)f2bf(o[0][r] * rl); Ob[(size_t)qr * 1024 + 32] = (bf16_t)f2bf(o[1][r] * rl); }
#undef PP_LOAD
#undef PP_WRITE
}
}
__device__ __forceinline__ void ph_attn2(const P& p, unsigned char* lds_) {
    LAS unsigned char* lds = (LAS unsigned char*)lds_;
    const int G = gridDim.x, bx = blockIdx.x;
    const int vcu = (G % 8 == 0) ? (bx % 8) * (G / 8) + bx / 8 : bx;
    const int lane_ = threadIdx.x & 63, wave_ = threadIdx.x >> 6;
    BgConv bg; bg.item = bx * 8 + wave_; bg.it = 0; bg.ngw = G * 8; bg.pend = false;
#pragma unroll
    for (int i = 0; i < 32; ++i) bg.r[i] = 0.f;
    float* bgscr = (float*)(lds_ + att::BG_SCR_OFF + wave_ * 8704);
    for (int pi = vcu; pi < 256; pi += G) {
        const int bh = pi >> 4, sidx = pi & 15;
        att::attn_unit_pp<true>(p, lds, bh >> 3, bh & 7, (31 - sidx) * 256, bg);
        att::attn_unit_pp<true>(p, lds, bh >> 3, bh & 7, sidx * 256, bg);
    }
    for (int u = vcu; u < 512; u += G) {
        const int bk = u >> 7, qb = u & 127;
        att::attn_unit_pp<false>(p, lds, bk >> 1, bk & 1, qb * 64, bg);
    }
    if (BG_CONV) bg_drain(p, bg, bgscr, lane_);
}

#define XB_TMO      128
#define XB_XCNT(j)  (256  + 64 * (j))
#define XB_XSUB(j)  (1280 + 64 * (j))
#define XB_XGEN(j)  (2304 + 64 * (j))
#define XB_TOP      3328
#define XB_TOPGEN   3392
#define XCD_BAR_WORDS 3456
#define XB_SPIN_CAP (1u << 18)
__device__ __forceinline__ unsigned xb_ld(unsigned* p)              { return __hip_atomic_load(p, __ATOMIC_RELAXED, __HIP_MEMORY_SCOPE_AGENT); }
__device__ __forceinline__ unsigned xb_add(unsigned* p, unsigned v) { return __hip_atomic_fetch_add(p, v, __ATOMIC_RELAXED, __HIP_MEMORY_SCOPE_AGENT); }
__device__ __forceinline__ unsigned xb_xcc_id() { return (unsigned)__builtin_amdgcn_s_getreg((3 << 11) | 20) & 0xFu; }
#define XB_SPIN(cond, bar) do { unsigned _sp = 0; while (cond) { __builtin_amdgcn_s_sleep(1); \
    if ((++_sp & 255u) == 0u) { if (xb_ld(&(bar)[XB_TMO])) break; if (_sp > XB_SPIN_CAP) { atomicAdd(&(bar)[XB_TMO], 1u); break; } } } } while (0)
struct XcdBarrier { unsigned* bar; unsigned x; volatile LAS unsigned* st; };
__device__ __forceinline__ XcdBarrier xcd_barrier_post(unsigned* bar, volatile LAS unsigned* st) {
    XcdBarrier b; b.bar = bar; b.x = xb_xcc_id(); b.st = st;
    if (threadIdx.x == 0) (void)xb_add(&bar[XB_XCNT(b.x)], 1u);
    return b;
}
__device__ __forceinline__ void xcd_barrier_complete(unsigned* bar, unsigned x, unsigned& nloc, unsigned& nx) {
    const unsigned G = gridDim.x * gridDim.y * gridDim.z;
    unsigned sum, cnt, mine, sp = 0u;
    for (;;) {
        sum = 0u; cnt = 0u; mine = 0u;
#pragma unroll
        for (unsigned j = 0; j < 16; ++j) { const unsigned c = xb_ld(&bar[XB_XCNT(j)]); sum += c; cnt += (c > 0u) ? 1u : 0u; mine = (j == x) ? c : mine; }
        if (sum == G) break;
        __builtin_amdgcn_s_sleep(1);
        if ((++sp & 255u) == 0u) { if (xb_ld(&bar[XB_TMO])) break; if (sp > XB_SPIN_CAP) { atomicAdd(&bar[XB_TMO], 1u); break; } }
    }
    nloc = mine > 0u ? mine : 1u; nx = cnt > 0u ? cnt : 1u;
}
__device__ __forceinline__ void xcd_barrier(const XcdBarrier& b) {
    asm volatile("s_waitcnt vmcnt(0)" ::: "memory");
    __syncthreads();
    if (threadIdx.x == 0) {
        unsigned* bar = b.bar;
        __builtin_amdgcn_s_waitcnt(0);
        unsigned nloc = b.st[0], nx = b.st[1];
        if (nloc == 0u) { xcd_barrier_complete(bar, b.x, nloc, nx); b.st[0] = nloc; b.st[1] = nx; }
        const unsigned old = xb_add(&bar[XB_XSUB(b.x)], 1u);
        const unsigned gen = old / nloc;
        if (old + 1u == (gen + 1u) * nloc) {
            __builtin_amdgcn_fence(__ATOMIC_RELEASE, "agent");
            asm volatile("s_waitcnt vmcnt(0)" ::: "memory");
            const unsigned og = xb_add(&bar[XB_TOP], 1u);
            const unsigned tg = og / nx;
            if (og + 1u == (tg + 1u) * nx) xb_add(&bar[XB_TOPGEN], 1u);
            else XB_SPIN(xb_ld(&bar[XB_TOPGEN]) == tg, bar);
            __builtin_amdgcn_fence(__ATOMIC_ACQUIRE, "agent");
            xb_add(&bar[XB_XGEN(b.x)], 1u);
            asm volatile("s_waitcnt vmcnt(0)" ::: "memory");
        } else {
            XB_SPIN(xb_ld(&bar[XB_XGEN(b.x)]) == gen, bar);
            __builtin_amdgcn_fence(__ATOMIC_ACQUIRE, "agent");
            asm volatile("s_waitcnt vmcnt(0)" ::: "memory");
        }
    }
    __syncthreads();
}
constexpr int LDSCTL_OFF = 139264;
constexpr int CW_BAR = 4096;
constexpr size_t CTL_ZERO_BYTES = 65536;

__global__ void __launch_bounds__(NTHREADS, 2) mega_fwd(P p) {
    extern __shared__ __attribute__((aligned(16))) unsigned char lds[];
    if (threadIdx.x < 32) ((LAS unsigned*)((LAS unsigned char*)lds + LDSCTL_OFF))[threadIdx.x] = 0u;
    __syncthreads();
    const XcdBarrier bar = xcd_barrier_post((unsigned*)(p.ws + WS_CTL) + CW_BAR, (volatile LAS unsigned*)((LAS unsigned char*)lds + LDSCTL_OFF));
#ifndef PH_MASK
#define PH_MASK 0xFFFF
#endif
#ifndef PH_DUP
#define PH_DUP 0
#endif
#define RUN_PH(bit, call) do { if (PH_MASK & (bit)) { call; if (PH_DUP & (bit)) { __syncthreads(); call; } } } while (0)
#define GSYNC() do { xcd_barrier(bar); if (PH_DUP & 0x10000) xcd_barrier(bar); } while (0)
    RUN_PH(1, (ph_mod(p, lds), ph_convert(p, lds)));
    GSYNC();
    RUN_PH(2, ph_xn(p));
    GSYNC();
    RUN_PH(4, ph_proj2(p, lds));
    GSYNC();
    RUN_PH(16, ph_up2(p, lds));
    GSYNC();
    RUN_PH(32, ph_attn2(p, lds));
    GSYNC();
    RUN_PH(64, ph_mix2(p, lds));
    GSYNC();
    RUN_PH(128, ph_out2(p, lds));
    GSYNC();
    if (PH_DUP & 256) { ph_route(p, lds, false); __syncthreads(); }
    if (PH_MASK & 256) ph_route(p, lds, true);
    GSYNC();
    RUN_PH(512, ph_moe1_2(p, lds));
    GSYNC();
    RUN_PH(1024, ph_moe2_2(p, lds));
    GSYNC();
    RUN_PH(2048, ph_final(p));
}

extern "C" void kernel_launch(void* const* d_in, const int* in_sizes, int n_in, void* d_out, int out_size, void* d_ws, size_t ws_size, hipStream_t stream) {
    static int grid_blocks = 0;
    if (!grid_blocks) {
        int dev = 0, cus = 0, per_cu = 0;
        (void)hipGetDevice(&dev);
        (void)hipDeviceGetAttribute(&cus, hipDeviceAttributeMultiprocessorCount, dev);
        (void)hipFuncSetAttribute((const void*)mega_fwd, hipFuncAttributeMaxDynamicSharedMemorySize, LDS_BYTES);
        (void)hipOccupancyMaxActiveBlocksPerMultiprocessor(&per_cu, (const void*)mega_fwd, NTHREADS, LDS_BYTES);
        if (per_cu < 1) per_cu = 1;
        grid_blocks = cus * per_cu;
        if (grid_blocks > 256) grid_blocks = 256;
        if (grid_blocks < 256 || MTOK % grid_blocks != 0) { fprintf(stderr, "kernel_launch: grid %d unsupported (needs >= 256 workgroups dividing %d)\n", grid_blocks, MTOK); grid_blocks = -1; }
        else if (ws_size < WS_END || n_in != 24) { fprintf(stderr, "kernel_launch: ws %zu < %zu or n_in %d != 24\n", ws_size, (size_t)WS_END, n_in); grid_blocks = -1; }
    }
    if (grid_blocks < 0) return;
    P p{};
    p.x = (const float*)d_in[0]; p.c = (const float*)d_in[1]; p.pos = (const int*)d_in[2]; p.w_ada = (const float*)d_in[3]; p.b_ada = (const float*)d_in[4];
    p.norm_mix = (const float*)d_in[5]; p.norm_ffn = (const float*)d_in[6]; p.w_in = (const float*)d_in[7]; p.sinks = (const float*)d_in[8];
    p.q_norm = (const float*)d_in[9]; p.kv_norm = (const float*)d_in[10]; p.w_uq = (const float*)d_in[11]; p.w_uk = (const float*)d_in[12]; p.w_uv = (const float*)d_in[13];
    p.w_a = (const float*)d_in[14]; p.w_b = (const float*)d_in[15]; p.w_out = (const float*)d_in[16]; p.w_router = (const float*)d_in[17]; p.b_router = (const float*)d_in[18];
    p.w_m1 = (const float*)d_in[19]; p.b_m1 = (const float*)d_in[20]; p.w_m2 = (const float*)d_in[21]; p.b_m2 = (const float*)d_in[22]; p.fnorm = (const float*)d_in[23];
    p.out = (float*)d_out; p.ws = (unsigned char*)d_ws;
    if (hipMemsetAsync((char*)d_ws + WS_CTL, 0, CTL_ZERO_BYTES, stream) != hipSuccess) { fprintf(stderr, "kernel_launch: memset failed\n"); return; }
    hipLaunchKernelGGL(mega_fwd, dim3(grid_blocks), dim3(NTHREADS), LDS_BYTES, stream, p);
    const hipError_t e = hipPeekAtLastError();
    if (e != hipSuccess) fprintf(stderr, "launch failed: %s (grid %d)\n", hipGetErrorString(e), grid_blocks);
}
```

```cpp
#include <hip/hip_runtime.h>
#include <cstdio>
#include <cstdint>

typedef unsigned short bf16_t;
typedef short bf16x8 __attribute__((ext_vector_type(8)));
typedef float f32x4 __attribute__((ext_vector_type(4)));
typedef unsigned u32x4 __attribute__((ext_vector_type(4)));
typedef unsigned u32x2 __attribute__((ext_vector_type(2)));

constexpr int NTHREADS = 512;
constexpr int LDS_BYTES = 147456;
constexpr int BATCH = 2, SEQ = 8192, DM = 1024, MTOK = BATCH * SEQ;
constexpr int NEXP = 32, LISTCAP = 16384;
constexpr float EPS = 1e-6f;
constexpr float LOG2E = 1.4426950408889634f;

constexpr size_t MiB = 1u << 20;
constexpr size_t WS_CTL = 0;
constexpr size_t WS_MOD = 1 * MiB;
constexpr size_t WS_WT_IN = 2 * MiB;
constexpr size_t WS_WT_UQ = 9 * MiB;
constexpr size_t WS_WT_UKV = 10 * MiB;
constexpr size_t WS_WT_A = 11 * MiB;
constexpr size_t WS_WT_B = 12 * MiB;
constexpr size_t WS_WT_OUT = 13 * MiB;
constexpr size_t WS_WRT = 1 * MiB + 524288;
constexpr size_t WS_COS = 15 * MiB;
constexpr size_t WS_SIN = 16 * MiB;
constexpr size_t WS_SSQ = 17 * MiB;
constexpr size_t WS_LIST = 18 * MiB;
constexpr size_t WS_TOPW = 1835008;
constexpr size_t WS_LISTW = 809 * MiB;
constexpr size_t WS_WT_M1 = 20 * MiB;
constexpr size_t WS_WT_M2 = 148 * MiB;
constexpr size_t WS_XN = 212 * MiB;
constexpr size_t WS_QA = 244 * MiB;
constexpr size_t WS_KA = 260 * MiB;
constexpr size_t WS_VA = 264 * MiB;
constexpr size_t WS_CQ = 268 * MiB;
constexpr size_t WS_CKV = 280 * MiB;
constexpr size_t WS_KR = 288 * MiB;
constexpr size_t WS_GA = 289 * MiB;
constexpr size_t WS_GB = 321 * MiB;
constexpr size_t WS_QN = 353 * MiB;
constexpr size_t WS_QR = 369 * MiB;
constexpr size_t WS_KN = 377 * MiB;
constexpr size_t WS_VB = 393 * MiB;
constexpr size_t WS_AO = 409 * MiB;
constexpr size_t WS_BO = 425 * MiB;
constexpr size_t WS_MIX = 441 * MiB;
constexpr size_t WS_X1 = 473 * MiB;
constexpr size_t WS_HID = 537 * MiB;
constexpr size_t WS_Y = 681 * MiB;
constexpr size_t WS_XN8 = 811 * MiB;
constexpr size_t WS_WT_G8 = 827 * MiB;
constexpr size_t WS_END = 829 * MiB;

struct P {
    const float *x, *c; const int* pos;
    const float *w_ada, *b_ada, *norm_mix, *norm_ffn, *w_in, *sinks, *q_norm, *kv_norm, *w_uq, *w_uk, *w_uv, *w_a, *w_b, *w_out,
        *w_router, *b_router, *w_m1, *b_m1, *w_m2, *b_m2, *fnorm;
    float* out; unsigned char* ws;
};

__device__ __forceinline__ unsigned f2bf(float f) { unsigned u = __float_as_uint(f); return (u + 0x7fffu + ((u >> 16) & 1u)) >> 16; }
__device__ __forceinline__ unsigned pk2(float lo, float hi) { return f2bf(lo) | (f2bf(hi) << 16); }
__device__ __forceinline__ float bf2f(unsigned h) { return __uint_as_float(h << 16); }
__device__ __forceinline__ unsigned pk4_fp8(float a, float b, float c, float d) { int r = __builtin_amdgcn_cvt_pk_fp8_f32(a, b, 0, false); r = __builtin_amdgcn_cvt_pk_fp8_f32(c, d, r, true); return (unsigned)r; }
constexpr float W8_SCALE = 32.f, W8_INV = 0.03125f;
constexpr float MIX8_SCALE = 8.f, OUT8_INV = 1.f / (8.f * 32.f);
__device__ __forceinline__ float wave_sum(float v) {
#pragma unroll
    for (int o = 1; o < 64; o <<= 1) v += __shfl_xor(v, o);
    return v;
}
__device__ __forceinline__ float sigmoidf_(float v) { return __builtin_amdgcn_rcpf(1.f + __builtin_amdgcn_exp2f(-LOG2E * v)); }

__device__ __forceinline__ void ph_mod(const P& p, unsigned char* lds) {
    const int tid = threadIdx.x, lane = tid & 63, wave = tid >> 6;
    float* red = (float*)lds;
    float* mod = (float*)(p.ws + WS_MOD);
    for (int item = blockIdx.x; item < 192; item += gridDim.x) {
        const int n0 = item * 32, cn = lane & 31, kq = lane >> 5;
        float a0 = 0.f, a1 = 0.f;
#pragma unroll 1
        for (int i0 = 0; i0 < 64; i0 += 16) {
            float wv[16];
#pragma unroll
            for (int i = 0; i < 16; ++i) wv[i] = __builtin_nontemporal_load(p.w_ada + (size_t)(wave * 128 + 2 * (i0 + i) + kq) * 6144 + n0 + cn);
#pragma unroll
            for (int i = 0; i < 16; ++i) { const int k = wave * 128 + 2 * (i0 + i) + kq; const float c0 = p.c[k], c1 = p.c[1024 + k];
                a0 += c0 * sigmoidf_(c0) * wv[i]; a1 += c1 * sigmoidf_(c1) * wv[i]; }
        }
        a0 += __shfl_xor(a0, 32); a1 += __shfl_xor(a1, 32);
        if (lane < 32) { red[(wave * 2 + 0) * 32 + cn] = a0; red[(wave * 2 + 1) * 32 + cn] = a1; }
        __syncthreads();
        if (tid < 64) { const int b = tid >> 5, cc = tid & 31; float s = 0.f;
            for (int w = 0; w < 8; ++w) s += red[(w * 2 + b) * 32 + cc];
            mod[b * 6144 + n0 + cc] = s + p.b_ada[n0 + cc]; }
        __syncthreads();
    }
}
__device__ __forceinline__ int ropeperm(int d) { return d < 16 ? 8 * (d >> 2) + (d & 3) : 8 * ((d - 16) >> 2) + 4 + (d & 3); }
__device__ __forceinline__ void transpose_item(const float* W, int N, int K, bf16_t* WT, int k0, int n0, int dst_row0, const float* kscale, float* scr, int lane, bool rperm = false) {
    float tv[32];
#pragma unroll
    for (int i = 0; i < 32; ++i) tv[i] = W[(size_t)(k0 + 2 * i + (lane >> 5)) * N + n0 + (lane & 31)];
#pragma unroll
    for (int i = 0; i < 32; ++i) { const int kk = 2 * i + (lane >> 5); float v = tv[i]; if (kscale) v *= kscale[k0 + kk]; scr[kk * 33 + (lane & 31)] = v; }
    __builtin_amdgcn_s_waitcnt(0); __builtin_amdgcn_wave_barrier();
    const int c = lane & 7;
#pragma unroll
    for (int j = 0; j < 4; ++j) { const int n = (lane >> 3) + 8 * j; const float* s = scr + (8 * c) * 33 + n;
        u32x4 o; o.x = pk2(s[0 * 33], s[1 * 33]); o.y = pk2(s[2 * 33], s[3 * 33]); o.z = pk2(s[4 * 33], s[5 * 33]); o.w = pk2(s[6 * 33], s[7 * 33]);
        *(u32x4*)(WT + (size_t)(dst_row0 + (rperm ? ropeperm(n) : n)) * K + k0 + 8 * c) = o; }
    __builtin_amdgcn_s_waitcnt(0); __builtin_amdgcn_wave_barrier();
}
__device__ __forceinline__ void transpose_item_fp8(const float* W, int N, int K, unsigned char* WT, int k0, int n0, int dst_row0, float* scr, int lane) {
    float tv[32];
#pragma unroll
    for (int i = 0; i < 32; ++i) tv[i] = W[(size_t)(k0 + 2 * i + (lane >> 5)) * N + n0 + (lane & 31)];
#pragma unroll
    for (int i = 0; i < 32; ++i) { const int kk = 2 * i + (lane >> 5); scr[kk * 33 + (lane & 31)] = tv[i] * W8_SCALE; }
    __builtin_amdgcn_s_waitcnt(0); __builtin_amdgcn_wave_barrier();
    const int c = lane & 3;
#pragma unroll
    for (int j = 0; j < 2; ++j) { const int n = (lane >> 2) + 16 * j; const float* sp = scr + (16 * c) * 33 + n;
        u32x4 o; o.x = pk4_fp8(sp[0 * 33], sp[1 * 33], sp[2 * 33], sp[3 * 33]); o.y = pk4_fp8(sp[4 * 33], sp[5 * 33], sp[6 * 33], sp[7 * 33]);
        o.z = pk4_fp8(sp[8 * 33], sp[9 * 33], sp[10 * 33], sp[11 * 33]); o.w = pk4_fp8(sp[12 * 33], sp[13 * 33], sp[14 * 33], sp[15 * 33]);
        *(u32x4*)(WT + (size_t)(dst_row0 + n) * K + k0 + 16 * c) = o; }
    __builtin_amdgcn_s_waitcnt(0); __builtin_amdgcn_wave_barrier();
}
__device__ __forceinline__ int in_colmap(int s) {
    if (s < 768) return s;
    if (s < 1152) return 1024 + (s - 768);
    if (s < 1408) return 768 + (s - 1152);
    if (s < 1440) return s;
    if (s < 2464) return 1536 + (s - 1440);
    return 2560 + (s - 2464);
}
#ifndef BG_CONV
#define BG_CONV 1
#endif
constexpr int BG_I_M1 = 32 * 16 * 64, BG_I_M2 = 32 * 16 * 32, BG_TOTAL = BG_I_M1 + BG_I_M2;
struct BgConv { float r[32]; int item, it, ngw; bool pend; };
__device__ __forceinline__ void bg_decode(const P& p, int item, const float*& W, int& N, unsigned char*& WT, int& k0, int& n0, int& dst) {
    if (item < BG_I_M1) { const int e = item >> 10, q = item & 1023, kb = q >> 6, nb = q & 63; n0 = nb * 32; const int j = n0 & 1023, lin = n0 >> 10;
        dst = (j >> 7) * 256 + lin * 128 + (j & 127); W = p.w_m1 + (size_t)e * 1024 * 2048; N = 2048; WT = p.ws + WS_WT_M1 + (size_t)e * 2048 * 1024; k0 = kb * 64; }
    else { const int r = item - BG_I_M1, e = r >> 9, q = r & 511, kb = q >> 5, nb = q & 31; n0 = nb * 32; dst = n0;
        W = p.w_m2 + (size_t)e * 1024 * 1024; N = 1024; WT = p.ws + WS_WT_M2 + (size_t)e * 1024 * 1024; k0 = kb * 64; }
}
__device__ __forceinline__ void bg_issue(const P& p, BgConv& g, int lane) {
    const float* W; int N, k0, n0, dst; unsigned char* WT; bg_decode(p, g.item, W, N, WT, k0, n0, dst);
    const float* src = W + (size_t)(k0 + (lane >> 5)) * N + n0 + (lane & 31);
#pragma unroll
    for (int i = 0; i < 32; ++i) g.r[i] = __builtin_nontemporal_load(src + (size_t)(2 * i) * N);
}
__device__ __forceinline__ void bg_finish(const P& p, BgConv& g, float* scr, int lane) {
    const float* W; int N, k0, n0, dst; unsigned char* WT; bg_decode(p, g.item, W, N, WT, k0, n0, dst);
    unsigned w[8];
#pragma unroll
    for (int i = 0; i < 16; i += 2) {
        const auto s0 = __builtin_amdgcn_permlane32_swap(__float_as_uint(g.r[i] * W8_SCALE), __float_as_uint(g.r[i + 16] * W8_SCALE), false, false);
        const auto s1 = __builtin_amdgcn_permlane32_swap(__float_as_uint(g.r[i + 1] * W8_SCALE), __float_as_uint(g.r[i + 17] * W8_SCALE), false, false);
        w[i >> 1] = pk4_fp8(__uint_as_float(s0[0]), __uint_as_float(s0[1]), __uint_as_float(s1[0]), __uint_as_float(s1[1]));
    }
    unsigned char* o = WT + (size_t)(dst + (lane & 31)) * 1024 + k0 + 32 * (lane >> 5);
    __builtin_nontemporal_store((u32x4){w[0], w[1], w[2], w[3]}, (u32x4*)o); __builtin_nontemporal_store((u32x4){w[4], w[5], w[6], w[7]}, (u32x4*)(o + 16));
}
__device__ __forceinline__ void bg_step(const P& p, BgConv& g, float* scr, int lane) {
    if ((g.it & 3) == 2 && g.pend) { bg_finish(p, g, scr, lane); g.item += g.ngw; g.pend = false; }
    if ((g.it & 3) == 0 && g.item < BG_TOTAL) { bg_issue(p, g, lane); g.pend = true; }
    ++g.it;
}
__device__ __forceinline__ void bg_step_fin(const P& p, BgConv& g, int lane) { if ((g.it & 3) == 2 && g.pend) { bg_finish(p, g, nullptr, lane); g.item += g.ngw; g.pend = false; } }
__device__ __forceinline__ void bg_step_iss(const P& p, BgConv& g, int lane) { if ((g.it & 3) == 0 && g.item < BG_TOTAL) { bg_issue(p, g, lane); g.pend = true; } ++g.it; }
__device__ __forceinline__ void bg_drain(const P& p, BgConv& g, float* scr, int lane) {
    if (g.pend) { bg_finish(p, g, scr, lane); g.item += g.ngw; g.pend = false; }
    while (g.item < BG_TOTAL) { bg_issue(p, g, lane); bg_finish(p, g, scr, lane); g.item += g.ngw; }
}
__device__ __forceinline__ void ph_convert(const P& p, unsigned char* lds) {
    const int tid = threadIdx.x, lane = tid & 63, wave = tid >> 6;
    const int gw = blockIdx.x * 8 + wave, NGW = gridDim.x * 8;
    float* scr = (float*)(lds + wave * 8704);
    bf16_t* WT_IN = (bf16_t*)(p.ws + WS_WT_IN); bf16_t* WT_UQ = (bf16_t*)(p.ws + WS_WT_UQ); bf16_t* WT_UKV = (bf16_t*)(p.ws + WS_WT_UKV);
    bf16_t* WT_A = (bf16_t*)(p.ws + WS_WT_A); bf16_t* WT_B = (bf16_t*)(p.ws + WS_WT_B); bf16_t* WT_OUT = (bf16_t*)(p.ws + WS_WT_OUT);
    bf16_t* WT_M1 = (bf16_t*)(p.ws + WS_WT_M1); bf16_t* WT_M2 = (bf16_t*)(p.ws + WS_WT_M2);
    constexpr int I_IN = 16 * 109, I_UQ = 6 * 24, I_UK = 4 * 16, I_A = 8 * 32, I_OUT = 16 * 32, I_M1 = 32 * 16 * 64, I_M2 = 32 * 16 * 32;
    constexpr int TOTAL = I_IN + I_UQ + 2 * I_UK + 2 * I_A + I_OUT + (BG_CONV ? 0 : I_M1 + I_M2);
    for (int it = gw; it < TOTAL; it += NGW) {
        int r = it;
        if (r < I_IN) { const int kb = r / 109, nb = r % 109;
            if (nb * 32 < 1440) transpose_item(p.w_in, 3488, 1024, WT_IN, kb * 64, nb * 32, in_colmap(nb * 32), nullptr, scr, lane, nb * 32 == 1408);
            else transpose_item_fp8(p.w_in, 3488, 1024, p.ws + WS_WT_G8, kb * 64, nb * 32, nb * 32 - 1440, scr, lane);
            continue; } r -= I_IN;
        if (r < I_UQ) { const int kb = r / 24, nb = r % 24; const int n0 = nb * 32, hh = n0 / 96, d = n0 % 96;
            const int dst = d < 64 ? hh * 64 + d : 512 + hh * 32; transpose_item(p.w_uq, 768, 384, WT_UQ, kb * 64, n0, dst, p.q_norm, scr, lane, d >= 64); continue; } r -= I_UQ;
        if (r < I_UK) { const int kb = r / 16, nb = r % 16; transpose_item(p.w_uk, 512, 256, WT_UKV, kb * 64, nb * 32, nb * 32, p.kv_norm, scr, lane); continue; } r -= I_UK;
        if (r < I_UK) { const int kb = r / 16, nb = r % 16; transpose_item(p.w_uv, 512, 256, WT_UKV, kb * 64, nb * 32, 512 + nb * 32, p.kv_norm, scr, lane); continue; } r -= I_UK;
        if (r < I_A) { const int kb = r / 32, nb = r % 32; transpose_item(p.w_a, 1024, 1024, WT_A, kb * 64, nb * 32, nb * 32, nullptr, scr, lane); continue; } r -= I_A;
        if (r < I_A) { const int kb = r / 32, nb = r % 32; transpose_item(p.w_b, 1024, 1024, WT_A + 512, kb * 64, nb * 32, nb * 32, nullptr, scr, lane); continue; } r -= I_A;
        if (r < I_OUT) { const int kb = r / 32, nb = r % 32; transpose_item_fp8(p.w_out, 1024, 1024, (unsigned char*)WT_OUT, kb * 64, nb * 32, nb * 32, scr, lane); continue; } r -= I_OUT;
        if (r < I_M1) { const int e = r / 1024, q = r % 1024, kb = q / 64, nb = q % 64; const int n0 = nb * 32, j = n0 & 1023, lin = n0 >> 10;
            const int dst = (j >> 7) * 256 + lin * 128 + (j & 127);
            transpose_item_fp8(p.w_m1 + (size_t)e * 1024 * 2048, 2048, 1024, (unsigned char*)WT_M1 + (size_t)e * 2048 * 1024, kb * 64, n0, dst, scr, lane); continue; } r -= I_M1;
        { const int e = r / 512, q = r % 512, kb = q / 32, nb = q % 32;
            transpose_item_fp8(p.w_m2 + (size_t)e * 1024 * 1024, 1024, 1024, (unsigned char*)WT_M2 + (size_t)e * 1024 * 1024, kb * 64, nb * 32, nb * 32, scr, lane); }
    }
    for (int i = blockIdx.x * NTHREADS + tid; i < 1024 * 32; i += gridDim.x * NTHREADS) { const int k = i >> 5, e = i & 31; ((float*)(p.ws + WS_WRT))[e * 1028 + k] = p.w_router[i]; }
    for (int i = blockIdx.x * NTHREADS + tid; i < 96 * 128; i += gridDim.x * NTHREADS) ((u32x4*)(WT_IN + (size_t)1440 * 1024))[i] = (u32x4){0u, 0u, 0u, 0u};
}

__device__ __forceinline__ void ph_xn(const P& p) {
    const int tid = threadIdx.x, lane = tid & 63, wave = tid >> 6;
    const int gw = blockIdx.x * 8 + wave, NGW = gridDim.x * 8;
    const float* mod = (const float*)(p.ws + WS_MOD);
    bf16_t* XN = (bf16_t*)(p.ws + WS_XN); float* COS = (float*)(p.ws + WS_COS); float* SIN = (float*)(p.ws + WS_SIN);
    for (int m = gw; m < MTOK; m += NGW) {
        const int b = m >> 13;
        const f32x4* xr = (const f32x4*)(p.x + (size_t)m * DM);
        f32x4 v[4]; float s = 0.f;
#pragma unroll
        for (int j = 0; j < 4; ++j) { v[j] = xr[lane + 64 * j]; s += v[j].x * v[j].x + v[j].y * v[j].y + v[j].z * v[j].z + v[j].w * v[j].w; }
        s = wave_sum(s);
        const float rstd = rsqrtf(s * (1.f / DM) + EPS);
#pragma unroll
        for (int j = 0; j < 4; ++j) { const int col = 4 * lane + 256 * j;
            const f32x4 g = *(const f32x4*)(p.norm_mix + col), sc = *(const f32x4*)(mod + b * 6144 + 1024 + col), sh = *(const f32x4*)(mod + b * 6144 + col);
            const f32x4 h = v[j] * rstd * g * (sc + 1.0f) + sh;
            u32x2 o; o.x = pk2(h.x, h.y); o.y = pk2(h.z, h.w); *(u32x2*)(XN + (size_t)m * DM + col) = o;
            *(unsigned*)(p.ws + WS_XN8 + (size_t)m * DM + col) = pk4_fp8(h.x, h.y, h.z, h.w); }
        if (lane < 16) {
            const float freq = exp2f(-(float)lane * 0.8304820237218406f);
            const float ang = (float)p.pos[m] * freq;
            double t = (double)ang * 0.15915494309189535; t -= rint(t);
            const float fr = (float)t;
            COS[m * 16 + lane] = __builtin_amdgcn_cosf(fr); SIN[m * 16 + lane] = __builtin_amdgcn_sinf(fr);
        }
    }
}

namespace pg8 {
#define PG8_LAS __attribute__((address_space(3)))
constexpr int BM = 256, BK = 64, HALF = 128, HTB = HALF * BK * 2, STAGE_BYTES = 8 * HTB, NXCD = 8, WGM = 8;
__device__ __forceinline__ int lds_byte(int r, int c) { const int st = (r >> 4) * 2 + (c >> 5), rr = r & 15, cc = c & 31, ob = rr * 64 + cc * 2; return st * 1024 + (ob ^ (((ob >> 9) & 1) << 5)); }
__device__ __forceinline__ void stage_rc(int b, int& R, int& C) { const int st = b / 1024, sb = b % 1024, swz = sb ^ (((sb >> 9) & 1) << 5); R = (st >> 1) * 16 + swz / 64; C = (st & 1) * 32 + (swz % 64) / 2; }
__device__ __forceinline__ int perm32(int rho) { const int n = rho >> 4, i = rho & 15; return 8 * (i >> 2) + 4 * n + (i & 3); }
struct GUnit { const char* a; const char* b; int pm, pn, e, cnt, tile, pad_; };
typedef float f32x2_t __attribute__((ext_vector_type(2))); typedef __bf16 bf16x2_t __attribute__((ext_vector_type(2)));
__device__ __forceinline__ unsigned cvt_pk_bf16(float lo, float hi) { f32x2_t v = {lo, hi}; bf16x2_t b = __builtin_convertvector(v, bf16x2_t); return __builtin_bit_cast(unsigned, b); }

struct DenseOrder {
    const char* A; const char* Bt; int K, nM, nN, nwg, G, c;
    __device__ void init(const void* A_, const void* Bt_, int M, int N, int K_, int G_, int c_) { A = (const char*)A_; Bt = (const char*)Bt_; K = K_; nM = M / BM; nN = N / BM; nwg = nM * nN; G = G_; c = c_; }
    __device__ bool next(int i, GUnit& u) const {
        const long L = (long)i * G + c; if (L >= nwg) return false;
        int wgid = (int)L; { const int q = nwg / NXCD, r = nwg % NXCD, xcd = wgid % NXCD, off = wgid / NXCD; wgid = (xcd < r ? xcd * (q + 1) : r * (q + 1) + (xcd - r) * q) + off; }
        const int nig = WGM * nN, gid = wgid / nig, fm = gid * WGM, gsz = (nM - fm) < WGM ? (nM - fm) : WGM;
        u.pm = fm + ((wgid % nig) % gsz); u.pn = (wgid % nig) / gsz; u.e = 0; u.cnt = 0; u.tile = 0; u.pad_ = 0;
        u.a = A + (size_t)u.pm * BM * K * 2; u.b = Bt + (size_t)u.pn * BM * K * 2; return true;
    }
    __device__ __forceinline__ unsigned a_rowoff(const GUnit&, int) const { return 0u; }
};

typedef int v8i32 __attribute__((ext_vector_type(8)));
typedef int v4i32 __attribute__((ext_vector_type(4)));
template <class Epi, class Sched, bool ALIGN_EPI, bool GATHER, bool FP8 = false>
__device__ __forceinline__ void gemm_phase(PG8_LAS unsigned char* lds, const int K, const Sched& S, const Epi& E) {
    int tid_ = threadIdx.x; asm volatile("" : "+v"(tid_));
    const int tid = tid_, wid = __builtin_amdgcn_readfirstlane(tid >> 6), lane = tid & 63, wr = wid >> 2, wc = wid & 3, fr = lane & 15, fq = lane >> 4;
    const int nt = K / BK;
    int RA[2]; unsigned CA[2], voffB[2];
#pragma unroll
    for (int i = 0; i < 2; ++i) { int R, C; stage_rc(tid * 16 + i * 8192, R, C); const int Rb = Epi::PERM ? ((R & ~31) + perm32(R & 31)) : R;
        RA[i] = R; CA[i] = (unsigned)C * 2u; voffB[i] = (unsigned)(Rb * K + C) * 2u; }
    const size_t kstep = (size_t)(BK * 2);
    const size_t hstep = (size_t)HALF * K * 2;
    const unsigned ldsw = (unsigned)wid * 1024u;
    const int aoff = lds_byte(wr * 64 + fr, FP8 ? fq * 16 : fq * 8), boff = lds_byte(wc * 32 + fr, FP8 ? fq * 16 : fq * 8);
#define PG8_SA(b, h) (((b) * 2 + (h)) * HTB)
#define PG8_SB(b, h) ((4 + (b) * 2 + (h)) * HTB)
#define PG8_STAGE(bufoff, gbase, voff) do { _Pragma("unroll") for (int _i = 0; _i < 2; ++_i) { unsigned o_ = (voff)[_i]; asm volatile("" : "+v"(o_));     \
        __builtin_amdgcn_global_load_lds((const unsigned*)((const char*)(gbase) + o_), (PG8_LAS unsigned*)(lds + (bufoff) + ldsw + _i * 8192), 16, 0, 0); } } while (0)
#define PG8_LD16(p) (*(const PG8_LAS v4i32*)(p))
#define PG8_LDA(dst, b, h) do { if constexpr (FP8) { _Pragma("unroll") for (int m = 0; m < 4; ++m) { const PG8_LAS unsigned char* p_ = lds + PG8_SA(b, h) + aoff + m * 2048; \
            dst##8[m] = __builtin_shufflevector(PG8_LD16(p_), PG8_LD16(p_ + 16), 0, 1, 2, 3, 4, 5, 6, 7); } } \
        else { _Pragma("unroll") for (int m = 0; m < 4; ++m) _Pragma("unroll") for (int k = 0; k < 2; ++k) dst[m][k] = *(const PG8_LAS bf16x8*)(lds + PG8_SA(b, h) + aoff + m * 2048 + k * 1024); } } while (0)
#define PG8_LDB(dst, b, h) do { if constexpr (FP8) { _Pragma("unroll") for (int n = 0; n < 2; ++n) { const PG8_LAS unsigned char* p_ = lds + PG8_SB(b, h) + boff + n * 2048; \
            dst##8[n] = __builtin_shufflevector(PG8_LD16(p_), PG8_LD16(p_ + 16), 0, 1, 2, 3, 4, 5, 6, 7); } } \
        else { _Pragma("unroll") for (int n = 0; n < 2; ++n) _Pragma("unroll") for (int k = 0; k < 2; ++k) dst[n][k] = *(const PG8_LAS bf16x8*)(lds + PG8_SB(b, h) + boff + n * 2048 + k * 1024); } } while (0)
#define PG8_MMA(ai, bj, At, Bt) do { __builtin_amdgcn_s_setprio(1); \
        if constexpr (FP8) { _Pragma("unroll") for (int m = 0; m < 4; ++m) _Pragma("unroll") for (int n = 0; n < 2; ++n) \
                asm volatile("v_mfma_scale_f32_16x16x128_f8f6f4 %0, %1, %2, %0, %3, %3 op_sel_hi:[0,0,0]" : "+v"(acc[ai][bj][m][n]) : "v"(Bt##8[n]), "v"(At##8[m]), "v"(scl8)); } \
        else { _Pragma("unroll") for (int m = 0; m < 4; ++m) _Pragma("unroll") for (int n = 0; n < 2; ++n) _Pragma("unroll") for (int k = 0; k < 2; ++k) \
                acc[ai][bj][m][n] = __builtin_amdgcn_mfma_f32_16x16x32_bf16(Bt[n][k], At[m][k], acc[ai][bj][m][n], 0, 0, 0); } \
        __builtin_amdgcn_s_setprio(0); } while (0)
#define PG8_WAIT_V(n) asm volatile("s_waitcnt vmcnt(" #n ")" ::: "memory")
#define PG8_WAIT_L(n) asm volatile("s_waitcnt lgkmcnt(" #n ")" ::: "memory")
#define PG8_BAR __builtin_amdgcn_s_barrier()
#define PG8_SCHED __builtin_amdgcn_sched_barrier(0)
#define PG8_VOFF(u, v) do { _Pragma("unroll") for (int _i = 0; _i < 2; ++_i) { int r_ = RA[_i]; if (GATHER) asm volatile("" : "+v"(r_));     \
        _Pragma("unroll") for (int _h = 0; _h < 2; ++_h) v[_h][_i] = GATHER ? (S.a_rowoff(u, _h * HALF + r_) + CA[_i]) : ((unsigned)((_h * HALF + r_) * K) * 2u + CA[_i]); } } while (0)
    GUnit cur, nxt; int ui = 0;
    if (!S.next(0, cur)) return;
    f32x4 acc[2][2][4][2];
#pragma unroll
    for (int a = 0; a < 2; ++a)
#pragma unroll
        for (int b = 0; b < 2; ++b)
#pragma unroll
            for (int m = 0; m < 4; ++m)
#pragma unroll
                for (int n = 0; n < 2; ++n) acc[a][b][m][n] = (f32x4){0.f, 0.f, 0.f, 0.f};
    bf16x8 At[4][2], B0[2][2], B1[2][2];
    v8i32 At8[4], B08[2], B18[2];
    const int scl8 = 0x7f7f7f7f;
    unsigned vAc[2][2], vAn[2][2];
    PG8_VOFF(cur, vAc);
    if (GATHER) { asm volatile("s_waitcnt vmcnt(0)" : "+v"(vAc[0][0]), "+v"(vAc[0][1]), "+v"(vAc[1][0]), "+v"(vAc[1][1]) :: "memory"); }
    const char* cA = cur.a; const char* cB = cur.b;
    PG8_STAGE(PG8_SB(0, 0), cB, voffB); PG8_STAGE(PG8_SB(0, 1), cB + hstep, voffB); PG8_STAGE(PG8_SA(0, 0), cA, vAc[0]); PG8_STAGE(PG8_SA(0, 1), cA, vAc[1]);
    if (wr == 1) PG8_BAR;
    PG8_WAIT_V(2); PG8_BAR;
    PG8_STAGE(PG8_SB(1, 0), cB + kstep, voffB); PG8_STAGE(PG8_SA(1, 0), cA + kstep, vAc[0]); PG8_STAGE(PG8_SB(1, 1), cB + hstep + kstep, voffB);
    PG8_WAIT_V(6); PG8_BAR;
    for (;;) {
        const bool has_next = S.next(ui + 1, nxt);
        const char* nA = has_next ? nxt.a : cA; const char* nB = has_next ? nxt.b : cB;
        if (GATHER) {
            if (has_next) { PG8_VOFF(nxt, vAn); }
            else {
#pragma unroll
                for (int h = 0; h < 2; ++h)
#pragma unroll
                    for (int i = 0; i < 2; ++i) vAn[h][i] = vAc[h][i]; }
            asm volatile("s_waitcnt vmcnt(0)" : "+v"(vAn[0][0]), "+v"(vAn[0][1]), "+v"(vAn[1][0]), "+v"(vAn[1][1]) :: "memory");
        }
#pragma unroll 1
        for (int t = 0; t < nt; t += 2) {
            const bool last = (t == nt - 2);
            if constexpr (Epi::HAS_MID) { if (t == (nt >> 1)) { int t_ = threadIdx.x; asm volatile("" : "+v"(t_)); E.mid(acc, cur, wr, wc, t_ & 15, (t_ >> 4) & 3); } }
            const char* a1 = cA + (size_t)(t + 1) * kstep;
            const char* a2 = last ? nA : cA + (size_t)(t + 2) * kstep; const char* b2 = last ? nB : cB + (size_t)(t + 2) * kstep;
            const char* a3 = a2 + kstep; const char* b3 = b2 + kstep;
            unsigned v2[2][2];
#pragma unroll
            for (int h = 0; h < 2; ++h)
#pragma unroll
                for (int i = 0; i < 2; ++i) v2[h][i] = (GATHER && last) ? vAn[h][i] : vAc[h][i];
            PG8_LDB(B0, 0, 0); PG8_LDB(B1, 0, 1); PG8_SCHED; PG8_LDA(At, 0, 0); PG8_STAGE(PG8_SA(1, 1), a1, vAc[1]);
            PG8_WAIT_V(8); PG8_WAIT_L(0); PG8_BAR; PG8_MMA(0, 0, At, B0); PG8_MMA(0, 1, At, B1); PG8_BAR; PG8_SCHED;
            PG8_LDA(At, 0, 1); PG8_STAGE(PG8_SB(0, 0), b2, voffB); PG8_STAGE(PG8_SB(0, 1), b2 + hstep, voffB); PG8_STAGE(PG8_SA(0, 0), a2, v2[0]);
            PG8_WAIT_V(8); PG8_WAIT_L(0); PG8_BAR; PG8_MMA(1, 0, At, B0); PG8_MMA(1, 1, At, B1); PG8_BAR; PG8_SCHED;
            PG8_LDB(B0, 1, 0); PG8_LDB(B1, 1, 1); PG8_SCHED; PG8_LDA(At, 1, 0); PG8_STAGE(PG8_SA(0, 1), a2, v2[1]);
            PG8_WAIT_V(8); PG8_WAIT_L(0); PG8_BAR; PG8_MMA(0, 0, At, B0); PG8_MMA(0, 1, At, B1); PG8_BAR; PG8_SCHED;
            PG8_LDA(At, 1, 1); PG8_STAGE(PG8_SB(1, 0), b3, voffB); PG8_STAGE(PG8_SB(1, 1), b3 + hstep, voffB); PG8_STAGE(PG8_SA(1, 0), a3, v2[0]);
            PG8_WAIT_V(8); PG8_WAIT_L(0); PG8_BAR; PG8_MMA(1, 0, At, B0); PG8_MMA(1, 1, At, B1); PG8_BAR; PG8_SCHED;
        }
        if constexpr (FP8) {
            asm volatile("s_nop 15\n\ts_nop 15" ::: "memory");
#pragma unroll
            for (int a = 0; a < 2; ++a)
#pragma unroll
                for (int b = 0; b < 2; ++b)
#pragma unroll
                    for (int m = 0; m < 4; ++m) asm volatile("" : "+v"(acc[a][b][m][0]), "+v"(acc[a][b][m][1]));
        }
        if constexpr (ALIGN_EPI) { if (wr == 0) PG8_BAR; }
        { int t_ = threadIdx.x; asm volatile("" : "+v"(t_));
          E(acc, cur, wr, wc, t_ & 15, (t_ >> 4) & 3); }
        if (!has_next) break;
#pragma unroll
        for (int a = 0; a < 2; ++a)
#pragma unroll
            for (int b = 0; b < 2; ++b)
#pragma unroll
                for (int m = 0; m < 4; ++m)
#pragma unroll
                    for (int n = 0; n < 2; ++n) acc[a][b][m][n] = (f32x4){0.f, 0.f, 0.f, 0.f};
        cur = nxt; cA = nA; cB = nB; ++ui;
#pragma unroll
        for (int h = 0; h < 2; ++h)
#pragma unroll
            for (int i = 0; i < 2; ++i) vAc[h][i] = vAn[h][i];
        if constexpr (ALIGN_EPI) { if (wr == 1) PG8_BAR; }
    }
    PG8_WAIT_V(0);
    if constexpr (!ALIGN_EPI) { if (wr == 0) PG8_BAR; }
    PG8_BAR;
#undef PG8_SA
#undef PG8_SB
#undef PG8_STAGE
#undef PG8_LDA
#undef PG8_LDB
#undef PG8_MMA
#undef PG8_LD16
#undef PG8_WAIT_V
#undef PG8_WAIT_L
#undef PG8_BAR
#undef PG8_SCHED
#undef PG8_VOFF
}
}
#define LAS __attribute__((address_space(3)))
__device__ __forceinline__ u32x4 pack8(const f32x4& v0, const f32x4& v1) { u32x4 w; w.x = pg8::cvt_pk_bf16(v0[0], v0[1]); w.y = pg8::cvt_pk_bf16(v0[2], v0[3]); w.z = pg8::cvt_pk_bf16(v1[0], v1[1]); w.w = pg8::cvt_pk_bf16(v1[2], v1[3]); return w; }
__device__ __forceinline__ void unpack8(const u32x4& w, f32x4& v0, f32x4& v1) { v0 = (f32x4){bf2f(w.x & 0xffffu), bf2f(w.x >> 16), bf2f(w.y & 0xffffu), bf2f(w.y >> 16)}; v1 = (f32x4){bf2f(w.z & 0xffffu), bf2f(w.z >> 16), bf2f(w.w & 0xffffu), bf2f(w.w >> 16)}; }
__device__ __forceinline__ float sigs_(float a) { return __builtin_amdgcn_rcpf(1.f + __builtin_amdgcn_exp2f(a * (-LOG2E * W8_INV))); }
__device__ __forceinline__ f32x4 sig4s(const f32x4& v) { return (f32x4){sigs_(v[0]), sigs_(v[1]), sigs_(v[2]), sigs_(v[3])}; }
__device__ __forceinline__ f32x4 sig4(const f32x4& v) { return (f32x4){sigmoidf_(v[0]), sigmoidf_(v[1]), sigmoidf_(v[2]), sigmoidf_(v[3])}; }

struct EpiProj {
    static constexpr bool PERM = true, HAS_MID = false;
    unsigned char* ws;
    __device__ __forceinline__ void operator()(const f32x4 (&acc)[2][2][4][2], const pg8::GUnit& u, int wr, int wc, int fr, int fq) const {
        const int row0 = u.pm * 256 + wr * 64 + fr;
#pragma unroll
        for (int bj = 0; bj < 2; ++bj) {
            const int cl = bj * 128 + wc * 32 + 8 * fq;
            bf16_t* base; int ld, c; float sc = 1.f; bool sg = false;
            const int pn = u.pn;
            if (pn < 2) { base = (bf16_t*)(ws + WS_QA); ld = 512; c = pn * 256 + cl; sc = 0.125f * LOG2E; }
            else if (pn == 2) { base = (bf16_t*)(ws + (bj == 0 ? WS_KA : WS_VA)); ld = 128; c = wc * 32 + 8 * fq; }
            else if (pn == 3) { base = (bf16_t*)(ws + WS_CKV); ld = 256; c = cl; }
            else if (pn == 4) { base = (bf16_t*)(ws + WS_CQ); ld = 384; c = cl; }
            else if (pn == 5) { if (bj == 0) { base = (bf16_t*)(ws + WS_CQ); ld = 384; c = 256 + wc * 32 + 8 * fq; } else { if (wc != 0) continue; base = (bf16_t*)(ws + WS_KR); ld = 32; c = 8 * fq; } }
            else if (pn < 10) { base = (bf16_t*)(ws + WS_GA); ld = 1024; c = (pn - 6) * 256 + cl; sg = true; }
            else { base = (bf16_t*)(ws + WS_GB); ld = 1024; c = (pn - 10) * 256 + cl; sg = true; }
            const bool is_kr = pn == 5 && bj == 1;
#pragma unroll
            for (int ai = 0; ai < 2; ++ai)
#pragma unroll
                for (int m = 0; m < 4; ++m) { f32x4 v0 = acc[ai][bj][m][0], v1 = acc[ai][bj][m][1]; const int row = row0 + ai * 128 + m * 16;
                    if (is_kr) { const f32x4 cs = *(const f32x4*)((const float*)(ws + WS_COS) + row * 16 + 4 * fq), sn = *(const f32x4*)((const float*)(ws + WS_SIN) + row * 16 + 4 * fq);
                        const f32x4 o1 = v0 * cs - v1 * sn, o2 = v1 * cs + v0 * sn; v0 = o1; v1 = o2; }
                    else if (sg) { v0 = sig4(v0); v1 = sig4(v1); } else { v0 = v0 * sc; v1 = v1 * sc; }
                    *(u32x4*)(base + (size_t)row * ld + c) = pack8(v0, v1); }
        }
        if (u.pn >= 3 && u.pn <= 5) {
            float* SSQ = (float*)(ws + WS_SSQ);
#pragma unroll
            for (int ai = 0; ai < 2; ++ai)
#pragma unroll
                for (int m = 0; m < 4; ++m) { float q = 0.f;
#pragma unroll
                    for (int bj = 0; bj < 2; ++bj) { if (u.pn == 5 && bj == 1) continue;
#pragma unroll
                        for (int n = 0; n < 2; ++n) { const f32x4 v = acc[ai][bj][m][n]; q += (v[0] * v[0] + v[1] * v[1]) + (v[2] * v[2] + v[3] * v[3]); } }
                    q += __shfl_xor(q, 16); q += __shfl_xor(q, 32);
                    const int slot = u.pn == 3 ? 8 + wc : u.pn == 4 ? wc : 4 + wc;
                    if (fq == 0) SSQ[slot * MTOK + row0 + ai * 128 + m * 16] = q; }
        }
    }
};
struct EpiUpQ {
    static constexpr bool PERM = true, HAS_MID = false;
    unsigned char* ws;
    __device__ __forceinline__ void operator()(const f32x4 (&acc)[2][2][4][2], const pg8::GUnit& u, int wr, int wc, int fr, int fq) const {
        const float qs0 = 0.10206207261596577f * LOG2E;
        const int row0 = u.pm * 256 + wr * 64 + fr;
        const float* COS = (const float*)(ws + WS_COS); const float* SIN = (const float*)(ws + WS_SIN); const float* SSQ = (const float*)(ws + WS_SSQ);
        float rq[2][4];
#pragma unroll
        for (int ai = 0; ai < 2; ++ai)
#pragma unroll
            for (int m = 0; m < 4; ++m) { const int row = row0 + ai * 128 + m * 16; float q = 0.f;
#pragma unroll
                for (int sl = 0; sl < 8; ++sl) q += SSQ[sl * MTOK + row];
                rq[ai][m] = rsqrtf(q * (1.f / 384.f) + EPS); }
#pragma unroll
        for (int bj = 0; bj < 2; ++bj) { const int cl = bj * 128 + wc * 32 + 8 * fq;
#pragma unroll
            for (int ai = 0; ai < 2; ++ai)
#pragma unroll
                for (int m = 0; m < 4; ++m) { const int row = row0 + ai * 128 + m * 16; f32x4 v0 = acc[ai][bj][m][0], v1 = acc[ai][bj][m][1];
                    const float qs = qs0 * rq[ai][m];
                    if (u.pn < 2) { *(u32x4*)((bf16_t*)(ws + WS_QN) + (size_t)row * 512 + u.pn * 256 + cl) = pack8(v0 * qs, v1 * qs); }
                    else { const f32x4 cs = *(const f32x4*)(COS + row * 16 + 4 * fq), sn = *(const f32x4*)(SIN + row * 16 + 4 * fq);
                        const f32x4 o1 = (v0 * cs - v1 * sn) * qs, o2 = (v1 * cs + v0 * sn) * qs;
                        *(u32x4*)((bf16_t*)(ws + WS_QR) + (size_t)row * 256 + cl) = pack8(o1, o2); }
                    asm volatile("" ::: "memory"); }
        }
    }
};
struct EpiUpKV {
    static constexpr bool PERM = true, HAS_MID = false;
    unsigned char* ws;
    __device__ __forceinline__ void operator()(const f32x4 (&acc)[2][2][4][2], const pg8::GUnit& u, int wr, int wc, int fr, int fq) const {
        const int row0 = u.pm * 256 + wr * 64 + fr;
        bf16_t* base = (bf16_t*)(ws + (u.pn < 2 ? WS_KN : WS_VB)); const float* SSQ = (const float*)(ws + WS_SSQ);
        float rk[2][4];
#pragma unroll
        for (int ai = 0; ai < 2; ++ai)
#pragma unroll
            for (int m = 0; m < 4; ++m) { const int row = row0 + ai * 128 + m * 16;
                const float q = (SSQ[8 * MTOK + row] + SSQ[9 * MTOK + row]) + (SSQ[10 * MTOK + row] + SSQ[11 * MTOK + row]);
                rk[ai][m] = rsqrtf(q * (1.f / 256.f) + EPS); }
#pragma unroll
        for (int bj = 0; bj < 2; ++bj) { const int c = (u.pn & 1) * 256 + bj * 128 + wc * 32 + 8 * fq;
#pragma unroll
            for (int ai = 0; ai < 2; ++ai)
#pragma unroll
                for (int m = 0; m < 4; ++m) *(u32x4*)(base + (size_t)(row0 + ai * 128 + m * 16) * 512 + c) = pack8(acc[ai][bj][m][0] * rk[ai][m], acc[ai][bj][m][1] * rk[ai][m]); }
    }
};
struct EpiMixF {
    static constexpr bool PERM = true, HAS_MID = true;
    unsigned char* ws;
    __device__ __forceinline__ void mid(f32x4 (&acc)[2][2][4][2], const pg8::GUnit& u, int wr, int wc, int fr, int fq) const {
        const int row0 = u.pm * 256 + wr * 64 + fr;
        const bf16_t* GA = (const bf16_t*)(ws + WS_GA); const bf16_t* GB = (const bf16_t*)(ws + WS_GB);
#pragma unroll
        for (int bj = 0; bj < 2; ++bj) { const int c = u.pn * 256 + bj * 128 + wc * 32 + 8 * fq;
#pragma unroll
            for (int ai = 0; ai < 2; ++ai)
#pragma unroll
                for (int m = 0; m < 4; ++m) { const size_t idx = (size_t)(row0 + ai * 128 + m * 16) * 1024 + c;
                    f32x4 a0, a1, b0, b1; unpack8(*(const u32x4*)(GA + idx), a0, a1); unpack8(*(const u32x4*)(GB + idx), b0, b1);
#pragma unroll
                    for (int i = 0; i < 4; ++i) { acc[ai][bj][m][0][i] *= a0[i] * __builtin_amdgcn_rcpf(fmaxf(b0[i], 1e-30f)); acc[ai][bj][m][1][i] *= a1[i] * __builtin_amdgcn_rcpf(fmaxf(b1[i], 1e-30f)); }
                    if (m == 3) asm volatile("" ::: "memory"); } }
    }
    __device__ __forceinline__ void operator()(const f32x4 (&acc)[2][2][4][2], const pg8::GUnit& u, int wr, int wc, int fr, int fq) const {
        const int row0 = u.pm * 256 + wr * 64 + fr;
        const bf16_t* GB = (const bf16_t*)(ws + WS_GB); bf16_t* MIX = (bf16_t*)(ws + WS_MIX);
#pragma unroll
        for (int bj = 0; bj < 2; ++bj) { const int c = u.pn * 256 + bj * 128 + wc * 32 + 8 * fq;
#pragma unroll
            for (int ai = 0; ai < 2; ++ai)
#pragma unroll
                for (int m = 0; m < 4; ++m) { const size_t idx = (size_t)(row0 + ai * 128 + m * 16) * 1024 + c;
                    f32x4 g0, g1; unpack8(*(const u32x4*)(GB + idx), g0, g1);
                    const f32x4 y0 = g0 * acc[ai][bj][m][0] * MIX8_SCALE, y1 = g1 * acc[ai][bj][m][1] * MIX8_SCALE;
                    u32x2 o8; o8.x = pk4_fp8(y0[0], y0[1], y0[2], y0[3]); o8.y = pk4_fp8(y1[0], y1[1], y1[2], y1[3]);
                    *(u32x2*)((unsigned char*)MIX + idx) = o8; if (m & 1) asm volatile("" ::: "memory"); } }
    }
};
struct EpiOut {
    static constexpr bool PERM = true, HAS_MID = false;
    unsigned char* ws; const float* x;
    __device__ __forceinline__ void operator()(const f32x4 (&acc)[2][2][4][2], const pg8::GUnit& u, int wr, int wc, int fr, int fq) const {
        const int row0 = u.pm * 256 + wr * 64 + fr; const int b = (u.pm * 256) >> 13;
        const float* mod = (const float*)(ws + WS_MOD); bf16_t* X1 = (bf16_t*)(ws + WS_X1);
#pragma unroll
        for (int bj = 0; bj < 2; ++bj) { const int c = u.pn * 256 + bj * 128 + wc * 32 + 8 * fq;
            const f32x4 g0 = *(const f32x4*)(mod + b * 6144 + 2048 + c) * OUT8_INV, g1 = *(const f32x4*)(mod + b * 6144 + 2048 + c + 4) * OUT8_INV;
#pragma unroll
            for (int ai = 0; ai < 2; ++ai)
#pragma unroll
                for (int m = 0; m < 4; ++m) { const size_t idx = (size_t)(row0 + ai * 128 + m * 16) * 1024 + c;
                    const f32x4 x0 = *(const f32x4*)(x + idx), x1 = *(const f32x4*)(x + idx + 4);
                    *(u32x4*)(X1 + idx) = pack8(x0 + g0 * acc[ai][bj][m][0], x1 + g1 * acc[ai][bj][m][1]); if (m & 1) asm volatile("" ::: "memory"); } }
    }
};

constexpr int RT_LD = 1028;
__device__ __forceinline__ void ph_route(const P& p, unsigned char* lds, bool commit = true) {
    const int tid = threadIdx.x, lane = tid & 63, wave = tid >> 6, e = lane & 31, hf = lane >> 5;
    const int RPW = MTOK / gridDim.x;
    float* h2s = (float*)lds;
    unsigned* lcnt = (unsigned*)(lds + 132096); unsigned* lbase = lcnt + 32; unsigned* lent = lcnt + 64; float* lw = (float*)(lcnt + 64 + 256);
    float* lg = (float*)(lcnt + 64 + 512) + wave * 128 + hf * 64;
    if (tid < NEXP) lcnt[tid] = 0u;
    const float* mod = (const float*)(p.ws + WS_MOD); const bf16_t* X1 = (const bf16_t*)(p.ws + WS_X1); unsigned char* H2 = p.ws + WS_XN;
    unsigned* cnt = (unsigned*)(p.ws + WS_CTL); unsigned* LIST = (unsigned*)(p.ws + WS_LIST); float* LISTW = (float*)(p.ws + WS_LISTW);
    u32x4 wh[8], wl[8];
    { const float* wrt = (const float*)(p.ws + WS_WRT) + e * 1028 + 128 * wave + 8 * hf;
#pragma unroll
      for (int ks = 0; ks < 8; ++ks) { const f32x4 a = *(const f32x4*)(wrt + 16 * ks), b = *(const f32x4*)(wrt + 16 * ks + 4); f32x4 ha, hb;
          wh[ks] = pack8(a, b); unpack8(wh[ks], ha, hb); wl[ks] = pack8(a - ha, b - hb); } }
    const float brt = p.b_router[e];
    for (int pass = 0; pass * 32 < RPW; ++pass) {
        u32x2 xw[4][4];
#pragma unroll
        for (int rr = 0; rr < 4; ++rr) { const u32x2* xr = (const u32x2*)(X1 + (size_t)(blockIdx.x * RPW + pass * 32 + 4 * wave + rr) * DM);
#pragma unroll
            for (int j = 0; j < 4; ++j) xw[rr][j] = xr[lane + 64 * j]; }
#pragma unroll
        for (int rr = 0; rr < 4; ++rr) {
            const int rl = 4 * wave + rr, m = blockIdx.x * RPW + pass * 32 + rl, b = m >> 13;
            f32x4 v[4]; float s = 0.f;
#pragma unroll
            for (int j = 0; j < 4; ++j) { const u32x2 w = xw[rr][j]; v[j] = (f32x4){bf2f(w.x & 0xffffu), bf2f(w.x >> 16), bf2f(w.y & 0xffffu), bf2f(w.y >> 16)};
                s += v[j].x * v[j].x + v[j].y * v[j].y + v[j].z * v[j].z + v[j].w * v[j].w; }
            s = wave_sum(s);
            const float rstd = rsqrtf(s * (1.f / DM) + EPS);
#pragma unroll
            for (int j = 0; j < 4; ++j) { const int col = 4 * lane + 256 * j;
                const f32x4 g = *(const f32x4*)(p.norm_ffn + col), sc = *(const f32x4*)(mod + b * 6144 + 4096 + col), sh = *(const f32x4*)(mod + b * 6144 + 3072 + col);
                v[j] = v[j] * rstd * g * (sc + 1.0f) + sh;
                *(unsigned*)(H2 + (size_t)m * DM + col) = pk4_fp8(v[j].x, v[j].y, v[j].z, v[j].w);
                *(f32x4*)(h2s + rl * RT_LD + col) = v[j]; }
        }
        __syncthreads();
        typedef float f32x16r __attribute__((ext_vector_type(16)));
        f32x16r acc, acc1, acc2;
#pragma unroll
        for (int r = 0; r < 16; ++r) { acc[r] = 0.f; acc1[r] = 0.f; acc2[r] = 0.f; }
        const float* ap = h2s + e * RT_LD + 128 * wave + 8 * hf;
#pragma unroll
        for (int ks = 0; ks < 8; ++ks) { const f32x4 a = *(const f32x4*)(ap + 16 * ks), b = *(const f32x4*)(ap + 16 * ks + 4); f32x4 ha, hb;
            const u32x4 ah = pack8(a, b); unpack8(ah, ha, hb); const u32x4 al = pack8(a - ha, b - hb);
            acc  = __builtin_amdgcn_mfma_f32_32x32x16_bf16(__builtin_bit_cast(bf16x8, ah), __builtin_bit_cast(bf16x8, wh[ks]), acc, 0, 0, 0);
            acc1 = __builtin_amdgcn_mfma_f32_32x32x16_bf16(__builtin_bit_cast(bf16x8, ah), __builtin_bit_cast(bf16x8, wl[ks]), acc1, 0, 0, 0);
            acc2 = __builtin_amdgcn_mfma_f32_32x32x16_bf16(__builtin_bit_cast(bf16x8, al), __builtin_bit_cast(bf16x8, wh[ks]), acc2, 0, 0, 0); }
#pragma unroll
        for (int r = 0; r < 16; ++r) acc[r] += acc1[r] + acc2[r];
        __syncthreads();
#pragma unroll
        for (int r = 0; r < 16; ++r) h2s[(wave * 32 + ((r & 3) + 8 * (r >> 2) + 4 * hf)) * 32 + e] = acc[r];
        __syncthreads();
#pragma unroll 1
        for (int it = 0; it < 2; ++it) {
            const int rl = 4 * wave + 2 * it + hf, ri = pass * 32 + rl;
            float val = brt;
#pragma unroll
            for (int w8 = 0; w8 < 8; ++w8) val += h2s[(w8 * 32 + rl) * 32 + e];
            lg[e] = val;
            int rank = 0;
#pragma unroll
            for (int e4 = 0; e4 < 8; ++e4) { const f32x4 o = *(const f32x4*)(lg + 4 * e4);
#pragma unroll
                for (int i = 0; i < 4; ++i) { const int ee = 4 * e4 + i; rank += (o[i] > val || (o[i] == val && ee < e)) ? 1 : 0; } }
            if (rank < 4) { lg[32 + rank] = val; lg[36 + rank] = __int_as_float(e); }
            const f32x4 tvv = *(const f32x4*)(lg + 32), tiv = *(const f32x4*)(lg + 36);
            const float e1 = __expf(tvv[1] - tvv[0]), e2 = __expf(tvv[2] - tvv[0]), e3 = __expf(tvv[3] - tvv[0]);
            const float inv = 1.f / (1.f + e1 + e2 + e3);
            if (e < 4) {
                const int ex = __float_as_int(e == 0 ? tiv[0] : e == 1 ? tiv[1] : e == 2 ? tiv[2] : tiv[3]);
                const float w = (e == 0 ? 1.f : e == 1 ? e1 : e == 2 ? e2 : e3) * inv;
                const unsigned lr = atomicAdd(&lcnt[ex], 1u);
                lent[ri * 4 + e] = (unsigned)ex | (lr << 8); lw[ri * 4 + e] = w;
            }
        }
        __syncthreads();
    }
    if (!commit) return;
    if (tid < NEXP) lbase[tid] = atomicAdd(&cnt[tid * 64], lcnt[tid]);
    __syncthreads();
    for (int a = tid; a < RPW * 4; a += NTHREADS) {
        const unsigned en = lent[a]; const int ex = (int)(en & 255u); const unsigned pos = lbase[ex] + (en >> 8);
        LIST[(size_t)ex * LISTCAP + pos] = (unsigned)((blockIdx.x * RPW + (a >> 2)) * 4 + (a & 3));
        ((float*)(p.ws + WS_TOPW))[(size_t)blockIdx.x * RPW * 4 + a] = lw[a];
    }
}
__device__ __forceinline__ void ph_final(const P& p) {
    const int tid = threadIdx.x, lane = tid & 63, wave = tid >> 6;
    const int gw = blockIdx.x * 8 + wave, NGW = gridDim.x * 8;
    const float* mod = (const float*)(p.ws + WS_MOD); const bf16_t* X1 = (const bf16_t*)(p.ws + WS_X1); const unsigned char* Y = (const unsigned char*)(p.ws + WS_Y);
    for (int m = gw; m < MTOK; m += NGW) {
        const int b = m >> 13;
        const u32x2* xr = (const u32x2*)(X1 + (size_t)m * DM);
        f32x4 v[4]; float s = 0.f;
        const f32x4 tw = *(const f32x4*)((const float*)(p.ws + WS_TOPW) + (size_t)m * 4);
#pragma unroll
        for (int j = 0; j < 4; ++j) { const int col = 4 * lane + 256 * j;
            f32x4 y = (f32x4){0.f, 0.f, 0.f, 0.f};
#pragma unroll
            for (int k = 0; k < 4; ++k) { const int w = (int)__builtin_nontemporal_load((const unsigned*)(Y + ((size_t)m * 4 + k) * 1024 + col));
                y.x += tw[k] * __builtin_amdgcn_cvt_f32_fp8(w, 0); y.y += tw[k] * __builtin_amdgcn_cvt_f32_fp8(w, 1); y.z += tw[k] * __builtin_amdgcn_cvt_f32_fp8(w, 2); y.w += tw[k] * __builtin_amdgcn_cvt_f32_fp8(w, 3); }
            const f32x4 g2 = *(const f32x4*)(mod + b * 6144 + 5120 + col);
            const u32x2 xw = xr[lane + 64 * j];
            v[j] = (f32x4){bf2f(xw.x & 0xffffu), bf2f(xw.x >> 16), bf2f(xw.y & 0xffffu), bf2f(xw.y >> 16)} + g2 * y;
            s += v[j].x * v[j].x + v[j].y * v[j].y + v[j].z * v[j].z + v[j].w * v[j].w; }
        s = wave_sum(s);
        const float rstd = rsqrtf(s * (1.f / DM) + EPS);
#pragma unroll
        for (int j = 0; j < 4; ++j) { const int col = 4 * lane + 256 * j; const f32x4 g = *(const f32x4*)(p.fnorm + col);
            *(f32x4*)(p.out + (size_t)m * DM + col) = v[j] * rstd * g; }
    }
}


struct EpiGate {
    static constexpr bool PERM = true, HAS_MID = false;
    unsigned char* ws;
    __device__ __forceinline__ void operator()(const f32x4 (&acc)[2][2][4][2], const pg8::GUnit& u, int wr, int wc, int fr, int fq) const {
        const int row0 = u.pm * 256 + wr * 64 + fr;
        bf16_t* base = (bf16_t*)(ws + (u.pn < 4 ? WS_GA : WS_GB));
#pragma unroll
        for (int bj = 0; bj < 2; ++bj) { const int c = (u.pn & 3) * 256 + bj * 128 + wc * 32 + 8 * fq;
#pragma unroll
            for (int ai = 0; ai < 2; ++ai)
#pragma unroll
                for (int m = 0; m < 4; ++m) *(u32x4*)(base + (size_t)(row0 + ai * 128 + m * 16) * 1024 + c) = pack8(sig4s(acc[ai][bj][m][0]), sig4s(acc[ai][bj][m][1])); }
    }
};
struct GateOrder {
    const char* A; const char* Bt; int G, c;
    __device__ __forceinline__ bool next(int i, pg8::GUnit& u) const {
        int un;
        if (G == 256) { if (c < 128) { if (i > 0) return false; un = c; } else { if (i > 2) return false; un = 128 + 3 * (c - 128) + i; } }
        else { un = i * G + c; if (un >= 512) return false; }
        u.pm = un >> 3; u.pn = un & 7; u.e = 0; u.cnt = 0; u.tile = 0; u.pad_ = 0;
        u.a = A + (size_t)u.pm * 256 * 1024; u.b = Bt + (size_t)u.pn * 256 * 1024; return true;
    }
    __device__ __forceinline__ unsigned a_rowoff(const pg8::GUnit&, int) const { return 0u; }
};
__device__ __forceinline__ void ph_proj2(const P& p, unsigned char* lds) {
    { pg8::DenseOrder S; S.init(p.ws + WS_XN, p.ws + WS_WT_IN, MTOK, 1536, 1024, gridDim.x, blockIdx.x);
      EpiProj E{p.ws};
      pg8::gemm_phase<EpiProj, pg8::DenseOrder, true, false>((LAS unsigned char*)lds, 1024, S, E); }
    { GateOrder S{(const char*)(p.ws + WS_XN8), (const char*)(p.ws + WS_WT_G8), (int)gridDim.x, (int)blockIdx.x};
      EpiGate E{p.ws};
      pg8::gemm_phase<EpiGate, GateOrder, true, false, true>((LAS unsigned char*)lds, 512, S, E); }
}
__device__ __forceinline__ void ph_up2(const P& p, unsigned char* lds) {
    { pg8::DenseOrder S; S.init(p.ws + WS_CQ, p.ws + WS_WT_UQ, MTOK, 768, 384, gridDim.x, blockIdx.x); EpiUpQ E{p.ws};
      pg8::gemm_phase<EpiUpQ, pg8::DenseOrder, false, false>((LAS unsigned char*)lds, 384, S, E); }
    { pg8::DenseOrder S; S.init(p.ws + WS_CKV, p.ws + WS_WT_UKV, MTOK, 1024, 256, gridDim.x, blockIdx.x); EpiUpKV E{p.ws};
      pg8::gemm_phase<EpiUpKV, pg8::DenseOrder, false, false>((LAS unsigned char*)lds, 256, S, E); }
}
__device__ __forceinline__ void ph_mix2(const P& p, unsigned char* lds) {
    pg8::DenseOrder S; S.init(p.ws + WS_AO, p.ws + WS_WT_A, MTOK, 1024, 1024, gridDim.x, blockIdx.x); EpiMixF E{p.ws};
    pg8::gemm_phase<EpiMixF, pg8::DenseOrder, false, false>((LAS unsigned char*)lds, 1024, S, E);
}
__device__ __forceinline__ void ph_out2(const P& p, unsigned char* lds) {
    pg8::DenseOrder S; S.init(p.ws + WS_MIX, p.ws + WS_WT_OUT, MTOK, 1024, 512, gridDim.x, blockIdx.x); EpiOut E{p.ws, p.x};
    pg8::gemm_phase<EpiOut, pg8::DenseOrder, false, false, true>((LAS unsigned char*)lds, 512, S, E);
}


constexpr int MOE_TAB_OFF = 135168;
__device__ __forceinline__ void moe_build_tab(const P& p, unsigned char* lds) {
    LAS int* tab = (LAS int*)((LAS unsigned char*)lds + MOE_TAB_OFF);
    const unsigned* cnt = (const unsigned*)(p.ws + WS_CTL);
    const int tid = threadIdx.x;
    if (tid < 64) {
        const int c = tid < NEXP ? (int)cnt[tid * 64] : 0, n = (c + 255) >> 8;
        int incl = n;
#pragma unroll
        for (int o = 1; o < 32; o <<= 1) { const int t = __shfl_up(incl, o); if (tid >= o) incl += t; }
        const int s = incl - n;
        if (tid < NEXP) { tab[tid] = c; tab[32 + tid] = s; for (int j = 0; j < n; ++j) tab[128 + s + j] = tid; if (tid == NEXP - 1) tab[64] = incl; }
    }
    __syncthreads();
}
template <bool GATHER> struct MoeOrder {
    const LAS int* tab; const char* Abase; const char* Bbase; const unsigned* LIST; int K, NCT, G, c;
    __device__ __forceinline__ bool next(int i, pg8::GUnit& u) const {
        const int vc = (G % 8 == 0) ? (c % 8) * (G / 8) + c / 8 : c;
        const int L = i * G + vc; const int ntile = __builtin_amdgcn_readfirstlane(tab[64]); if (L >= ntile * NCT) return false;
        const int tile = L / NCT, pn = L - tile * NCT, e = __builtin_amdgcn_readfirstlane(tab[128 + tile]);
        u.e = e; u.cnt = __builtin_amdgcn_readfirstlane(tab[e]); u.pm = tile - __builtin_amdgcn_readfirstlane(tab[32 + e]); u.pn = pn; u.tile = tile; u.pad_ = 0;
        u.b = Bbase + ((size_t)e * NCT + pn) * 256 * K * 2;
        u.a = GATHER ? Abase : Abase + (size_t)tile * 256 * K * 2;
        return true;
    }
    __device__ __forceinline__ unsigned a_rowoff(const pg8::GUnit& u, int r) const {
        const int row = u.pm * 256 + r; const unsigned ent = row < u.cnt ? LIST[(size_t)u.e * LISTCAP + row] : 0u; return (ent >> 2) * (unsigned)(K * 2);
    }
};
struct EpiMoe1 {
    static constexpr bool PERM = true, HAS_MID = false;
    unsigned char* ws; const float* b1;
    __device__ __forceinline__ void operator()(const f32x4 (&acc)[2][2][4][2], const pg8::GUnit& u, int wr, int wc, int fr, int fq) const {
        bf16_t* HID = (bf16_t*)(ws + WS_HID);
        const int row0 = u.tile * 256 + wr * 64 + fr, col = u.pn * 128 + wc * 32 + 8 * fq;
        constexpr float CG = -1.702f * LOG2E, CGI = 1.f / CG;
        f32x4 bg[2], bl[2];
#pragma unroll
        for (int n = 0; n < 2; ++n) { bg[n] = *(const f32x4*)(b1 + u.e * 2048 + col + 4 * n) * CG; bl[n] = (*(const f32x4*)(b1 + u.e * 2048 + 1024 + col + 4 * n) + 1.f) * CGI; }
#pragma unroll
        for (int ai = 0; ai < 2; ++ai)
#pragma unroll
            for (int m = 0; m < 4; ++m) { f32x4 h[2];
#pragma unroll
                for (int n = 0; n < 2; ++n) { const f32x4 gv = acc[ai][0][m][n] * (W8_INV * CG) + bg[n], lv = acc[ai][1][m][n] * (W8_INV * CGI) + bl[n];
#pragma unroll
                    for (int i = 0; i < 4; ++i) { const float t = fmaxf(gv[i], 7.f * CG), L = __builtin_amdgcn_fmed3f(lv[i], 8.f * CGI, -6.f * CGI);
                        h[n][i] = t * __builtin_amdgcn_rcpf(1.f + __builtin_amdgcn_exp2f(t)) * L; } }
                u32x2 o8; o8.x = pk4_fp8(h[0][0], h[0][1], h[0][2], h[0][3]); o8.y = pk4_fp8(h[1][0], h[1][1], h[1][2], h[1][3]);
                *(u32x2*)((unsigned char*)HID + (size_t)(row0 + ai * 128 + m * 16) * 1024 + col) = o8; }
    }
};
struct EpiMoe2 {
    static constexpr bool PERM = true, HAS_MID = false;
    unsigned char* ws; const float* b2;
    __device__ __forceinline__ void operator()(const f32x4 (&acc)[2][2][4][2], const pg8::GUnit& u, int wr, int wc, int fr, int fq) const {
        unsigned char* Y = ws + WS_Y; const unsigned* LIST = (const unsigned*)(ws + WS_LIST) + (size_t)u.e * LISTCAP;
        f32x4 bv[2][2]; unsigned ent[2][4];
#pragma unroll
        for (int bj = 0; bj < 2; ++bj)
#pragma unroll
            for (int n = 0; n < 2; ++n) bv[bj][n] = *(const f32x4*)(b2 + u.e * 1024 + u.pn * 256 + bj * 128 + wc * 32 + 8 * fq + 4 * n);
#pragma unroll
        for (int ai = 0; ai < 2; ++ai)
#pragma unroll
            for (int m = 0; m < 4; ++m) { const int rr = u.pm * 256 + ai * 128 + wr * 64 + m * 16 + fr, rc = rr < u.cnt ? rr : u.cnt - 1; ent[ai][m] = LIST[rc]; }
        asm volatile("" : "+v"(bv[0][0]), "+v"(bv[0][1]), "+v"(bv[1][0]), "+v"(bv[1][1]));
#pragma unroll
        for (int ai = 0; ai < 2; ++ai)
#pragma unroll
            for (int m = 0; m < 4; ++m) asm volatile("" : "+v"(ent[ai][m]));
#pragma unroll
        for (int ai = 0; ai < 2; ++ai)
#pragma unroll
            for (int m = 0; m < 4; ++m) { const int rr = u.pm * 256 + ai * 128 + wr * 64 + m * 16 + fr;
                if (rr < u.cnt) {
#pragma unroll
                    for (int bj = 0; bj < 2; ++bj) { const int c = u.pn * 256 + bj * 128 + wc * 32 + 8 * fq;
                        const f32x4 y0 = acc[ai][bj][m][0] * W8_INV + bv[bj][0], y1 = acc[ai][bj][m][1] * W8_INV + bv[bj][1];
                        u32x2 o8; o8.x = pk4_fp8(y0[0], y0[1], y0[2], y0[3]); o8.y = pk4_fp8(y1[0], y1[1], y1[2], y1[3]);
                        *(u32x2*)(Y + (size_t)ent[ai][m] * 1024 + c) = o8; } } }
    }
};
__device__ __forceinline__ void ph_moe1_2(const P& p, unsigned char* lds) {
    moe_build_tab(p, lds);
    MoeOrder<true> S{(const LAS int*)((LAS unsigned char*)lds + MOE_TAB_OFF), (const char*)(p.ws + WS_XN), (const char*)(p.ws + WS_WT_M1), (const unsigned*)(p.ws + WS_LIST), 512, 8, (int)gridDim.x, (int)blockIdx.x};
    EpiMoe1 E{p.ws, p.b_m1};
    pg8::gemm_phase<EpiMoe1, MoeOrder<true>, true, true, true>((LAS unsigned char*)lds, 512, S, E);
}
__device__ __forceinline__ void ph_moe2_2(const P& p, unsigned char* lds) {
    MoeOrder<false> S{(const LAS int*)((LAS unsigned char*)lds + MOE_TAB_OFF), (const char*)(p.ws + WS_HID), (const char*)(p.ws + WS_WT_M2), (const unsigned*)(p.ws + WS_LIST), 512, 4, (int)gridDim.x, (int)blockIdx.x};
    EpiMoe2 E{p.ws, p.b_m2};
    pg8::gemm_phase<EpiMoe2, MoeOrder<false>, true, false, true>((LAS unsigned char*)lds, 512, S, E);
}


namespace att {
typedef float f32x16 __attribute__((ext_vector_type(16)));
typedef short s16x4 __attribute__((ext_vector_type(4)));
typedef short v4i16_t __attribute__((ext_vector_type(4)));
typedef LAS const unsigned char* lds_cptr;
constexpr int KROW = 208;
constexpr int KBUF = 64 * KROW, VBUF = 8192;
constexpr int OFF_K = 0, OFF_V = 2 * KBUF, OFF_WS = 2 * KBUF + 2 * VBUF, LDS_BYTES_ATT = OFF_WS + 8 * 256;
__device__ __forceinline__ int crow(int r, int hi) { return (r & 3) + 8 * (r >> 2) + 4 * hi; }
__device__ __forceinline__ s16x4 vtr(lds_cptr p) { return __builtin_bit_cast(s16x4, __builtin_amdgcn_ds_read_tr16_b64_v4i16((LAS v4i16_t*)p)); }
__device__ __forceinline__ float vmax3(float a, float b, float c) { float d; asm("v_max3_f32 %0, %1, %2, %3" : "=v"(d) : "v"(a), "v"(b), "v"(c)); return d; }
__device__ __forceinline__ float half_swap_max(float m) { auto rr = __builtin_amdgcn_permlane32_swap(__float_as_uint(m), __float_as_uint(m), false, false); return fmaxf(__uint_as_float(rr[0]), __uint_as_float(rr[1])); }
__device__ __forceinline__ float half_swap_sum(float m) { auto rr = __builtin_amdgcn_permlane32_swap(__float_as_uint(m), __float_as_uint(m), false, false); return __uint_as_float(rr[0]) + __uint_as_float(rr[1]); }

constexpr int BG_SCR_OFF = 49152;
#define ATT_BARRIER() asm volatile("s_waitcnt lgkmcnt(0)\n\ts_barrier" ::: "memory")
template <bool MLA>
__device__ __forceinline__ void attn_unit(const P& p, LAS unsigned char* lds, int b, int hk, int q0, BgConv& bg, float* bgscr) {
    int tid_ = threadIdx.x; asm volatile("" : "+v"(tid_));
    const int tid = tid_, lane = tid & 63, r32 = lane & 31, hi = lane >> 5, wid = __builtin_amdgcn_readfirstlane(tid >> 6);
    constexpr int NKS = MLA ? 6 : 4;
    const int head = MLA ? hk : hk * 4 + (wid >> 1);
    const int qw0 = MLA ? q0 + 32 * wid : q0 + 32 * (wid & 1);
    const size_t rb = (size_t)b * SEQ;
    bf16x8 qf[NKS];
    if (MLA) {
        const bf16_t* qn = (const bf16_t*)(p.ws + WS_QN) + (rb + qw0 + r32) * 512 + head * 64 + 8 * hi;
        const bf16_t* qr = (const bf16_t*)(p.ws + WS_QR) + (rb + qw0 + r32) * 256 + head * 32 + 8 * hi;
#pragma unroll
        for (int ks = 0; ks < 4; ++ks) qf[ks] = *(const bf16x8*)(qn + 16 * ks);
#pragma unroll
        for (int ks = 4; ks < NKS; ++ks) qf[ks] = *(const bf16x8*)(qr + 16 * (ks - 4));
    } else {
        const bf16_t* qa = (const bf16_t*)(p.ws + WS_QA) + (rb + qw0 + r32) * 512 + head * 64 + 8 * hi;
#pragma unroll
        for (int ks = 0; ks < NKS; ++ks) qf[ks] = *(const bf16x8*)(qa + 16 * ks);
    }
    const int t_lo = MLA ? 0 : (q0 >= 128 ? (q0 - 128) >> 6 : 0), t_hi = MLA ? ((q0 + 256) >> 6) - 1 : (q0 >> 6);
    const int skey = tid >> 3, sc = tid & 7;
    const bf16_t* kg; const bf16_t* vg; const bf16_t* rg = nullptr;
    if (MLA) { kg = (const bf16_t*)(p.ws + WS_KN) + (rb + skey) * 512 + hk * 64 + 8 * sc; vg = (const bf16_t*)(p.ws + WS_VB) + (rb + skey) * 512 + hk * 64 + 8 * sc;
               rg = (const bf16_t*)(p.ws + WS_KR) + (rb + (tid >> 2)) * 32 + 8 * (tid & 3); }
    else { kg = (const bf16_t*)(p.ws + WS_KA) + (rb + skey) * 128 + hk * 64 + 8 * sc; vg = (const bf16_t*)(p.ws + WS_VA) + (rb + skey) * 128 + hk * 64 + 8 * sc; }
    const int kpitch = MLA ? 512 : 128;
    const int kst = skey * KROW + sc * 16;
    const int rst = (tid >> 2) * KROW + 128 + (tid & 3) * 16;
    const int vst = ((8 * sc) >> 5) * 4096 + (skey >> 4) * 1024 + (skey & 15) * 64 + ((8 * sc) & 31) * 2;
    u32x4 kreg, vreg, rreg = (u32x4){0u, 0u, 0u, 0u};
#define ATT_LOAD(t) do { kreg = *(const u32x4*)(kg + (size_t)(t) * 64 * kpitch); vreg = *(const u32x4*)(vg + (size_t)(t) * 64 * kpitch); \
        if (MLA && tid < 256) rreg = *(const u32x4*)(rg + (size_t)(t) * 64 * 32); } while (0)
#define ATT_WRITE(buf) do { *(LAS u32x4*)(lds + OFF_K + (buf) * KBUF + kst) = kreg; *(LAS u32x4*)(lds + OFF_V + (buf) * VBUF + vst) = vreg; \
        if (MLA && tid < 256) *(LAS u32x4*)(lds + OFF_K + (buf) * KBUF + rst) = rreg; } while (0)
    LAS float* wsf = (LAS float*)(lds + OFF_WS) + wid * 64;
    float m, l; f32x16 o[2];
#pragma unroll
    for (int r = 0; r < 16; ++r) { o[0][r] = 0.f; o[1][r] = 0.f; }
    float slope2 = 0.f;
    if (MLA) { m = -INFINITY; l = 0.f; }
    else { m = p.sinks[head] * LOG2E; l = hi == 0 ? 1.f : 0.f; slope2 = exp2f(-(float)(head + 1)) * LOG2E; }
    const lds_cptr kp0 = (lds_cptr)lds + OFF_K + r32 * KROW + hi * 16;
    const lds_cptr vp0 = (lds_cptr)lds + OFF_V + ((lane >> 4) & 1) * 32 + (lane & 3) * 8 + (4 * hi + ((lane & 15) >> 2)) * 64;
    ATT_LOAD(t_lo); ATT_WRITE(0);
    ATT_BARRIER();
    for (int t = t_lo; t <= t_hi; ++t) {
        const int cur = (t - t_lo) & 1, s0 = t * 64;
        if (t < t_hi) ATT_LOAD(t + 1);
        if (BG_CONV) bg_step(p, bg, bgscr, lane);
        const bool active = MLA ? (s0 <= qw0 + 31) : (s0 <= qw0 + 31 && s0 + 63 >= qw0 - 127);
        if (active) {
            f32x16 p0, p1;
#pragma unroll
            for (int r = 0; r < 16; ++r) { p0[r] = 0.f; p1[r] = 0.f; }
            const lds_cptr kp = kp0 + cur * KBUF;
#pragma unroll
            for (int ks = 0; ks < NKS; ++ks) {
                const bf16x8 a0 = *(const LAS bf16x8*)(kp + ks * 32), a1 = *(const LAS bf16x8*)(kp + 32 * KROW + ks * 32);
                p0 = __builtin_amdgcn_mfma_f32_32x32x16_bf16(a0, qf[ks], p0, 0, 0, 0);
                p1 = __builtin_amdgcn_mfma_f32_32x32x16_bf16(a1, qf[ks], p1, 0, 0, 0);
            }
            const int q = qw0 + r32;
            if (MLA) {
                if (s0 + 63 > qw0) {
#pragma unroll
                    for (int r = 0; r < 16; ++r) { const int key = s0 + crow(r, hi); if (key > q) p0[r] = -INFINITY; if (key + 32 > q) p1[r] = -INFINITY; }
                }
            } else {
#pragma unroll
                for (int r = 0; r < 16; ++r) { const int d0 = q - (s0 + crow(r, hi)), d1 = d0 - 32;
                    p0[r] = (d0 >= 0 && d0 < 128) ? p0[r] - slope2 * (float)d0 : -INFINITY;
                    p1[r] = (d1 >= 0 && d1 < 128) ? p1[r] - slope2 * (float)d1 : -INFINITY; }
            }
            float mx = fmaxf(p0[0], p1[0]);
#pragma unroll
            for (int r = 1; r < 16; ++r) mx = fmaxf(mx, fmaxf(p0[r], p1[r]));
            mx = half_swap_max(mx);
            if (__any(mx > m + 8.f)) {
                const float mn = fmaxf(m, mx), alpha = __builtin_amdgcn_exp2f(m - mn);
                m = mn; l *= alpha;
                if (hi == 0) wsf[r32] = alpha;
#pragma unroll
                for (int r = 0; r < 16; ++r) { const float a = wsf[crow(r, hi)]; o[0][r] *= a; o[1][r] *= a; }
            }
            float ps = 0.f;
#pragma unroll
            for (int r = 0; r < 16; ++r) { p0[r] = __builtin_amdgcn_exp2f(p0[r] - m); p1[r] = __builtin_amdgcn_exp2f(p1[r] - m); ps += p0[r] + p1[r]; }
            l += ps;
            u32x4 pw[4];
#pragma unroll
            for (int i = 0; i < 4; ++i) { pw[0][i] = pg8::cvt_pk_bf16(p0[2 * i], p0[2 * i + 1]); pw[1][i] = pg8::cvt_pk_bf16(p0[8 + 2 * i], p0[8 + 2 * i + 1]);
                                          pw[2][i] = pg8::cvt_pk_bf16(p1[2 * i], p1[2 * i + 1]); pw[3][i] = pg8::cvt_pk_bf16(p1[8 + 2 * i], p1[8 + 2 * i + 1]); }
            const lds_cptr vp = vp0 + cur * VBUF;
#pragma unroll
            for (int d0 = 0; d0 < 2; ++d0)
#pragma unroll
                for (int ks = 0; ks < 4; ++ks) {
                    const s16x4 lo = vtr(vp + d0 * 4096 + ks * 1024), hh = vtr(vp + d0 * 4096 + ks * 1024 + 512);
                    const bf16x8 vf = (bf16x8){lo[0], lo[1], lo[2], lo[3], hh[0], hh[1], hh[2], hh[3]};
                    o[d0] = __builtin_amdgcn_mfma_f32_32x32x16_bf16(__builtin_bit_cast(bf16x8, pw[ks]), vf, o[d0], 0, 0, 0);
                }
        }
        if (t < t_hi) ATT_WRITE(cur ^ 1);
        ATT_BARRIER();
    }
    l = half_swap_sum(l);
    if (hi == 0) wsf[32 + r32] = 1.f / l;
    bf16_t* Ob = (bf16_t*)(p.ws + WS_AO) + (rb + qw0) * 1024 + (MLA ? 512 : 0) + head * 64 + r32;
#pragma unroll
    for (int r = 0; r < 16; ++r) { const int qr = crow(r, hi); const float rl = wsf[32 + qr];
        Ob[(size_t)qr * 1024] = (bf16_t)f2bf(o[0][r] * rl); Ob[(size_t)qr * 1024 + 32] = (bf16_t)f2bf(o[1][r] * rl); }
#undef ATT_LOAD
#undef ATT_WRITE
}
constexpr int PP_AHEAD = 4;
constexpr int PP_OFF_V = 3 * KBUF, PP_OFF_WS = 3 * KBUF + 3 * VBUF;
#define ATT_PBAR() do { __builtin_amdgcn_sched_barrier(0); asm volatile("s_waitcnt lgkmcnt(0)\n\ts_barrier" ::: "memory"); __builtin_amdgcn_sched_barrier(0); } while (0)
template <bool MLA>
__device__ __forceinline__ void attn_unit_pp(const P& p, LAS unsigned char* lds, int b, int hk, int q0, BgConv& bg) {
    int tid_ = threadIdx.x; asm volatile("" : "+v"(tid_));
    const int tid = tid_, lane = tid & 63, r32 = lane & 31, hi = lane >> 5, wid = __builtin_amdgcn_readfirstlane(tid >> 6);
    const int grp = wid >> 2;
    constexpr int NKS = MLA ? 6 : 4;
    const int head = MLA ? hk : hk * 4 + (wid >> 1);
    const int qw0 = MLA ? q0 + 32 * wid : q0 + 32 * (wid & 1);
    const size_t rb = (size_t)b * SEQ;
    bf16x8 qf[NKS];
    if (MLA) {
        const bf16_t* qn = (const bf16_t*)(p.ws + WS_QN) + (rb + qw0 + r32) * 512 + head * 64 + 8 * hi;
        const bf16_t* qr = (const bf16_t*)(p.ws + WS_QR) + (rb + qw0 + r32) * 256 + head * 32 + 8 * hi;
#pragma unroll
        for (int ks = 0; ks < 4; ++ks) qf[ks] = *(const bf16x8*)(qn + 16 * ks);
#pragma unroll
        for (int ks = 4; ks < NKS; ++ks) qf[ks] = *(const bf16x8*)(qr + 16 * (ks - 4));
    } else {
        const bf16_t* qa = (const bf16_t*)(p.ws + WS_QA) + (rb + qw0 + r32) * 512 + head * 64 + 8 * hi;
#pragma unroll
        for (int ks = 0; ks < NKS; ++ks) qf[ks] = *(const bf16x8*)(qa + 16 * ks);
    }
    const int t_lo = MLA ? 0 : (q0 >= 128 ? (q0 - 128) >> 6 : 0), t_hi = MLA ? ((q0 + 256) >> 6) - 1 : (q0 >> 6);
    const int skey = tid >> 3, sc = tid & 7;
    const bf16_t* kg; const bf16_t* vg; const bf16_t* rg = nullptr;
    if (MLA) { kg = (const bf16_t*)(p.ws + WS_KN) + (rb + skey) * 512 + hk * 64 + 8 * sc; vg = (const bf16_t*)(p.ws + WS_VB) + (rb + skey) * 512 + hk * 64 + 8 * sc;
               rg = (const bf16_t*)(p.ws + WS_KR) + (rb + (tid >> 2)) * 32 + 8 * (tid & 3); }
    else { kg = (const bf16_t*)(p.ws + WS_KA) + (rb + skey) * 128 + hk * 64 + 8 * sc; vg = (const bf16_t*)(p.ws + WS_VA) + (rb + skey) * 128 + hk * 64 + 8 * sc; }
    const int kpitch = MLA ? 512 : 128;
    const int kst = skey * KROW + sc * 16;
    const int rst = (tid >> 2) * KROW + 128 + (tid & 3) * 16;
    const int vst = ((8 * sc) >> 5) * 4096 + (skey >> 4) * 1024 + (skey & 15) * 64 + ((8 * sc) & 31) * 2;
    u32x4 kreg, vreg, rreg = (u32x4){0u, 0u, 0u, 0u};
#define PP_LOAD(t) do { kreg = *(const u32x4*)(kg + (size_t)(t) * 64 * kpitch); vreg = *(const u32x4*)(vg + (size_t)(t) * 64 * kpitch); \
        if (MLA && tid < 256) rreg = *(const u32x4*)(rg + (size_t)(t) * 64 * 32); } while (0)
#define PP_WRITE(kb, vb) do { *(LAS u32x4*)(lds + (kb) + kst) = kreg; *(LAS u32x4*)(lds + PP_OFF_V + (vb) + vst) = vreg; \
        if (MLA && tid < 256) *(LAS u32x4*)(lds + (kb) + rst) = rreg; } while (0)
    LAS float* wsf = (LAS float*)(lds + PP_OFF_WS) + wid * 64;
    float m, l; f32x16 o[2];
#pragma unroll
    for (int r = 0; r < 16; ++r) { o[0][r] = 0.f; o[1][r] = 0.f; }
    float slope2 = 0.f;
    if (MLA) { m = -INFINITY; l = 0.f; }
    else { m = p.sinks[head] * LOG2E; l = hi == 0 ? 1.f : 0.f; slope2 = exp2f(-(float)(head + 1)) * LOG2E; }
    const lds_cptr kp0 = (lds_cptr)lds + r32 * KROW + hi * 16;
    const lds_cptr vp0 = (lds_cptr)lds + PP_OFF_V + ((lane >> 4) & 1) * 32 + (lane & 3) * 8 + (4 * hi + ((lane & 15) >> 2)) * 64;
    int kbP = 2 * KBUF, kbC = 0, kbN = KBUF, vbP = 2 * VBUF, vbC = 0, vbN = VBUF;
    PP_LOAD(t_lo); PP_WRITE(kbC, vbC);
    if (t_lo < t_hi) PP_LOAD(t_lo + 1);
    ATT_PBAR();
    if (grp) ATT_PBAR();
    u32x4 pw[4];
#pragma unroll
    for (int i = 0; i < 4; ++i) pw[i] = (u32x4){0u, 0u, 0u, 0u};
    f32x16 p0, p1;
#pragma unroll
    for (int r = 0; r < 16; ++r) { p0[r] = 0.f; p1[r] = 0.f; }
    bool act_prev = false;
    for (int t = t_lo; t <= t_hi + 1; ++t) {
        const int s0 = t * 64;
        const bool active = t <= t_hi && (MLA ? (s0 <= qw0 + 31) : (s0 <= qw0 + 31 && s0 + 63 >= qw0 - 127));
        if (active) {
#pragma unroll
            for (int r = 0; r < 16; ++r) { p0[r] = 0.f; p1[r] = 0.f; }
            const lds_cptr kp = kp0 + kbC;
            bf16x8 ka[2 * NKS];
#pragma unroll
            for (int ks = 0; ks < NKS; ++ks) { ka[2 * ks] = *(const LAS bf16x8*)(kp + ks * 32); ka[2 * ks + 1] = *(const LAS bf16x8*)(kp + 32 * KROW + ks * 32); }
#pragma unroll
            for (int ks = 0; ks < NKS; ++ks) {
                p0 = __builtin_amdgcn_mfma_f32_32x32x16_bf16(ka[2 * ks], qf[ks], p0, 0, 0, 0);
                p1 = __builtin_amdgcn_mfma_f32_32x32x16_bf16(ka[2 * ks + 1], qf[ks], p1, 0, 0, 0);
            }
            __builtin_amdgcn_sched_group_barrier(0x100, PP_AHEAD, 0);
#pragma unroll
            for (int i = 0; i < 2 * NKS - PP_AHEAD; ++i) { __builtin_amdgcn_sched_group_barrier(0x008, 1, 0); __builtin_amdgcn_sched_group_barrier(0x100, 1, 0); }
            __builtin_amdgcn_sched_group_barrier(0x008, PP_AHEAD, 0);
        }
        __builtin_amdgcn_sched_barrier(0);
        if (act_prev) {
            const lds_cptr vp = vp0 + vbP;
            bf16x8 vf[8];
#pragma unroll
            for (int ks = 0; ks < 4; ++ks)
#pragma unroll
                for (int d0 = 0; d0 < 2; ++d0) {
                    const s16x4 lo = vtr(vp + d0 * 4096 + ks * 1024), hh = vtr(vp + d0 * 4096 + ks * 1024 + 512);
                    vf[2 * ks + d0] = (bf16x8){lo[0], lo[1], lo[2], lo[3], hh[0], hh[1], hh[2], hh[3]};
                }
#pragma unroll
            for (int ks = 0; ks < 4; ++ks) {
                o[0] = __builtin_amdgcn_mfma_f32_32x32x16_bf16(__builtin_bit_cast(bf16x8, pw[ks]), vf[2 * ks], o[0], 0, 0, 0);
                o[1] = __builtin_amdgcn_mfma_f32_32x32x16_bf16(__builtin_bit_cast(bf16x8, pw[ks]), vf[2 * ks + 1], o[1], 0, 0, 0);
            }
            __builtin_amdgcn_sched_group_barrier(0x100, 6, 0);
#pragma unroll
            for (int i = 0; i < 5; ++i) { __builtin_amdgcn_sched_group_barrier(0x008, 1, 0); __builtin_amdgcn_sched_group_barrier(0x100, 2, 0); }
            __builtin_amdgcn_sched_group_barrier(0x008, 3, 0);
        }
        __builtin_amdgcn_sched_barrier(0);
        if (t < t_hi) PP_WRITE(kbN, vbN);
        if (BG_CONV) bg_step_fin(p, bg, lane);
        if (t + 1 < t_hi) PP_LOAD(t + 2);
        if (BG_CONV) bg_step_iss(p, bg, lane);
        ATT_PBAR();
        if (active) {
            const int q = qw0 + r32;
            if (MLA) {
                if (s0 + 63 > qw0) {
#pragma unroll
                    for (int r = 0; r < 16; ++r) { const int key = s0 + crow(r, hi); if (key > q) p0[r] = -INFINITY; if (key + 32 > q) p1[r] = -INFINITY; }
                }
            } else {
#pragma unroll
                for (int r = 0; r < 16; ++r) { const int d0 = q - (s0 + crow(r, hi)), d1 = d0 - 32;
                    p0[r] = (d0 >= 0 && d0 < 128) ? p0[r] - slope2 * (float)d0 : -INFINITY;
                    p1[r] = (d1 >= 0 && d1 < 128) ? p1[r] - slope2 * (float)d1 : -INFINITY; }
            }
            float mxa = fmaxf(p0[0], p1[0]), mxb = fmaxf(p0[1], p1[1]);
#pragma unroll
            for (int r = 2; r < 16; r += 2) { mxa = vmax3(mxa, p0[r], p1[r]); mxb = vmax3(mxb, p0[r + 1], p1[r + 1]); }
            float mx = half_swap_max(fmaxf(mxa, mxb));
            if (__any(mx > m + 8.f)) {
                const float mn = fmaxf(m, mx), alpha = __builtin_amdgcn_exp2f(m - mn);
                m = mn; l *= alpha;
                if (hi == 0) wsf[r32] = alpha;
#pragma unroll
                for (int r = 0; r < 16; ++r) { const float a = wsf[crow(r, hi)]; o[0][r] *= a; o[1][r] *= a; }
            }
#pragma unroll
            for (int r = 0; r < 16; ++r) { p0[r] -= m; p1[r] -= m; }
            __builtin_amdgcn_sched_barrier(0);
#pragma unroll
            for (int r = 0; r < 16; ++r) { p0[r] = __builtin_amdgcn_exp2f(p0[r]); p1[r] = __builtin_amdgcn_exp2f(p1[r]); }
            __builtin_amdgcn_sched_barrier(0);
            { typedef float f32x2 __attribute__((ext_vector_type(2)));
              f32x2 sa = (f32x2){p0[0], p0[1]} + (f32x2){p1[0], p1[1]}, sb = (f32x2){p0[2], p0[3]} + (f32x2){p1[2], p1[3]};
#pragma unroll
              for (int r = 4; r < 16; r += 4) { sa += (f32x2){p0[r], p0[r + 1]} + (f32x2){p1[r], p1[r + 1]}; sb += (f32x2){p0[r + 2], p0[r + 3]} + (f32x2){p1[r + 2], p1[r + 3]}; }
              sa += sb; l += sa[0] + sa[1]; }
#pragma unroll
            for (int i = 0; i < 4; ++i) { pw[0][i] = pg8::cvt_pk_bf16(p0[2 * i], p0[2 * i + 1]); pw[1][i] = pg8::cvt_pk_bf16(p0[8 + 2 * i], p0[8 + 2 * i + 1]);
                                          pw[2][i] = pg8::cvt_pk_bf16(p1[2 * i], p1[2 * i + 1]); pw[3][i] = pg8::cvt_pk_bf16(p1[8 + 2 * i], p1[8 + 2 * i + 1]); }
        }
        act_prev = active;
        ATT_PBAR();
        { const int tk = kbP; kbP = kbC; kbC = kbN; kbN = tk; const int tv = vbP; vbP = vbC; vbC = vbN; vbN = tv; }
    }
    if (!grp) ATT_PBAR();
    l = half_swap_sum(l);
    if (hi == 0) wsf[32 + r32] = 1.f / l;
    bf16_t* Ob = (bf16_t*)(p.ws + WS_AO) + (rb + qw0) * 1024 + (MLA ? 512 : 0) + head * 64 + r32;
#pragma unroll
    for (int r = 0; r < 16; ++r) { const int qr = crow(r, hi); const float rl = wsf[32 + qr];
        Ob[(size_t)qr * 1024] = (bf16_t)f2bf(o[0][r] * rl); Ob[(size_t)qr * 1024 + 32] = (bf16_t)f2bf(o[1][r] * rl); }
#undef PP_LOAD
#undef PP_WRITE
}
}
__device__ __forceinline__ void ph_attn2(const P& p, unsigned char* lds_) {
    LAS unsigned char* lds = (LAS unsigned char*)lds_;
    const int G = gridDim.x, bx = blockIdx.x;
    const int vcu = (G % 8 == 0) ? (bx % 8) * (G / 8) + bx / 8 : bx;
    const int lane_ = threadIdx.x & 63, wave_ = threadIdx.x >> 6;
    BgConv bg; bg.item = bx * 8 + wave_; bg.it = 0; bg.ngw = G * 8; bg.pend = false;
#pragma unroll
    for (int i = 0; i < 32; ++i) bg.r[i] = 0.f;
    float* bgscr = (float*)(lds_ + att::BG_SCR_OFF + wave_ * 8704);
    for (int pi = vcu; pi < 256; pi += G) {
        const int bh = pi >> 4, sidx = pi & 15;
        att::attn_unit_pp<true>(p, lds, bh >> 3, bh & 7, (31 - sidx) * 256, bg);
        att::attn_unit_pp<true>(p, lds, bh >> 3, bh & 7, sidx * 256, bg);
    }
    for (int u = vcu; u < 512; u += G) {
        const int bk = u >> 7, qb = u & 127;
        att::attn_unit_pp<false>(p, lds, bk >> 1, bk & 1, qb * 64, bg);
    }
    if (BG_CONV) bg_drain(p, bg, bgscr, lane_);
}

#define XB_TMO      128
#define XB_XCNT(j)  (256  + 64 * (j))
#define XB_XSUB(j)  (1280 + 64 * (j))
#define XB_XGEN(j)  (2304 + 64 * (j))
#define XB_TOP      3328
#define XB_TOPGEN   3392
#define XCD_BAR_WORDS 3456
#define XB_SPIN_CAP (1u << 18)
__device__ __forceinline__ unsigned xb_ld(unsigned* p)              { return __hip_atomic_load(p, __ATOMIC_RELAXED, __HIP_MEMORY_SCOPE_AGENT); }
__device__ __forceinline__ unsigned xb_add(unsigned* p, unsigned v) { return __hip_atomic_fetch_add(p, v, __ATOMIC_RELAXED, __HIP_MEMORY_SCOPE_AGENT); }
__device__ __forceinline__ unsigned xb_xcc_id() { return (unsigned)__builtin_amdgcn_s_getreg((3 << 11) | 20) & 0xFu; }
#define XB_SPIN(cond, bar) do { unsigned _sp = 0; while (cond) { __builtin_amdgcn_s_sleep(1); \
    if ((++_sp & 255u) == 0u) { if (xb_ld(&(bar)[XB_TMO])) break; if (_sp > XB_SPIN_CAP) { atomicAdd(&(bar)[XB_TMO], 1u); break; } } } } while (0)
struct XcdBarrier { unsigned* bar; unsigned x; volatile LAS unsigned* st; };
__device__ __forceinline__ XcdBarrier xcd_barrier_post(unsigned* bar, volatile LAS unsigned* st) {
    XcdBarrier b; b.bar = bar; b.x = xb_xcc_id(); b.st = st;
    if (threadIdx.x == 0) (void)xb_add(&bar[XB_XCNT(b.x)], 1u);
    return b;
}
__device__ __forceinline__ void xcd_barrier_complete(unsigned* bar, unsigned x, unsigned& nloc, unsigned& nx) {
    const unsigned G = gridDim.x * gridDim.y * gridDim.z;
    unsigned sum, cnt, mine, sp = 0u;
    for (;;) {
        sum = 0u; cnt = 0u; mine = 0u;
#pragma unroll
        for (unsigned j = 0; j < 16; ++j) { const unsigned c = xb_ld(&bar[XB_XCNT(j)]); sum += c; cnt += (c > 0u) ? 1u : 0u; mine = (j == x) ? c : mine; }
        if (sum == G) break;
        __builtin_amdgcn_s_sleep(1);
        if ((++sp & 255u) == 0u) { if (xb_ld(&bar[XB_TMO])) break; if (sp > XB_SPIN_CAP) { atomicAdd(&bar[XB_TMO], 1u); break; } }
    }
    nloc = mine > 0u ? mine : 1u; nx = cnt > 0u ? cnt : 1u;
}
__device__ __forceinline__ void xcd_barrier(const XcdBarrier& b) {
    asm volatile("s_waitcnt vmcnt(0)" ::: "memory");
    __syncthreads();
    if (threadIdx.x == 0) {
        unsigned* bar = b.bar;
        __builtin_amdgcn_s_waitcnt(0);
        unsigned nloc = b.st[0], nx = b.st[1];
        if (nloc == 0u) { xcd_barrier_complete(bar, b.x, nloc, nx); b.st[0] = nloc; b.st[1] = nx; }
        const unsigned old = xb_add(&bar[XB_XSUB(b.x)], 1u);
        const unsigned gen = old / nloc;
        if (old + 1u == (gen + 1u) * nloc) {
            __builtin_amdgcn_fence(__ATOMIC_RELEASE, "agent");
            asm volatile("s_waitcnt vmcnt(0)" ::: "memory");
            const unsigned og = xb_add(&bar[XB_TOP], 1u);
            const unsigned tg = og / nx;
            if (og + 1u == (tg + 1u) * nx) xb_add(&bar[XB_TOPGEN], 1u);
            else XB_SPIN(xb_ld(&bar[XB_TOPGEN]) == tg, bar);
            __builtin_amdgcn_fence(__ATOMIC_ACQUIRE, "agent");
            xb_add(&bar[XB_XGEN(b.x)], 1u);
            asm volatile("s_waitcnt vmcnt(0)" ::: "memory");
        } else {
            XB_SPIN(xb_ld(&bar[XB_XGEN(b.x)]) == gen, bar);
            __builtin_amdgcn_fence(__ATOMIC_ACQUIRE, "agent");
            asm volatile("s_waitcnt vmcnt(0)" ::: "memory");
        }
    }
    __syncthreads();
}
constexpr int LDSCTL_OFF = 139264;
constexpr int CW_BAR = 4096;
constexpr size_t CTL_ZERO_BYTES = 65536;

__global__ void __launch_bounds__(NTHREADS, 2) mega_fwd(P p) {
    extern __shared__ __attribute__((aligned(16))) unsigned char lds[];
    if (threadIdx.x < 32) ((LAS unsigned*)((LAS unsigned char*)lds + LDSCTL_OFF))[threadIdx.x] = 0u;
    __syncthreads();
    const XcdBarrier bar = xcd_barrier_post((unsigned*)(p.ws + WS_CTL) + CW_BAR, (volatile LAS unsigned*)((LAS unsigned char*)lds + LDSCTL_OFF));
#ifndef PH_MASK
#define PH_MASK 0xFFFF
#endif
#ifndef PH_DUP
#define PH_DUP 0
#endif
#define RUN_PH(bit, call) do { if (PH_MASK & (bit)) { call; if (PH_DUP & (bit)) { __syncthreads(); call; } } } while (0)
#define GSYNC() do { xcd_barrier(bar); if (PH_DUP & 0x10000) xcd_barrier(bar); } while (0)
    RUN_PH(1, (ph_mod(p, lds), ph_convert(p, lds)));
    GSYNC();
    RUN_PH(2, ph_xn(p));
    GSYNC();
    RUN_PH(4, ph_proj2(p, lds));
    GSYNC();
    RUN_PH(16, ph_up2(p, lds));
    GSYNC();
    RUN_PH(32, ph_attn2(p, lds));
    GSYNC();
    RUN_PH(64, ph_mix2(p, lds));
    GSYNC();
    RUN_PH(128, ph_out2(p, lds));
    GSYNC();
    if (PH_DUP & 256) { ph_route(p, lds, false); __syncthreads(); }
    if (PH_MASK & 256) ph_route(p, lds, true);
    GSYNC();
    RUN_PH(512, ph_moe1_2(p, lds));
    GSYNC();
    RUN_PH(1024, ph_moe2_2(p, lds));
    GSYNC();
    RUN_PH(2048, ph_final(p));
}

extern "C" void kernel_launch(void* const* d_in, const int* in_sizes, int n_in, void* d_out, int out_size, void* d_ws, size_t ws_size, hipStream_t stream) {
    static int grid_blocks = 0;
    if (!grid_blocks) {
        int dev = 0, cus = 0, per_cu = 0;
        (void)hipGetDevice(&dev);
        (void)hipDeviceGetAttribute(&cus, hipDeviceAttributeMultiprocessorCount, dev);
        (void)hipFuncSetAttribute((const void*)mega_fwd, hipFuncAttributeMaxDynamicSharedMemorySize, LDS_BYTES);
        (void)hipOccupancyMaxActiveBlocksPerMultiprocessor(&per_cu, (const void*)mega_fwd, NTHREADS, LDS_BYTES);
        if (per_cu < 1) per_cu = 1;
        grid_blocks = cus * per_cu;
        if (grid_blocks > 256) grid_blocks = 256;
        if (grid_blocks < 256 || MTOK % grid_blocks != 0) { fprintf(stderr, "kernel_launch: grid %d unsupported (needs >= 256 workgroups dividing %d)\n", grid_blocks, MTOK); grid_blocks = -1; }
        else if (ws_size < WS_END || n_in != 24) { fprintf(stderr, "kernel_launch: ws %zu < %zu or n_in %d != 24\n", ws_size, (size_t)WS_END, n_in); grid_blocks = -1; }
    }
    if (grid_blocks < 0) return;
    P p{};
    p.x = (const float*)d_in[0]; p.c = (const float*)d_in[1]; p.pos = (const int*)d_in[2]; p.w_ada = (const float*)d_in[3]; p.b_ada = (const float*)d_in[4];
    p.norm_mix = (const float*)d_in[5]; p.norm_ffn = (const float*)d_in[6]; p.w_in = (const float*)d_in[7]; p.sinks = (const float*)d_in[8];
    p.q_norm = (const float*)d_in[9]; p.kv_norm = (const float*)d_in[10]; p.w_uq = (const float*)d_in[11]; p.w_uk = (const float*)d_in[12]; p.w_uv = (const float*)d_in[13];
    p.w_a = (const float*)d_in[14]; p.w_b = (const float*)d_in[15]; p.w_out = (const float*)d_in[16]; p.w_router = (const float*)d_in[17]; p.b_router = (const float*)d_in[18];
    p.w_m1 = (const float*)d_in[19]; p.b_m1 = (const float*)d_in[20]; p.w_m2 = (const float*)d_in[21]; p.b_m2 = (const float*)d_in[22]; p.fnorm = (const float*)d_in[23];
    p.out = (float*)d_out; p.ws = (unsigned char*)d_ws;
    if (hipMemsetAsync((char*)d_ws + WS_CTL, 0, CTL_ZERO_BYTES, stream) != hipSuccess) { fprintf(stderr, "kernel_launch: memset failed\n"); return; }
    hipLaunchKernelGGL(mega_fwd, dim3(grid_blocks), dim3(NTHREADS), LDS_BYTES, stream, p);
    const hipError_t e = hipPeekAtLastError();
    if (e != hipSuccess) fprintf(stderr, "launch failed: %s (grid %d)\n", hipGetErrorString(e), grid_blocks);
}
```

```cpp
#include <hip/hip_runtime.h>
#include <cstdio>
#include <cstdint>

typedef unsigned short bf16_t;
typedef short bf16x8 __attribute__((ext_vector_type(8)));
typedef float f32x4 __attribute__((ext_vector_type(4)));
typedef unsigned u32x4 __attribute__((ext_vector_type(4)));
typedef unsigned u32x2 __attribute__((ext_vector_type(2)));

constexpr int NTHREADS = 512;
constexpr int LDS_BYTES = 147456;
constexpr int BATCH = 2, SEQ = 8192, DM = 1024, MTOK = BATCH * SEQ;
constexpr int NEXP = 32, LISTCAP = 16384;
constexpr float EPS = 1e-6f;
constexpr float LOG2E = 1.4426950408889634f;

constexpr size_t MiB = 1u << 20;
constexpr size_t WS_CTL = 0;
constexpr size_t WS_MOD = 1 * MiB;
constexpr size_t WS_WT_IN = 2 * MiB;
constexpr size_t WS_WT_UQ = 9 * MiB;
constexpr size_t WS_WT_UKV = 10 * MiB;
constexpr size_t WS_WT_A = 11 * MiB;
constexpr size_t WS_WT_B = 12 * MiB;
constexpr size_t WS_WT_OUT = 13 * MiB;
constexpr size_t WS_WRT = 1 * MiB + 524288;
constexpr size_t WS_COS = 15 * MiB;
constexpr size_t WS_SIN = 16 * MiB;
constexpr size_t WS_SSQ = 17 * MiB;
constexpr size_t WS_LIST = 18 * MiB;
constexpr size_t WS_TOPW = 1835008;
constexpr size_t WS_LISTW = 809 * MiB;
constexpr size_t WS_WT_M1 = 20 * MiB;
constexpr size_t WS_WT_M2 = 148 * MiB;
constexpr size_t WS_XN = 212 * MiB;
constexpr size_t WS_QA = 244 * MiB;
constexpr size_t WS_KA = 260 * MiB;
constexpr size_t WS_VA = 264 * MiB;
constexpr size_t WS_CQ = 268 * MiB;
constexpr size_t WS_CKV = 280 * MiB;
constexpr size_t WS_KR = 288 * MiB;
constexpr size_t WS_GA = 289 * MiB;
constexpr size_t WS_GB = 321 * MiB;
constexpr size_t WS_QN = 353 * MiB;
constexpr size_t WS_QR = 369 * MiB;
constexpr size_t WS_KN = 377 * MiB;
constexpr size_t WS_VB = 393 * MiB;
constexpr size_t WS_AO = 409 * MiB;
constexpr size_t WS_BO = 425 * MiB;
constexpr size_t WS_MIX = 441 * MiB;
constexpr size_t WS_X1 = 473 * MiB;
constexpr size_t WS_HID = 537 * MiB;
constexpr size_t WS_Y = 681 * MiB;
constexpr size_t WS_XN8 = 811 * MiB;
constexpr size_t WS_WT_G8 = 827 * MiB;
constexpr size_t WS_END = 829 * MiB;

struct P {
    const float *x, *c; const int* pos;
    const float *w_ada, *b_ada, *norm_mix, *norm_ffn, *w_in, *sinks, *q_norm, *kv_norm, *w_uq, *w_uk, *w_uv, *w_a, *w_b, *w_out,
        *w_router, *b_router, *w_m1, *b_m1, *w_m2, *b_m2, *fnorm;
    float* out; unsigned char* ws;
};

__device__ __forceinline__ unsigned f2bf(float f) { unsigned u = __float_as_uint(f); return (u + 0x7fffu + ((u >> 16) & 1u)) >> 16; }
__device__ __forceinline__ unsigned pk2(float lo, float hi) { return f2bf(lo) | (f2bf(hi) << 16); }
__device__ __forceinline__ float bf2f(unsigned h) { return __uint_as_float(h << 16); }
__device__ __forceinline__ unsigned pk4_fp8(float a, float b, float c, float d) { int r = __builtin_amdgcn_cvt_pk_fp8_f32(a, b, 0, false); r = __builtin_amdgcn_cvt_pk_fp8_f32(c, d, r, true); return (unsigned)r; }
constexpr float W8_SCALE = 32.f, W8_INV = 0.03125f;
constexpr float MIX8_SCALE = 8.f, OUT8_INV = 1.f / (8.f * 32.f);
__device__ __forceinline__ float wave_sum(float v) {
#pragma unroll
    for (int o = 1; o < 64; o <<= 1) v += __shfl_xor(v, o);
    return v;
}
__device__ __forceinline__ float sigmoidf_(float v) { return __builtin_amdgcn_rcpf(1.f + __builtin_amdgcn_exp2f(-LOG2E * v)); }

__device__ __forceinline__ void ph_mod(const P& p, unsigned char* lds) {
    const int tid = threadIdx.x, lane = tid & 63, wave = tid >> 6;
    float* red = (float*)lds;
    float* mod = (float*)(p.ws + WS_MOD);
    for (int item = blockIdx.x; item < 192; item += gridDim.x) {
        const int n0 = item * 32, cn = lane & 31, kq = lane >> 5;
        float a0 = 0.f, a1 = 0.f;
#pragma unroll 1
        for (int i0 = 0; i0 < 64; i0 += 16) {
            float wv[16];
#pragma unroll
            for (int i = 0; i < 16; ++i) wv[i] = __builtin_nontemporal_load(p.w_ada + (size_t)(wave * 128 + 2 * (i0 + i) + kq) * 6144 + n0 + cn);
#pragma unroll
            for (int i = 0; i < 16; ++i) { const int k = wave * 128 + 2 * (i0 + i) + kq; const float c0 = p.c[k], c1 = p.c[1024 + k];
                a0 += c0 * sigmoidf_(c0) * wv[i]; a1 += c1 * sigmoidf_(c1) * wv[i]; }
        }
        a0 += __shfl_xor(a0, 32); a1 += __shfl_xor(a1, 32);
        if (lane < 32) { red[(wave * 2 + 0) * 32 + cn] = a0; red[(wave * 2 + 1) * 32 + cn] = a1; }
        __syncthreads();
        if (tid < 64) { const int b = tid >> 5, cc = tid & 31; float s = 0.f;
            for (int w = 0; w < 8; ++w) s += red[(w * 2 + b) * 32 + cc];
            mod[b * 6144 + n0 + cc] = s + p.b_ada[n0 + cc]; }
        __syncthreads();
    }
}
__device__ __forceinline__ int ropeperm(int d) { return d < 16 ? 8 * (d >> 2) + (d & 3) : 8 * ((d - 16) >> 2) + 4 + (d & 3); }
__device__ __forceinline__ void transpose_item(const float* W, int N, int K, bf16_t* WT, int k0, int n0, int dst_row0, const float* kscale, float* scr, int lane, bool rperm = false) {
    float tv[32];
#pragma unroll
    for (int i = 0; i < 32; ++i) tv[i] = W[(size_t)(k0 + 2 * i + (lane >> 5)) * N + n0 + (lane & 31)];
#pragma unroll
    for (int i = 0; i < 32; ++i) { const int kk = 2 * i + (lane >> 5); float v = tv[i]; if (kscale) v *= kscale[k0 + kk]; scr[kk * 33 + (lane & 31)] = v; }
    __builtin_amdgcn_s_waitcnt(0); __builtin_amdgcn_wave_barrier();
    const int c = lane & 7;
#pragma unroll
    for (int j = 0; j < 4; ++j) { const int n = (lane >> 3) + 8 * j; const float* s = scr + (8 * c) * 33 + n;
        u32x4 o; o.x = pk2(s[0 * 33], s[1 * 33]); o.y = pk2(s[2 * 33], s[3 * 33]); o.z = pk2(s[4 * 33], s[5 * 33]); o.w = pk2(s[6 * 33], s[7 * 33]);
        *(u32x4*)(WT + (size_t)(dst_row0 + (rperm ? ropeperm(n) : n)) * K + k0 + 8 * c) = o; }
    __builtin_amdgcn_s_waitcnt(0); __builtin_amdgcn_wave_barrier();
}
__device__ __forceinline__ void transpose_item_fp8(const float* W, int N, int K, unsigned char* WT, int k0, int n0, int dst_row0, float* scr, int lane) {
    float tv[32];
#pragma unroll
    for (int i = 0; i < 32; ++i) tv[i] = W[(size_t)(k0 + 2 * i + (lane >> 5)) * N + n0 + (lane & 31)];
#pragma unroll
    for (int i = 0; i < 32; ++i) { const int kk = 2 * i + (lane >> 5); scr[kk * 33 + (lane & 31)] = tv[i] * W8_SCALE; }
    __builtin_amdgcn_s_waitcnt(0); __builtin_amdgcn_wave_barrier();
    const int c = lane & 3;
#pragma unroll
    for (int j = 0; j < 2; ++j) { const int n = (lane >> 2) + 16 * j; const float* sp = scr + (16 * c) * 33 + n;
        u32x4 o; o.x = pk4_fp8(sp[0 * 33], sp[1 * 33], sp[2 * 33], sp[3 * 33]); o.y = pk4_fp8(sp[4 * 33], sp[5 * 33], sp[6 * 33], sp[7 * 33]);
        o.z = pk4_fp8(sp[8 * 33], sp[9 * 33], sp[10 * 33], sp[11 * 33]); o.w = pk4_fp8(sp[12 * 33], sp[13 * 33], sp[14 * 33], sp[15 * 33]);
        *(u32x4*)(WT + (size_t)(dst_row0 + n) * K + k0 + 16 * c) = o; }
    __builtin_amdgcn_s_waitcnt(0); __builtin_amdgcn_wave_barrier();
}
__device__ __forceinline__ int in_colmap(int s) {
    if (s < 768) return s;
    if (s < 1152) return 1024 + (s - 768);
    if (s < 1408) return 768 + (s - 1152);
    if (s < 1440) return s;
    if (s < 2464) return 1536 + (s - 1440);
    return 2560 + (s - 2464);
}
#ifndef BG_CONV
#define BG_CONV 1
#endif
constexpr int BG_I_M1 = 32 * 16 * 64, BG_I_M2 = 32 * 16 * 32, BG_TOTAL = BG_I_M1 + BG_I_M2;
struct BgConv { float r[32]; int item, it, ngw; bool pend; };
__device__ __forceinline__ void bg_decode(const P& p, int item, const float*& W, int& N, unsigned char*& WT, int& k0, int& n0, int& dst) {
    if (item < BG_I_M1) { const int e = item >> 10, q = item & 1023, kb = q >> 6, nb = q & 63; n0 = nb * 32; const int j = n0 & 1023, lin = n0 >> 10;
        dst = (j >> 7) * 256 + lin * 128 + (j & 127); W = p.w_m1 + (size_t)e * 1024 * 2048; N = 2048; WT = p.ws + WS_WT_M1 + (size_t)e * 2048 * 1024; k0 = kb * 64; }
    else { const int r = item - BG_I_M1, e = r >> 9, q = r & 511, kb = q >> 5, nb = q & 31; n0 = nb * 32; dst = n0;
        W = p.w_m2 + (size_t)e * 1024 * 1024; N = 1024; WT = p.ws + WS_WT_M2 + (size_t)e * 1024 * 1024; k0 = kb * 64; }
}
__device__ __forceinline__ void bg_issue(const P& p, BgConv& g, int lane) {
    const float* W; int N, k0, n0, dst; unsigned char* WT; bg_decode(p, g.item, W, N, WT, k0, n0, dst);
    const float* src = W + (size_t)(k0 + (lane >> 5)) * N + n0 + (lane & 31);
#pragma unroll
    for (int i = 0; i < 32; ++i) g.r[i] = __builtin_nontemporal_load(src + (size_t)(2 * i) * N);
}
__device__ __forceinline__ void bg_finish(const P& p, BgConv& g, float* scr, int lane) {
    const float* W; int N, k0, n0, dst; unsigned char* WT; bg_decode(p, g.item, W, N, WT, k0, n0, dst);
    unsigned w[8];
#pragma unroll
    for (int i = 0; i < 16; i += 2) {
        const auto s0 = __builtin_amdgcn_permlane32_swap(__float_as_uint(g.r[i] * W8_SCALE), __float_as_uint(g.r[i + 16] * W8_SCALE), false, false);
        const auto s1 = __builtin_amdgcn_permlane32_swap(__float_as_uint(g.r[i + 1] * W8_SCALE), __float_as_uint(g.r[i + 17] * W8_SCALE), false, false);
        w[i >> 1] = pk4_fp8(__uint_as_float(s0[0]), __uint_as_float(s0[1]), __uint_as_float(s1[0]), __uint_as_float(s1[1]));
    }
    unsigned char* o = WT + (size_t)(dst + (lane & 31)) * 1024 + k0 + 32 * (lane >> 5);
    __builtin_nontemporal_store((u32x4){w[0], w[1], w[2], w[3]}, (u32x4*)o); __builtin_nontemporal_store((u32x4){w[4], w[5], w[6], w[7]}, (u32x4*)(o + 16));
}
__device__ __forceinline__ void bg_step(const P& p, BgConv& g, float* scr, int lane) {
    if ((g.it & 3) == 2 && g.pend) { bg_finish(p, g, scr, lane); g.item += g.ngw; g.pend = false; }
    if ((g.it & 3) == 0 && g.item < BG_TOTAL) { bg_issue(p, g, lane); g.pend = true; }
    ++g.it;
}
__device__ __forceinline__ void bg_step_fin(const P& p, BgConv& g, int lane) { if ((g.it & 3) == 2 && g.pend) { bg_finish(p, g, nullptr, lane); g.item += g.ngw; g.pend = false; } }
__device__ __forceinline__ void bg_step_iss(const P& p, BgConv& g, int lane) { if ((g.it & 3) == 0 && g.item < BG_TOTAL) { bg_issue(p, g, lane); g.pend = true; } ++g.it; }
__device__ __forceinline__ void bg_drain(const P& p, BgConv& g, float* scr, int lane) {
    if (g.pend) { bg_finish(p, g, scr, lane); g.item += g.ngw; g.pend = false; }
    while (g.item < BG_TOTAL) { bg_issue(p, g, lane); bg_finish(p, g, scr, lane); g.item += g.ngw; }
}
__device__ __forceinline__ void ph_convert(const P& p, unsigned char* lds) {
    const int tid = threadIdx.x, lane = tid & 63, wave = tid >> 6;
    const int gw = blockIdx.x * 8 + wave, NGW = gridDim.x * 8;
    float* scr = (float*)(lds + wave * 8704);
    bf16_t* WT_IN = (bf16_t*)(p.ws + WS_WT_IN); bf16_t* WT_UQ = (bf16_t*)(p.ws + WS_WT_UQ); bf16_t* WT_UKV = (bf16_t*)(p.ws + WS_WT_UKV);
    bf16_t* WT_A = (bf16_t*)(p.ws + WS_WT_A); bf16_t* WT_B = (bf16_t*)(p.ws + WS_WT_B); bf16_t* WT_OUT = (bf16_t*)(p.ws + WS_WT_OUT);
    bf16_t* WT_M1 = (bf16_t*)(p.ws + WS_WT_M1); bf16_t* WT_M2 = (bf16_t*)(p.ws + WS_WT_M2);
    constexpr int I_IN = 16 * 109, I_UQ = 6 * 24, I_UK = 4 * 16, I_A = 8 * 32, I_OUT = 16 * 32, I_M1 = 32 * 16 * 64, I_M2 = 32 * 16 * 32;
    constexpr int TOTAL = I_IN + I_UQ + 2 * I_UK + 2 * I_A + I_OUT + (BG_CONV ? 0 : I_M1 + I_M2);
    for (int it = gw; it < TOTAL; it += NGW) {
        int r = it;
        if (r < I_IN) { const int kb = r / 109, nb = r % 109;
            if (nb * 32 < 1440) transpose_item(p.w_in, 3488, 1024, WT_IN, kb * 64, nb * 32, in_colmap(nb * 32), nullptr, scr, lane, nb * 32 == 1408);
            else transpose_item_fp8(p.w_in, 3488, 1024, p.ws + WS_WT_G8, kb * 64, nb * 32, nb * 32 - 1440, scr, lane);
            continue; } r -= I_IN;
        if (r < I_UQ) { const int kb = r / 24, nb = r % 24; const int n0 = nb * 32, hh = n0 / 96, d = n0 % 96;
            const int dst = d < 64 ? hh * 64 + d : 512 + hh * 32; transpose_item(p.w_uq, 768, 384, WT_UQ, kb * 64, n0, dst, p.q_norm, scr, lane, d >= 64); continue; } r -= I_UQ;
        if (r < I_UK) { const int kb = r / 16, nb = r % 16; transpose_item(p.w_uk, 512, 256, WT_UKV, kb * 64, nb * 32, nb * 32, p.kv_norm, scr, lane); continue; } r -= I_UK;
        if (r < I_UK) { const int kb = r / 16, nb = r % 16; transpose_item(p.w_uv, 512, 256, WT_UKV, kb * 64, nb * 32, 512 + nb * 32, p.kv_norm, scr, lane); continue; } r -= I_UK;
        if (r < I_A) { const int kb = r / 32, nb = r % 32; transpose_item(p.w_a, 1024, 1024, WT_A, kb * 64, nb * 32, nb * 32, nullptr, scr, lane); continue; } r -= I_A;
        if (r < I_A) { const int kb = r / 32, nb = r % 32; transpose_item(p.w_b, 1024, 1024, WT_A + 512, kb * 64, nb * 32, nb * 32, nullptr, scr, lane); continue; } r -= I_A;
        if (r < I_OUT) { const int kb = r / 32, nb = r % 32; transpose_item_fp8(p.w_out, 1024, 1024, (unsigned char*)WT_OUT, kb * 64, nb * 32, nb * 32, scr, lane); continue; } r -= I_OUT;
        if (r < I_M1) { const int e = r / 1024, q = r % 1024, kb = q / 64, nb = q % 64; const int n0 = nb * 32, j = n0 & 1023, lin = n0 >> 10;
            const int dst = (j >> 7) * 256 + lin * 128 + (j & 127);
            transpose_item_fp8(p.w_m1 + (size_t)e * 1024 * 2048, 2048, 1024, (unsigned char*)WT_M1 + (size_t)e * 2048 * 1024, kb * 64, n0, dst, scr, lane); continue; } r -= I_M1;
        { const int e = r / 512, q = r % 512, kb = q / 32, nb = q % 32;
            transpose_item_fp8(p.w_m2 + (size_t)e * 1024 * 1024, 1024, 1024, (unsigned char*)WT_M2 + (size_t)e * 1024 * 1024, kb * 64, nb * 32, nb * 32, scr, lane); }
    }
    for (int i = blockIdx.x * NTHREADS + tid; i < 1024 * 32; i += gridDim.x * NTHREADS) { const int k = i >> 5, e = i & 31; ((float*)(p.ws + WS_WRT))[e * 1028 + k] = p.w_router[i]; }
    for (int i = blockIdx.x * NTHREADS + tid; i < 96 * 128; i += gridDim.x * NTHREADS) ((u32x4*)(WT_IN + (size_t)1440 * 1024))[i] = (u32x4){0u, 0u, 0u, 0u};
}

__device__ __forceinline__ void ph_xn(const P& p) {
    const int tid = threadIdx.x, lane = tid & 63, wave = tid >> 6;
    const int gw = blockIdx.x * 8 + wave, NGW = gridDim.x * 8;
    const float* mod = (const float*)(p.ws + WS_MOD);
    bf16_t* XN = (bf16_t*)(p.ws + WS_XN); float* COS = (float*)(p.ws + WS_COS); float* SIN = (float*)(p.ws + WS_SIN);
    for (int m = gw; m < MTOK; m += NGW) {
        const int b = m >> 13;
        const f32x4* xr = (const f32x4*)(p.x + (size_t)m * DM);
        f32x4 v[4]; float s = 0.f;
#pragma unroll
        for (int j = 0; j < 4; ++j) { v[j] = xr[lane + 64 * j]; s += v[j].x * v[j].x + v[j].y * v[j].y + v[j].z * v[j].z + v[j].w * v[j].w; }
        s = wave_sum(s);
        const float rstd = rsqrtf(s * (1.f / DM) + EPS);
#pragma unroll
        for (int j = 0; j < 4; ++j) { const int col = 4 * lane + 256 * j;
            const f32x4 g = *(const f32x4*)(p.norm_mix + col), sc = *(const f32x4*)(mod + b * 6144 + 1024 + col), sh = *(const f32x4*)(mod + b * 6144 + col);
            const f32x4 h = v[j] * rstd * g * (sc + 1.0f) + sh;
            u32x2 o; o.x = pk2(h.x, h.y); o.y = pk2(h.z, h.w); *(u32x2*)(XN + (size_t)m * DM + col) = o;
            *(unsigned*)(p.ws + WS_XN8 + (size_t)m * DM + col) = pk4_fp8(h.x, h.y, h.z, h.w); }
        if (lane < 16) {
            const float freq = exp2f(-(float)lane * 0.8304820237218406f);
            const float ang = (float)p.pos[m] * freq;
            double t = (double)ang * 0.15915494309189535; t -= rint(t);
            const float fr = (float)t;
            COS[m * 16 + lane] = __builtin_amdgcn_cosf(fr); SIN[m * 16 + lane] = __builtin_amdgcn_sinf(fr);
        }
    }
}

namespace pg8 {
#define PG8_LAS __attribute__((address_space(3)))
constexpr int BM = 256, BK = 64, HALF = 128, HTB = HALF * BK * 2, STAGE_BYTES = 8 * HTB, NXCD = 8, WGM = 8;
__device__ __forceinline__ int lds_byte(int r, int c) { const int st = (r >> 4) * 2 + (c >> 5), rr = r & 15, cc = c & 31, ob = rr * 64 + cc * 2; return st * 1024 + (ob ^ (((ob >> 9) & 1) << 5)); }
__device__ __forceinline__ void stage_rc(int b, int& R, int& C) { const int st = b / 1024, sb = b % 1024, swz = sb ^ (((sb >> 9) & 1) << 5); R = (st >> 1) * 16 + swz / 64; C = (st & 1) * 32 + (swz % 64) / 2; }
__device__ __forceinline__ int perm32(int rho) { const int n = rho >> 4, i = rho & 15; return 8 * (i >> 2) + 4 * n + (i & 3); }
struct GUnit { const char* a; const char* b; int pm, pn, e, cnt, tile, pad_; };
typedef float f32x2_t __attribute__((ext_vector_type(2))); typedef __bf16 bf16x2_t __attribute__((ext_vector_type(2)));
__device__ __forceinline__ unsigned cvt_pk_bf16(float lo, float hi) { f32x2_t v = {lo, hi}; bf16x2_t b = __builtin_convertvector(v, bf16x2_t); return __builtin_bit_cast(unsigned, b); }

struct DenseOrder {
    const char* A; const char* Bt; int K, nM, nN, nwg, G, c;
    __device__ void init(const void* A_, const void* Bt_, int M, int N, int K_, int G_, int c_) { A = (const char*)A_; Bt = (const char*)Bt_; K = K_; nM = M / BM; nN = N / BM; nwg = nM * nN; G = G_; c = c_; }
    __device__ bool next(int i, GUnit& u) const {
        const long L = (long)i * G + c; if (L >= nwg) return false;
        int wgid = (int)L; { const int q = nwg / NXCD, r = nwg % NXCD, xcd = wgid % NXCD, off = wgid / NXCD; wgid = (xcd < r ? xcd * (q + 1) : r * (q + 1) + (xcd - r) * q) + off; }
        const int nig = WGM * nN, gid = wgid / nig, fm = gid * WGM, gsz = (nM - fm) < WGM ? (nM - fm) : WGM;
        u.pm = fm + ((wgid % nig) % gsz); u.pn = (wgid % nig) / gsz; u.e = 0; u.cnt = 0; u.tile = 0; u.pad_ = 0;
        u.a = A + (size_t)u.pm * BM * K * 2; u.b = Bt + (size_t)u.pn * BM * K * 2; return true;
    }
    __device__ __forceinline__ unsigned a_rowoff(const GUnit&, int) const { return 0u; }
};

typedef int v8i32 __attribute__((ext_vector_type(8)));
typedef int v4i32 __attribute__((ext_vector_type(4)));
template <class Epi, class Sched, bool ALIGN_EPI, bool GATHER, bool FP8 = false>
__device__ __forceinline__ void gemm_phase(PG8_LAS unsigned char* lds, const int K, const Sched& S, const Epi& E) {
    int tid_ = threadIdx.x; asm volatile("" : "+v"(tid_));
    const int tid = tid_, wid = __builtin_amdgcn_readfirstlane(tid >> 6), lane = tid & 63, wr = wid >> 2, wc = wid & 3, fr = lane & 15, fq = lane >> 4;
    const int nt = K / BK;
    int RA[2]; unsigned CA[2], voffB[2];
#pragma unroll
    for (int i = 0; i < 2; ++i) { int R, C; stage_rc(tid * 16 + i * 8192, R, C); const int Rb = Epi::PERM ? ((R & ~31) + perm32(R & 31)) : R;
        RA[i] = R; CA[i] = (unsigned)C * 2u; voffB[i] = (unsigned)(Rb * K + C) * 2u; }
    const size_t kstep = (size_t)(BK * 2);
    const size_t hstep = (size_t)HALF * K * 2;
    const unsigned ldsw = (unsigned)wid * 1024u;
    const int aoff = lds_byte(wr * 64 + fr, FP8 ? fq * 16 : fq * 8), boff = lds_byte(wc * 32 + fr, FP8 ? fq * 16 : fq * 8);
#define PG8_SA(b, h) (((b) * 2 + (h)) * HTB)
#define PG8_SB(b, h) ((4 + (b) * 2 + (h)) * HTB)
#define PG8_STAGE(bufoff, gbase, voff) do { _Pragma("unroll") for (int _i = 0; _i < 2; ++_i) { unsigned o_ = (voff)[_i]; asm volatile("" : "+v"(o_));     \
        __builtin_amdgcn_global_load_lds((const unsigned*)((const char*)(gbase) + o_), (PG8_LAS unsigned*)(lds + (bufoff) + ldsw + _i * 8192), 16, 0, 0); } } while (0)
#define PG8_LD16(p) (*(const PG8_LAS v4i32*)(p))
#define PG8_LDA(dst, b, h) do { if constexpr (FP8) { _Pragma("unroll") for (int m = 0; m < 4; ++m) { const PG8_LAS unsigned char* p_ = lds + PG8_SA(b, h) + aoff + m * 2048; \
            dst##8[m] = __builtin_shufflevector(PG8_LD16(p_), PG8_LD16(p_ + 16), 0, 1, 2, 3, 4, 5, 6, 7); } } \
        else { _Pragma("unroll") for (int m = 0; m < 4; ++m) _Pragma("unroll") for (int k = 0; k < 2; ++k) dst[m][k] = *(const PG8_LAS bf16x8*)(lds + PG8_SA(b, h) + aoff + m * 2048 + k * 1024); } } while (0)
#define PG8_LDB(dst, b, h) do { if constexpr (FP8) { _Pragma("unroll") for (int n = 0; n < 2; ++n) { const PG8_LAS unsigned char* p_ = lds + PG8_SB(b, h) + boff + n * 2048; \
            dst##8[n] = __builtin_shufflevector(PG8_LD16(p_), PG8_LD16(p_ + 16), 0, 1, 2, 3, 4, 5, 6, 7); } } \
        else { _Pragma("unroll") for (int n = 0; n < 2; ++n) _Pragma("unroll") for (int k = 0; k < 2; ++k) dst[n][k] = *(const PG8_LAS bf16x8*)(lds + PG8_SB(b, h) + boff + n * 2048 + k * 1024); } } while (0)
#define PG8_MMA(ai, bj, At, Bt) do { __builtin_amdgcn_s_setprio(1); \
        if constexpr (FP8) { _Pragma("unroll") for (int m = 0; m < 4; ++m) _Pragma("unroll") for (int n = 0; n < 2; ++n) \
                asm volatile("v_mfma_scale_f32_16x16x128_f8f6f4 %0, %1, %2, %0, %3, %3 op_sel_hi:[0,0,0]" : "+v"(acc[ai][bj][m][n]) : "v"(Bt##8[n]), "v"(At##8[m]), "v"(scl8)); } \
        else { _Pragma("unroll") for (int m = 0; m < 4; ++m) _Pragma("unroll") for (int n = 0; n < 2; ++n) _Pragma("unroll") for (int k = 0; k < 2; ++k) \
                acc[ai][bj][m][n] = __builtin_amdgcn_mfma_f32_16x16x32_bf16(Bt[n][k], At[m][k], acc[ai][bj][m][n], 0, 0, 0); } \
        __builtin_amdgcn_s_setprio(0); } while (0)
#define PG8_WAIT_V(n) asm volatile("s_waitcnt vmcnt(" #n ")" ::: "memory")
#define PG8_WAIT_L(n) asm volatile("s_waitcnt lgkmcnt(" #n ")" ::: "memory")
#define PG8_BAR __builtin_amdgcn_s_barrier()
#define PG8_SCHED __builtin_amdgcn_sched_barrier(0)
#define PG8_VOFF(u, v) do { _Pragma("unroll") for (int _i = 0; _i < 2; ++_i) { int r_ = RA[_i]; if (GATHER) asm volatile("" : "+v"(r_));     \
        _Pragma("unroll") for (int _h = 0; _h < 2; ++_h) v[_h][_i] = GATHER ? (S.a_rowoff(u, _h * HALF + r_) + CA[_i]) : ((unsigned)((_h * HALF + r_) * K) * 2u + CA[_i]); } } while (0)
    GUnit cur, nxt; int ui = 0;
    if (!S.next(0, cur)) return;
    f32x4 acc[2][2][4][2];
#pragma unroll
    for (int a = 0; a < 2; ++a)
#pragma unroll
        for (int b = 0; b < 2; ++b)
#pragma unroll
            for (int m = 0; m < 4; ++m)
#pragma unroll
                for (int n = 0; n < 2; ++n) acc[a][b][m][n] = (f32x4){0.f, 0.f, 0.f, 0.f};
    bf16x8 At[4][2], B0[2][2], B1[2][2];
    v8i32 At8[4], B08[2], B18[2];
    const int scl8 = 0x7f7f7f7f;
    unsigned vAc[2][2], vAn[2][2];
    PG8_VOFF(cur, vAc);
    if (GATHER) { asm volatile("s_waitcnt vmcnt(0)" : "+v"(vAc[0][0]), "+v"(vAc[0][1]), "+v"(vAc[1][0]), "+v"(vAc[1][1]) :: "memory"); }
    const char* cA = cur.a; const char* cB = cur.b;
    PG8_STAGE(PG8_SB(0, 0), cB, voffB); PG8_STAGE(PG8_SB(0, 1), cB + hstep, voffB); PG8_STAGE(PG8_SA(0, 0), cA, vAc[0]); PG8_STAGE(PG8_SA(0, 1), cA, vAc[1]);
    if (wr == 1) PG8_BAR;
    PG8_WAIT_V(2); PG8_BAR;
    PG8_STAGE(PG8_SB(1, 0), cB + kstep, voffB); PG8_STAGE(PG8_SA(1, 0), cA + kstep, vAc[0]); PG8_STAGE(PG8_SB(1, 1), cB + hstep + kstep, voffB);
    PG8_WAIT_V(6); PG8_BAR;
    for (;;) {
        const bool has_next = S.next(ui + 1, nxt);
        const char* nA = has_next ? nxt.a : cA; const char* nB = has_next ? nxt.b : cB;
        if (GATHER) {
            if (has_next) { PG8_VOFF(nxt, vAn); }
            else {
#pragma unroll
                for (int h = 0; h < 2; ++h)
#pragma unroll
                    for (int i = 0; i < 2; ++i) vAn[h][i] = vAc[h][i]; }
            asm volatile("s_waitcnt vmcnt(0)" : "+v"(vAn[0][0]), "+v"(vAn[0][1]), "+v"(vAn[1][0]), "+v"(vAn[1][1]) :: "memory");
        }
#pragma unroll 1
        for (int t = 0; t < nt; t += 2) {
            const bool last = (t == nt - 2);
            if constexpr (Epi::HAS_MID) { if (t == (nt >> 1)) { int t_ = threadIdx.x; asm volatile("" : "+v"(t_)); E.mid(acc, cur, wr, wc, t_ & 15, (t_ >> 4) & 3); } }
            const char* a1 = cA + (size_t)(t + 1) * kstep;
            const char* a2 = last ? nA : cA + (size_t)(t + 2) * kstep; const char* b2 = last ? nB : cB + (size_t)(t + 2) * kstep;
            const char* a3 = a2 + kstep; const char* b3 = b2 + kstep;
            unsigned v2[2][2];
#pragma unroll
            for (int h = 0; h < 2; ++h)
#pragma unroll
                for (int i = 0; i < 2; ++i) v2[h][i] = (GATHER && last) ? vAn[h][i] : vAc[h][i];
            PG8_LDB(B0, 0, 0); PG8_LDB(B1, 0, 1); PG8_SCHED; PG8_LDA(At, 0, 0); PG8_STAGE(PG8_SA(1, 1), a1, vAc[1]);
            PG8_WAIT_V(8); PG8_WAIT_L(0); PG8_BAR; PG8_MMA(0, 0, At, B0); PG8_MMA(0, 1, At, B1); PG8_BAR; PG8_SCHED;
            PG8_LDA(At, 0, 1); PG8_STAGE(PG8_SB(0, 0), b2, voffB); PG8_STAGE(PG8_SB(0, 1), b2 + hstep, voffB); PG8_STAGE(PG8_SA(0, 0), a2, v2[0]);
            PG8_WAIT_V(8); PG8_WAIT_L(0); PG8_BAR; PG8_MMA(1, 0, At, B0); PG8_MMA(1, 1, At, B1); PG8_BAR; PG8_SCHED;
            PG8_LDB(B0, 1, 0); PG8_LDB(B1, 1, 1); PG8_SCHED; PG8_LDA(At, 1, 0); PG8_STAGE(PG8_SA(0, 1), a2, v2[1]);
            PG8_WAIT_V(8); PG8_WAIT_L(0); PG8_BAR; PG8_MMA(0, 0, At, B0); PG8_MMA(0, 1, At, B1); PG8_BAR; PG8_SCHED;
            PG8_LDA(At, 1, 1); PG8_STAGE(PG8_SB(1, 0), b3, voffB); PG8_STAGE(PG8_SB(1, 1), b3 + hstep, voffB); PG8_STAGE(PG8_SA(1, 0), a3, v2[0]);
            PG8_WAIT_V(8); PG8_WAIT_L(0); PG8_BAR; PG8_MMA(1, 0, At, B0); PG8_MMA(1, 1, At, B1); PG8_BAR; PG8_SCHED;
        }
        if constexpr (FP8) {
            asm volatile("s_nop 15\n\ts_nop 15" ::: "memory");
#pragma unroll
            for (int a = 0; a < 2; ++a)
#pragma unroll
                for (int b = 0; b < 2; ++b)
#pragma unroll
                    for (int m = 0; m < 4; ++m) asm volatile("" : "+v"(acc[a][b][m][0]), "+v"(acc[a][b][m][1]));
        }
        if constexpr (ALIGN_EPI) { if (wr == 0) PG8_BAR; }
        { int t_ = threadIdx.x; asm volatile("" : "+v"(t_));
          E(acc, cur, wr, wc, t_ & 15, (t_ >> 4) & 3); }
        if (!has_next) break;
#pragma unroll
        for (int a = 0; a < 2; ++a)
#pragma unroll
            for (int b = 0; b < 2; ++b)
#pragma unroll
                for (int m = 0; m < 4; ++m)
#pragma unroll
                    for (int n = 0; n < 2; ++n) acc[a][b][m][n] = (f32x4){0.f, 0.f, 0.f, 0.f};
        cur = nxt; cA = nA; cB = nB; ++ui;
#pragma unroll
        for (int h = 0; h < 2; ++h)
#pragma unroll
            for (int i = 0; i < 2; ++i) vAc[h][i] = vAn[h][i];
        if constexpr (ALIGN_EPI) { if (wr == 1) PG8_BAR; }
    }
    PG8_WAIT_V(0);
    if constexpr (!ALIGN_EPI) { if (wr == 0) PG8_BAR; }
    PG8_BAR;
#undef PG8_SA
#undef PG8_SB
#undef PG8_STAGE
#undef PG8_LDA
#undef PG8_LDB
#undef PG8_MMA
#undef PG8_LD16
#undef PG8_WAIT_V
#undef PG8_WAIT_L
#undef PG8_BAR
#undef PG8_SCHED
#undef PG8_VOFF
}
}
#define LAS __attribute__((address_space(3)))
__device__ __forceinline__ u32x4 pack8(const f32x4& v0, const f32x4& v1) { u32x4 w; w.x = pg8::cvt_pk_bf16(v0[0], v0[1]); w.y = pg8::cvt_pk_bf16(v0[2], v0[3]); w.z = pg8::cvt_pk_bf16(v1[0], v1[1]); w.w = pg8::cvt_pk_bf16(v1[2], v1[3]); return w; }
__device__ __forceinline__ void unpack8(const u32x4& w, f32x4& v0, f32x4& v1) { v0 = (f32x4){bf2f(w.x & 0xffffu), bf2f(w.x >> 16), bf2f(w.y & 0xffffu), bf2f(w.y >> 16)}; v1 = (f32x4){bf2f(w.z & 0xffffu), bf2f(w.z >> 16), bf2f(w.w & 0xffffu), bf2f(w.w >> 16)}; }
__device__ __forceinline__ float sigs_(float a) { return __builtin_amdgcn_rcpf(1.f + __builtin_amdgcn_exp2f(a * (-LOG2E * W8_INV))); }
__device__ __forceinline__ f32x4 sig4s(const f32x4& v) { return (f32x4){sigs_(v[0]), sigs_(v[1]), sigs_(v[2]), sigs_(v[3])}; }
__device__ __forceinline__ f32x4 sig4(const f32x4& v) { return (f32x4){sigmoidf_(v[0]), sigmoidf_(v[1]), sigmoidf_(v[2]), sigmoidf_(v[3])}; }

struct EpiProj {
    static constexpr bool PERM = true, HAS_MID = false;
    unsigned char* ws;
    __device__ __forceinline__ void operator()(const f32x4 (&acc)[2][2][4][2], const pg8::GUnit& u, int wr, int wc, int fr, int fq) const {
        const int row0 = u.pm * 256 + wr * 64 + fr;
#pragma unroll
        for (int bj = 0; bj < 2; ++bj) {
            const int cl = bj * 128 + wc * 32 + 8 * fq;
            bf16_t* base; int ld, c; float sc = 1.f; bool sg = false;
            const int pn = u.pn;
            if (pn < 2) { base = (bf16_t*)(ws + WS_QA); ld = 512; c = pn * 256 + cl; sc = 0.125f * LOG2E; }
            else if (pn == 2) { base = (bf16_t*)(ws + (bj == 0 ? WS_KA : WS_VA)); ld = 128; c = wc * 32 + 8 * fq; }
            else if (pn == 3) { base = (bf16_t*)(ws + WS_CKV); ld = 256; c = cl; }
            else if (pn == 4) { base = (bf16_t*)(ws + WS_CQ); ld = 384; c = cl; }
            else if (pn == 5) { if (bj == 0) { base = (bf16_t*)(ws + WS_CQ); ld = 384; c = 256 + wc * 32 + 8 * fq; } else { if (wc != 0) continue; base = (bf16_t*)(ws + WS_KR); ld = 32; c = 8 * fq; } }
            else if (pn < 10) { base = (bf16_t*)(ws + WS_GA); ld = 1024; c = (pn - 6) * 256 + cl; sg = true; }
            else { base = (bf16_t*)(ws + WS_GB); ld = 1024; c = (pn - 10) * 256 + cl; sg = true; }
            const bool is_kr = pn == 5 && bj == 1;
#pragma unroll
            for (int ai = 0; ai < 2; ++ai)
#pragma unroll
                for (int m = 0; m < 4; ++m) { f32x4 v0 = acc[ai][bj][m][0], v1 = acc[ai][bj][m][1]; const int row = row0 + ai * 128 + m * 16;
                    if (is_kr) { const f32x4 cs = *(const f32x4*)((const float*)(ws + WS_COS) + row * 16 + 4 * fq), sn = *(const f32x4*)((const float*)(ws + WS_SIN) + row * 16 + 4 * fq);
                        const f32x4 o1 = v0 * cs - v1 * sn, o2 = v1 * cs + v0 * sn; v0 = o1; v1 = o2; }
                    else if (sg) { v0 = sig4(v0); v1 = sig4(v1); } else { v0 = v0 * sc; v1 = v1 * sc; }
                    *(u32x4*)(base + (size_t)row * ld + c) = pack8(v0, v1); }
        }
        if (u.pn >= 3 && u.pn <= 5) {
            float* SSQ = (float*)(ws + WS_SSQ);
#pragma unroll
            for (int ai = 0; ai < 2; ++ai)
#pragma unroll
                for (int m = 0; m < 4; ++m) { float q = 0.f;
#pragma unroll
                    for (int bj = 0; bj < 2; ++bj) { if (u.pn == 5 && bj == 1) continue;
#pragma unroll
                        for (int n = 0; n < 2; ++n) { const f32x4 v = acc[ai][bj][m][n]; q += (v[0] * v[0] + v[1] * v[1]) + (v[2] * v[2] + v[3] * v[3]); } }
                    q += __shfl_xor(q, 16); q += __shfl_xor(q, 32);
                    const int slot = u.pn == 3 ? 8 + wc : u.pn == 4 ? wc : 4 + wc;
                    if (fq == 0) SSQ[slot * MTOK + row0 + ai * 128 + m * 16] = q; }
        }
    }
};
struct EpiUpQ {
    static constexpr bool PERM = true, HAS_MID = false;
    unsigned char* ws;
    __device__ __forceinline__ void operator()(const f32x4 (&acc)[2][2][4][2], const pg8::GUnit& u, int wr, int wc, int fr, int fq) const {
        const float qs0 = 0.10206207261596577f * LOG2E;
        const int row0 = u.pm * 256 + wr * 64 + fr;
        const float* COS = (const float*)(ws + WS_COS); const float* SIN = (const float*)(ws + WS_SIN); const float* SSQ = (const float*)(ws + WS_SSQ);
        float rq[2][4];
#pragma unroll
        for (int ai = 0; ai < 2; ++ai)
#pragma unroll
            for (int m = 0; m < 4; ++m) { const int row = row0 + ai * 128 + m * 16; float q = 0.f;
#pragma unroll
                for (int sl = 0; sl < 8; ++sl) q += SSQ[sl * MTOK + row];
                rq[ai][m] = rsqrtf(q * (1.f / 384.f) + EPS); }
#pragma unroll
        for (int bj = 0; bj < 2; ++bj) { const int cl = bj * 128 + wc * 32 + 8 * fq;
#pragma unroll
            for (int ai = 0; ai < 2; ++ai)
#pragma unroll
                for (int m = 0; m < 4; ++m) { const int row = row0 + ai * 128 + m * 16; f32x4 v0 = acc[ai][bj][m][0], v1 = acc[ai][bj][m][1];
                    const float qs = qs0 * rq[ai][m];
                    if (u.pn < 2) { *(u32x4*)((bf16_t*)(ws + WS_QN) + (size_t)row * 512 + u.pn * 256 + cl) = pack8(v0 * qs, v1 * qs); }
                    else { const f32x4 cs = *(const f32x4*)(COS + row * 16 + 4 * fq), sn = *(const f32x4*)(SIN + row * 16 + 4 * fq);
                        const f32x4 o1 = (v0 * cs - v1 * sn) * qs, o2 = (v1 * cs + v0 * sn) * qs;
                        *(u32x4*)((bf16_t*)(ws + WS_QR) + (size_t)row * 256 + cl) = pack8(o1, o2); }
                    asm volatile("" ::: "memory"); }
        }
    }
};
struct EpiUpKV {
    static constexpr bool PERM = true, HAS_MID = false;
    unsigned char* ws;
    __device__ __forceinline__ void operator()(const f32x4 (&acc)[2][2][4][2], const pg8::GUnit& u, int wr, int wc, int fr, int fq) const {
        const int row0 = u.pm * 256 + wr * 64 + fr;
        bf16_t* base = (bf16_t*)(ws + (u.pn < 2 ? WS_KN : WS_VB)); const float* SSQ = (const float*)(ws + WS_SSQ);
        float rk[2][4];
#pragma unroll
        for (int ai = 0; ai < 2; ++ai)
#pragma unroll
            for (int m = 0; m < 4; ++m) { const int row = row0 + ai * 128 + m * 16;
                const float q = (SSQ[8 * MTOK + row] + SSQ[9 * MTOK + row]) + (SSQ[10 * MTOK + row] + SSQ[11 * MTOK + row]);
                rk[ai][m] = rsqrtf(q * (1.f / 256.f) + EPS); }
#pragma unroll
        for (int bj = 0; bj < 2; ++bj) { const int c = (u.pn & 1) * 256 + bj * 128 + wc * 32 + 8 * fq;
#pragma unroll
            for (int ai = 0; ai < 2; ++ai)
#pragma unroll
                for (int m = 0; m < 4; ++m) *(u32x4*)(base + (size_t)(row0 + ai * 128 + m * 16) * 512 + c) = pack8(acc[ai][bj][m][0] * rk[ai][m], acc[ai][bj][m][1] * rk[ai][m]); }
    }
};
struct EpiMixF {
    static constexpr bool PERM = true, HAS_MID = true;
    unsigned char* ws;
    __device__ __forceinline__ void mid(f32x4 (&acc)[2][2][4][2], const pg8::GUnit& u, int wr, int wc, int fr, int fq) const {
        const int row0 = u.pm * 256 + wr * 64 + fr;
        const bf16_t* GA = (const bf16_t*)(ws + WS_GA); const bf16_t* GB = (const bf16_t*)(ws + WS_GB);
#pragma unroll
        for (int bj = 0; bj < 2; ++bj) { const int c = u.pn * 256 + bj * 128 + wc * 32 + 8 * fq;
#pragma unroll
            for (int ai = 0; ai < 2; ++ai)
#pragma unroll
                for (int m = 0; m < 4; ++m) { const size_t idx = (size_t)(row0 + ai * 128 + m * 16) * 1024 + c;
                    f32x4 a0, a1, b0, b1; unpack8(*(const u32x4*)(GA + idx), a0, a1); unpack8(*(const u32x4*)(GB + idx), b0, b1);
#pragma unroll
                    for (int i = 0; i < 4; ++i) { acc[ai][bj][m][0][i] *= a0[i] * __builtin_amdgcn_rcpf(fmaxf(b0[i], 1e-30f)); acc[ai][bj][m][1][i] *= a1[i] * __builtin_amdgcn_rcpf(fmaxf(b1[i], 1e-30f)); }
                    if (m == 3) asm volatile("" ::: "memory"); } }
    }
    __device__ __forceinline__ void operator()(const f32x4 (&acc)[2][2][4][2], const pg8::GUnit& u, int wr, int wc, int fr, int fq) const {
        const int row0 = u.pm * 256 + wr * 64 + fr;
        const bf16_t* GB = (const bf16_t*)(ws + WS_GB); bf16_t* MIX = (bf16_t*)(ws + WS_MIX);
#pragma unroll
        for (int bj = 0; bj < 2; ++bj) { const int c = u.pn * 256 + bj * 128 + wc * 32 + 8 * fq;
#pragma unroll
            for (int ai = 0; ai < 2; ++ai)
#pragma unroll
                for (int m = 0; m < 4; ++m) { const size_t idx = (size_t)(row0 + ai * 128 + m * 16) * 1024 + c;
                    f32x4 g0, g1; unpack8(*(const u32x4*)(GB + idx), g0, g1);
                    const f32x4 y0 = g0 * acc[ai][bj][m][0] * MIX8_SCALE, y1 = g1 * acc[ai][bj][m][1] * MIX8_SCALE;
                    u32x2 o8; o8.x = pk4_fp8(y0[0], y0[1], y0[2], y0[3]); o8.y = pk4_fp8(y1[0], y1[1], y1[2], y1[3]);
                    *(u32x2*)((unsigned char*)MIX + idx) = o8; if (m & 1) asm volatile("" ::: "memory"); } }
    }
};
struct EpiOut {
    static constexpr bool PERM = true, HAS_MID = false;
    unsigned char* ws; const float* x;
    __device__ __forceinline__ void operator()(const f32x4 (&acc)[2][2][4][2], const pg8::GUnit& u, int wr, int wc, int fr, int fq) const {
        const int row0 = u.pm * 256 + wr * 64 + fr; const int b = (u.pm * 256) >> 13;
        const float* mod = (const float*)(ws + WS_MOD); bf16_t* X1 = (bf16_t*)(ws + WS_X1);
#pragma unroll
        for (int bj = 0; bj < 2; ++bj) { const int c = u.pn * 256 + bj * 128 + wc * 32 + 8 * fq;
            const f32x4 g0 = *(const f32x4*)(mod + b * 6144 + 2048 + c) * OUT8_INV, g1 = *(const f32x4*)(mod + b * 6144 + 2048 + c + 4) * OUT8_INV;
#pragma unroll
            for (int ai = 0; ai < 2; ++ai)
#pragma unroll
                for (int m = 0; m < 4; ++m) { const size_t idx = (size_t)(row0 + ai * 128 + m * 16) * 1024 + c;
                    const f32x4 x0 = *(const f32x4*)(x + idx), x1 = *(const f32x4*)(x + idx + 4);
                    *(u32x4*)(X1 + idx) = pack8(x0 + g0 * acc[ai][bj][m][0], x1 + g1 * acc[ai][bj][m][1]); if (m & 1) asm volatile("" ::: "memory"); } }
    }
};

constexpr int RT_LD = 1028;
__device__ __forceinline__ void ph_route(const P& p, unsigned char* lds, bool commit = true) {
    const int tid = threadIdx.x, lane = tid & 63, wave = tid >> 6, e = lane & 31, hf = lane >> 5;
    const int RPW = MTOK / gridDim.x;
    float* h2s = (float*)lds;
    unsigned* lcnt = (unsigned*)(lds + 132096); unsigned* lbase = lcnt + 32; unsigned* lent = lcnt + 64; float* lw = (float*)(lcnt + 64 + 256);
    float* lg = (float*)(lcnt + 64 + 512) + wave * 128 + hf * 64;
    if (tid < NEXP) lcnt[tid] = 0u;
    const float* mod = (const float*)(p.ws + WS_MOD); const bf16_t* X1 = (const bf16_t*)(p.ws + WS_X1); unsigned char* H2 = p.ws + WS_XN;
    unsigned* cnt = (unsigned*)(p.ws + WS_CTL); unsigned* LIST = (unsigned*)(p.ws + WS_LIST); float* LISTW = (float*)(p.ws + WS_LISTW);
    u32x4 wh[8], wl[8];
    { const float* wrt = (const float*)(p.ws + WS_WRT) + e * 1028 + 128 * wave + 8 * hf;
#pragma unroll
      for (int ks = 0; ks < 8; ++ks) { const f32x4 a = *(const f32x4*)(wrt + 16 * ks), b = *(const f32x4*)(wrt + 16 * ks + 4); f32x4 ha, hb;
          wh[ks] = pack8(a, b); unpack8(wh[ks], ha, hb); wl[ks] = pack8(a - ha, b - hb); } }
    const float brt = p.b_router[e];
    for (int pass = 0; pass * 32 < RPW; ++pass) {
        u32x2 xw[4][4];
#pragma unroll
        for (int rr = 0; rr < 4; ++rr) { const u32x2* xr = (const u32x2*)(X1 + (size_t)(blockIdx.x * RPW + pass * 32 + 4 * wave + rr) * DM);
#pragma unroll
            for (int j = 0; j < 4; ++j) xw[rr][j] = xr[lane + 64 * j]; }
#pragma unroll
        for (int rr = 0; rr < 4; ++rr) {
            const int rl = 4 * wave + rr, m = blockIdx.x * RPW + pass * 32 + rl, b = m >> 13;
            f32x4 v[4]; float s = 0.f;
#pragma unroll
            for (int j = 0; j < 4; ++j) { const u32x2 w = xw[rr][j]; v[j] = (f32x4){bf2f(w.x & 0xffffu), bf2f(w.x >> 16), bf2f(w.y & 0xffffu), bf2f(w.y >> 16)};
                s += v[j].x * v[j].x + v[j].y * v[j].y + v[j].z * v[j].z + v[j].w * v[j].w; }
            s = wave_sum(s);
            const float rstd = rsqrtf(s * (1.f / DM) + EPS);
#pragma unroll
            for (int j = 0; j < 4; ++j) { const int col = 4 * lane + 256 * j;
                const f32x4 g = *(const f32x4*)(p.norm_ffn + col), sc = *(const f32x4*)(mod + b * 6144 + 4096 + col), sh = *(const f32x4*)(mod + b * 6144 + 3072 + col);
                v[j] = v[j] * rstd * g * (sc + 1.0f) + sh;
                *(unsigned*)(H2 + (size_t)m * DM + col) = pk4_fp8(v[j].x, v[j].y, v[j].z, v[j].w);
                *(f32x4*)(h2s + rl * RT_LD + col) = v[j]; }
        }
        __syncthreads();
        typedef float f32x16r __attribute__((ext_vector_type(16)));
        f32x16r acc, acc1, acc2;
#pragma unroll
        for (int r = 0; r < 16; ++r) { acc[r] = 0.f; acc1[r] = 0.f; acc2[r] = 0.f; }
        const float* ap = h2s + e * RT_LD + 128 * wave + 8 * hf;
#pragma unroll
        for (int ks = 0; ks < 8; ++ks) { const f32x4 a = *(const f32x4*)(ap + 16 * ks), b = *(const f32x4*)(ap + 16 * ks + 4); f32x4 ha, hb;
            const u32x4 ah = pack8(a, b); unpack8(ah, ha, hb); const u32x4 al = pack8(a - ha, b - hb);
            acc  = __builtin_amdgcn_mfma_f32_32x32x16_bf16(__builtin_bit_cast(bf16x8, ah), __builtin_bit_cast(bf16x8, wh[ks]), acc, 0, 0, 0);
            acc1 = __builtin_amdgcn_mfma_f32_32x32x16_bf16(__builtin_bit_cast(bf16x8, ah), __builtin_bit_cast(bf16x8, wl[ks]), acc1, 0, 0, 0);
            acc2 = __builtin_amdgcn_mfma_f32_32x32x16_bf16(__builtin_bit_cast(bf16x8, al), __builtin_bit_cast(bf16x8, wh[ks]), acc2, 0, 0, 0); }
#pragma unroll
        for (int r = 0; r < 16; ++r) acc[r] += acc1[r] + acc2[r];
        __syncthreads();
#pragma unroll
        for (int r = 0; r < 16; ++r) h2s[(wave * 32 + ((r & 3) + 8 * (r >> 2) + 4 * hf)) * 32 + e] = acc[r];
        __syncthreads();
#pragma unroll 1
        for (int it = 0; it < 2; ++it) {
            const int rl = 4 * wave + 2 * it + hf, ri = pass * 32 + rl;
            float val = brt;
#pragma unroll
            for (int w8 = 0; w8 < 8; ++w8) val += h2s[(w8 * 32 + rl) * 32 + e];
            lg[e] = val;
            int rank = 0;
#pragma unroll
            for (int e4 = 0; e4 < 8; ++e4) { const f32x4 o = *(const f32x4*)(lg + 4 * e4);
#pragma unroll
                for (int i = 0; i < 4; ++i) { const int ee = 4 * e4 + i; rank += (o[i] > val || (o[i] == val && ee < e)) ? 1 : 0; } }
            if (rank < 4) { lg[32 + rank] = val; lg[36 + rank] = __int_as_float(e); }
            const f32x4 tvv = *(const f32x4*)(lg + 32), tiv = *(const f32x4*)(lg + 36);
            const float e1 = __expf(tvv[1] - tvv[0]), e2 = __expf(tvv[2] - tvv[0]), e3 = __expf(tvv[3] - tvv[0]);
            const float inv = 1.f / (1.f + e1 + e2 + e3);
            if (e < 4) {
                const int ex = __float_as_int(e == 0 ? tiv[0] : e == 1 ? tiv[1] : e == 2 ? tiv[2] : tiv[3]);
                const float w = (e == 0 ? 1.f : e == 1 ? e1 : e == 2 ? e2 : e3) * inv;
                const unsigned lr = atomicAdd(&lcnt[ex], 1u);
                lent[ri * 4 + e] = (unsigned)ex | (lr << 8); lw[ri * 4 + e] = w;
            }
        }
        __syncthreads();
    }
    if (!commit) return;
    if (tid < NEXP) lbase[tid] = atomicAdd(&cnt[tid * 64], lcnt[tid]);
    __syncthreads();
    for (int a = tid; a < RPW * 4; a += NTHREADS) {
        const unsigned en = lent[a]; const int ex = (int)(en & 255u); const unsigned pos = lbase[ex] + (en >> 8);
        LIST[(size_t)ex * LISTCAP + pos] = (unsigned)((blockIdx.x * RPW + (a >> 2)) * 4 + (a & 3));
        ((float*)(p.ws + WS_TOPW))[(size_t)blockIdx.x * RPW * 4 + a] = lw[a];
    }
}
__device__ __forceinline__ void ph_final(const P& p) {
    const int tid = threadIdx.x, lane = tid & 63, wave = tid >> 6;
    const int gw = blockIdx.x * 8 + wave, NGW = gridDim.x * 8;
    const float* mod = (const float*)(p.ws + WS_MOD); const bf16_t* X1 = (const bf16_t*)(p.ws + WS_X1); const unsigned char* Y = (const unsigned char*)(p.ws + WS_Y);
    for (int m = gw; m < MTOK; m += NGW) {
        const int b = m >> 13;
        const u32x2* xr = (const u32x2*)(X1 + (size_t)m * DM);
        f32x4 v[4]; float s = 0.f;
        const f32x4 tw = *(const f32x4*)((const float*)(p.ws + WS_TOPW) + (size_t)m * 4);
#pragma unroll
        for (int j = 0; j < 4; ++j) { const int col = 4 * lane + 256 * j;
            f32x4 y = (f32x4){0.f, 0.f, 0.f, 0.f};
#pragma unroll
            for (int k = 0; k < 4; ++k) { const int w = (int)__builtin_nontemporal_load((const unsigned*)(Y + ((size_t)m * 4 + k) * 1024 + col));
                y.x += tw[k] * __builtin_amdgcn_cvt_f32_fp8(w, 0); y.y += tw[k] * __builtin_amdgcn_cvt_f32_fp8(w, 1); y.z += tw[k] * __builtin_amdgcn_cvt_f32_fp8(w, 2); y.w += tw[k] * __builtin_amdgcn_cvt_f32_fp8(w, 3); }
            const f32x4 g2 = *(const f32x4*)(mod + b * 6144 + 5120 + col);
            const u32x2 xw = xr[lane + 64 * j];
            v[j] = (f32x4){bf2f(xw.x & 0xffffu), bf2f(xw.x >> 16), bf2f(xw.y & 0xffffu), bf2f(xw.y >> 16)} + g2 * y;
            s += v[j].x * v[j].x + v[j].y * v[j].y + v[j].z * v[j].z + v[j].w * v[j].w; }
        s = wave_sum(s);
        const float rstd = rsqrtf(s * (1.f / DM) + EPS);
#pragma unroll
        for (int j = 0; j < 4; ++j) { const int col = 4 * lane + 256 * j; const f32x4 g = *(const f32x4*)(p.fnorm + col);
            *(f32x4*)(p.out + (size_t)m * DM + col) = v[j] * rstd * g; }
    }
}


struct EpiGate {
    static constexpr bool PERM = true, HAS_MID = false;
    unsigned char* ws;
    __device__ __forceinline__ void operator()(const f32x4 (&acc)[2][2][4][2], const pg8::GUnit& u, int wr, int wc, int fr, int fq) const {
        const int row0 = u.pm * 256 + wr * 64 + fr;
        bf16_t* base = (bf16_t*)(ws + (u.pn < 4 ? WS_GA : WS_GB));
#pragma unroll
        for (int bj = 0; bj < 2; ++bj) { const int c = (u.pn & 3) * 256 + bj * 128 + wc * 32 + 8 * fq;
#pragma unroll
            for (int ai = 0; ai < 2; ++ai)
#pragma unroll
                for (int m = 0; m < 4; ++m) *(u32x4*)(base + (size_t)(row0 + ai * 128 + m * 16) * 1024 + c) = pack8(sig4s(acc[ai][bj][m][0]), sig4s(acc[ai][bj][m][1])); }
    }
};
struct GateOrder {
    const char* A; const char* Bt; int G, c;
    __device__ __forceinline__ bool next(int i, pg8::GUnit& u) const {
        int un;
        if (G == 256) { if (c < 128) { if (i > 0) return false; un = c; } else { if (i > 2) return false; un = 128 + 3 * (c - 128) + i; } }
        else { un = i * G + c; if (un >= 512) return false; }
        u.pm = un >> 3; u.pn = un & 7; u.e = 0; u.cnt = 0; u.tile = 0; u.pad_ = 0;
        u.a = A + (size_t)u.pm * 256 * 1024; u.b = Bt + (size_t)u.pn * 256 * 1024; return true;
    }
    __device__ __forceinline__ unsigned a_rowoff(const pg8::GUnit&, int) const { return 0u; }
};
__device__ __forceinline__ void ph_proj2(const P& p, unsigned char* lds) {
    { pg8::DenseOrder S; S.init(p.ws + WS_XN, p.ws + WS_WT_IN, MTOK, 1536, 1024, gridDim.x, blockIdx.x);
      EpiProj E{p.ws};
      pg8::gemm_phase<EpiProj, pg8::DenseOrder, true, false>((LAS unsigned char*)lds, 1024, S, E); }
    { GateOrder S{(const char*)(p.ws + WS_XN8), (const char*)(p.ws + WS_WT_G8), (int)gridDim.x, (int)blockIdx.x};
      EpiGate E{p.ws};
      pg8::gemm_phase<EpiGate, GateOrder, true, false, true>((LAS unsigned char*)lds, 512, S, E); }
}
__device__ __forceinline__ void ph_up2(const P& p, unsigned char* lds) {
    { pg8::DenseOrder S; S.init(p.ws + WS_CQ, p.ws + WS_WT_UQ, MTOK, 768, 384, gridDim.x, blockIdx.x); EpiUpQ E{p.ws};
      pg8::gemm_phase<EpiUpQ, pg8::DenseOrder, false, false>((LAS unsigned char*)lds, 384, S, E); }
    { pg8::DenseOrder S; S.init(p.ws + WS_CKV, p.ws + WS_WT_UKV, MTOK, 1024, 256, gridDim.x, blockIdx.x); EpiUpKV E{p.ws};
      pg8::gemm_phase<EpiUpKV, pg8::DenseOrder, false, false>((LAS unsigned char*)lds, 256, S, E); }
}
__device__ __forceinline__ void ph_mix2(const P& p, unsigned char* lds) {
    pg8::DenseOrder S; S.init(p.ws + WS_AO, p.ws + WS_WT_A, MTOK, 1024, 1024, gridDim.x, blockIdx.x); EpiMixF E{p.ws};
    pg8::gemm_phase<EpiMixF, pg8::DenseOrder, false, false>((LAS unsigned char*)lds, 1024, S, E);
}
__device__ __forceinline__ void ph_out2(const P& p, unsigned char* lds) {
    pg8::DenseOrder S; S.init(p.ws + WS_MIX, p.ws + WS_WT_OUT, MTOK, 1024, 512, gridDim.x, blockIdx.x); EpiOut E{p.ws, p.x};
    pg8::gemm_phase<EpiOut, pg8::DenseOrder, false, false, true>((LAS unsigned char*)lds, 512, S, E);
}


constexpr int MOE_TAB_OFF = 135168;
__device__ __forceinline__ void moe_build_tab(const P& p, unsigned char* lds) {
    LAS int* tab = (LAS int*)((LAS unsigned char*)lds + MOE_TAB_OFF);
    const unsigned* cnt = (const unsigned*)(p.ws + WS_CTL);
    const int tid = threadIdx.x;
    if (tid < 64) {
        const int c = tid < NEXP ? (int)cnt[tid * 64] : 0, n = (c + 255) >> 8;
        int incl = n;
#pragma unroll
        for (int o = 1; o < 32; o <<= 1) { const int t = __shfl_up(incl, o); if (tid >= o) incl += t; }
        const int s = incl - n;
        if (tid < NEXP) { tab[tid] = c; tab[32 + tid] = s; for (int j = 0; j < n; ++j) tab[128 + s + j] = tid; if (tid == NEXP - 1) tab[64] = incl; }
    }
    __syncthreads();
}
template <bool GATHER> struct MoeOrder {
    const LAS int* tab; const char* Abase; const char* Bbase; const unsigned* LIST; int K, NCT, G, c;
    __device__ __forceinline__ bool next(int i, pg8::GUnit& u) const {
        const int vc = (G % 8 == 0) ? (c % 8) * (G / 8) + c / 8 : c;
        const int L = i * G + vc; const int ntile = __builtin_amdgcn_readfirstlane(tab[64]); if (L >= ntile * NCT) return false;
        const int tile = L / NCT, pn = L - tile * NCT, e = __builtin_amdgcn_readfirstlane(tab[128 + tile]);
        u.e = e; u.cnt = __builtin_amdgcn_readfirstlane(tab[e]); u.pm = tile - __builtin_amdgcn_readfirstlane(tab[32 + e]); u.pn = pn; u.tile = tile; u.pad_ = 0;
        u.b = Bbase + ((size_t)e * NCT + pn) * 256 * K * 2;
        u.a = GATHER ? Abase : Abase + (size_t)tile * 256 * K * 2;
        return true;
    }
    __device__ __forceinline__ unsigned a_rowoff(const pg8::GUnit& u, int r) const {
        const int row = u.pm * 256 + r; const unsigned ent = row < u.cnt ? LIST[(size_t)u.e * LISTCAP + row] : 0u; return (ent >> 2) * (unsigned)(K * 2);
    }
};
struct EpiMoe1 {
    static constexpr bool PERM = true, HAS_MID = false;
    unsigned char* ws; const float* b1;
    __device__ __forceinline__ void operator()(const f32x4 (&acc)[2][2][4][2], const pg8::GUnit& u, int wr, int wc, int fr, int fq) const {
        bf16_t* HID = (bf16_t*)(ws + WS_HID);
        const int row0 = u.tile * 256 + wr * 64 + fr, col = u.pn * 128 + wc * 32 + 8 * fq;
        constexpr float CG = -1.702f * LOG2E, CGI = 1.f / CG;
        f32x4 bg[2], bl[2];
#pragma unroll
        for (int n = 0; n < 2; ++n) { bg[n] = *(const f32x4*)(b1 + u.e * 2048 + col + 4 * n) * CG; bl[n] = (*(const f32x4*)(b1 + u.e * 2048 + 1024 + col + 4 * n) + 1.f) * CGI; }
#pragma unroll
        for (int ai = 0; ai < 2; ++ai)
#pragma unroll
            for (int m = 0; m < 4; ++m) { f32x4 h[2];
#pragma unroll
                for (int n = 0; n < 2; ++n) { const f32x4 gv = acc[ai][0][m][n] * (W8_INV * CG) + bg[n], lv = acc[ai][1][m][n] * (W8_INV * CGI) + bl[n];
#pragma unroll
                    for (int i = 0; i < 4; ++i) { const float t = fmaxf(gv[i], 7.f * CG), L = __builtin_amdgcn_fmed3f(lv[i], 8.f * CGI, -6.f * CGI);
                        h[n][i] = t * __builtin_amdgcn_rcpf(1.f + __builtin_amdgcn_exp2f(t)) * L; } }
                u32x2 o8; o8.x = pk4_fp8(h[0][0], h[0][1], h[0][2], h[0][3]); o8.y = pk4_fp8(h[1][0], h[1][1], h[1][2], h[1][3]);
                *(u32x2*)((unsigned char*)HID + (size_t)(row0 + ai * 128 + m * 16) * 1024 + col) = o8; }
    }
};
struct EpiMoe2 {
    static constexpr bool PERM = true, HAS_MID = false;
    unsigned char* ws; const float* b2;
    __device__ __forceinline__ void operator()(const f32x4 (&acc)[2][2][4][2], const pg8::GUnit& u, int wr, int wc, int fr, int fq) const {
        unsigned char* Y = ws + WS_Y; const unsigned* LIST = (const unsigned*)(ws + WS_LIST) + (size_t)u.e * LISTCAP;
        f32x4 bv[2][2]; unsigned ent[2][4];
#pragma unroll
        for (int bj = 0; bj < 2; ++bj)
#pragma unroll
            for (int n = 0; n < 2; ++n) bv[bj][n] = *(const f32x4*)(b2 + u.e * 1024 + u.pn * 256 + bj * 128 + wc * 32 + 8 * fq + 4 * n);
#pragma unroll
        for (int ai = 0; ai < 2; ++ai)
#pragma unroll
            for (int m = 0; m < 4; ++m) { const int rr = u.pm * 256 + ai * 128 + wr * 64 + m * 16 + fr, rc = rr < u.cnt ? rr : u.cnt - 1; ent[ai][m] = LIST[rc]; }
        asm volatile("" : "+v"(bv[0][0]), "+v"(bv[0][1]), "+v"(bv[1][0]), "+v"(bv[1][1]));
#pragma unroll
        for (int ai = 0; ai < 2; ++ai)
#pragma unroll
            for (int m = 0; m < 4; ++m) asm volatile("" : "+v"(ent[ai][m]));
#pragma unroll
        for (int ai = 0; ai < 2; ++ai)
#pragma unroll
            for (int m = 0; m < 4; ++m) { const int rr = u.pm * 256 + ai * 128 + wr * 64 + m * 16 + fr;
                if (rr < u.cnt) {
#pragma unroll
                    for (int bj = 0; bj < 2; ++bj) { const int c = u.pn * 256 + bj * 128 + wc * 32 + 8 * fq;
                        const f32x4 y0 = acc[ai][bj][m][0] * W8_INV + bv[bj][0], y1 = acc[ai][bj][m][1] * W8_INV + bv[bj][1];
                        u32x2 o8; o8.x = pk4_fp8(y0[0], y0[1], y0[2], y0[3]); o8.y = pk4_fp8(y1[0], y1[1], y1[2], y1[3]);
                        *(u32x2*)(Y + (size_t)ent[ai][m] * 1024 + c) = o8; } } }
    }
};
__device__ __forceinline__ void ph_moe1_2(const P& p, unsigned char* lds) {
    moe_build_tab(p, lds);
    MoeOrder<true> S{(const LAS int*)((LAS unsigned char*)lds + MOE_TAB_OFF), (const char*)(p.ws + WS_XN), (const char*)(p.ws + WS_WT_M1), (const unsigned*)(p.ws + WS_LIST), 512, 8, (int)gridDim.x, (int)blockIdx.x};
    EpiMoe1 E{p.ws, p.b_m1};
    pg8::gemm_phase<EpiMoe1, MoeOrder<true>, true, true, true>((LAS unsigned char*)lds, 512, S, E);
}
__device__ __forceinline__ void ph_moe2_2(const P& p, unsigned char* lds) {
    MoeOrder<false> S{(const LAS int*)((LAS unsigned char*)lds + MOE_TAB_OFF), (const char*)(p.ws + WS_HID), (const char*)(p.ws + WS_WT_M2), (const unsigned*)(p.ws + WS_LIST), 512, 4, (int)gridDim.x, (int)blockIdx.x};
    EpiMoe2 E{p.ws, p.b_m2};
    pg8::gemm_phase<EpiMoe2, MoeOrder<false>, true, false, true>((LAS unsigned char*)lds, 512, S, E);
}


namespace att {
typedef float f32x16 __attribute__((ext_vector_type(16)));
typedef short s16x4 __attribute__((ext_vector_type(4)));
typedef short v4i16_t __attribute__((ext_vector_type(4)));
typedef LAS const unsigned char* lds_cptr;
constexpr int KROW = 208;
constexpr int KBUF = 64 * KROW, VBUF = 8192;
constexpr int OFF_K = 0, OFF_V = 2 * KBUF, OFF_WS = 2 * KBUF + 2 * VBUF, LDS_BYTES_ATT = OFF_WS + 8 * 256;
__device__ __forceinline__ int crow(int r, int hi) { return (r & 3) + 8 * (r >> 2) + 4 * hi; }
__device__ __forceinline__ s16x4 vtr(lds_cptr p) { return __builtin_bit_cast(s16x4, __builtin_amdgcn_ds_read_tr16_b64_v4i16((LAS v4i16_t*)p)); }
__device__ __forceinline__ float vmax3(float a, float b, float c) { float d; asm("v_max3_f32 %0, %1, %2, %3" : "=v"(d) : "v"(a), "v"(b), "v"(c)); return d; }
__device__ __forceinline__ float half_swap_max(float m) { auto rr = __builtin_amdgcn_permlane32_swap(__float_as_uint(m), __float_as_uint(m), false, false); return fmaxf(__uint_as_float(rr[0]), __uint_as_float(rr[1])); }
__device__ __forceinline__ float half_swap_sum(float m) { auto rr = __builtin_amdgcn_permlane32_swap(__float_as_uint(m), __float_as_uint(m), false, false); return __uint_as_float(rr[0]) + __uint_as_float(rr[1]); }

constexpr int BG_SCR_OFF = 49152;
#define ATT_BARRIER() asm volatile("s_waitcnt lgkmcnt(0)\n\ts_barrier" ::: "memory")
template <bool MLA>
__device__ __forceinline__ void attn_unit(const P& p, LAS unsigned char* lds, int b, int hk, int q0, BgConv& bg, float* bgscr) {
    int tid_ = threadIdx.x; asm volatile("" : "+v"(tid_));
    const int tid = tid_, lane = tid & 63, r32 = lane & 31, hi = lane >> 5, wid = __builtin_amdgcn_readfirstlane(tid >> 6);
    constexpr int NKS = MLA ? 6 : 4;
    const int head = MLA ? hk : hk * 4 + (wid >> 1);
    const int qw0 = MLA ? q0 + 32 * wid : q0 + 32 * (wid & 1);
    const size_t rb = (size_t)b * SEQ;
    bf16x8 qf[NKS];
    if (MLA) {
        const bf16_t* qn = (const bf16_t*)(p.ws + WS_QN) + (rb + qw0 + r32) * 512 + head * 64 + 8 * hi;
        const bf16_t* qr = (const bf16_t*)(p.ws + WS_QR) + (rb + qw0 + r32) * 256 + head * 32 + 8 * hi;
#pragma unroll
        for (int ks = 0; ks < 4; ++ks) qf[ks] = *(const bf16x8*)(qn + 16 * ks);
#pragma unroll
        for (int ks = 4; ks < NKS; ++ks) qf[ks] = *(const bf16x8*)(qr + 16 * (ks - 4));
    } else {
        const bf16_t* qa = (const bf16_t*)(p.ws + WS_QA) + (rb + qw0 + r32) * 512 + head * 64 + 8 * hi;
#pragma unroll
        for (int ks = 0; ks < NKS; ++ks) qf[ks] = *(const bf16x8*)(qa + 16 * ks);
    }
    const int t_lo = MLA ? 0 : (q0 >= 128 ? (q0 - 128) >> 6 : 0), t_hi = MLA ? ((q0 + 256) >> 6) - 1 : (q0 >> 6);
    const int skey = tid >> 3, sc = tid & 7;
    const bf16_t* kg; const bf16_t* vg; const bf16_t* rg = nullptr;
    if (MLA) { kg = (const bf16_t*)(p.ws + WS_KN) + (rb + skey) * 512 + hk * 64 + 8 * sc; vg = (const bf16_t*)(p.ws + WS_VB) + (rb + skey) * 512 + hk * 64 + 8 * sc;
               rg = (const bf16_t*)(p.ws + WS_KR) + (rb + (tid >> 2)) * 32 + 8 * (tid & 3); }
    else { kg = (const bf16_t*)(p.ws + WS_KA) + (rb + skey) * 128 + hk * 64 + 8 * sc; vg = (const bf16_t*)(p.ws + WS_VA) + (rb + skey) * 128 + hk * 64 + 8 * sc; }
    const int kpitch = MLA ? 512 : 128;
    const int kst = skey * KROW + sc * 16;
    const int rst = (tid >> 2) * KROW + 128 + (tid & 3) * 16;
    const int vst = ((8 * sc) >> 5) * 4096 + (skey >> 4) * 1024 + (skey & 15) * 64 + ((8 * sc) & 31) * 2;
    u32x4 kreg, vreg, rreg = (u32x4){0u, 0u, 0u, 0u};
#define ATT_LOAD(t) do { kreg = *(const u32x4*)(kg + (size_t)(t) * 64 * kpitch); vreg = *(const u32x4*)(vg + (size_t)(t) * 64 * kpitch); \
        if (MLA && tid < 256) rreg = *(const u32x4*)(rg + (size_t)(t) * 64 * 32); } while (0)
#define ATT_WRITE(buf) do { *(LAS u32x4*)(lds + OFF_K + (buf) * KBUF + kst) = kreg; *(LAS u32x4*)(lds + OFF_V + (buf) * VBUF + vst) = vreg; \
        if (MLA && tid < 256) *(LAS u32x4*)(lds + OFF_K + (buf) * KBUF + rst) = rreg; } while (0)
    LAS float* wsf = (LAS float*)(lds + OFF_WS) + wid * 64;
    float m, l; f32x16 o[2];
#pragma unroll
    for (int r = 0; r < 16; ++r) { o[0][r] = 0.f; o[1][r] = 0.f; }
    float slope2 = 0.f;
    if (MLA) { m = -INFINITY; l = 0.f; }
    else { m = p.sinks[head] * LOG2E; l = hi == 0 ? 1.f : 0.f; slope2 = exp2f(-(float)(head + 1)) * LOG2E; }
    const lds_cptr kp0 = (lds_cptr)lds + OFF_K + r32 * KROW + hi * 16;
    const lds_cptr vp0 = (lds_cptr)lds + OFF_V + ((lane >> 4) & 1) * 32 + (lane & 3) * 8 + (4 * hi + ((lane & 15) >> 2)) * 64;
    ATT_LOAD(t_lo); ATT_WRITE(0);
    ATT_BARRIER();
    for (int t = t_lo; t <= t_hi; ++t) {
        const int cur = (t - t_lo) & 1, s0 = t * 64;
        if (t < t_hi) ATT_LOAD(t + 1);
        if (BG_CONV) bg_step(p, bg, bgscr, lane);
        const bool active = MLA ? (s0 <= qw0 + 31) : (s0 <= qw0 + 31 && s0 + 63 >= qw0 - 127);
        if (active) {
            f32x16 p0, p1;
#pragma unroll
            for (int r = 0; r < 16; ++r) { p0[r] = 0.f; p1[r] = 0.f; }
            const lds_cptr kp = kp0 + cur * KBUF;
#pragma unroll
            for (int ks = 0; ks < NKS; ++ks) {
                const bf16x8 a0 = *(const LAS bf16x8*)(kp + ks * 32), a1 = *(const LAS bf16x8*)(kp + 32 * KROW + ks * 32);
                p0 = __builtin_amdgcn_mfma_f32_32x32x16_bf16(a0, qf[ks], p0, 0, 0, 0);
                p1 = __builtin_amdgcn_mfma_f32_32x32x16_bf16(a1, qf[ks], p1, 0, 0, 0);
            }
            const int q = qw0 + r32;
            if (MLA) {
                if (s0 + 63 > qw0) {
#pragma unroll
                    for (int r = 0; r < 16; ++r) { const int key = s0 + crow(r, hi); if (key > q) p0[r] = -INFINITY; if (key + 32 > q) p1[r] = -INFINITY; }
                }
            } else {
#pragma unroll
                for (int r = 0; r < 16; ++r) { const int d0 = q - (s0 + crow(r, hi)), d1 = d0 - 32;
                    p0[r] = (d0 >= 0 && d0 < 128) ? p0[r] - slope2 * (float)d0 : -INFINITY;
                    p1[r] = (d1 >= 0 && d1 < 128) ? p1[r] - slope2 * (float)d1 : -INFINITY; }
            }
            float mx = fmaxf(p0[0], p1[0]);
#pragma unroll
            for (int r = 1; r < 16; ++r) mx = fmaxf(mx, fmaxf(p0[r], p1[r]));
            mx = half_swap_max(mx);
            if (__any(mx > m + 8.f)) {
                const float mn = fmaxf(m, mx), alpha = __builtin_amdgcn_exp2f(m - mn);
                m = mn; l *= alpha;
                if (hi == 0) wsf[r32] = alpha;
#pragma unroll
                for (int r = 0; r < 16; ++r) { const float a = wsf[crow(r, hi)]; o[0][r] *= a; o[1][r] *= a; }
            }
            float ps = 0.f;
#pragma unroll
            for (int r = 0; r < 16; ++r) { p0[r] = __builtin_amdgcn_exp2f(p0[r] - m); p1[r] = __builtin_amdgcn_exp2f(p1[r] - m); ps += p0[r] + p1[r]; }
            l += ps;
            u32x4 pw[4];
#pragma unroll
            for (int i = 0; i < 4; ++i) { pw[0][i] = pg8::cvt_pk_bf16(p0[2 * i], p0[2 * i + 1]); pw[1][i] = pg8::cvt_pk_bf16(p0[8 + 2 * i], p0[8 + 2 * i + 1]);
                                          pw[2][i] = pg8::cvt_pk_bf16(p1[2 * i], p1[2 * i + 1]); pw[3][i] = pg8::cvt_pk_bf16(p1[8 + 2 * i], p1[8 + 2 * i + 1]); }
            const lds_cptr vp = vp0 + cur * VBUF;
#pragma unroll
            for (int d0 = 0; d0 < 2; ++d0)
#pragma unroll
                for (int ks = 0; ks < 4; ++ks) {
                    const s16x4 lo = vtr(vp + d0 * 4096 + ks * 1024), hh = vtr(vp + d0 * 4096 + ks * 1024 + 512);
                    const bf16x8 vf = (bf16x8){lo[0], lo[1], lo[2], lo[3], hh[0], hh[1], hh[2], hh[3]};
                    o[d0] = __builtin_amdgcn_mfma_f32_32x32x16_bf16(__builtin_bit_cast(bf16x8, pw[ks]), vf, o[d0], 0, 0, 0);
                }
        }
        if (t < t_hi) ATT_WRITE(cur ^ 1);
        ATT_BARRIER();
    }
    l = half_swap_sum(l);
    if (hi == 0) wsf[32 + r32] = 1.f / l;
    bf16_t* Ob = (bf16_t*)(p.ws + WS_AO) + (rb + qw0) * 1024 + (MLA ? 512 : 0) + head * 64 + r32;
#pragma unroll
    for (int r = 0; r < 16; ++r) { const int qr = crow(r, hi); const float rl = wsf[32 + qr];
        Ob[(size_t)qr * 1024] = (bf16_t)f2bf(o[0][r] * rl); Ob[(size_t)qr * 1024 + 32] = (bf16_t)f2bf(o[1][r] * rl); }
#undef ATT_LOAD
#undef ATT_WRITE
}
constexpr int PP_AHEAD = 4;
constexpr int PP_OFF_V = 3 * KBUF, PP_OFF_WS = 3 * KBUF + 3 * VBUF;
#define ATT_PBAR() do { __builtin_amdgcn_sched_barrier(0); asm volatile("s_waitcnt lgkmcnt(0)\n\ts_barrier" ::: "memory"); __builtin_amdgcn_sched_barrier(0); } while (0)
template <bool MLA>
__device__ __forceinline__ void attn_unit_pp(const P& p, LAS unsigned char* lds, int b, int hk, int q0, BgConv& bg) {
    int tid_ = threadIdx.x; asm volatile("" : "+v"(tid_));
    const int tid = tid_, lane = tid & 63, r32 = lane & 31, hi = lane >> 5, wid = __builtin_amdgcn_readfirstlane(tid >> 6);
    const int grp = wid >> 2;
    constexpr int NKS = MLA ? 6 : 4;
    const int head = MLA ? hk : hk * 4 + (wid >> 1);
    const int qw0 = MLA ? q0 + 32 * wid : q0 + 32 * (wid & 1);
    const size_t rb = (size_t)b * SEQ;
    bf16x8 qf[NKS];
    if (MLA) {
        const bf16_t* qn = (const bf16_t*)(p.ws + WS_QN) + (rb + qw0 + r32) * 512 + head * 64 + 8 * hi;
        const bf16_t* qr = (const bf16_t*)(p.ws + WS_QR) + (rb + qw0 + r32) * 256 + head * 32 + 8 * hi;
#pragma unroll
        for (int ks = 0; ks < 4; ++ks) qf[ks] = *(const bf16x8*)(qn + 16 * ks);
#pragma unroll
        for (int ks = 4; ks < NKS; ++ks) qf[ks] = *(const bf16x8*)(qr + 16 * (ks - 4));
    } else {
        const bf16_t* qa = (const bf16_t*)(p.ws + WS_QA) + (rb + qw0 + r32) * 512 + head * 64 + 8 * hi;
#pragma unroll
        for (int ks = 0; ks < NKS; ++ks) qf[ks] = *(const bf16x8*)(qa + 16 * ks);
    }
    const int t_lo = MLA ? 0 : (q0 >= 128 ? (q0 - 128) >> 6 : 0), t_hi = MLA ? ((q0 + 256) >> 6) - 1 : (q0 >> 6);
    const int skey = tid >> 3, sc = tid & 7;
    const bf16_t* kg; const bf16_t* vg; const bf16_t* rg = nullptr;
    if (MLA) { kg = (const bf16_t*)(p.ws + WS_KN) + (rb + skey) * 512 + hk * 64 + 8 * sc; vg = (const bf16_t*)(p.ws + WS_VB) + (rb + skey) * 512 + hk * 64 + 8 * sc;
               rg = (const bf16_t*)(p.ws + WS_KR) + (rb + (tid >> 2)) * 32 + 8 * (tid & 3); }
    else { kg = (const bf16_t*)(p.ws + WS_KA) + (rb + skey) * 128 + hk * 64 + 8 * sc; vg = (const bf16_t*)(p.ws + WS_VA) + (rb + skey) * 128 + hk * 64 + 8 * sc; }
    const int kpitch = MLA ? 512 : 128;
    const int kst = skey * KROW + sc * 16;
    const int rst = (tid >> 2) * KROW + 128 + (tid & 3) * 16;
    const int vst = ((8 * sc) >> 5) * 4096 + (skey >> 4) * 1024 + (skey & 15) * 64 + ((8 * sc) & 31) * 2;
    u32x4 kreg, vreg, rreg = (u32x4){0u, 0u, 0u, 0u};
#define PP_LOAD(t) do { kreg = *(const u32x4*)(kg + (size_t)(t) * 64 * kpitch); vreg = *(const u32x4*)(vg + (size_t)(t) * 64 * kpitch); \
        if (MLA && tid < 256) rreg = *(const u32x4*)(rg + (size_t)(t) * 64 * 32); } while (0)
#define PP_WRITE(kb, vb) do { *(LAS u32x4*)(lds + (kb) + kst) = kreg; *(LAS u32x4*)(lds + PP_OFF_V + (vb) + vst) = vreg; \
        if (MLA && tid < 256) *(LAS u32x4*)(lds + (kb) + rst) = rreg; } while (0)
    LAS float* wsf = (LAS float*)(lds + PP_OFF_WS) + wid * 64;
    float m, l; f32x16 o[2];
#pragma unroll
    for (int r = 0; r < 16; ++r) { o[0][r] = 0.f; o[1][r] = 0.f; }
    float slope2 = 0.f;
    if (MLA) { m = -INFINITY; l = 0.f; }
    else { m = p.sinks[head] * LOG2E; l = hi == 0 ? 1.f : 0.f; slope2 = exp2f(-(float)(head + 1)) * LOG2E; }
    const lds_cptr kp0 = (lds_cptr)lds + r32 * KROW + hi * 16;
    const lds_cptr vp0 = (lds_cptr)lds + PP_OFF_V + ((lane >> 4) & 1) * 32 + (lane & 3) * 8 + (4 * hi + ((lane & 15) >> 2)) * 64;
    int kbP = 2 * KBUF, kbC = 0, kbN = KBUF, vbP = 2 * VBUF, vbC = 0, vbN = VBUF;
    PP_LOAD(t_lo); PP_WRITE(kbC, vbC);
    if (t_lo < t_hi) PP_LOAD(t_lo + 1);
    ATT_PBAR();
    if (grp) ATT_PBAR();
    u32x4 pw[4];
#pragma unroll
    for (int i = 0; i < 4; ++i) pw[i] = (u32x4){0u, 0u, 0u, 0u};
    f32x16 p0, p1;
#pragma unroll
    for (int r = 0; r < 16; ++r) { p0[r] = 0.f; p1[r] = 0.f; }
    bool act_prev = false;
    for (int t = t_lo; t <= t_hi + 1; ++t) {
        const int s0 = t * 64;
        const bool active = t <= t_hi && (MLA ? (s0 <= qw0 + 31) : (s0 <= qw0 + 31 && s0 + 63 >= qw0 - 127));
        __builtin_amdgcn_s_setprio(1);
        if (active) {
#pragma unroll
            for (int r = 0; r < 16; ++r) { p0[r] = 0.f; p1[r] = 0.f; }
            const lds_cptr kp = kp0 + kbC;
            bf16x8 ka[2 * NKS];
#pragma unroll
            for (int ks = 0; ks < NKS; ++ks) { ka[2 * ks] = *(const LAS bf16x8*)(kp + ks * 32); ka[2 * ks + 1] = *(const LAS bf16x8*)(kp + 32 * KROW + ks * 32); }
#pragma unroll
            for (int ks = 0; ks < NKS; ++ks) {
                p0 = __builtin_amdgcn_mfma_f32_32x32x16_bf16(ka[2 * ks], qf[ks], p0, 0, 0, 0);
                p1 = __builtin_amdgcn_mfma_f32_32x32x16_bf16(ka[2 * ks + 1], qf[ks], p1, 0, 0, 0);
            }
            __builtin_amdgcn_sched_group_barrier(0x100, PP_AHEAD, 0);
#pragma unroll
            for (int i = 0; i < 2 * NKS - PP_AHEAD; ++i) { __builtin_amdgcn_sched_group_barrier(0x008, 1, 0); __builtin_amdgcn_sched_group_barrier(0x100, 1, 0); }
            __builtin_amdgcn_sched_group_barrier(0x008, PP_AHEAD, 0);
        }
        __builtin_amdgcn_sched_barrier(0);
        if (act_prev) {
            const lds_cptr vp = vp0 + vbP;
            bf16x8 vf[8];
#pragma unroll
            for (int ks = 0; ks < 4; ++ks)
#pragma unroll
                for (int d0 = 0; d0 < 2; ++d0) {
                    const s16x4 lo = vtr(vp + d0 * 4096 + ks * 1024), hh = vtr(vp + d0 * 4096 + ks * 1024 + 512);
                    vf[2 * ks + d0] = (bf16x8){lo[0], lo[1], lo[2], lo[3], hh[0], hh[1], hh[2], hh[3]};
                }
#pragma unroll
            for (int ks = 0; ks < 4; ++ks) {
                o[0] = __builtin_amdgcn_mfma_f32_32x32x16_bf16(__builtin_bit_cast(bf16x8, pw[ks]), vf[2 * ks], o[0], 0, 0, 0);
                o[1] = __builtin_amdgcn_mfma_f32_32x32x16_bf16(__builtin_bit_cast(bf16x8, pw[ks]), vf[2 * ks + 1], o[1], 0, 0, 0);
            }
            __builtin_amdgcn_sched_group_barrier(0x100, 6, 0);
#pragma unroll
            for (int i = 0; i < 5; ++i) { __builtin_amdgcn_sched_group_barrier(0x008, 1, 0); __builtin_amdgcn_sched_group_barrier(0x100, 2, 0); }
            __builtin_amdgcn_sched_group_barrier(0x008, 3, 0);
        }
        __builtin_amdgcn_sched_barrier(0);
        __builtin_amdgcn_s_setprio(0);
        if (t < t_hi) PP_WRITE(kbN, vbN);
        if (BG_CONV) bg_step_fin(p, bg, lane);
        if (t + 1 < t_hi) PP_LOAD(t + 2);
        if (BG_CONV) bg_step_iss(p, bg, lane);
        ATT_PBAR();
        if (active) {
            const int q = qw0 + r32;
            if (MLA) {
                if (s0 + 63 > qw0) {
#pragma unroll
                    for (int r = 0; r < 16; ++r) { const int key = s0 + crow(r, hi); if (key > q) p0[r] = -INFINITY; if (key + 32 > q) p1[r] = -INFINITY; }
                }
            } else {
#pragma unroll
                for (int r = 0; r < 16; ++r) { const int d0 = q - (s0 + crow(r, hi)), d1 = d0 - 32;
                    p0[r] = (d0 >= 0 && d0 < 128) ? p0[r] - slope2 * (float)d0 : -INFINITY;
                    p1[r] = (d1 >= 0 && d1 < 128) ? p1[r] - slope2 * (float)d1 : -INFINITY; }
            }
            float mxa = fmaxf(p0[0], p1[0]), mxb = fmaxf(p0[1], p1[1]);
#pragma unroll
            for (int r = 2; r < 16; r += 2) { mxa = vmax3(mxa, p0[r], p1[r]); mxb = vmax3(mxb, p0[r + 1], p1[r + 1]); }
            float mx = half_swap_max(fmaxf(mxa, mxb));
            if (__any(mx > m + 8.f)) {
                const float mn = fmaxf(m, mx), alpha = __builtin_amdgcn_exp2f(m - mn);
                m = mn; l *= alpha;
                if (hi == 0) wsf[r32] = alpha;
#pragma unroll
                for (int r = 0; r < 16; ++r) { const float a = wsf[crow(r, hi)]; o[0][r] *= a; o[1][r] *= a; }
            }
#pragma unroll
            for (int r = 0; r < 16; ++r) { p0[r] -= m; p1[r] -= m; }
            __builtin_amdgcn_sched_barrier(0);
#pragma unroll
            for (int r = 0; r < 16; ++r) { p0[r] = __builtin_amdgcn_exp2f(p0[r]); p1[r] = __builtin_amdgcn_exp2f(p1[r]); }
            __builtin_amdgcn_sched_barrier(0);
            { typedef float f32x2 __attribute__((ext_vector_type(2)));
              f32x2 sa = (f32x2){p0[0], p0[1]} + (f32x2){p1[0], p1[1]}, sb = (f32x2){p0[2], p0[3]} + (f32x2){p1[2], p1[3]};
#pragma unroll
              for (int r = 4; r < 16; r += 4) { sa += (f32x2){p0[r], p0[r + 1]} + (f32x2){p1[r], p1[r + 1]}; sb += (f32x2){p0[r + 2], p0[r + 3]} + (f32x2){p1[r + 2], p1[r + 3]}; }
              sa += sb; l += sa[0] + sa[1]; }
#pragma unroll
            for (int i = 0; i < 4; ++i) { pw[0][i] = pg8::cvt_pk_bf16(p0[2 * i], p0[2 * i + 1]); pw[1][i] = pg8::cvt_pk_bf16(p0[8 + 2 * i], p0[8 + 2 * i + 1]);
                                          pw[2][i] = pg8::cvt_pk_bf16(p1[2 * i], p1[2 * i + 1]); pw[3][i] = pg8::cvt_pk_bf16(p1[8 + 2 * i], p1[8 + 2 * i + 1]); }
        }
        act_prev = active;
        ATT_PBAR();
        { const int tk = kbP; kbP = kbC; kbC = kbN; kbN = tk; const int tv = vbP; vbP = vbC; vbC = vbN; vbN = tv; }
    }
    if (!grp) ATT_PBAR();
    l = half_swap_sum(l);
    if (hi == 0) wsf[32 + r32] = 1.f / l;
    bf16_t* Ob = (bf16_t*)(p.ws + WS_AO) + (rb + qw0) * 1024 + (MLA ? 512 : 0) + head * 64 + r32;
#pragma unroll
    for (int r = 0; r < 16; ++r) { const int qr = crow(r, hi); const float rl = wsf[32 + qr];
        Ob[(size_t)qr * 1024] = (bf16_t)f2bf(o[0][r] * rl); Ob[(size_t)qr * 1024 + 32] = (bf16_t)f2bf(o[1][r] * rl); }
#undef PP_LOAD
#undef PP_WRITE
}
}
__device__ __forceinline__ void ph_attn2(const P& p, unsigned char* lds_) {
    LAS unsigned char* lds = (LAS unsigned char*)lds_;
    const int G = gridDim.x, bx = blockIdx.x;
    const int vcu = (G % 8 == 0) ? (bx % 8) * (G / 8) + bx / 8 : bx;
    const int lane_ = threadIdx.x & 63, wave_ = threadIdx.x >> 6;
    BgConv bg; bg.item = bx * 8 + wave_; bg.it = 0; bg.ngw = G * 8; bg.pend = false;
#pragma unroll
    for (int i = 0; i < 32; ++i) bg.r[i] = 0.f;
    float* bgscr = (float*)(lds_ + att::BG_SCR_OFF + wave_ * 8704);
    for (int pi = vcu; pi < 256; pi += G) {
        const int bh = pi >> 4, sidx = pi & 15;
        att::attn_unit_pp<true>(p, lds, bh >> 3, bh & 7, (31 - sidx) * 256, bg);
        att::attn_unit_pp<true>(p, lds, bh >> 3, bh & 7, sidx * 256, bg);
    }
    for (int u = vcu; u < 512; u += G) {
        const int bk = u >> 7, qb = u & 127;
        att::attn_unit_pp<false>(p, lds, bk >> 1, bk & 1, qb * 64, bg);
    }
    if (BG_CONV) bg_drain(p, bg, bgscr, lane_);
}

#define XB_TMO      128
#define XB_XCNT(j)  (256  + 64 * (j))
#define XB_XSUB(j)  (1280 + 64 * (j))
#define XB_XGEN(j)  (2304 + 64 * (j))
#define XB_TOP      3328
#define XB_TOPGEN   3392
#define XCD_BAR_WORDS 3456
#define XB_SPIN_CAP (1u << 18)
__device__ __forceinline__ unsigned xb_ld(unsigned* p)              { return __hip_atomic_load(p, __ATOMIC_RELAXED, __HIP_MEMORY_SCOPE_AGENT); }
__device__ __forceinline__ unsigned xb_add(unsigned* p, unsigned v) { return __hip_atomic_fetch_add(p, v, __ATOMIC_RELAXED, __HIP_MEMORY_SCOPE_AGENT); }
__device__ __forceinline__ unsigned xb_xcc_id() { return (unsigned)__builtin_amdgcn_s_getreg((3 << 11) | 20) & 0xFu; }
#define XB_SPIN(cond, bar) do { unsigned _sp = 0; while (cond) { __builtin_amdgcn_s_sleep(1); \
    if ((++_sp & 255u) == 0u) { if (xb_ld(&(bar)[XB_TMO])) break; if (_sp > XB_SPIN_CAP) { atomicAdd(&(bar)[XB_TMO], 1u); break; } } } } while (0)
struct XcdBarrier { unsigned* bar; unsigned x; volatile LAS unsigned* st; };
__device__ __forceinline__ XcdBarrier xcd_barrier_post(unsigned* bar, volatile LAS unsigned* st) {
    XcdBarrier b; b.bar = bar; b.x = xb_xcc_id(); b.st = st;
    if (threadIdx.x == 0) (void)xb_add(&bar[XB_XCNT(b.x)], 1u);
    return b;
}
__device__ __forceinline__ void xcd_barrier_complete(unsigned* bar, unsigned x, unsigned& nloc, unsigned& nx) {
    const unsigned G = gridDim.x * gridDim.y * gridDim.z;
    unsigned sum, cnt, mine, sp = 0u;
    for (;;) {
        sum = 0u; cnt = 0u; mine = 0u;
#pragma unroll
        for (unsigned j = 0; j < 16; ++j) { const unsigned c = xb_ld(&bar[XB_XCNT(j)]); sum += c; cnt += (c > 0u) ? 1u : 0u; mine = (j == x) ? c : mine; }
        if (sum == G) break;
        __builtin_amdgcn_s_sleep(1);
        if ((++sp & 255u) == 0u) { if (xb_ld(&bar[XB_TMO])) break; if (sp > XB_SPIN_CAP) { atomicAdd(&bar[XB_TMO], 1u); break; } }
    }
    nloc = mine > 0u ? mine : 1u; nx = cnt > 0u ? cnt : 1u;
}
__device__ __forceinline__ void xcd_barrier(const XcdBarrier& b) {
    asm volatile("s_waitcnt vmcnt(0)" ::: "memory");
    __syncthreads();
    if (threadIdx.x == 0) {
        unsigned* bar = b.bar;
        __builtin_amdgcn_s_waitcnt(0);
        unsigned nloc = b.st[0], nx = b.st[1];
        if (nloc == 0u) { xcd_barrier_complete(bar, b.x, nloc, nx); b.st[0] = nloc; b.st[1] = nx; }
        const unsigned old = xb_add(&bar[XB_XSUB(b.x)], 1u);
        const unsigned gen = old / nloc;
        if (old + 1u == (gen + 1u) * nloc) {
            __builtin_amdgcn_fence(__ATOMIC_RELEASE, "agent");
            asm volatile("s_waitcnt vmcnt(0)" ::: "memory");
            const unsigned og = xb_add(&bar[XB_TOP], 1u);
            const unsigned tg = og / nx;
            if (og + 1u == (tg + 1u) * nx) xb_add(&bar[XB_TOPGEN], 1u);
            else XB_SPIN(xb_ld(&bar[XB_TOPGEN]) == tg, bar);
            __builtin_amdgcn_fence(__ATOMIC_ACQUIRE, "agent");
            xb_add(&bar[XB_XGEN(b.x)], 1u);
            asm volatile("s_waitcnt vmcnt(0)" ::: "memory");
        } else {
            XB_SPIN(xb_ld(&bar[XB_XGEN(b.x)]) == gen, bar);
            __builtin_amdgcn_fence(__ATOMIC_ACQUIRE, "agent");
            asm volatile("s_waitcnt vmcnt(0)" ::: "memory");
        }
    }
    __syncthreads();
}
constexpr int LDSCTL_OFF = 139264;
constexpr int CW_BAR = 4096;
constexpr size_t CTL_ZERO_BYTES = 65536;

__global__ void __launch_bounds__(NTHREADS, 2) mega_fwd(P p) {
    extern __shared__ __attribute__((aligned(16))) unsigned char lds[];
    if (threadIdx.x < 32) ((LAS unsigned*)((LAS unsigned char*)lds + LDSCTL_OFF))[threadIdx.x] = 0u;
    __syncthreads();
    const XcdBarrier bar = xcd_barrier_post((unsigned*)(p.ws + WS_CTL) + CW_BAR, (volatile LAS unsigned*)((LAS unsigned char*)lds + LDSCTL_OFF));
#ifndef PH_MASK
#define PH_MASK 0xFFFF
#endif
#ifndef PH_DUP
#define PH_DUP 0
#endif
#define RUN_PH(bit, call) do { if (PH_MASK & (bit)) { call; if (PH_DUP & (bit)) { __syncthreads(); call; } } } while (0)
#define GSYNC() do { xcd_barrier(bar); if (PH_DUP & 0x10000) xcd_barrier(bar); } while (0)
    RUN_PH(1, (ph_mod(p, lds), ph_convert(p, lds)));
    GSYNC();
    RUN_PH(2, ph_xn(p));
    GSYNC();
    RUN_PH(4, ph_proj2(p, lds));
    GSYNC();
    RUN_PH(16, ph_up2(p, lds));
    GSYNC();
    RUN_PH(32, ph_attn2(p, lds));
    GSYNC();
    RUN_PH(64, ph_mix2(p, lds));
    GSYNC();
    RUN_PH(128, ph_out2(p, lds));
    GSYNC();
    if (PH_DUP & 256) { ph_route(p, lds, false); __syncthreads(); }
    if (PH_MASK & 256) ph_route(p, lds, true);
    GSYNC();
    RUN_PH(512, ph_moe1_2(p, lds));
    GSYNC();
    RUN_PH(1024, ph_moe2_2(p, lds));
    GSYNC();
    RUN_PH(2048, ph_final(p));
}

extern "C" void kernel_launch(void* const* d_in, const int* in_sizes, int n_in, void* d_out, int out_size, void* d_ws, size_t ws_size, hipStream_t stream) {
    static int grid_blocks = 0;
    if (!grid_blocks) {
        int dev = 0, cus = 0, per_cu = 0;
        (void)hipGetDevice(&dev);
        (void)hipDeviceGetAttribute(&cus, hipDeviceAttributeMultiprocessorCount, dev);
        (void)hipFuncSetAttribute((const void*)mega_fwd, hipFuncAttributeMaxDynamicSharedMemorySize, LDS_BYTES);
        (void)hipOccupancyMaxActiveBlocksPerMultiprocessor(&per_cu, (const void*)mega_fwd, NTHREADS, LDS_BYTES);
        if (per_cu < 1) per_cu = 1;
        grid_blocks = cus * per_cu;
        if (grid_blocks > 256) grid_blocks = 256;
        if (grid_blocks < 256 || MTOK % grid_blocks != 0) { fprintf(stderr, "kernel_launch: grid %d unsupported (needs >= 256 workgroups dividing %d)\n", grid_blocks, MTOK); grid_blocks = -1; }
        else if (ws_size < WS_END || n_in != 24) { fprintf(stderr, "kernel_launch: ws %zu < %zu or n_in %d != 24\n", ws_size, (size_t)WS_END, n_in); grid_blocks = -1; }
    }
    if (grid_blocks < 0) return;
    P p{};
    p.x = (const float*)d_in[0]; p.c = (const float*)d_in[1]; p.pos = (const int*)d_in[2]; p.w_ada = (const float*)d_in[3]; p.b_ada = (const float*)d_in[4];
    p.norm_mix = (const float*)d_in[5]; p.norm_ffn = (const float*)d_in[6]; p.w_in = (const float*)d_in[7]; p.sinks = (const float*)d_in[8];
    p.q_norm = (const float*)d_in[9]; p.kv_norm = (const float*)d_in[10]; p.w_uq = (const float*)d_in[11]; p.w_uk = (const float*)d_in[12]; p.w_uv = (const float*)d_in[13];
    p.w_a = (const float*)d_in[14]; p.w_b = (const float*)d_in[15]; p.w_out = (const float*)d_in[16]; p.w_router = (const float*)d_in[17]; p.b_router = (const float*)d_in[18];
    p.w_m1 = (const float*)d_in[19]; p.b_m1 = (const float*)d_in[20]; p.w_m2 = (const float*)d_in[21]; p.b_m2 = (const float*)d_in[22]; p.fnorm = (const float*)d_in[23];
    p.out = (float*)d_out; p.ws = (unsigned char*)d_ws;
    if (hipMemsetAsync((char*)d_ws + WS_CTL, 0, CTL_ZERO_BYTES, stream) != hipSuccess) { fprintf(stderr, "kernel_launch: memset failed\n"); return; }
    hipLaunchKernelGGL(mega_fwd, dim3(grid_blocks), dim3(NTHREADS), LDS_BYTES, stream, p);
    const hipError_t e = hipPeekAtLastError();
    if (e != hipSuccess) fprintf(stderr, "launch failed: %s (grid %d)\n", hipGetErrorString(e), grid_blocks);
}
```

```cpp
#include <hip/hip_runtime.h>
#include <cstdio>
#include <cstdint>

typedef unsigned short bf16_t;
typedef short bf16x8 __attribute__((ext_vector_type(8)));
typedef float f32x4 __attribute__((ext_vector_type(4)));
typedef unsigned u32x4 __attribute__((ext_vector_type(4)));
typedef unsigned u32x2 __attribute__((ext_vector_type(2)));

constexpr int NTHREADS = 512;
constexpr int LDS_BYTES = 147456;
constexpr int BATCH = 2, SEQ = 8192, DM = 1024, MTOK = BATCH * SEQ;
constexpr int NEXP = 32, LISTCAP = 16384;
constexpr float EPS = 1e-6f;
constexpr float LOG2E = 1.4426950408889634f;

constexpr size_t MiB = 1u << 20;
constexpr size_t WS_CTL = 0;
constexpr size_t WS_MOD = 1 * MiB;
constexpr size_t WS_WT_IN = 2 * MiB;
constexpr size_t WS_WT_UQ = 9 * MiB;
constexpr size_t WS_WT_UKV = 10 * MiB;
constexpr size_t WS_WT_A = 11 * MiB;
constexpr size_t WS_WT_B = 12 * MiB;
constexpr size_t WS_WT_OUT = 13 * MiB;
constexpr size_t WS_WRT = 1 * MiB + 524288;
constexpr size_t WS_COS = 15 * MiB;
constexpr size_t WS_SIN = 16 * MiB;
constexpr size_t WS_SSQ = 17 * MiB;
constexpr size_t WS_LIST = 18 * MiB;
constexpr size_t WS_TOPW = 1835008;
constexpr size_t WS_LISTW = 809 * MiB;
constexpr size_t WS_WT_M1 = 20 * MiB;
constexpr size_t WS_WT_M2 = 148 * MiB;
constexpr size_t WS_XN = 212 * MiB;
constexpr size_t WS_QA = 244 * MiB;
constexpr size_t WS_KA = 260 * MiB;
constexpr size_t WS_VA = 264 * MiB;
constexpr size_t WS_CQ = 268 * MiB;
constexpr size_t WS_CKV = 280 * MiB;
constexpr size_t WS_KR = 288 * MiB;
constexpr size_t WS_GA = 289 * MiB;
constexpr size_t WS_GB = 321 * MiB;
constexpr size_t WS_QN = 353 * MiB;
constexpr size_t WS_QR = 369 * MiB;
constexpr size_t WS_KN = 377 * MiB;
constexpr size_t WS_VB = 393 * MiB;
constexpr size_t WS_AO = 409 * MiB;
constexpr size_t WS_BO = 425 * MiB;
constexpr size_t WS_MIX = 441 * MiB;
constexpr size_t WS_X1 = 473 * MiB;
constexpr size_t WS_HID = 537 * MiB;
constexpr size_t WS_Y = 681 * MiB;
constexpr size_t WS_XN8 = 811 * MiB;
constexpr size_t WS_WT_G8 = 827 * MiB;
constexpr size_t WS_END = 829 * MiB;

struct P {
    const float *x, *c; const int* pos;
    const float *w_ada, *b_ada, *norm_mix, *norm_ffn, *w_in, *sinks, *q_norm, *kv_norm, *w_uq, *w_uk, *w_uv, *w_a, *w_b, *w_out,
        *w_router, *b_router, *w_m1, *b_m1, *w_m2, *b_m2, *fnorm;
    float* out; unsigned char* ws;
};

__device__ __forceinline__ unsigned f2bf(float f) { unsigned u = __float_as_uint(f); return (u + 0x7fffu + ((u >> 16) & 1u)) >> 16; }
__device__ __forceinline__ unsigned pk2(float lo, float hi) { return f2bf(lo) | (f2bf(hi) << 16); }
__device__ __forceinline__ float bf2f(unsigned h) { return __uint_as_float(h << 16); }
__device__ __forceinline__ unsigned pk4_fp8(float a, float b, float c, float d) { int r = __builtin_amdgcn_cvt_pk_fp8_f32(a, b, 0, false); r = __builtin_amdgcn_cvt_pk_fp8_f32(c, d, r, true); return (unsigned)r; }
constexpr float W8_SCALE = 32.f, W8_INV = 0.03125f;
constexpr float MIX8_SCALE = 8.f, OUT8_INV = 1.f / (8.f * 32.f);
__device__ __forceinline__ float wave_sum(float v) {
#pragma unroll
    for (int o = 1; o < 64; o <<= 1) v += __shfl_xor(v, o);
    return v;
}
__device__ __forceinline__ float sigmoidf_(float v) { return __builtin_amdgcn_rcpf(1.f + __builtin_amdgcn_exp2f(-LOG2E * v)); }

__device__ __forceinline__ void ph_mod(const P& p, unsigned char* lds) {
    const int tid = threadIdx.x, lane = tid & 63, wave = tid >> 6;
    float* red = (float*)lds;
    float* mod = (float*)(p.ws + WS_MOD);
    for (int item = blockIdx.x; item < 192; item += gridDim.x) {
        const int n0 = item * 32, cn = lane & 31, kq = lane >> 5;
        float a0 = 0.f, a1 = 0.f;
#pragma unroll 1
        for (int i0 = 0; i0 < 64; i0 += 16) {
            float wv[16];
#pragma unroll
            for (int i = 0; i < 16; ++i) wv[i] = __builtin_nontemporal_load(p.w_ada + (size_t)(wave * 128 + 2 * (i0 + i) + kq) * 6144 + n0 + cn);
#pragma unroll
            for (int i = 0; i < 16; ++i) { const int k = wave * 128 + 2 * (i0 + i) + kq; const float c0 = p.c[k], c1 = p.c[1024 + k];
                a0 += c0 * sigmoidf_(c0) * wv[i]; a1 += c1 * sigmoidf_(c1) * wv[i]; }
        }
        a0 += __shfl_xor(a0, 32); a1 += __shfl_xor(a1, 32);
        if (lane < 32) { red[(wave * 2 + 0) * 32 + cn] = a0; red[(wave * 2 + 1) * 32 + cn] = a1; }
        __syncthreads();
        if (tid < 64) { const int b = tid >> 5, cc = tid & 31; float s = 0.f;
            for (int w = 0; w < 8; ++w) s += red[(w * 2 + b) * 32 + cc];
            mod[b * 6144 + n0 + cc] = s + p.b_ada[n0 + cc]; }
        __syncthreads();
    }
}
__device__ __forceinline__ int ropeperm(int d) { return d < 16 ? 8 * (d >> 2) + (d & 3) : 8 * ((d - 16) >> 2) + 4 + (d & 3); }
__device__ __forceinline__ void transpose_item(const float* W, int N, int K, bf16_t* WT, int k0, int n0, int dst_row0, const float* kscale, float* scr, int lane, bool rperm = false) {
    float tv[32];
#pragma unroll
    for (int i = 0; i < 32; ++i) tv[i] = W[(size_t)(k0 + 2 * i + (lane >> 5)) * N + n0 + (lane & 31)];
#pragma unroll
    for (int i = 0; i < 32; ++i) { const int kk = 2 * i + (lane >> 5); float v = tv[i]; if (kscale) v *= kscale[k0 + kk]; scr[kk * 33 + (lane & 31)] = v; }
    __builtin_amdgcn_s_waitcnt(0); __builtin_amdgcn_wave_barrier();
    const int c = lane & 7;
#pragma unroll
    for (int j = 0; j < 4; ++j) { const int n = (lane >> 3) + 8 * j; const float* s = scr + (8 * c) * 33 + n;
        u32x4 o; o.x = pk2(s[0 * 33], s[1 * 33]); o.y = pk2(s[2 * 33], s[3 * 33]); o.z = pk2(s[4 * 33], s[5 * 33]); o.w = pk2(s[6 * 33], s[7 * 33]);
        *(u32x4*)(WT + (size_t)(dst_row0 + (rperm ? ropeperm(n) : n)) * K + k0 + 8 * c) = o; }
    __builtin_amdgcn_s_waitcnt(0); __builtin_amdgcn_wave_barrier();
}
__device__ __forceinline__ void transpose_item_fp8(const float* W, int N, int K, unsigned char* WT, int k0, int n0, int dst_row0, float* scr, int lane) {
    float tv[32];
#pragma unroll
    for (int i = 0; i < 32; ++i) tv[i] = W[(size_t)(k0 + 2 * i + (lane >> 5)) * N + n0 + (lane & 31)];
#pragma unroll
    for (int i = 0; i < 32; ++i) { const int kk = 2 * i + (lane >> 5); scr[kk * 33 + (lane & 31)] = tv[i] * W8_SCALE; }
    __builtin_amdgcn_s_waitcnt(0); __builtin_amdgcn_wave_barrier();
    const int c = lane & 3;
#pragma unroll
    for (int j = 0; j < 2; ++j) { const int n = (lane >> 2) + 16 * j; const float* sp = scr + (16 * c) * 33 + n;
        u32x4 o; o.x = pk4_fp8(sp[0 * 33], sp[1 * 33], sp[2 * 33], sp[3 * 33]); o.y = pk4_fp8(sp[4 * 33], sp[5 * 33], sp[6 * 33], sp[7 * 33]);
        o.z = pk4_fp8(sp[8 * 33], sp[9 * 33], sp[10 * 33], sp[11 * 33]); o.w = pk4_fp8(sp[12 * 33], sp[13 * 33], sp[14 * 33], sp[15 * 33]);
        *(u32x4*)(WT + (size_t)(dst_row0 + n) * K + k0 + 16 * c) = o; }
    __builtin_amdgcn_s_waitcnt(0); __builtin_amdgcn_wave_barrier();
}
__device__ __forceinline__ int in_colmap(int s) {
    if (s < 768) return s;
    if (s < 1152) return 1024 + (s - 768);
    if (s < 1408) return 768 + (s - 1152);
    if (s < 1440) return s;
    if (s < 2464) return 1536 + (s - 1440);
    return 2560 + (s - 2464);
}
#ifndef BG_CONV
#define BG_CONV 1
#endif
constexpr int BG_I_M1 = 32 * 16 * 64, BG_I_M2 = 32 * 16 * 32, BG_TOTAL = BG_I_M1 + BG_I_M2;
struct BgConv { float r[32]; int item, it, ngw; bool pend; };
__device__ __forceinline__ void bg_decode(const P& p, int item, const float*& W, int& N, unsigned char*& WT, int& k0, int& n0, int& dst) {
    if (item < BG_I_M1) { const int e = item >> 10, q = item & 1023, kb = q >> 6, nb = q & 63; n0 = nb * 32; const int j = n0 & 1023, lin = n0 >> 10;
        dst = (j >> 7) * 256 + lin * 128 + (j & 127); W = p.w_m1 + (size_t)e * 1024 * 2048; N = 2048; WT = p.ws + WS_WT_M1 + (size_t)e * 2048 * 1024; k0 = kb * 64; }
    else { const int r = item - BG_I_M1, e = r >> 9, q = r & 511, kb = q >> 5, nb = q & 31; n0 = nb * 32; dst = n0;
        W = p.w_m2 + (size_t)e * 1024 * 1024; N = 1024; WT = p.ws + WS_WT_M2 + (size_t)e * 1024 * 1024; k0 = kb * 64; }
}
__device__ __forceinline__ void bg_issue(const P& p, BgConv& g, int lane) {
    const float* W; int N, k0, n0, dst; unsigned char* WT; bg_decode(p, g.item, W, N, WT, k0, n0, dst);
    const float* src = W + (size_t)(k0 + (lane >> 5)) * N + n0 + (lane & 31);
#pragma unroll
    for (int i = 0; i < 32; ++i) g.r[i] = __builtin_nontemporal_load(src + (size_t)(2 * i) * N);
}
__device__ __forceinline__ void bg_finish(const P& p, BgConv& g, float* scr, int lane) {
    const float* W; int N, k0, n0, dst; unsigned char* WT; bg_decode(p, g.item, W, N, WT, k0, n0, dst);
    unsigned w[8];
#pragma unroll
    for (int i = 0; i < 16; i += 2) {
        const auto s0 = __builtin_amdgcn_permlane32_swap(__float_as_uint(g.r[i] * W8_SCALE), __float_as_uint(g.r[i + 16] * W8_SCALE), false, false);
        const auto s1 = __builtin_amdgcn_permlane32_swap(__float_as_uint(g.r[i + 1] * W8_SCALE), __float_as_uint(g.r[i + 17] * W8_SCALE), false, false);
        w[i >> 1] = pk4_fp8(__uint_as_float(s0[0]), __uint_as_float(s0[1]), __uint_as_float(s1[0]), __uint_as_float(s1[1]));
    }
    unsigned char* o = WT + (size_t)(dst + (lane & 31)) * 1024 + k0 + 32 * (lane >> 5);
    __builtin_nontemporal_store((u32x4){w[0], w[1], w[2], w[3]}, (u32x4*)o); __builtin_nontemporal_store((u32x4){w[4], w[5], w[6], w[7]}, (u32x4*)(o + 16));
}
__device__ __forceinline__ void bg_step(const P& p, BgConv& g, float* scr, int lane) {
    if ((g.it & 3) == 2 && g.pend) { bg_finish(p, g, scr, lane); g.item += g.ngw; g.pend = false; }
    if ((g.it & 3) == 0 && g.item < BG_TOTAL) { bg_issue(p, g, lane); g.pend = true; }
    ++g.it;
}
__device__ __forceinline__ void bg_step_fin(const P& p, BgConv& g, int lane) { if ((g.it & 3) == 2 && g.pend) { bg_finish(p, g, nullptr, lane); g.item += g.ngw; g.pend = false; } }
__device__ __forceinline__ void bg_step_iss(const P& p, BgConv& g, int lane) { if ((g.it & 3) == 0 && g.item < BG_TOTAL) { bg_issue(p, g, lane); g.pend = true; } ++g.it; }
__device__ __forceinline__ void bg_drain(const P& p, BgConv& g, float* scr, int lane) {
    if (g.pend) { bg_finish(p, g, scr, lane); g.item += g.ngw; g.pend = false; }
    while (g.item < BG_TOTAL) { bg_issue(p, g, lane); bg_finish(p, g, scr, lane); g.item += g.ngw; }
}
__device__ __forceinline__ void ph_convert(const P& p, unsigned char* lds) {
    const int tid = threadIdx.x, lane = tid & 63, wave = tid >> 6;
    const int gw = blockIdx.x * 8 + wave, NGW = gridDim.x * 8;
    float* scr = (float*)(lds + wave * 8704);
    bf16_t* WT_IN = (bf16_t*)(p.ws + WS_WT_IN); bf16_t* WT_UQ = (bf16_t*)(p.ws + WS_WT_UQ); bf16_t* WT_UKV = (bf16_t*)(p.ws + WS_WT_UKV);
    bf16_t* WT_A = (bf16_t*)(p.ws + WS_WT_A); bf16_t* WT_B = (bf16_t*)(p.ws + WS_WT_B); bf16_t* WT_OUT = (bf16_t*)(p.ws + WS_WT_OUT);
    bf16_t* WT_M1 = (bf16_t*)(p.ws + WS_WT_M1); bf16_t* WT_M2 = (bf16_t*)(p.ws + WS_WT_M2);
    constexpr int I_IN = 16 * 109, I_UQ = 6 * 24, I_UK = 4 * 16, I_A = 8 * 32, I_OUT = 16 * 32, I_M1 = 32 * 16 * 64, I_M2 = 32 * 16 * 32;
    constexpr int TOTAL = I_IN + I_UQ + 2 * I_UK + 2 * I_A + I_OUT + (BG_CONV ? 0 : I_M1 + I_M2);
    for (int it = gw; it < TOTAL; it += NGW) {
        int r = it;
        if (r < I_IN) { const int kb = r / 109, nb = r % 109;
            if (nb * 32 < 1440) transpose_item(p.w_in, 3488, 1024, WT_IN, kb * 64, nb * 32, in_colmap(nb * 32), nullptr, scr, lane, nb * 32 == 1408);
            else transpose_item_fp8(p.w_in, 3488, 1024, p.ws + WS_WT_G8, kb * 64, nb * 32, nb * 32 - 1440, scr, lane);
            continue; } r -= I_IN;
        if (r < I_UQ) { const int kb = r / 24, nb = r % 24; const int n0 = nb * 32, hh = n0 / 96, d = n0 % 96;
            const int dst = d < 64 ? hh * 64 + d : 512 + hh * 32; transpose_item(p.w_uq, 768, 384, WT_UQ, kb * 64, n0, dst, p.q_norm, scr, lane, d >= 64); continue; } r -= I_UQ;
        if (r < I_UK) { const int kb = r / 16, nb = r % 16; transpose_item(p.w_uk, 512, 256, WT_UKV, kb * 64, nb * 32, nb * 32, p.kv_norm, scr, lane); continue; } r -= I_UK;
        if (r < I_UK) { const int kb = r / 16, nb = r % 16; transpose_item(p.w_uv, 512, 256, WT_UKV, kb * 64, nb * 32, 512 + nb * 32, p.kv_norm, scr, lane); continue; } r -= I_UK;
        if (r < I_A) { const int kb = r / 32, nb = r % 32; transpose_item(p.w_a, 1024, 1024, WT_A, kb * 64, nb * 32, nb * 32, nullptr, scr, lane); continue; } r -= I_A;
        if (r < I_A) { const int kb = r / 32, nb = r % 32; transpose_item(p.w_b, 1024, 1024, WT_A + 512, kb * 64, nb * 32, nb * 32, nullptr, scr, lane); continue; } r -= I_A;
        if (r < I_OUT) { const int kb = r / 32, nb = r % 32; transpose_item_fp8(p.w_out, 1024, 1024, (unsigned char*)WT_OUT, kb * 64, nb * 32, nb * 32, scr, lane); continue; } r -= I_OUT;
        if (r < I_M1) { const int e = r / 1024, q = r % 1024, kb = q / 64, nb = q % 64; const int n0 = nb * 32, j = n0 & 1023, lin = n0 >> 10;
            const int dst = (j >> 7) * 256 + lin * 128 + (j & 127);
            transpose_item_fp8(p.w_m1 + (size_t)e * 1024 * 2048, 2048, 1024, (unsigned char*)WT_M1 + (size_t)e * 2048 * 1024, kb * 64, n0, dst, scr, lane); continue; } r -= I_M1;
        { const int e = r / 512, q = r % 512, kb = q / 32, nb = q % 32;
            transpose_item_fp8(p.w_m2 + (size_t)e * 1024 * 1024, 1024, 1024, (unsigned char*)WT_M2 + (size_t)e * 1024 * 1024, kb * 64, nb * 32, nb * 32, scr, lane); }
    }
    for (int i = blockIdx.x * NTHREADS + tid; i < 1024 * 32; i += gridDim.x * NTHREADS) { const int k = i >> 5, e = i & 31; ((float*)(p.ws + WS_WRT))[e * 1028 + k] = p.w_router[i]; }
    for (int i = blockIdx.x * NTHREADS + tid; i < 96 * 128; i += gridDim.x * NTHREADS) ((u32x4*)(WT_IN + (size_t)1440 * 1024))[i] = (u32x4){0u, 0u, 0u, 0u};
}

__device__ __forceinline__ void ph_xn(const P& p) {
    const int tid = threadIdx.x, lane = tid & 63, wave = tid >> 6;
    const int gw = blockIdx.x * 8 + wave, NGW = gridDim.x * 8;
    const float* mod = (const float*)(p.ws + WS_MOD);
    bf16_t* XN = (bf16_t*)(p.ws + WS_XN); float* COS = (float*)(p.ws + WS_COS); float* SIN = (float*)(p.ws + WS_SIN);
    for (int m = gw; m < MTOK; m += NGW) {
        const int b = m >> 13;
        const f32x4* xr = (const f32x4*)(p.x + (size_t)m * DM);
        f32x4 v[4]; float s = 0.f;
#pragma unroll
        for (int j = 0; j < 4; ++j) { v[j] = xr[lane + 64 * j]; s += v[j].x * v[j].x + v[j].y * v[j].y + v[j].z * v[j].z + v[j].w * v[j].w; }
        s = wave_sum(s);
        const float rstd = rsqrtf(s * (1.f / DM) + EPS);
#pragma unroll
        for (int j = 0; j < 4; ++j) { const int col = 4 * lane + 256 * j;
            const f32x4 g = *(const f32x4*)(p.norm_mix + col), sc = *(const f32x4*)(mod + b * 6144 + 1024 + col), sh = *(const f32x4*)(mod + b * 6144 + col);
            const f32x4 h = v[j] * rstd * g * (sc + 1.0f) + sh;
            u32x2 o; o.x = pk2(h.x, h.y); o.y = pk2(h.z, h.w); *(u32x2*)(XN + (size_t)m * DM + col) = o;
            *(unsigned*)(p.ws + WS_XN8 + (size_t)m * DM + col) = pk4_fp8(h.x, h.y, h.z, h.w); }
        if (lane < 16) {
            const float freq = exp2f(-(float)lane * 0.8304820237218406f);
            const float ang = (float)p.pos[m] * freq;
            double t = (double)ang * 0.15915494309189535; t -= rint(t);
            const float fr = (float)t;
            COS[m * 16 + lane] = __builtin_amdgcn_cosf(fr); SIN[m * 16 + lane] = __builtin_amdgcn_sinf(fr);
        }
    }
}

namespace pg8 {
#define PG8_LAS __attribute__((address_space(3)))
constexpr int BM = 256, BK = 64, HALF = 128, HTB = HALF * BK * 2, STAGE_BYTES = 8 * HTB, NXCD = 8, WGM = 8;
__device__ __forceinline__ int lds_byte(int r, int c) { const int st = (r >> 4) * 2 + (c >> 5), rr = r & 15, cc = c & 31, ob = rr * 64 + cc * 2; return st * 1024 + (ob ^ (((ob >> 9) & 1) << 5)); }
__device__ __forceinline__ void stage_rc(int b, int& R, int& C) { const int st = b / 1024, sb = b % 1024, swz = sb ^ (((sb >> 9) & 1) << 5); R = (st >> 1) * 16 + swz / 64; C = (st & 1) * 32 + (swz % 64) / 2; }
__device__ __forceinline__ int perm32(int rho) { const int n = rho >> 4, i = rho & 15; return 8 * (i >> 2) + 4 * n + (i & 3); }
struct GUnit { const char* a; const char* b; int pm, pn, e, cnt, tile, pad_; };
typedef float f32x2_t __attribute__((ext_vector_type(2))); typedef __bf16 bf16x2_t __attribute__((ext_vector_type(2)));
__device__ __forceinline__ unsigned cvt_pk_bf16(float lo, float hi) { f32x2_t v = {lo, hi}; bf16x2_t b = __builtin_convertvector(v, bf16x2_t); return __builtin_bit_cast(unsigned, b); }

struct DenseOrder {
    const char* A; const char* Bt; int K, nM, nN, nwg, G, c;
    __device__ void init(const void* A_, const void* Bt_, int M, int N, int K_, int G_, int c_) { A = (const char*)A_; Bt = (const char*)Bt_; K = K_; nM = M / BM; nN = N / BM; nwg = nM * nN; G = G_; c = c_; }
    __device__ bool next(int i, GUnit& u) const {
        const long L = (long)i * G + c; if (L >= nwg) return false;
        int wgid = (int)L; { const int q = nwg / NXCD, r = nwg % NXCD, xcd = wgid % NXCD, off = wgid / NXCD; wgid = (xcd < r ? xcd * (q + 1) : r * (q + 1) + (xcd - r) * q) + off; }
        const int nig = WGM * nN, gid = wgid / nig, fm = gid * WGM, gsz = (nM - fm) < WGM ? (nM - fm) : WGM;
        u.pm = fm + ((wgid % nig) % gsz); u.pn = (wgid % nig) / gsz; u.e = 0; u.cnt = 0; u.tile = 0; u.pad_ = 0;
        u.a = A + (size_t)u.pm * BM * K * 2; u.b = Bt + (size_t)u.pn * BM * K * 2; return true;
    }
    __device__ __forceinline__ unsigned a_rowoff(const GUnit&, int) const { return 0u; }
};

typedef int v8i32 __attribute__((ext_vector_type(8)));
typedef int v4i32 __attribute__((ext_vector_type(4)));
template <class Epi, class Sched, bool ALIGN_EPI, bool GATHER, bool FP8 = false>
__device__ __forceinline__ void gemm_phase(PG8_LAS unsigned char* lds, const int K, const Sched& S, const Epi& E) {
    int tid_ = threadIdx.x; asm volatile("" : "+v"(tid_));
    const int tid = tid_, wid = __builtin_amdgcn_readfirstlane(tid >> 6), lane = tid & 63, wr = wid >> 2, wc = wid & 3, fr = lane & 15, fq = lane >> 4;
    const int nt = K / BK;
    int RA[2]; unsigned CA[2], voffB[2];
#pragma unroll
    for (int i = 0; i < 2; ++i) { int R, C; stage_rc(tid * 16 + i * 8192, R, C); const int Rb = Epi::PERM ? ((R & ~31) + perm32(R & 31)) : R;
        RA[i] = R; CA[i] = (unsigned)C * 2u; voffB[i] = (unsigned)(Rb * K + C) * 2u; }
    const size_t kstep = (size_t)(BK * 2);
    const size_t hstep = (size_t)HALF * K * 2;
    const unsigned ldsw = (unsigned)wid * 1024u;
    const int aoff = lds_byte(wr * 64 + fr, FP8 ? fq * 16 : fq * 8), boff = lds_byte(wc * 32 + fr, FP8 ? fq * 16 : fq * 8);
#define PG8_SA(b, h) (((b) * 2 + (h)) * HTB)
#define PG8_SB(b, h) ((4 + (b) * 2 + (h)) * HTB)
#define PG8_STAGE(bufoff, gbase, voff) do { _Pragma("unroll") for (int _i = 0; _i < 2; ++_i) { unsigned o_ = (voff)[_i]; asm volatile("" : "+v"(o_));     \
        __builtin_amdgcn_global_load_lds((const unsigned*)((const char*)(gbase) + o_), (PG8_LAS unsigned*)(lds + (bufoff) + ldsw + _i * 8192), 16, 0, 0); } } while (0)
#define PG8_LD16(p) (*(const PG8_LAS v4i32*)(p))
#define PG8_LDA(dst, b, h) do { if constexpr (FP8) { _Pragma("unroll") for (int m = 0; m < 4; ++m) { const PG8_LAS unsigned char* p_ = lds + PG8_SA(b, h) + aoff + m * 2048; \
            dst##8[m] = __builtin_shufflevector(PG8_LD16(p_), PG8_LD16(p_ + 16), 0, 1, 2, 3, 4, 5, 6, 7); } } \
        else { _Pragma("unroll") for (int m = 0; m < 4; ++m) _Pragma("unroll") for (int k = 0; k < 2; ++k) dst[m][k] = *(const PG8_LAS bf16x8*)(lds + PG8_SA(b, h) + aoff + m * 2048 + k * 1024); } } while (0)
#define PG8_LDB(dst, b, h) do { if constexpr (FP8) { _Pragma("unroll") for (int n = 0; n < 2; ++n) { const PG8_LAS unsigned char* p_ = lds + PG8_SB(b, h) + boff + n * 2048; \
            dst##8[n] = __builtin_shufflevector(PG8_LD16(p_), PG8_LD16(p_ + 16), 0, 1, 2, 3, 4, 5, 6, 7); } } \
        else { _Pragma("unroll") for (int n = 0; n < 2; ++n) _Pragma("unroll") for (int k = 0; k < 2; ++k) dst[n][k] = *(const PG8_LAS bf16x8*)(lds + PG8_SB(b, h) + boff + n * 2048 + k * 1024); } } while (0)
#define PG8_MMA(ai, bj, At, Bt) do { __builtin_amdgcn_s_setprio(1); \
        if constexpr (FP8) { _Pragma("unroll") for (int m = 0; m < 4; ++m) _Pragma("unroll") for (int n = 0; n < 2; ++n) \
                asm volatile("v_mfma_scale_f32_16x16x128_f8f6f4 %0, %1, %2, %0, %3, %3 op_sel_hi:[0,0,0]" : "+v"(acc[ai][bj][m][n]) : "v"(Bt##8[n]), "v"(At##8[m]), "v"(scl8)); } \
        else { _Pragma("unroll") for (int m = 0; m < 4; ++m) _Pragma("unroll") for (int n = 0; n < 2; ++n) _Pragma("unroll") for (int k = 0; k < 2; ++k) \
                acc[ai][bj][m][n] = __builtin_amdgcn_mfma_f32_16x16x32_bf16(Bt[n][k], At[m][k], acc[ai][bj][m][n], 0, 0, 0); } \
        __builtin_amdgcn_s_setprio(0); } while (0)
#define PG8_WAIT_V(n) asm volatile("s_waitcnt vmcnt(" #n ")" ::: "memory")
#define PG8_WAIT_L(n) asm volatile("s_waitcnt lgkmcnt(" #n ")" ::: "memory")
#define PG8_BAR __builtin_amdgcn_s_barrier()
#define PG8_SCHED __builtin_amdgcn_sched_barrier(0)
#define PG8_VOFF(u, v) do { _Pragma("unroll") for (int _i = 0; _i < 2; ++_i) { int r_ = RA[_i]; if (GATHER) asm volatile("" : "+v"(r_));     \
        _Pragma("unroll") for (int _h = 0; _h < 2; ++_h) v[_h][_i] = GATHER ? (S.a_rowoff(u, _h * HALF + r_) + CA[_i]) : ((unsigned)((_h * HALF + r_) * K) * 2u + CA[_i]); } } while (0)
    GUnit cur, nxt; int ui = 0;
    if (!S.next(0, cur)) return;
    f32x4 acc[2][2][4][2];
#pragma unroll
    for (int a = 0; a < 2; ++a)
#pragma unroll
        for (int b = 0; b < 2; ++b)
#pragma unroll
            for (int m = 0; m < 4; ++m)
#pragma unroll
                for (int n = 0; n < 2; ++n) acc[a][b][m][n] = (f32x4){0.f, 0.f, 0.f, 0.f};
    bf16x8 At[4][2], B0[2][2], B1[2][2];
    v8i32 At8[4], B08[2], B18[2];
    const int scl8 = 0x7f7f7f7f;
    unsigned vAc[2][2], vAn[2][2];
    PG8_VOFF(cur, vAc);
    if (GATHER) { asm volatile("s_waitcnt vmcnt(0)" : "+v"(vAc[0][0]), "+v"(vAc[0][1]), "+v"(vAc[1][0]), "+v"(vAc[1][1]) :: "memory"); }
    const char* cA = cur.a; const char* cB = cur.b;
    PG8_STAGE(PG8_SB(0, 0), cB, voffB); PG8_STAGE(PG8_SB(0, 1), cB + hstep, voffB); PG8_STAGE(PG8_SA(0, 0), cA, vAc[0]); PG8_STAGE(PG8_SA(0, 1), cA, vAc[1]);
    if (wr == 1) PG8_BAR;
    PG8_WAIT_V(2); PG8_BAR;
    PG8_STAGE(PG8_SB(1, 0), cB + kstep, voffB); PG8_STAGE(PG8_SA(1, 0), cA + kstep, vAc[0]); PG8_STAGE(PG8_SB(1, 1), cB + hstep + kstep, voffB);
    PG8_WAIT_V(6); PG8_BAR;
    for (;;) {
        const bool has_next = S.next(ui + 1, nxt);
        const char* nA = has_next ? nxt.a : cA; const char* nB = has_next ? nxt.b : cB;
        if (GATHER) {
            if (has_next) { PG8_VOFF(nxt, vAn); }
            else {
#pragma unroll
                for (int h = 0; h < 2; ++h)
#pragma unroll
                    for (int i = 0; i < 2; ++i) vAn[h][i] = vAc[h][i]; }
            asm volatile("s_waitcnt vmcnt(0)" : "+v"(vAn[0][0]), "+v"(vAn[0][1]), "+v"(vAn[1][0]), "+v"(vAn[1][1]) :: "memory");
        }
#pragma unroll 1
        for (int t = 0; t < nt; t += 2) {
            const bool last = (t == nt - 2);
            if constexpr (Epi::HAS_MID) { if (t == (nt >> 1)) { int t_ = threadIdx.x; asm volatile("" : "+v"(t_)); E.mid(acc, cur, wr, wc, t_ & 15, (t_ >> 4) & 3); } }
            const char* a1 = cA + (size_t)(t + 1) * kstep;
            const char* a2 = last ? nA : cA + (size_t)(t + 2) * kstep; const char* b2 = last ? nB : cB + (size_t)(t + 2) * kstep;
            const char* a3 = a2 + kstep; const char* b3 = b2 + kstep;
            unsigned v2[2][2];
#pragma unroll
            for (int h = 0; h < 2; ++h)
#pragma unroll
                for (int i = 0; i < 2; ++i) v2[h][i] = (GATHER && last) ? vAn[h][i] : vAc[h][i];
            PG8_LDB(B0, 0, 0); PG8_LDB(B1, 0, 1); PG8_SCHED; PG8_LDA(At, 0, 0); PG8_STAGE(PG8_SA(1, 1), a1, vAc[1]);
            PG8_WAIT_V(8); PG8_WAIT_L(0); PG8_BAR; PG8_MMA(0, 0, At, B0); PG8_MMA(0, 1, At, B1); PG8_BAR; PG8_SCHED;
            PG8_LDA(At, 0, 1); PG8_STAGE(PG8_SB(0, 0), b2, voffB); PG8_STAGE(PG8_SB(0, 1), b2 + hstep, voffB); PG8_STAGE(PG8_SA(0, 0), a2, v2[0]);
            PG8_WAIT_V(8); PG8_WAIT_L(0); PG8_BAR; PG8_MMA(1, 0, At, B0); PG8_MMA(1, 1, At, B1); PG8_BAR; PG8_SCHED;
            PG8_LDB(B0, 1, 0); PG8_LDB(B1, 1, 1); PG8_SCHED; PG8_LDA(At, 1, 0); PG8_STAGE(PG8_SA(0, 1), a2, v2[1]);
            PG8_WAIT_V(8); PG8_WAIT_L(0); PG8_BAR; PG8_MMA(0, 0, At, B0); PG8_MMA(0, 1, At, B1); PG8_BAR; PG8_SCHED;
            PG8_LDA(At, 1, 1); PG8_STAGE(PG8_SB(1, 0), b3, voffB); PG8_STAGE(PG8_SB(1, 1), b3 + hstep, voffB); PG8_STAGE(PG8_SA(1, 0), a3, v2[0]);
            PG8_WAIT_V(8); PG8_WAIT_L(0); PG8_BAR; PG8_MMA(1, 0, At, B0); PG8_MMA(1, 1, At, B1); PG8_BAR; PG8_SCHED;
        }
        if constexpr (FP8) {
            asm volatile("s_nop 15\n\ts_nop 15" ::: "memory");
#pragma unroll
            for (int a = 0; a < 2; ++a)
#pragma unroll
                for (int b = 0; b < 2; ++b)
#pragma unroll
                    for (int m = 0; m < 4; ++m) asm volatile("" : "+v"(acc[a][b][m][0]), "+v"(acc[a][b][m][1]));
        }
        if constexpr (ALIGN_EPI) { if (wr == 0) PG8_BAR; }
        { int t_ = threadIdx.x; asm volatile("" : "+v"(t_));
          E(acc, cur, wr, wc, t_ & 15, (t_ >> 4) & 3); }
        if (!has_next) break;
#pragma unroll
        for (int a = 0; a < 2; ++a)
#pragma unroll
            for (int b = 0; b < 2; ++b)
#pragma unroll
                for (int m = 0; m < 4; ++m)
#pragma unroll
                    for (int n = 0; n < 2; ++n) acc[a][b][m][n] = (f32x4){0.f, 0.f, 0.f, 0.f};
        cur = nxt; cA = nA; cB = nB; ++ui;
#pragma unroll
        for (int h = 0; h < 2; ++h)
#pragma unroll
            for (int i = 0; i < 2; ++i) vAc[h][i] = vAn[h][i];
        if constexpr (ALIGN_EPI) { if (wr == 1) PG8_BAR; }
    }
    PG8_WAIT_V(0);
    if constexpr (!ALIGN_EPI) { if (wr == 0) PG8_BAR; }
    PG8_BAR;
#undef PG8_SA
#undef PG8_SB
#undef PG8_STAGE
#undef PG8_LDA
#undef PG8_LDB
#undef PG8_MMA
#undef PG8_LD16
#undef PG8_WAIT_V
#undef PG8_WAIT_L
#undef PG8_BAR
#undef PG8_SCHED
#undef PG8_VOFF
}
}
#define LAS __attribute__((address_space(3)))
__device__ __forceinline__ u32x4 pack8(const f32x4& v0, const f32x4& v1) { u32x4 w; w.x = pg8::cvt_pk_bf16(v0[0], v0[1]); w.y = pg8::cvt_pk_bf16(v0[2], v0[3]); w.z = pg8::cvt_pk_bf16(v1[0], v1[1]); w.w = pg8::cvt_pk_bf16(v1[2], v1[3]); return w; }
__device__ __forceinline__ void unpack8(const u32x4& w, f32x4& v0, f32x4& v1) { v0 = (f32x4){bf2f(w.x & 0xffffu), bf2f(w.x >> 16), bf2f(w.y & 0xffffu), bf2f(w.y >> 16)}; v1 = (f32x4){bf2f(w.z & 0xffffu), bf2f(w.z >> 16), bf2f(w.w & 0xffffu), bf2f(w.w >> 16)}; }
__device__ __forceinline__ float sigs_(float a) { return __builtin_amdgcn_rcpf(1.f + __builtin_amdgcn_exp2f(a * (-LOG2E * W8_INV))); }
__device__ __forceinline__ f32x4 sig4s(const f32x4& v) { return (f32x4){sigs_(v[0]), sigs_(v[1]), sigs_(v[2]), sigs_(v[3])}; }
__device__ __forceinline__ f32x4 sig4(const f32x4& v) { return (f32x4){sigmoidf_(v[0]), sigmoidf_(v[1]), sigmoidf_(v[2]), sigmoidf_(v[3])}; }

struct EpiProj {
    static constexpr bool PERM = true, HAS_MID = false;
    unsigned char* ws;
    __device__ __forceinline__ void operator()(const f32x4 (&acc)[2][2][4][2], const pg8::GUnit& u, int wr, int wc, int fr, int fq) const {
        const int row0 = u.pm * 256 + wr * 64 + fr;
#pragma unroll
        for (int bj = 0; bj < 2; ++bj) {
            const int cl = bj * 128 + wc * 32 + 8 * fq;
            bf16_t* base; int ld, c; float sc = 1.f; bool sg = false;
            const int pn = u.pn;
            if (pn < 2) { base = (bf16_t*)(ws + WS_QA); ld = 512; c = pn * 256 + cl; sc = 0.125f * LOG2E; }
            else if (pn == 2) { base = (bf16_t*)(ws + (bj == 0 ? WS_KA : WS_VA)); ld = 128; c = wc * 32 + 8 * fq; }
            else if (pn == 3) { base = (bf16_t*)(ws + WS_CKV); ld = 256; c = cl; }
            else if (pn == 4) { base = (bf16_t*)(ws + WS_CQ); ld = 384; c = cl; }
            else if (pn == 5) { if (bj == 0) { base = (bf16_t*)(ws + WS_CQ); ld = 384; c = 256 + wc * 32 + 8 * fq; } else { if (wc != 0) continue; base = (bf16_t*)(ws + WS_KR); ld = 32; c = 8 * fq; } }
            else if (pn < 10) { base = (bf16_t*)(ws + WS_GA); ld = 1024; c = (pn - 6) * 256 + cl; sg = true; }
            else { base = (bf16_t*)(ws + WS_GB); ld = 1024; c = (pn - 10) * 256 + cl; sg = true; }
            const bool is_kr = pn == 5 && bj == 1;
#pragma unroll
            for (int ai = 0; ai < 2; ++ai) {
                f32x4 cs[4], sn[4];
                if (is_kr) {
#pragma unroll
                    for (int m = 0; m < 4; ++m) { const int row = row0 + ai * 128 + m * 16; cs[m] = *(const f32x4*)((const float*)(ws + WS_COS) + row * 16 + 4 * fq); sn[m] = *(const f32x4*)((const float*)(ws + WS_SIN) + row * 16 + 4 * fq); }
                    asm volatile("" : "+v"(cs[0]), "+v"(cs[1]), "+v"(cs[2]), "+v"(cs[3]), "+v"(sn[0]), "+v"(sn[1]), "+v"(sn[2]), "+v"(sn[3]) :: "memory");
                }
#pragma unroll
                for (int m = 0; m < 4; ++m) { f32x4 v0 = acc[ai][bj][m][0], v1 = acc[ai][bj][m][1]; const int row = row0 + ai * 128 + m * 16;
                    if (is_kr) { const f32x4 o1 = v0 * cs[m] - v1 * sn[m], o2 = v1 * cs[m] + v0 * sn[m]; v0 = o1; v1 = o2; }
                    else if (sg) { v0 = sig4(v0); v1 = sig4(v1); } else { v0 = v0 * sc; v1 = v1 * sc; }
                    *(u32x4*)(base + (size_t)row * ld + c) = pack8(v0, v1); }
            }
        }
        if (u.pn >= 3 && u.pn <= 5) {
            float* SSQ = (float*)(ws + WS_SSQ);
#pragma unroll
            for (int ai = 0; ai < 2; ++ai)
#pragma unroll
                for (int m = 0; m < 4; ++m) { float q = 0.f;
#pragma unroll
                    for (int bj = 0; bj < 2; ++bj) { if (u.pn == 5 && bj == 1) continue;
#pragma unroll
                        for (int n = 0; n < 2; ++n) { const f32x4 v = acc[ai][bj][m][n]; q += (v[0] * v[0] + v[1] * v[1]) + (v[2] * v[2] + v[3] * v[3]); } }
                    q += __shfl_xor(q, 16); q += __shfl_xor(q, 32);
                    const int slot = u.pn == 3 ? 8 + wc : u.pn == 4 ? wc : 4 + wc;
                    if (fq == 0) SSQ[slot * MTOK + row0 + ai * 128 + m * 16] = q; }
        }
    }
};
struct EpiUpQ {
    static constexpr bool PERM = true, HAS_MID = false;
    unsigned char* ws;
    __device__ __forceinline__ void operator()(const f32x4 (&acc)[2][2][4][2], const pg8::GUnit& u, int wr, int wc, int fr, int fq) const {
        const float qs0 = 0.10206207261596577f * LOG2E;
        const int row0 = u.pm * 256 + wr * 64 + fr;
        const float* COS = (const float*)(ws + WS_COS); const float* SIN = (const float*)(ws + WS_SIN); const float* SSQ = (const float*)(ws + WS_SSQ);
        float rq[2][4];
#pragma unroll
        for (int ai = 0; ai < 2; ++ai)
#pragma unroll
            for (int m = 0; m < 4; ++m) { const int row = row0 + ai * 128 + m * 16; float q = 0.f;
#pragma unroll
                for (int sl = 0; sl < 8; ++sl) q += SSQ[sl * MTOK + row];
                rq[ai][m] = rsqrtf(q * (1.f / 384.f) + EPS); }
        asm volatile("" : "+v"(rq[0][0]), "+v"(rq[0][1]), "+v"(rq[0][2]), "+v"(rq[0][3]), "+v"(rq[1][0]), "+v"(rq[1][1]), "+v"(rq[1][2]), "+v"(rq[1][3]) :: "memory");
#pragma unroll
        for (int ai = 0; ai < 2; ++ai) { f32x4 cs[4], sn[4];
            if (u.pn >= 2) {
#pragma unroll
                for (int m = 0; m < 4; ++m) { const int row = row0 + ai * 128 + m * 16; cs[m] = *(const f32x4*)(COS + row * 16 + 4 * fq); sn[m] = *(const f32x4*)(SIN + row * 16 + 4 * fq); }
                asm volatile("" : "+v"(cs[0]), "+v"(cs[1]), "+v"(cs[2]), "+v"(cs[3]), "+v"(sn[0]), "+v"(sn[1]), "+v"(sn[2]), "+v"(sn[3]) :: "memory");
            }
#pragma unroll
            for (int bj = 0; bj < 2; ++bj) { const int cl = bj * 128 + wc * 32 + 8 * fq;
#pragma unroll
                for (int m = 0; m < 4; ++m) { const int row = row0 + ai * 128 + m * 16; const float qs = qs0 * rq[ai][m];
                    const f32x4 v0 = acc[ai][bj][m][0], v1 = acc[ai][bj][m][1];
                    if (u.pn < 2) { *(u32x4*)((bf16_t*)(ws + WS_QN) + (size_t)row * 512 + u.pn * 256 + cl) = pack8(v0 * qs, v1 * qs); }
                    else { const f32x4 o1 = (v0 * cs[m] - v1 * sn[m]) * qs, o2 = (v1 * cs[m] + v0 * sn[m]) * qs;
                        *(u32x4*)((bf16_t*)(ws + WS_QR) + (size_t)row * 256 + cl) = pack8(o1, o2); }
                }
                asm volatile("" ::: "memory"); }
        }
    }
};
struct EpiUpKV {
    static constexpr bool PERM = true, HAS_MID = false;
    unsigned char* ws;
    __device__ __forceinline__ void operator()(const f32x4 (&acc)[2][2][4][2], const pg8::GUnit& u, int wr, int wc, int fr, int fq) const {
        const int row0 = u.pm * 256 + wr * 64 + fr;
        bf16_t* base = (bf16_t*)(ws + (u.pn < 2 ? WS_KN : WS_VB)); const float* SSQ = (const float*)(ws + WS_SSQ);
        float rk[2][4];
#pragma unroll
        for (int ai = 0; ai < 2; ++ai)
#pragma unroll
            for (int m = 0; m < 4; ++m) { const int row = row0 + ai * 128 + m * 16;
                const float q = (SSQ[8 * MTOK + row] + SSQ[9 * MTOK + row]) + (SSQ[10 * MTOK + row] + SSQ[11 * MTOK + row]);
                rk[ai][m] = rsqrtf(q * (1.f / 256.f) + EPS); }
#pragma unroll
        for (int bj = 0; bj < 2; ++bj) { const int c = (u.pn & 1) * 256 + bj * 128 + wc * 32 + 8 * fq;
#pragma unroll
            for (int ai = 0; ai < 2; ++ai)
#pragma unroll
                for (int m = 0; m < 4; ++m) *(u32x4*)(base + (size_t)(row0 + ai * 128 + m * 16) * 512 + c) = pack8(acc[ai][bj][m][0] * rk[ai][m], acc[ai][bj][m][1] * rk[ai][m]); }
    }
};
struct EpiMixF {
    static constexpr bool PERM = true, HAS_MID = true;
    unsigned char* ws;
    __device__ __forceinline__ void mid(f32x4 (&acc)[2][2][4][2], const pg8::GUnit& u, int wr, int wc, int fr, int fq) const {
        const int row0 = u.pm * 256 + wr * 64 + fr;
        const bf16_t* GA = (const bf16_t*)(ws + WS_GA); const bf16_t* GB = (const bf16_t*)(ws + WS_GB);
#pragma unroll
        for (int bj = 0; bj < 2; ++bj) { const int c = u.pn * 256 + bj * 128 + wc * 32 + 8 * fq;
#pragma unroll
            for (int ai = 0; ai < 2; ++ai)
#pragma unroll
                for (int mh = 0; mh < 4; mh += 2) { u32x4 ga[2], gb[2];
#pragma unroll
                    for (int m = 0; m < 2; ++m) { const size_t idx = (size_t)(row0 + ai * 128 + (mh + m) * 16) * 1024 + c; ga[m] = *(const u32x4*)(GA + idx); gb[m] = *(const u32x4*)(GB + idx); }
                    asm volatile("" : "+v"(ga[0]), "+v"(ga[1]), "+v"(gb[0]), "+v"(gb[1]) :: "memory");
#pragma unroll
                    for (int m = 0; m < 2; ++m) { f32x4 a0, a1, b0, b1; unpack8(ga[m], a0, a1); unpack8(gb[m], b0, b1);
#pragma unroll
                        for (int i = 0; i < 4; ++i) { acc[ai][bj][mh + m][0][i] *= a0[i] * __builtin_amdgcn_rcpf(fmaxf(b0[i], 1e-30f)); acc[ai][bj][mh + m][1][i] *= a1[i] * __builtin_amdgcn_rcpf(fmaxf(b1[i], 1e-30f)); } } } }
    }
    __device__ __forceinline__ void operator()(const f32x4 (&acc)[2][2][4][2], const pg8::GUnit& u, int wr, int wc, int fr, int fq) const {
        const int row0 = u.pm * 256 + wr * 64 + fr;
        const bf16_t* GB = (const bf16_t*)(ws + WS_GB); bf16_t* MIX = (bf16_t*)(ws + WS_MIX);
#pragma unroll
        for (int bj = 0; bj < 2; ++bj) { const int c = u.pn * 256 + bj * 128 + wc * 32 + 8 * fq;
#pragma unroll
            for (int ai = 0; ai < 2; ++ai) { u32x4 gb[4];
#pragma unroll
                for (int m = 0; m < 4; ++m) gb[m] = *(const u32x4*)(GB + (size_t)(row0 + ai * 128 + m * 16) * 1024 + c);
                asm volatile("" : "+v"(gb[0]), "+v"(gb[1]), "+v"(gb[2]), "+v"(gb[3]) :: "memory");
#pragma unroll
                for (int m = 0; m < 4; ++m) { const size_t idx = (size_t)(row0 + ai * 128 + m * 16) * 1024 + c;
                    f32x4 g0, g1; unpack8(gb[m], g0, g1);
                    const f32x4 y0 = g0 * acc[ai][bj][m][0] * MIX8_SCALE, y1 = g1 * acc[ai][bj][m][1] * MIX8_SCALE;
                    u32x2 o8; o8.x = pk4_fp8(y0[0], y0[1], y0[2], y0[3]); o8.y = pk4_fp8(y1[0], y1[1], y1[2], y1[3]);
                    *(u32x2*)((unsigned char*)MIX + idx) = o8; } } }
    }
};
struct EpiOut {
    static constexpr bool PERM = true, HAS_MID = false;
    unsigned char* ws; const float* x;
    __device__ __forceinline__ void operator()(const f32x4 (&acc)[2][2][4][2], const pg8::GUnit& u, int wr, int wc, int fr, int fq) const {
        const int row0 = u.pm * 256 + wr * 64 + fr; const int b = (u.pm * 256) >> 13;
        const float* mod = (const float*)(ws + WS_MOD); bf16_t* X1 = (bf16_t*)(ws + WS_X1);
#pragma unroll
        for (int bj = 0; bj < 2; ++bj) { const int c = u.pn * 256 + bj * 128 + wc * 32 + 8 * fq;
            const f32x4 g0 = *(const f32x4*)(mod + b * 6144 + 2048 + c) * OUT8_INV, g1 = *(const f32x4*)(mod + b * 6144 + 2048 + c + 4) * OUT8_INV;
#pragma unroll
            for (int ai = 0; ai < 2; ++ai) { f32x4 x0[4], x1[4];
#pragma unroll
                for (int m = 0; m < 4; ++m) { const size_t idx = (size_t)(row0 + ai * 128 + m * 16) * 1024 + c; x0[m] = *(const f32x4*)(x + idx); x1[m] = *(const f32x4*)(x + idx + 4); }
                asm volatile("" : "+v"(x0[0]), "+v"(x0[1]), "+v"(x0[2]), "+v"(x0[3]), "+v"(x1[0]), "+v"(x1[1]), "+v"(x1[2]), "+v"(x1[3]) :: "memory");
#pragma unroll
                for (int m = 0; m < 4; ++m) { const size_t idx = (size_t)(row0 + ai * 128 + m * 16) * 1024 + c;
                    *(u32x4*)(X1 + idx) = pack8(x0[m] + g0 * acc[ai][bj][m][0], x1[m] + g1 * acc[ai][bj][m][1]); } } }
    }
};

constexpr int RT_LD = 1028;
__device__ __forceinline__ void ph_route(const P& p, unsigned char* lds, bool commit = true) {
    const int tid = threadIdx.x, lane = tid & 63, wave = tid >> 6, e = lane & 31, hf = lane >> 5;
    const int RPW = MTOK / gridDim.x;
    float* h2s = (float*)lds;
    unsigned* lcnt = (unsigned*)(lds + 132096); unsigned* lbase = lcnt + 32; unsigned* lent = lcnt + 64; float* lw = (float*)(lcnt + 64 + 256);
    float* lg = (float*)(lcnt + 64 + 512) + wave * 128 + hf * 64;
    if (tid < NEXP) lcnt[tid] = 0u;
    const float* mod = (const float*)(p.ws + WS_MOD); const bf16_t* X1 = (const bf16_t*)(p.ws + WS_X1); unsigned char* H2 = p.ws + WS_XN;
    unsigned* cnt = (unsigned*)(p.ws + WS_CTL); unsigned* LIST = (unsigned*)(p.ws + WS_LIST); float* LISTW = (float*)(p.ws + WS_LISTW);
    u32x4 wh[8], wl[8];
    { const float* wrt = (const float*)(p.ws + WS_WRT) + e * 1028 + 128 * wave + 8 * hf;
#pragma unroll
      for (int ks = 0; ks < 8; ++ks) { const f32x4 a = *(const f32x4*)(wrt + 16 * ks), b = *(const f32x4*)(wrt + 16 * ks + 4); f32x4 ha, hb;
          wh[ks] = pack8(a, b); unpack8(wh[ks], ha, hb); wl[ks] = pack8(a - ha, b - hb); } }
    const float brt = p.b_router[e];
    for (int pass = 0; pass * 32 < RPW; ++pass) {
        u32x2 xw[4][4];
#pragma unroll
        for (int rr = 0; rr < 4; ++rr) { const u32x2* xr = (const u32x2*)(X1 + (size_t)(blockIdx.x * RPW + pass * 32 + 4 * wave + rr) * DM);
#pragma unroll
            for (int j = 0; j < 4; ++j) xw[rr][j] = xr[lane + 64 * j]; }
#pragma unroll
        for (int rr = 0; rr < 4; ++rr) {
            const int rl = 4 * wave + rr, m = blockIdx.x * RPW + pass * 32 + rl, b = m >> 13;
            f32x4 v[4]; float s = 0.f;
#pragma unroll
            for (int j = 0; j < 4; ++j) { const u32x2 w = xw[rr][j]; v[j] = (f32x4){bf2f(w.x & 0xffffu), bf2f(w.x >> 16), bf2f(w.y & 0xffffu), bf2f(w.y >> 16)};
                s += v[j].x * v[j].x + v[j].y * v[j].y + v[j].z * v[j].z + v[j].w * v[j].w; }
            s = wave_sum(s);
            const float rstd = rsqrtf(s * (1.f / DM) + EPS);
#pragma unroll
            for (int j = 0; j < 4; ++j) { const int col = 4 * lane + 256 * j;
                const f32x4 g = *(const f32x4*)(p.norm_ffn + col), sc = *(const f32x4*)(mod + b * 6144 + 4096 + col), sh = *(const f32x4*)(mod + b * 6144 + 3072 + col);
                v[j] = v[j] * rstd * g * (sc + 1.0f) + sh;
                *(unsigned*)(H2 + (size_t)m * DM + col) = pk4_fp8(v[j].x, v[j].y, v[j].z, v[j].w);
                *(f32x4*)(h2s + rl * RT_LD + col) = v[j]; }
        }
        __syncthreads();
        typedef float f32x16r __attribute__((ext_vector_type(16)));
        f32x16r acc, acc1, acc2;
#pragma unroll
        for (int r = 0; r < 16; ++r) { acc[r] = 0.f; acc1[r] = 0.f; acc2[r] = 0.f; }
        const float* ap = h2s + e * RT_LD + 128 * wave + 8 * hf;
#pragma unroll
        for (int ks = 0; ks < 8; ++ks) { const f32x4 a = *(const f32x4*)(ap + 16 * ks), b = *(const f32x4*)(ap + 16 * ks + 4); f32x4 ha, hb;
            const u32x4 ah = pack8(a, b); unpack8(ah, ha, hb); const u32x4 al = pack8(a - ha, b - hb);
            acc  = __builtin_amdgcn_mfma_f32_32x32x16_bf16(__builtin_bit_cast(bf16x8, ah), __builtin_bit_cast(bf16x8, wh[ks]), acc, 0, 0, 0);
            acc1 = __builtin_amdgcn_mfma_f32_32x32x16_bf16(__builtin_bit_cast(bf16x8, ah), __builtin_bit_cast(bf16x8, wl[ks]), acc1, 0, 0, 0);
            acc2 = __builtin_amdgcn_mfma_f32_32x32x16_bf16(__builtin_bit_cast(bf16x8, al), __builtin_bit_cast(bf16x8, wh[ks]), acc2, 0, 0, 0); }
#pragma unroll
        for (int r = 0; r < 16; ++r) acc[r] += acc1[r] + acc2[r];
        __syncthreads();
#pragma unroll
        for (int r = 0; r < 16; ++r) h2s[(wave * 32 + ((r & 3) + 8 * (r >> 2) + 4 * hf)) * 32 + e] = acc[r];
        __syncthreads();
#pragma unroll 1
        for (int it = 0; it < 2; ++it) {
            const int rl = 4 * wave + 2 * it + hf, ri = pass * 32 + rl;
            float val = brt;
#pragma unroll
            for (int w8 = 0; w8 < 8; ++w8) val += h2s[(w8 * 32 + rl) * 32 + e];
            lg[e] = val;
            int rank = 0;
#pragma unroll
            for (int e4 = 0; e4 < 8; ++e4) { const f32x4 o = *(const f32x4*)(lg + 4 * e4);
#pragma unroll
                for (int i = 0; i < 4; ++i) { const int ee = 4 * e4 + i; rank += (o[i] > val || (o[i] == val && ee < e)) ? 1 : 0; } }
            if (rank < 4) { lg[32 + rank] = val; lg[36 + rank] = __int_as_float(e); }
            const f32x4 tvv = *(const f32x4*)(lg + 32), tiv = *(const f32x4*)(lg + 36);
            const float e1 = __expf(tvv[1] - tvv[0]), e2 = __expf(tvv[2] - tvv[0]), e3 = __expf(tvv[3] - tvv[0]);
            const float inv = 1.f / (1.f + e1 + e2 + e3);
            if (e < 4) {
                const int ex = __float_as_int(e == 0 ? tiv[0] : e == 1 ? tiv[1] : e == 2 ? tiv[2] : tiv[3]);
                const float w = (e == 0 ? 1.f : e == 1 ? e1 : e == 2 ? e2 : e3) * inv;
                const unsigned lr = atomicAdd(&lcnt[ex], 1u);
                lent[ri * 4 + e] = (unsigned)ex | (lr << 8); lw[ri * 4 + e] = w;
            }
        }
        __syncthreads();
    }
    if (!commit) return;
    if (tid < NEXP) lbase[tid] = atomicAdd(&cnt[tid * 64], lcnt[tid]);
    __syncthreads();
    for (int a = tid; a < RPW * 4; a += NTHREADS) {
        const unsigned en = lent[a]; const int ex = (int)(en & 255u); const unsigned pos = lbase[ex] + (en >> 8);
        LIST[(size_t)ex * LISTCAP + pos] = (unsigned)((blockIdx.x * RPW + (a >> 2)) * 4 + (a & 3));
        ((float*)(p.ws + WS_TOPW))[(size_t)blockIdx.x * RPW * 4 + a] = lw[a];
    }
}
__device__ __forceinline__ void ph_final(const P& p) {
    const int tid = threadIdx.x, lane = tid & 63, wave = tid >> 6;
    const int gw = blockIdx.x * 8 + wave, NGW = gridDim.x * 8;
    const float* mod = (const float*)(p.ws + WS_MOD); const bf16_t* X1 = (const bf16_t*)(p.ws + WS_X1); const unsigned char* Y = (const unsigned char*)(p.ws + WS_Y);
    for (int m = gw; m < MTOK; m += NGW) {
        const int b = m >> 13;
        const u32x2* xr = (const u32x2*)(X1 + (size_t)m * DM);
        f32x4 v[4]; float s = 0.f;
        const f32x4 tw = *(const f32x4*)((const float*)(p.ws + WS_TOPW) + (size_t)m * 4);
#pragma unroll
        for (int j = 0; j < 4; ++j) { const int col = 4 * lane + 256 * j;
            f32x4 y = (f32x4){0.f, 0.f, 0.f, 0.f};
#pragma unroll
            for (int k = 0; k < 4; ++k) { const int w = (int)__builtin_nontemporal_load((const unsigned*)(Y + ((size_t)m * 4 + k) * 1024 + col));
                y.x += tw[k] * __builtin_amdgcn_cvt_f32_fp8(w, 0); y.y += tw[k] * __builtin_amdgcn_cvt_f32_fp8(w, 1); y.z += tw[k] * __builtin_amdgcn_cvt_f32_fp8(w, 2); y.w += tw[k] * __builtin_amdgcn_cvt_f32_fp8(w, 3); }
            const f32x4 g2 = *(const f32x4*)(mod + b * 6144 + 5120 + col);
            const u32x2 xw = xr[lane + 64 * j];
            v[j] = (f32x4){bf2f(xw.x & 0xffffu), bf2f(xw.x >> 16), bf2f(xw.y & 0xffffu), bf2f(xw.y >> 16)} + g2 * y;
            s += v[j].x * v[j].x + v[j].y * v[j].y + v[j].z * v[j].z + v[j].w * v[j].w; }
        s = wave_sum(s);
        const float rstd = rsqrtf(s * (1.f / DM) + EPS);
#pragma unroll
        for (int j = 0; j < 4; ++j) { const int col = 4 * lane + 256 * j; const f32x4 g = *(const f32x4*)(p.fnorm + col);
            *(f32x4*)(p.out + (size_t)m * DM + col) = v[j] * rstd * g; }
    }
}


struct EpiGate {
    static constexpr bool PERM = true, HAS_MID = false;
    unsigned char* ws;
    __device__ __forceinline__ void operator()(const f32x4 (&acc)[2][2][4][2], const pg8::GUnit& u, int wr, int wc, int fr, int fq) const {
        const int row0 = u.pm * 256 + wr * 64 + fr;
        bf16_t* base = (bf16_t*)(ws + (u.pn < 4 ? WS_GA : WS_GB));
#pragma unroll
        for (int bj = 0; bj < 2; ++bj) { const int c = (u.pn & 3) * 256 + bj * 128 + wc * 32 + 8 * fq;
#pragma unroll
            for (int ai = 0; ai < 2; ++ai)
#pragma unroll
                for (int m = 0; m < 4; ++m) *(u32x4*)(base + (size_t)(row0 + ai * 128 + m * 16) * 1024 + c) = pack8(sig4s(acc[ai][bj][m][0]), sig4s(acc[ai][bj][m][1])); }
    }
};
struct GateOrder {
    const char* A; const char* Bt; int G, c;
    __device__ __forceinline__ bool next(int i, pg8::GUnit& u) const {
        int un;
        if (G == 256) { if (c < 128) { if (i > 0) return false; un = c; } else { if (i > 2) return false; un = 128 + 3 * (c - 128) + i; } }
        else { un = i * G + c; if (un >= 512) return false; }
        u.pm = un >> 3; u.pn = un & 7; u.e = 0; u.cnt = 0; u.tile = 0; u.pad_ = 0;
        u.a = A + (size_t)u.pm * 256 * 1024; u.b = Bt + (size_t)u.pn * 256 * 1024; return true;
    }
    __device__ __forceinline__ unsigned a_rowoff(const pg8::GUnit&, int) const { return 0u; }
};
__device__ __forceinline__ void ph_proj2(const P& p, unsigned char* lds) {
    { pg8::DenseOrder S; S.init(p.ws + WS_XN, p.ws + WS_WT_IN, MTOK, 1536, 1024, gridDim.x, blockIdx.x);
      EpiProj E{p.ws};
      pg8::gemm_phase<EpiProj, pg8::DenseOrder, true, false>((LAS unsigned char*)lds, 1024, S, E); }
    { GateOrder S{(const char*)(p.ws + WS_XN8), (const char*)(p.ws + WS_WT_G8), (int)gridDim.x, (int)blockIdx.x};
      EpiGate E{p.ws};
      pg8::gemm_phase<EpiGate, GateOrder, true, false, true>((LAS unsigned char*)lds, 512, S, E); }
}
__device__ __forceinline__ void ph_up2(const P& p, unsigned char* lds) {
    { pg8::DenseOrder S; S.init(p.ws + WS_CQ, p.ws + WS_WT_UQ, MTOK, 768, 384, gridDim.x, blockIdx.x); EpiUpQ E{p.ws};
      pg8::gemm_phase<EpiUpQ, pg8::DenseOrder, false, false>((LAS unsigned char*)lds, 384, S, E); }
    { pg8::DenseOrder S; S.init(p.ws + WS_CKV, p.ws + WS_WT_UKV, MTOK, 1024, 256, gridDim.x, blockIdx.x); EpiUpKV E{p.ws};
      pg8::gemm_phase<EpiUpKV, pg8::DenseOrder, false, false>((LAS unsigned char*)lds, 256, S, E); }
}
__device__ __forceinline__ void ph_mix2(const P& p, unsigned char* lds) {
    pg8::DenseOrder S; S.init(p.ws + WS_AO, p.ws + WS_WT_A, MTOK, 1024, 1024, gridDim.x, blockIdx.x); EpiMixF E{p.ws};
    pg8::gemm_phase<EpiMixF, pg8::DenseOrder, false, false>((LAS unsigned char*)lds, 1024, S, E);
}
__device__ __forceinline__ void ph_out2(const P& p, unsigned char* lds) {
    pg8::DenseOrder S; S.init(p.ws + WS_MIX, p.ws + WS_WT_OUT, MTOK, 1024, 512, gridDim.x, blockIdx.x); EpiOut E{p.ws, p.x};
    pg8::gemm_phase<EpiOut, pg8::DenseOrder, false, false, true>((LAS unsigned char*)lds, 512, S, E);
}


constexpr int MOE_TAB_OFF = 135168;
__device__ __forceinline__ void moe_build_tab(const P& p, unsigned char* lds) {
    LAS int* tab = (LAS int*)((LAS unsigned char*)lds + MOE_TAB_OFF);
    const unsigned* cnt = (const unsigned*)(p.ws + WS_CTL);
    const int tid = threadIdx.x;
    if (tid < 64) {
        const int c = tid < NEXP ? (int)cnt[tid * 64] : 0, n = (c + 255) >> 8;
        int incl = n;
#pragma unroll
        for (int o = 1; o < 32; o <<= 1) { const int t = __shfl_up(incl, o); if (tid >= o) incl += t; }
        const int s = incl - n;
        if (tid < NEXP) { tab[tid] = c; tab[32 + tid] = s; for (int j = 0; j < n; ++j) tab[128 + s + j] = tid; if (tid == NEXP - 1) tab[64] = incl; }
    }
    __syncthreads();
}
template <bool GATHER> struct MoeOrder {
    const LAS int* tab; const char* Abase; const char* Bbase; const unsigned* LIST; int K, NCT, G, c;
    __device__ __forceinline__ bool next(int i, pg8::GUnit& u) const {
        const int vc = (G % 8 == 0) ? (c % 8) * (G / 8) + c / 8 : c;
        const int L = i * G + vc; const int ntile = __builtin_amdgcn_readfirstlane(tab[64]); if (L >= ntile * NCT) return false;
        const int tile = L / NCT, pn = L - tile * NCT, e = __builtin_amdgcn_readfirstlane(tab[128 + tile]);
        u.e = e; u.cnt = __builtin_amdgcn_readfirstlane(tab[e]); u.pm = tile - __builtin_amdgcn_readfirstlane(tab[32 + e]); u.pn = pn; u.tile = tile; u.pad_ = 0;
        u.b = Bbase + ((size_t)e * NCT + pn) * 256 * K * 2;
        u.a = GATHER ? Abase : Abase + (size_t)tile * 256 * K * 2;
        return true;
    }
    __device__ __forceinline__ unsigned a_rowoff(const pg8::GUnit& u, int r) const {
        const int row = u.pm * 256 + r; const unsigned ent = row < u.cnt ? LIST[(size_t)u.e * LISTCAP + row] : 0u; return (ent >> 2) * (unsigned)(K * 2);
    }
};
struct EpiMoe1 {
    static constexpr bool PERM = true, HAS_MID = false;
    unsigned char* ws; const float* b1;
    __device__ __forceinline__ void operator()(const f32x4 (&acc)[2][2][4][2], const pg8::GUnit& u, int wr, int wc, int fr, int fq) const {
        bf16_t* HID = (bf16_t*)(ws + WS_HID);
        const int row0 = u.tile * 256 + wr * 64 + fr, col = u.pn * 128 + wc * 32 + 8 * fq;
        constexpr float CG = -1.702f * LOG2E, CGI = 1.f / CG;
        f32x4 bg[2], bl[2];
#pragma unroll
        for (int n = 0; n < 2; ++n) { bg[n] = *(const f32x4*)(b1 + u.e * 2048 + col + 4 * n) * CG; bl[n] = (*(const f32x4*)(b1 + u.e * 2048 + 1024 + col + 4 * n) + 1.f) * CGI; }
#pragma unroll
        for (int ai = 0; ai < 2; ++ai)
#pragma unroll
            for (int m = 0; m < 4; ++m) { f32x4 h[2];
#pragma unroll
                for (int n = 0; n < 2; ++n) { const f32x4 gv = acc[ai][0][m][n] * (W8_INV * CG) + bg[n], lv = acc[ai][1][m][n] * (W8_INV * CGI) + bl[n];
#pragma unroll
                    for (int i = 0; i < 4; ++i) { const float t = fmaxf(gv[i], 7.f * CG), L = __builtin_amdgcn_fmed3f(lv[i], 8.f * CGI, -6.f * CGI);
                        h[n][i] = t * __builtin_amdgcn_rcpf(1.f + __builtin_amdgcn_exp2f(t)) * L; } }
                u32x2 o8; o8.x = pk4_fp8(h[0][0], h[0][1], h[0][2], h[0][3]); o8.y = pk4_fp8(h[1][0], h[1][1], h[1][2], h[1][3]);
                *(u32x2*)((unsigned char*)HID + (size_t)(row0 + ai * 128 + m * 16) * 1024 + col) = o8; }
    }
};
struct EpiMoe2 {
    static constexpr bool PERM = true, HAS_MID = false;
    unsigned char* ws; const float* b2;
    __device__ __forceinline__ void operator()(const f32x4 (&acc)[2][2][4][2], const pg8::GUnit& u, int wr, int wc, int fr, int fq) const {
        unsigned char* Y = ws + WS_Y; const unsigned* LIST = (const unsigned*)(ws + WS_LIST) + (size_t)u.e * LISTCAP;
        f32x4 bv[2][2]; unsigned ent[2][4];
#pragma unroll
        for (int bj = 0; bj < 2; ++bj)
#pragma unroll
            for (int n = 0; n < 2; ++n) bv[bj][n] = *(const f32x4*)(b2 + u.e * 1024 + u.pn * 256 + bj * 128 + wc * 32 + 8 * fq + 4 * n);
#pragma unroll
        for (int ai = 0; ai < 2; ++ai)
#pragma unroll
            for (int m = 0; m < 4; ++m) { const int rr = u.pm * 256 + ai * 128 + wr * 64 + m * 16 + fr, rc = rr < u.cnt ? rr : u.cnt - 1; ent[ai][m] = LIST[rc]; }
        asm volatile("" : "+v"(bv[0][0]), "+v"(bv[0][1]), "+v"(bv[1][0]), "+v"(bv[1][1]));
#pragma unroll
        for (int ai = 0; ai < 2; ++ai)
#pragma unroll
            for (int m = 0; m < 4; ++m) asm volatile("" : "+v"(ent[ai][m]));
#pragma unroll
        for (int ai = 0; ai < 2; ++ai)
#pragma unroll
            for (int m = 0; m < 4; ++m) { const int rr = u.pm * 256 + ai * 128 + wr * 64 + m * 16 + fr;
                if (rr < u.cnt) {
#pragma unroll
                    for (int bj = 0; bj < 2; ++bj) { const int c = u.pn * 256 + bj * 128 + wc * 32 + 8 * fq;
                        const f32x4 y0 = acc[ai][bj][m][0] * W8_INV + bv[bj][0], y1 = acc[ai][bj][m][1] * W8_INV + bv[bj][1];
                        u32x2 o8; o8.x = pk4_fp8(y0[0], y0[1], y0[2], y0[3]); o8.y = pk4_fp8(y1[0], y1[1], y1[2], y1[3]);
                        *(u32x2*)(Y + (size_t)ent[ai][m] * 1024 + c) = o8; } } }
    }
};
__device__ __forceinline__ void ph_moe1_2(const P& p, unsigned char* lds) {
    moe_build_tab(p, lds);
    MoeOrder<true> S{(const LAS int*)((LAS unsigned char*)lds + MOE_TAB_OFF), (const char*)(p.ws + WS_XN), (const char*)(p.ws + WS_WT_M1), (const unsigned*)(p.ws + WS_LIST), 512, 8, (int)gridDim.x, (int)blockIdx.x};
    EpiMoe1 E{p.ws, p.b_m1};
    pg8::gemm_phase<EpiMoe1, MoeOrder<true>, true, true, true>((LAS unsigned char*)lds, 512, S, E);
}
__device__ __forceinline__ void ph_moe2_2(const P& p, unsigned char* lds) {
    MoeOrder<false> S{(const LAS int*)((LAS unsigned char*)lds + MOE_TAB_OFF), (const char*)(p.ws + WS_HID), (const char*)(p.ws + WS_WT_M2), (const unsigned*)(p.ws + WS_LIST), 512, 4, (int)gridDim.x, (int)blockIdx.x};
    EpiMoe2 E{p.ws, p.b_m2};
    pg8::gemm_phase<EpiMoe2, MoeOrder<false>, true, false, true>((LAS unsigned char*)lds, 512, S, E);
}


namespace att {
typedef float f32x16 __attribute__((ext_vector_type(16)));
typedef short s16x4 __attribute__((ext_vector_type(4)));
typedef short v4i16_t __attribute__((ext_vector_type(4)));
typedef LAS const unsigned char* lds_cptr;
constexpr int KROW = 208;
constexpr int KBUF = 64 * KROW, VBUF = 8192;
constexpr int OFF_K = 0, OFF_V = 2 * KBUF, OFF_WS = 2 * KBUF + 2 * VBUF, LDS_BYTES_ATT = OFF_WS + 8 * 256;
__device__ __forceinline__ int crow(int r, int hi) { return (r & 3) + 8 * (r >> 2) + 4 * hi; }
__device__ __forceinline__ s16x4 vtr(lds_cptr p) { return __builtin_bit_cast(s16x4, __builtin_amdgcn_ds_read_tr16_b64_v4i16((LAS v4i16_t*)p)); }
__device__ __forceinline__ float vmax3(float a, float b, float c) { float d; asm("v_max3_f32 %0, %1, %2, %3" : "=v"(d) : "v"(a), "v"(b), "v"(c)); return d; }
__device__ __forceinline__ float half_swap_max(float m) { auto rr = __builtin_amdgcn_permlane32_swap(__float_as_uint(m), __float_as_uint(m), false, false); return fmaxf(__uint_as_float(rr[0]), __uint_as_float(rr[1])); }
__device__ __forceinline__ float half_swap_sum(float m) { auto rr = __builtin_amdgcn_permlane32_swap(__float_as_uint(m), __float_as_uint(m), false, false); return __uint_as_float(rr[0]) + __uint_as_float(rr[1]); }

constexpr int BG_SCR_OFF = 49152;
#define ATT_BARRIER() asm volatile("s_waitcnt lgkmcnt(0)\n\ts_barrier" ::: "memory")
template <bool MLA>
__device__ __forceinline__ void attn_unit(const P& p, LAS unsigned char* lds, int b, int hk, int q0, BgConv& bg, float* bgscr) {
    int tid_ = threadIdx.x; asm volatile("" : "+v"(tid_));
    const int tid = tid_, lane = tid & 63, r32 = lane & 31, hi = lane >> 5, wid = __builtin_amdgcn_readfirstlane(tid >> 6);
    constexpr int NKS = MLA ? 6 : 4;
    const int head = MLA ? hk : hk * 4 + (wid >> 1);
    const int qw0 = MLA ? q0 + 32 * wid : q0 + 32 * (wid & 1);
    const size_t rb = (size_t)b * SEQ;
    bf16x8 qf[NKS];
    if (MLA) {
        const bf16_t* qn = (const bf16_t*)(p.ws + WS_QN) + (rb + qw0 + r32) * 512 + head * 64 + 8 * hi;
        const bf16_t* qr = (const bf16_t*)(p.ws + WS_QR) + (rb + qw0 + r32) * 256 + head * 32 + 8 * hi;
#pragma unroll
        for (int ks = 0; ks < 4; ++ks) qf[ks] = *(const bf16x8*)(qn + 16 * ks);
#pragma unroll
        for (int ks = 4; ks < NKS; ++ks) qf[ks] = *(const bf16x8*)(qr + 16 * (ks - 4));
    } else {
        const bf16_t* qa = (const bf16_t*)(p.ws + WS_QA) + (rb + qw0 + r32) * 512 + head * 64 + 8 * hi;
#pragma unroll
        for (int ks = 0; ks < NKS; ++ks) qf[ks] = *(const bf16x8*)(qa + 16 * ks);
    }
    const int t_lo = MLA ? 0 : (q0 >= 128 ? (q0 - 128) >> 6 : 0), t_hi = MLA ? ((q0 + 256) >> 6) - 1 : (q0 >> 6);
    const int skey = tid >> 3, sc = tid & 7;
    const bf16_t* kg; const bf16_t* vg; const bf16_t* rg = nullptr;
    if (MLA) { kg = (const bf16_t*)(p.ws + WS_KN) + (rb + skey) * 512 + hk * 64 + 8 * sc; vg = (const bf16_t*)(p.ws + WS_VB) + (rb + skey) * 512 + hk * 64 + 8 * sc;
               rg = (const bf16_t*)(p.ws + WS_KR) + (rb + (tid >> 2)) * 32 + 8 * (tid & 3); }
    else { kg = (const bf16_t*)(p.ws + WS_KA) + (rb + skey) * 128 + hk * 64 + 8 * sc; vg = (const bf16_t*)(p.ws + WS_VA) + (rb + skey) * 128 + hk * 64 + 8 * sc; }
    const int kpitch = MLA ? 512 : 128;
    const int kst = skey * KROW + sc * 16;
    const int rst = (tid >> 2) * KROW + 128 + (tid & 3) * 16;
    const int vst = ((8 * sc) >> 5) * 4096 + (skey >> 4) * 1024 + (skey & 15) * 64 + ((8 * sc) & 31) * 2;
    u32x4 kreg, vreg, rreg = (u32x4){0u, 0u, 0u, 0u};
#define ATT_LOAD(t) do { kreg = *(const u32x4*)(kg + (size_t)(t) * 64 * kpitch); vreg = *(const u32x4*)(vg + (size_t)(t) * 64 * kpitch); \
        if (MLA && tid < 256) rreg = *(const u32x4*)(rg + (size_t)(t) * 64 * 32); } while (0)
#define ATT_WRITE(buf) do { *(LAS u32x4*)(lds + OFF_K + (buf) * KBUF + kst) = kreg; *(LAS u32x4*)(lds + OFF_V + (buf) * VBUF + vst) = vreg; \
        if (MLA && tid < 256) *(LAS u32x4*)(lds + OFF_K + (buf) * KBUF + rst) = rreg; } while (0)
    LAS float* wsf = (LAS float*)(lds + OFF_WS) + wid * 64;
    float m, l; f32x16 o[2];
#pragma unroll
    for (int r = 0; r < 16; ++r) { o[0][r] = 0.f; o[1][r] = 0.f; }
    float slope2 = 0.f;
    if (MLA) { m = -INFINITY; l = 0.f; }
    else { m = p.sinks[head] * LOG2E; l = hi == 0 ? 1.f : 0.f; slope2 = exp2f(-(float)(head + 1)) * LOG2E; }
    const lds_cptr kp0 = (lds_cptr)lds + OFF_K + r32 * KROW + hi * 16;
    const lds_cptr vp0 = (lds_cptr)lds + OFF_V + ((lane >> 4) & 1) * 32 + (lane & 3) * 8 + (4 * hi + ((lane & 15) >> 2)) * 64;
    ATT_LOAD(t_lo); ATT_WRITE(0);
    ATT_BARRIER();
    for (int t = t_lo; t <= t_hi; ++t) {
        const int cur = (t - t_lo) & 1, s0 = t * 64;
        if (t < t_hi) ATT_LOAD(t + 1);
        if (BG_CONV) bg_step(p, bg, bgscr, lane);
        const bool active = MLA ? (s0 <= qw0 + 31) : (s0 <= qw0 + 31 && s0 + 63 >= qw0 - 127);
        if (active) {
            f32x16 p0, p1;
#pragma unroll
            for (int r = 0; r < 16; ++r) { p0[r] = 0.f; p1[r] = 0.f; }
            const lds_cptr kp = kp0 + cur * KBUF;
#pragma unroll
            for (int ks = 0; ks < NKS; ++ks) {
                const bf16x8 a0 = *(const LAS bf16x8*)(kp + ks * 32), a1 = *(const LAS bf16x8*)(kp + 32 * KROW + ks * 32);
                p0 = __builtin_amdgcn_mfma_f32_32x32x16_bf16(a0, qf[ks], p0, 0, 0, 0);
                p1 = __builtin_amdgcn_mfma_f32_32x32x16_bf16(a1, qf[ks], p1, 0, 0, 0);
            }
            const int q = qw0 + r32;
            if (MLA) {
                if (s0 + 63 > qw0) {
#pragma unroll
                    for (int r = 0; r < 16; ++r) { const int key = s0 + crow(r, hi); if (key > q) p0[r] = -INFINITY; if (key + 32 > q) p1[r] = -INFINITY; }
                }
            } else {
#pragma unroll
                for (int r = 0; r < 16; ++r) { const int d0 = q - (s0 + crow(r, hi)), d1 = d0 - 32;
                    p0[r] = (d0 >= 0 && d0 < 128) ? p0[r] - slope2 * (float)d0 : -INFINITY;
                    p1[r] = (d1 >= 0 && d1 < 128) ? p1[r] - slope2 * (float)d1 : -INFINITY; }
            }
            float mx = fmaxf(p0[0], p1[0]);
#pragma unroll
            for (int r = 1; r < 16; ++r) mx = fmaxf(mx, fmaxf(p0[r], p1[r]));
            mx = half_swap_max(mx);
            if (__any(mx > m + 8.f)) {
                const float mn = fmaxf(m, mx), alpha = __builtin_amdgcn_exp2f(m - mn);
                m = mn; l *= alpha;
                if (hi == 0) wsf[r32] = alpha;
#pragma unroll
                for (int r = 0; r < 16; ++r) { const float a = wsf[crow(r, hi)]; o[0][r] *= a; o[1][r] *= a; }
            }
            float ps = 0.f;
#pragma unroll
            for (int r = 0; r < 16; ++r) { p0[r] = __builtin_amdgcn_exp2f(p0[r] - m); p1[r] = __builtin_amdgcn_exp2f(p1[r] - m); ps += p0[r] + p1[r]; }
            l += ps;
            u32x4 pw[4];
#pragma unroll
            for (int i = 0; i < 4; ++i) { pw[0][i] = pg8::cvt_pk_bf16(p0[2 * i], p0[2 * i + 1]); pw[1][i] = pg8::cvt_pk_bf16(p0[8 + 2 * i], p0[8 + 2 * i + 1]);
                                          pw[2][i] = pg8::cvt_pk_bf16(p1[2 * i], p1[2 * i + 1]); pw[3][i] = pg8::cvt_pk_bf16(p1[8 + 2 * i], p1[8 + 2 * i + 1]); }
            const lds_cptr vp = vp0 + cur * VBUF;
#pragma unroll
            for (int d0 = 0; d0 < 2; ++d0)
#pragma unroll
                for (int ks = 0; ks < 4; ++ks) {
                    const s16x4 lo = vtr(vp + d0 * 4096 + ks * 1024), hh = vtr(vp + d0 * 4096 + ks * 1024 + 512);
                    const bf16x8 vf = (bf16x8){lo[0], lo[1], lo[2], lo[3], hh[0], hh[1], hh[2], hh[3]};
                    o[d0] = __builtin_amdgcn_mfma_f32_32x32x16_bf16(__builtin_bit_cast(bf16x8, pw[ks]), vf, o[d0], 0, 0, 0);
                }
        }
        if (t < t_hi) ATT_WRITE(cur ^ 1);
        ATT_BARRIER();
    }
    l = half_swap_sum(l);
    if (hi == 0) wsf[32 + r32] = 1.f / l;
    bf16_t* Ob = (bf16_t*)(p.ws + WS_AO) + (rb + qw0) * 1024 + (MLA ? 512 : 0) + head * 64 + r32;
#pragma unroll
    for (int r = 0; r < 16; ++r) { const int qr = crow(r, hi); const float rl = wsf[32 + qr];
        Ob[(size_t)qr * 1024] = (bf16_t)f2bf(o[0][r] * rl); Ob[(size_t)qr * 1024 + 32] = (bf16_t)f2bf(o[1][r] * rl); }
#undef ATT_LOAD
#undef ATT_WRITE
}
constexpr int PP_AHEAD = 4;
constexpr int PP_OFF_V = 3 * KBUF, PP_OFF_WS = 3 * KBUF + 3 * VBUF;
#define ATT_PBAR() do { __builtin_amdgcn_sched_barrier(0); asm volatile("s_waitcnt lgkmcnt(0)\n\ts_barrier" ::: "memory"); __builtin_amdgcn_sched_barrier(0); } while (0)
template <bool MLA>
__device__ __forceinline__ void attn_unit_pp(const P& p, LAS unsigned char* lds, int b, int hk, int q0, BgConv& bg) {
    int tid_ = threadIdx.x; asm volatile("" : "+v"(tid_));
    const int tid = tid_, lane = tid & 63, r32 = lane & 31, hi = lane >> 5, wid = __builtin_amdgcn_readfirstlane(tid >> 6);
    const int grp = wid >> 2;
    constexpr int NKS = MLA ? 6 : 4;
    const int head = MLA ? hk : hk * 4 + (wid >> 1);
    const int qw0 = MLA ? q0 + 32 * wid : q0 + 32 * (wid & 1);
    const size_t rb = (size_t)b * SEQ;
    bf16x8 qf[NKS];
    if (MLA) {
        const bf16_t* qn = (const bf16_t*)(p.ws + WS_QN) + (rb + qw0 + r32) * 512 + head * 64 + 8 * hi;
        const bf16_t* qr = (const bf16_t*)(p.ws + WS_QR) + (rb + qw0 + r32) * 256 + head * 32 + 8 * hi;
#pragma unroll
        for (int ks = 0; ks < 4; ++ks) qf[ks] = *(const bf16x8*)(qn + 16 * ks);
#pragma unroll
        for (int ks = 4; ks < NKS; ++ks) qf[ks] = *(const bf16x8*)(qr + 16 * (ks - 4));
    } else {
        const bf16_t* qa = (const bf16_t*)(p.ws + WS_QA) + (rb + qw0 + r32) * 512 + head * 64 + 8 * hi;
#pragma unroll
        for (int ks = 0; ks < NKS; ++ks) qf[ks] = *(const bf16x8*)(qa + 16 * ks);
    }
    const int t_lo = MLA ? 0 : (q0 >= 128 ? (q0 - 128) >> 6 : 0), t_hi = MLA ? ((q0 + 256) >> 6) - 1 : (q0 >> 6);
    const int skey = tid >> 3, sc = tid & 7;
    const bf16_t* kg; const bf16_t* vg; const bf16_t* rg = nullptr;
    if (MLA) { kg = (const bf16_t*)(p.ws + WS_KN) + (rb + skey) * 512 + hk * 64 + 8 * sc; vg = (const bf16_t*)(p.ws + WS_VB) + (rb + skey) * 512 + hk * 64 + 8 * sc;
               rg = (const bf16_t*)(p.ws + WS_KR) + (rb + (tid >> 2)) * 32 + 8 * (tid & 3); }
    else { kg = (const bf16_t*)(p.ws + WS_KA) + (rb + skey) * 128 + hk * 64 + 8 * sc; vg = (const bf16_t*)(p.ws + WS_VA) + (rb + skey) * 128 + hk * 64 + 8 * sc; }
    const int kpitch = MLA ? 512 : 128;
    const int kst = skey * KROW + sc * 16;
    const int rst = (tid >> 2) * KROW + 128 + (tid & 3) * 16;
    const int vst = ((8 * sc) >> 5) * 4096 + (skey >> 4) * 1024 + (skey & 15) * 64 + ((8 * sc) & 31) * 2;
    u32x4 kreg, vreg, rreg = (u32x4){0u, 0u, 0u, 0u};
#define PP_LOAD(t) do { kreg = *(const u32x4*)(kg + (size_t)(t) * 64 * kpitch); vreg = *(const u32x4*)(vg + (size_t)(t) * 64 * kpitch); \
        if (MLA && tid < 256) rreg = *(const u32x4*)(rg + (size_t)(t) * 64 * 32); } while (0)
#define PP_WRITE(kb, vb) do { *(LAS u32x4*)(lds + (kb) + kst) = kreg; *(LAS u32x4*)(lds + PP_OFF_V + (vb) + vst) = vreg; \
        if (MLA && tid < 256) *(LAS u32x4*)(lds + (kb) + rst) = rreg; } while (0)
    LAS float* wsf = (LAS float*)(lds + PP_OFF_WS) + wid * 64;
    float m, l; f32x16 o[2];
#pragma unroll
    for (int r = 0; r < 16; ++r) { o[0][r] = 0.f; o[1][r] = 0.f; }
    float slope2 = 0.f;
    if (MLA) { m = -INFINITY; l = 0.f; }
    else { m = p.sinks[head] * LOG2E; l = hi == 0 ? 1.f : 0.f; slope2 = exp2f(-(float)(head + 1)) * LOG2E; }
    const lds_cptr kp0 = (lds_cptr)lds + r32 * KROW + hi * 16;
    const lds_cptr vp0 = (lds_cptr)lds + PP_OFF_V + ((lane >> 4) & 1) * 32 + (lane & 3) * 8 + (4 * hi + ((lane & 15) >> 2)) * 64;
    int kbP = 2 * KBUF, kbC = 0, kbN = KBUF, vbP = 2 * VBUF, vbC = 0, vbN = VBUF;
    PP_LOAD(t_lo); PP_WRITE(kbC, vbC);
    if (t_lo < t_hi) PP_LOAD(t_lo + 1);
    ATT_PBAR();
    if (grp) ATT_PBAR();
    u32x4 pw[4];
#pragma unroll
    for (int i = 0; i < 4; ++i) pw[i] = (u32x4){0u, 0u, 0u, 0u};
    f32x16 p0, p1;
#pragma unroll
    for (int r = 0; r < 16; ++r) { p0[r] = 0.f; p1[r] = 0.f; }
    bool act_prev = false;
    for (int t = t_lo; t <= t_hi + 1; ++t) {
        const int s0 = t * 64;
        const bool active = t <= t_hi && (MLA ? (s0 <= qw0 + 31) : (s0 <= qw0 + 31 && s0 + 63 >= qw0 - 127));
        __builtin_amdgcn_s_setprio(1);
        if (active) {
#pragma unroll
            for (int r = 0; r < 16; ++r) { p0[r] = 0.f; p1[r] = 0.f; }
            const lds_cptr kp = kp0 + kbC;
            bf16x8 ka[2 * NKS];
#pragma unroll
            for (int ks = 0; ks < NKS; ++ks) { ka[2 * ks] = *(const LAS bf16x8*)(kp + ks * 32); ka[2 * ks + 1] = *(const LAS bf16x8*)(kp + 32 * KROW + ks * 32); }
#pragma unroll
            for (int ks = 0; ks < NKS; ++ks) {
                p0 = __builtin_amdgcn_mfma_f32_32x32x16_bf16(ka[2 * ks], qf[ks], p0, 0, 0, 0);
                p1 = __builtin_amdgcn_mfma_f32_32x32x16_bf16(ka[2 * ks + 1], qf[ks], p1, 0, 0, 0);
            }
            __builtin_amdgcn_sched_group_barrier(0x100, PP_AHEAD, 0);
#pragma unroll
            for (int i = 0; i < 2 * NKS - PP_AHEAD; ++i) { __builtin_amdgcn_sched_group_barrier(0x008, 1, 0); __builtin_amdgcn_sched_group_barrier(0x100, 1, 0); }
            __builtin_amdgcn_sched_group_barrier(0x008, PP_AHEAD, 0);
        }
        __builtin_amdgcn_sched_barrier(0);
        if (act_prev) {
            const lds_cptr vp = vp0 + vbP;
            bf16x8 vf[8];
#pragma unroll
            for (int ks = 0; ks < 4; ++ks)
#pragma unroll
                for (int d0 = 0; d0 < 2; ++d0) {
                    const s16x4 lo = vtr(vp + d0 * 4096 + ks * 1024), hh = vtr(vp + d0 * 4096 + ks * 1024 + 512);
                    vf[2 * ks + d0] = (bf16x8){lo[0], lo[1], lo[2], lo[3], hh[0], hh[1], hh[2], hh[3]};
                }
#pragma unroll
            for (int ks = 0; ks < 4; ++ks) {
                o[0] = __builtin_amdgcn_mfma_f32_32x32x16_bf16(__builtin_bit_cast(bf16x8, pw[ks]), vf[2 * ks], o[0], 0, 0, 0);
                o[1] = __builtin_amdgcn_mfma_f32_32x32x16_bf16(__builtin_bit_cast(bf16x8, pw[ks]), vf[2 * ks + 1], o[1], 0, 0, 0);
            }
            __builtin_amdgcn_sched_group_barrier(0x100, 6, 0);
#pragma unroll
            for (int i = 0; i < 5; ++i) { __builtin_amdgcn_sched_group_barrier(0x008, 1, 0); __builtin_amdgcn_sched_group_barrier(0x100, 2, 0); }
            __builtin_amdgcn_sched_group_barrier(0x008, 3, 0);
        }
        __builtin_amdgcn_sched_barrier(0);
        __builtin_amdgcn_s_setprio(0);
        if (t < t_hi) PP_WRITE(kbN, vbN);
        if (BG_CONV) bg_step_fin(p, bg, lane);
        if (t + 1 < t_hi) PP_LOAD(t + 2);
        if (BG_CONV) bg_step_iss(p, bg, lane);
        ATT_PBAR();
        if (active) {
            const int q = qw0 + r32;
            if (MLA) {
                if (s0 + 63 > qw0) {
#pragma unroll
                    for (int r = 0; r < 16; ++r) { const int key = s0 + crow(r, hi); if (key > q) p0[r] = -INFINITY; if (key + 32 > q) p1[r] = -INFINITY; }
                }
            } else {
#pragma unroll
                for (int r = 0; r < 16; ++r) { const int d0 = q - (s0 + crow(r, hi)), d1 = d0 - 32;
                    p0[r] = (d0 >= 0 && d0 < 128) ? p0[r] - slope2 * (float)d0 : -INFINITY;
                    p1[r] = (d1 >= 0 && d1 < 128) ? p1[r] - slope2 * (float)d1 : -INFINITY; }
            }
            float mxa = fmaxf(p0[0], p1[0]), mxb = fmaxf(p0[1], p1[1]);
#pragma unroll
            for (int r = 2; r < 16; r += 2) { mxa = vmax3(mxa, p0[r], p1[r]); mxb = vmax3(mxb, p0[r + 1], p1[r + 1]); }
            float mx = half_swap_max(fmaxf(mxa, mxb));
            if (__any(mx > m + 8.f)) {
                const float mn = fmaxf(m, mx), alpha = __builtin_amdgcn_exp2f(m - mn);
                m = mn; l *= alpha;
                if (hi == 0) wsf[r32] = alpha;
#pragma unroll
                for (int r = 0; r < 16; ++r) { const float a = wsf[crow(r, hi)]; o[0][r] *= a; o[1][r] *= a; }
            }
#pragma unroll
            for (int r = 0; r < 16; ++r) { p0[r] -= m; p1[r] -= m; }
            __builtin_amdgcn_sched_barrier(0);
#pragma unroll
            for (int r = 0; r < 16; ++r) { p0[r] = __builtin_amdgcn_exp2f(p0[r]); p1[r] = __builtin_amdgcn_exp2f(p1[r]); }
            __builtin_amdgcn_sched_barrier(0);
            { typedef float f32x2 __attribute__((ext_vector_type(2)));
              f32x2 sa = (f32x2){p0[0], p0[1]} + (f32x2){p1[0], p1[1]}, sb = (f32x2){p0[2], p0[3]} + (f32x2){p1[2], p1[3]};
#pragma unroll
              for (int r = 4; r < 16; r += 4) { sa += (f32x2){p0[r], p0[r + 1]} + (f32x2){p1[r], p1[r + 1]}; sb += (f32x2){p0[r + 2], p0[r + 3]} + (f32x2){p1[r + 2], p1[r + 3]}; }
              sa += sb; l += sa[0] + sa[1]; }
#pragma unroll
            for (int i = 0; i < 4; ++i) { pw[0][i] = pg8::cvt_pk_bf16(p0[2 * i], p0[2 * i + 1]); pw[1][i] = pg8::cvt_pk_bf16(p0[8 + 2 * i], p0[8 + 2 * i + 1]);
                                          pw[2][i] = pg8::cvt_pk_bf16(p1[2 * i], p1[2 * i + 1]); pw[3][i] = pg8::cvt_pk_bf16(p1[8 + 2 * i], p1[8 + 2 * i + 1]); }
        }
        act_prev = active;
        ATT_PBAR();
        { const int tk = kbP; kbP = kbC; kbC = kbN; kbN = tk; const int tv = vbP; vbP = vbC; vbC = vbN; vbN = tv; }
    }
    if (!grp) ATT_PBAR();
    l = half_swap_sum(l);
    if (hi == 0) wsf[32 + r32] = 1.f / l;
    bf16_t* Ob = (bf16_t*)(p.ws + WS_AO) + (rb + qw0) * 1024 + (MLA ? 512 : 0) + head * 64 + r32;
#pragma unroll
    for (int r = 0; r < 16; ++r) { const int qr = crow(r, hi); const float rl = wsf[32 + qr];
        Ob[(size_t)qr * 1024] = (bf16_t)f2bf(o[0][r] * rl); Ob[(size_t)qr * 1024 + 32] = (bf16_t)f2bf(o[1][r] * rl); }
#undef PP_LOAD
#undef PP_WRITE
}
}
__device__ __forceinline__ void ph_attn2(const P& p, unsigned char* lds_) {
    LAS unsigned char* lds = (LAS unsigned char*)lds_;
    const int G = gridDim.x, bx = blockIdx.x;
    const int vcu = (G % 8 == 0) ? (bx % 8) * (G / 8) + bx / 8 : bx;
    const int lane_ = threadIdx.x & 63, wave_ = threadIdx.x >> 6;
    BgConv bg; bg.item = bx * 8 + wave_; bg.it = 0; bg.ngw = G * 8; bg.pend = false;
#pragma unroll
    for (int i = 0; i < 32; ++i) bg.r[i] = 0.f;
    float* bgscr = (float*)(lds_ + att::BG_SCR_OFF + wave_ * 8704);
    for (int pi = vcu; pi < 256; pi += G) {
        const int bh = pi >> 4, sidx = pi & 15;
        att::attn_unit_pp<true>(p, lds, bh >> 3, bh & 7, (31 - sidx) * 256, bg);
        att::attn_unit_pp<true>(p, lds, bh >> 3, bh & 7, sidx * 256, bg);
    }
    for (int u = vcu; u < 512; u += G) {
        const int bk = u >> 7, qb = u & 127;
        att::attn_unit_pp<false>(p, lds, bk >> 1, bk & 1, qb * 64, bg);
    }
    if (BG_CONV) bg_drain(p, bg, bgscr, lane_);
}

#define XB_TMO      128
#define XB_XCNT(j)  (256  + 64 * (j))
#define XB_XSUB(j)  (1280 + 64 * (j))
#define XB_XGEN(j)  (2304 + 64 * (j))
#define XB_TOP      3328
#define XB_TOPGEN   3392
#define XCD_BAR_WORDS 3456
#define XB_SPIN_CAP (1u << 18)
__device__ __forceinline__ unsigned xb_ld(unsigned* p)              { return __hip_atomic_load(p, __ATOMIC_RELAXED, __HIP_MEMORY_SCOPE_AGENT); }
__device__ __forceinline__ unsigned xb_add(unsigned* p, unsigned v) { return __hip_atomic_fetch_add(p, v, __ATOMIC_RELAXED, __HIP_MEMORY_SCOPE_AGENT); }
__device__ __forceinline__ unsigned xb_xcc_id() { return (unsigned)__builtin_amdgcn_s_getreg((3 << 11) | 20) & 0xFu; }
#define XB_SPIN(cond, bar) do { unsigned _sp = 0; while (cond) { __builtin_amdgcn_s_sleep(1); \
    if ((++_sp & 255u) == 0u) { if (xb_ld(&(bar)[XB_TMO])) break; if (_sp > XB_SPIN_CAP) { atomicAdd(&(bar)[XB_TMO], 1u); break; } } } } while (0)
struct XcdBarrier { unsigned* bar; unsigned x; volatile LAS unsigned* st; };
__device__ __forceinline__ XcdBarrier xcd_barrier_post(unsigned* bar, volatile LAS unsigned* st) {
    XcdBarrier b; b.bar = bar; b.x = xb_xcc_id(); b.st = st;
    if (threadIdx.x == 0) (void)xb_add(&bar[XB_XCNT(b.x)], 1u);
    return b;
}
__device__ __forceinline__ void xcd_barrier_complete(unsigned* bar, unsigned x, unsigned& nloc, unsigned& nx) {
    const unsigned G = gridDim.x * gridDim.y * gridDim.z;
    unsigned sum, cnt, mine, sp = 0u;
    for (;;) {
        sum = 0u; cnt = 0u; mine = 0u;
#pragma unroll
        for (unsigned j = 0; j < 16; ++j) { const unsigned c = xb_ld(&bar[XB_XCNT(j)]); sum += c; cnt += (c > 0u) ? 1u : 0u; mine = (j == x) ? c : mine; }
        if (sum == G) break;
        __builtin_amdgcn_s_sleep(1);
        if ((++sp & 255u) == 0u) { if (xb_ld(&bar[XB_TMO])) break; if (sp > XB_SPIN_CAP) { atomicAdd(&bar[XB_TMO], 1u); break; } }
    }
    nloc = mine > 0u ? mine : 1u; nx = cnt > 0u ? cnt : 1u;
}
__device__ __forceinline__ void xcd_barrier(const XcdBarrier& b) {
    asm volatile("s_waitcnt vmcnt(0)" ::: "memory");
    __syncthreads();
    if (threadIdx.x == 0) {
        unsigned* bar = b.bar;
        __builtin_amdgcn_s_waitcnt(0);
        unsigned nloc = b.st[0], nx = b.st[1];
        if (nloc == 0u) { xcd_barrier_complete(bar, b.x, nloc, nx); b.st[0] = nloc; b.st[1] = nx; }
        const unsigned old = xb_add(&bar[XB_XSUB(b.x)], 1u);
        const unsigned gen = old / nloc;
        if (old + 1u == (gen + 1u) * nloc) {
            __builtin_amdgcn_fence(__ATOMIC_RELEASE, "agent");
            asm volatile("s_waitcnt vmcnt(0)" ::: "memory");
            const unsigned og = xb_add(&bar[XB_TOP], 1u);
            const unsigned tg = og / nx;
            if (og + 1u == (tg + 1u) * nx) xb_add(&bar[XB_TOPGEN], 1u);
            else XB_SPIN(xb_ld(&bar[XB_TOPGEN]) == tg, bar);
            __builtin_amdgcn_fence(__ATOMIC_ACQUIRE, "agent");
            xb_add(&bar[XB_XGEN(b.x)], 1u);
            asm volatile("s_waitcnt vmcnt(0)" ::: "memory");
        } else {
            XB_SPIN(xb_ld(&bar[XB_XGEN(b.x)]) == gen, bar);
            __builtin_amdgcn_fence(__ATOMIC_ACQUIRE, "agent");
            asm volatile("s_waitcnt vmcnt(0)" ::: "memory");
        }
    }
    __syncthreads();
}
constexpr int LDSCTL_OFF = 139264;
constexpr int CW_BAR = 4096;
constexpr size_t CTL_ZERO_BYTES = 65536;

__global__ void __launch_bounds__(NTHREADS, 2) mega_fwd(P p) {
    extern __shared__ __attribute__((aligned(16))) unsigned char lds[];
    if (threadIdx.x < 32) ((LAS unsigned*)((LAS unsigned char*)lds + LDSCTL_OFF))[threadIdx.x] = 0u;
    __syncthreads();
    const XcdBarrier bar = xcd_barrier_post((unsigned*)(p.ws + WS_CTL) + CW_BAR, (volatile LAS unsigned*)((LAS unsigned char*)lds + LDSCTL_OFF));
#ifndef PH_MASK
#define PH_MASK 0xFFFF
#endif
#ifndef PH_DUP
#define PH_DUP 0
#endif
#define RUN_PH(bit, call) do { if (PH_MASK & (bit)) { call; if (PH_DUP & (bit)) { __syncthreads(); call; } } } while (0)
#define GSYNC() do { xcd_barrier(bar); if (PH_DUP & 0x10000) xcd_barrier(bar); } while (0)
    RUN_PH(1, (ph_mod(p, lds), ph_convert(p, lds)));
    GSYNC();
    RUN_PH(2, ph_xn(p));
    GSYNC();
    RUN_PH(4, ph_proj2(p, lds));
    GSYNC();
    RUN_PH(16, ph_up2(p, lds));
    GSYNC();
    RUN_PH(32, ph_attn2(p, lds));
    GSYNC();
    RUN_PH(64, ph_mix2(p, lds));
    GSYNC();
    RUN_PH(128, ph_out2(p, lds));
    GSYNC();
    if (PH_DUP & 256) { ph_route(p, lds, false); __syncthreads(); }
    if (PH_MASK & 256) ph_route(p, lds, true);
    GSYNC();
    RUN_PH(512, ph_moe1_2(p, lds));
    GSYNC();
    RUN_PH(1024, ph_moe2_2(p, lds));
    GSYNC();
    RUN_PH(2048, ph_final(p));
}

extern "C" void kernel_launch(void* const* d_in, const int* in_sizes, int n_in, void* d_out, int out_size, void* d_ws, size_t ws_size, hipStream_t stream) {
    static int grid_blocks = 0;
    if (!grid_blocks) {
        int dev = 0, cus = 0, per_cu = 0;
        (void)hipGetDevice(&dev);
        (void)hipDeviceGetAttribute(&cus, hipDeviceAttributeMultiprocessorCount, dev);
        (void)hipFuncSetAttribute((const void*)mega_fwd, hipFuncAttributeMaxDynamicSharedMemorySize, LDS_BYTES);
        (void)hipOccupancyMaxActiveBlocksPerMultiprocessor(&per_cu, (const void*)mega_fwd, NTHREADS, LDS_BYTES);
        if (per_cu < 1) per_cu = 1;
        grid_blocks = cus * per_cu;
        if (grid_blocks > 256) grid_blocks = 256;
        if (grid_blocks < 256 || MTOK % grid_blocks != 0) { fprintf(stderr, "kernel_launch: grid %d unsupported (needs >= 256 workgroups dividing %d)\n", grid_blocks, MTOK); grid_blocks = -1; }
        else if (ws_size < WS_END || n_in != 24) { fprintf(stderr, "kernel_launch: ws %zu < %zu or n_in %d != 24\n", ws_size, (size_t)WS_END, n_in); grid_blocks = -1; }
    }
    if (grid_blocks < 0) return;
    P p{};
    p.x = (const float*)d_in[0]; p.c = (const float*)d_in[1]; p.pos = (const int*)d_in[2]; p.w_ada = (const float*)d_in[3]; p.b_ada = (const float*)d_in[4];
    p.norm_mix = (const float*)d_in[5]; p.norm_ffn = (const float*)d_in[6]; p.w_in = (const float*)d_in[7]; p.sinks = (const float*)d_in[8];
    p.q_norm = (const float*)d_in[9]; p.kv_norm = (const float*)d_in[10]; p.w_uq = (const float*)d_in[11]; p.w_uk = (const float*)d_in[12]; p.w_uv = (const float*)d_in[13];
    p.w_a = (const float*)d_in[14]; p.w_b = (const float*)d_in[15]; p.w_out = (const float*)d_in[16]; p.w_router = (const float*)d_in[17]; p.b_router = (const float*)d_in[18];
    p.w_m1 = (const float*)d_in[19]; p.b_m1 = (const float*)d_in[20]; p.w_m2 = (const float*)d_in[21]; p.b_m2 = (const float*)d_in[22]; p.fnorm = (const float*)d_in[23];
    p.out = (float*)d_out; p.ws = (unsigned char*)d_ws;
    if (hipMemsetAsync((char*)d_ws + WS_CTL, 0, CTL_ZERO_BYTES, stream) != hipSuccess) { fprintf(stderr, "kernel_launch: memset failed\n"); return; }
    hipLaunchKernelGGL(mega_fwd, dim3(grid_blocks), dim3(NTHREADS), LDS_BYTES, stream, p);
    const hipError_t e = hipPeekAtLastError();
    if (e != hipSuccess) fprintf(stderr, "launch failed: %s (grid %d)\n", hipGetErrorString(e), grid_blocks);
}
```

```cpp
#include <hip/hip_runtime.h>
#include <cstdio>
#include <cstdint>

typedef unsigned short bf16_t;
typedef short bf16x8 __attribute__((ext_vector_type(8)));
typedef float f32x4 __attribute__((ext_vector_type(4)));
typedef unsigned u32x4 __attribute__((ext_vector_type(4)));
typedef unsigned u32x2 __attribute__((ext_vector_type(2)));

constexpr int NTHREADS = 512;
constexpr int LDS_BYTES = 147456;
constexpr int BATCH = 2, SEQ = 8192, DM = 1024, MTOK = BATCH * SEQ;
constexpr int NEXP = 32, LISTCAP = 16384;
constexpr float EPS = 1e-6f;
constexpr float LOG2E = 1.4426950408889634f;

constexpr size_t MiB = 1u << 20;
constexpr size_t WS_CTL = 0;
constexpr size_t WS_MOD = 1 * MiB;
constexpr size_t WS_WT_IN = 2 * MiB;
constexpr size_t WS_WT_UQ = 9 * MiB;
constexpr size_t WS_WT_UKV = 10 * MiB;
constexpr size_t WS_WT_A = 11 * MiB;
constexpr size_t WS_WT_B = 12 * MiB;
constexpr size_t WS_WT_OUT = 13 * MiB;
constexpr size_t WS_WRT = 1 * MiB + 524288;
constexpr size_t WS_COS = 15 * MiB;
constexpr size_t WS_SIN = 16 * MiB;
constexpr size_t WS_SSQ = 17 * MiB;
constexpr size_t WS_LIST = 18 * MiB;
constexpr size_t WS_TOPW = 1835008;
constexpr size_t WS_LISTW = 809 * MiB;
constexpr size_t WS_WT_M1 = 20 * MiB;
constexpr size_t WS_WT_M2 = 148 * MiB;
constexpr size_t WS_XN = 212 * MiB;
constexpr size_t WS_QA = 244 * MiB;
constexpr size_t WS_KA = 260 * MiB;
constexpr size_t WS_VA = 264 * MiB;
constexpr size_t WS_CQ = 268 * MiB;
constexpr size_t WS_CKV = 280 * MiB;
constexpr size_t WS_KR = 288 * MiB;
constexpr size_t WS_GA = 289 * MiB;
constexpr size_t WS_GB = 321 * MiB;
constexpr size_t WS_QN = 353 * MiB;
constexpr size_t WS_QR = 369 * MiB;
constexpr size_t WS_KN = 377 * MiB;
constexpr size_t WS_VB = 393 * MiB;
constexpr size_t WS_AO = 409 * MiB;
constexpr size_t WS_BO = 425 * MiB;
constexpr size_t WS_MIX = 441 * MiB;
constexpr size_t WS_X1 = 473 * MiB;
constexpr size_t WS_HID = 537 * MiB;
constexpr size_t WS_Y = 681 * MiB;
constexpr size_t WS_XN8 = 811 * MiB;
constexpr size_t WS_WT_G8 = 827 * MiB;
constexpr size_t WS_END = 829 * MiB;

struct P {
    const float *x, *c; const int* pos;
    const float *w_ada, *b_ada, *norm_mix, *norm_ffn, *w_in, *sinks, *q_norm, *kv_norm, *w_uq, *w_uk, *w_uv, *w_a, *w_b, *w_out,
        *w_router, *b_router, *w_m1, *b_m1, *w_m2, *b_m2, *fnorm;
    float* out; unsigned char* ws;
};

__device__ __forceinline__ unsigned f2bf(float f) { unsigned u = __float_as_uint(f); return (u + 0x7fffu + ((u >> 16) & 1u)) >> 16; }
__device__ __forceinline__ unsigned pk2(float lo, float hi) { return f2bf(lo) | (f2bf(hi) << 16); }
__device__ __forceinline__ float bf2f(unsigned h) { return __uint_as_float(h << 16); }
__device__ __forceinline__ unsigned pk4_fp8(float a, float b, float c, float d) { int r = __builtin_amdgcn_cvt_pk_fp8_f32(a, b, 0, false); r = __builtin_amdgcn_cvt_pk_fp8_f32(c, d, r, true); return (unsigned)r; }
constexpr float W8_SCALE = 32.f, W8_INV = 0.03125f;
constexpr float MIX8_SCALE = 8.f, OUT8_INV = 1.f / (8.f * 32.f);
__device__ __forceinline__ float wave_sum(float v) {
#pragma unroll
    for (int o = 1; o < 64; o <<= 1) v += __shfl_xor(v, o);
    return v;
}
__device__ __forceinline__ float sigmoidf_(float v) { return __builtin_amdgcn_rcpf(1.f + __builtin_amdgcn_exp2f(-LOG2E * v)); }

__device__ __forceinline__ void ph_mod(const P& p, unsigned char* lds) {
    const int tid = threadIdx.x, lane = tid & 63, wave = tid >> 6;
    float* red = (float*)lds;
    float* mod = (float*)(p.ws + WS_MOD);
    for (int item = blockIdx.x; item < 192; item += gridDim.x) {
        const int n0 = item * 32, cn = lane & 31, kq = lane >> 5;
        float a0 = 0.f, a1 = 0.f;
#pragma unroll 1
        for (int i0 = 0; i0 < 64; i0 += 16) {
            float wv[16];
#pragma unroll
            for (int i = 0; i < 16; ++i) wv[i] = __builtin_nontemporal_load(p.w_ada + (size_t)(wave * 128 + 2 * (i0 + i) + kq) * 6144 + n0 + cn);
#pragma unroll
            for (int i = 0; i < 16; ++i) { const int k = wave * 128 + 2 * (i0 + i) + kq; const float c0 = p.c[k], c1 = p.c[1024 + k];
                a0 += c0 * sigmoidf_(c0) * wv[i]; a1 += c1 * sigmoidf_(c1) * wv[i]; }
        }
        a0 += __shfl_xor(a0, 32); a1 += __shfl_xor(a1, 32);
        if (lane < 32) { red[(wave * 2 + 0) * 32 + cn] = a0; red[(wave * 2 + 1) * 32 + cn] = a1; }
        __syncthreads();
        if (tid < 64) { const int b = tid >> 5, cc = tid & 31; float s = 0.f;
            for (int w = 0; w < 8; ++w) s += red[(w * 2 + b) * 32 + cc];
            mod[b * 6144 + n0 + cc] = s + p.b_ada[n0 + cc]; }
        __syncthreads();
    }
}
__device__ __forceinline__ int ropeperm(int d) { return d < 16 ? 8 * (d >> 2) + (d & 3) : 8 * ((d - 16) >> 2) + 4 + (d & 3); }
__device__ __forceinline__ void transpose_item(const float* W, int N, int K, bf16_t* WT, int k0, int n0, int dst_row0, const float* kscale, float* scr, int lane, bool rperm = false) {
    float tv[32];
#pragma unroll
    for (int i = 0; i < 32; ++i) tv[i] = W[(size_t)(k0 + 2 * i + (lane >> 5)) * N + n0 + (lane & 31)];
#pragma unroll
    for (int i = 0; i < 32; ++i) { const int kk = 2 * i + (lane >> 5); float v = tv[i]; if (kscale) v *= kscale[k0 + kk]; scr[kk * 33 + (lane & 31)] = v; }
    __builtin_amdgcn_s_waitcnt(0); __builtin_amdgcn_wave_barrier();
    const int c = lane & 7;
#pragma unroll
    for (int j = 0; j < 4; ++j) { const int n = (lane >> 3) + 8 * j; const float* s = scr + (8 * c) * 33 + n;
        u32x4 o; o.x = pk2(s[0 * 33], s[1 * 33]); o.y = pk2(s[2 * 33], s[3 * 33]); o.z = pk2(s[4 * 33], s[5 * 33]); o.w = pk2(s[6 * 33], s[7 * 33]);
        *(u32x4*)(WT + (size_t)(dst_row0 + (rperm ? ropeperm(n) : n)) * K + k0 + 8 * c) = o; }
    __builtin_amdgcn_s_waitcnt(0); __builtin_amdgcn_wave_barrier();
}
__device__ __forceinline__ void transpose_item_fp8(const float* W, int N, int K, unsigned char* WT, int k0, int n0, int dst_row0, float* scr, int lane) {
    float tv[32];
#pragma unroll
    for (int i = 0; i < 32; ++i) tv[i] = W[(size_t)(k0 + 2 * i + (lane >> 5)) * N + n0 + (lane & 31)];
#pragma unroll
    for (int i = 0; i < 32; ++i) { const int kk = 2 * i + (lane >> 5); scr[kk * 33 + (lane & 31)] = tv[i] * W8_SCALE; }
    __builtin_amdgcn_s_waitcnt(0); __builtin_amdgcn_wave_barrier();
    const int c = lane & 3;
#pragma unroll
    for (int j = 0; j < 2; ++j) { const int n = (lane >> 2) + 16 * j; const float* sp = scr + (16 * c) * 33 + n;
        u32x4 o; o.x = pk4_fp8(sp[0 * 33], sp[1 * 33], sp[2 * 33], sp[3 * 33]); o.y = pk4_fp8(sp[4 * 33], sp[5 * 33], sp[6 * 33], sp[7 * 33]);
        o.z = pk4_fp8(sp[8 * 33], sp[9 * 33], sp[10 * 33], sp[11 * 33]); o.w = pk4_fp8(sp[12 * 33], sp[13 * 33], sp[14 * 33], sp[15 * 33]);
        *(u32x4*)(WT + (size_t)(dst_row0 + n) * K + k0 + 16 * c) = o; }
    __builtin_amdgcn_s_waitcnt(0); __builtin_amdgcn_wave_barrier();
}
__device__ __forceinline__ int in_colmap(int s) {
    if (s < 768) return s;
    if (s < 1152) return 1024 + (s - 768);
    if (s < 1408) return 768 + (s - 1152);
    if (s < 1440) return s;
    if (s < 2464) return 1536 + (s - 1440);
    return 2560 + (s - 2464);
}
#ifndef BG_CONV
#define BG_CONV 1
#endif
constexpr int BG_I_M1 = 32 * 16 * 64, BG_I_M2 = 32 * 16 * 32, BG_TOTAL = BG_I_M1 + BG_I_M2;
struct BgConv { float r[32]; int item, it, ngw; bool pend; };
__device__ __forceinline__ void bg_decode(const P& p, int item, const float*& W, int& N, unsigned char*& WT, int& k0, int& n0, int& dst) {
    if (item < BG_I_M1) { const int e = item >> 10, q = item & 1023, kb = q >> 6, nb = q & 63; n0 = nb * 32; const int j = n0 & 1023, lin = n0 >> 10;
        dst = (j >> 7) * 256 + lin * 128 + (j & 127); W = p.w_m1 + (size_t)e * 1024 * 2048; N = 2048; WT = p.ws + WS_WT_M1 + (size_t)e * 2048 * 1024; k0 = kb * 64; }
    else { const int r = item - BG_I_M1, e = r >> 9, q = r & 511, kb = q >> 5, nb = q & 31; n0 = nb * 32; dst = n0;
        W = p.w_m2 + (size_t)e * 1024 * 1024; N = 1024; WT = p.ws + WS_WT_M2 + (size_t)e * 1024 * 1024; k0 = kb * 64; }
}
__device__ __forceinline__ void bg_issue(const P& p, BgConv& g, int lane) {
    const float* W; int N, k0, n0, dst; unsigned char* WT; bg_decode(p, g.item, W, N, WT, k0, n0, dst);
    const float* src = W + (size_t)(k0 + (lane >> 5)) * N + n0 + (lane & 31);
#pragma unroll
    for (int i = 0; i < 32; ++i) g.r[i] = __builtin_nontemporal_load(src + (size_t)(2 * i) * N);
}
__device__ __forceinline__ void bg_finish(const P& p, BgConv& g, float* scr, int lane) {
    const float* W; int N, k0, n0, dst; unsigned char* WT; bg_decode(p, g.item, W, N, WT, k0, n0, dst);
    unsigned w[8];
#pragma unroll
    for (int i = 0; i < 16; i += 2) {
        const auto s0 = __builtin_amdgcn_permlane32_swap(__float_as_uint(g.r[i] * W8_SCALE), __float_as_uint(g.r[i + 16] * W8_SCALE), false, false);
        const auto s1 = __builtin_amdgcn_permlane32_swap(__float_as_uint(g.r[i + 1] * W8_SCALE), __float_as_uint(g.r[i + 17] * W8_SCALE), false, false);
        w[i >> 1] = pk4_fp8(__uint_as_float(s0[0]), __uint_as_float(s0[1]), __uint_as_float(s1[0]), __uint_as_float(s1[1]));
    }
    unsigned char* o = WT + (size_t)(dst + (lane & 31)) * 1024 + k0 + 32 * (lane >> 5);
    __builtin_nontemporal_store((u32x4){w[0], w[1], w[2], w[3]}, (u32x4*)o); __builtin_nontemporal_store((u32x4){w[4], w[5], w[6], w[7]}, (u32x4*)(o + 16));
}
__device__ __forceinline__ void bg_step(const P& p, BgConv& g, float* scr, int lane) {
    if ((g.it & 3) == 2 && g.pend) { bg_finish(p, g, scr, lane); g.item += g.ngw; g.pend = false; }
    if ((g.it & 3) == 0 && g.item < BG_TOTAL) { bg_issue(p, g, lane); g.pend = true; }
    ++g.it;
}
__device__ __forceinline__ void bg_step_fin(const P& p, BgConv& g, int lane) { if ((g.it & 3) == 2 && g.pend) { bg_finish(p, g, nullptr, lane); g.item += g.ngw; g.pend = false; } }
__device__ __forceinline__ void bg_step_iss(const P& p, BgConv& g, int lane) { if ((g.it & 3) == 0 && g.item < BG_TOTAL) { bg_issue(p, g, lane); g.pend = true; } ++g.it; }
__device__ __forceinline__ void bg_drain(const P& p, BgConv& g, float* scr, int lane) {
    if (g.pend) { bg_finish(p, g, scr, lane); g.item += g.ngw; g.pend = false; }
    while (g.item < BG_TOTAL) { bg_issue(p, g, lane); bg_finish(p, g, scr, lane); g.item += g.ngw; }
}
__device__ __forceinline__ void ph_convert(const P& p, unsigned char* lds) {
    const int tid = threadIdx.x, lane = tid & 63, wave = tid >> 6;
    const int gw = blockIdx.x * 8 + wave, NGW = gridDim.x * 8;
    float* scr = (float*)(lds + wave * 8704);
    bf16_t* WT_IN = (bf16_t*)(p.ws + WS_WT_IN); bf16_t* WT_UQ = (bf16_t*)(p.ws + WS_WT_UQ); bf16_t* WT_UKV = (bf16_t*)(p.ws + WS_WT_UKV);
    bf16_t* WT_A = (bf16_t*)(p.ws + WS_WT_A); bf16_t* WT_B = (bf16_t*)(p.ws + WS_WT_B); bf16_t* WT_OUT = (bf16_t*)(p.ws + WS_WT_OUT);
    bf16_t* WT_M1 = (bf16_t*)(p.ws + WS_WT_M1); bf16_t* WT_M2 = (bf16_t*)(p.ws + WS_WT_M2);
    constexpr int I_IN = 16 * 109, I_UQ = 6 * 24, I_UK = 4 * 16, I_A = 8 * 32, I_OUT = 16 * 32, I_M1 = 32 * 16 * 64, I_M2 = 32 * 16 * 32;
    constexpr int TOTAL = I_IN + I_UQ + 2 * I_UK + 2 * I_A + I_OUT + (BG_CONV ? 0 : I_M1 + I_M2);
    for (int it = gw; it < TOTAL; it += NGW) {
        int r = it;
        if (r < I_IN) { const int kb = r / 109, nb = r % 109;
            if (nb * 32 < 1440) transpose_item(p.w_in, 3488, 1024, WT_IN, kb * 64, nb * 32, in_colmap(nb * 32), nullptr, scr, lane, nb * 32 == 1408);
            else transpose_item_fp8(p.w_in, 3488, 1024, p.ws + WS_WT_G8, kb * 64, nb * 32, nb * 32 - 1440, scr, lane);
            continue; } r -= I_IN;
        if (r < I_UQ) { const int kb = r / 24, nb = r % 24; const int n0 = nb * 32, hh = n0 / 96, d = n0 % 96;
            const int dst = d < 64 ? hh * 64 + d : 512 + hh * 32; transpose_item(p.w_uq, 768, 384, WT_UQ, kb * 64, n0, dst, p.q_norm, scr, lane, d >= 64); continue; } r -= I_UQ;
        if (r < I_UK) { const int kb = r / 16, nb = r % 16; transpose_item(p.w_uk, 512, 256, WT_UKV, kb * 64, nb * 32, nb * 32, p.kv_norm, scr, lane); continue; } r -= I_UK;
        if (r < I_UK) { const int kb = r / 16, nb = r % 16; transpose_item(p.w_uv, 512, 256, WT_UKV, kb * 64, nb * 32, 512 + nb * 32, p.kv_norm, scr, lane); continue; } r -= I_UK;
        if (r < I_A) { const int kb = r / 32, nb = r % 32; transpose_item(p.w_a, 1024, 1024, WT_A, kb * 64, nb * 32, nb * 32, nullptr, scr, lane); continue; } r -= I_A;
        if (r < I_A) { const int kb = r / 32, nb = r % 32; transpose_item(p.w_b, 1024, 1024, WT_A + 512, kb * 64, nb * 32, nb * 32, nullptr, scr, lane); continue; } r -= I_A;
        if (r < I_OUT) { const int kb = r / 32, nb = r % 32; transpose_item_fp8(p.w_out, 1024, 1024, (unsigned char*)WT_OUT, kb * 64, nb * 32, nb * 32, scr, lane); continue; } r -= I_OUT;
        if (r < I_M1) { const int e = r / 1024, q = r % 1024, kb = q / 64, nb = q % 64; const int n0 = nb * 32, j = n0 & 1023, lin = n0 >> 10;
            const int dst = (j >> 7) * 256 + lin * 128 + (j & 127);
            transpose_item_fp8(p.w_m1 + (size_t)e * 1024 * 2048, 2048, 1024, (unsigned char*)WT_M1 + (size_t)e * 2048 * 1024, kb * 64, n0, dst, scr, lane); continue; } r -= I_M1;
        { const int e = r / 512, q = r % 512, kb = q / 32, nb = q % 32;
            transpose_item_fp8(p.w_m2 + (size_t)e * 1024 * 1024, 1024, 1024, (unsigned char*)WT_M2 + (size_t)e * 1024 * 1024, kb * 64, nb * 32, nb * 32, scr, lane); }
    }
    for (int i = blockIdx.x * NTHREADS + tid; i < 1024 * 32; i += gridDim.x * NTHREADS) { const int k = i >> 5, e = i & 31; ((float*)(p.ws + WS_WRT))[e * 1028 + k] = p.w_router[i]; }
    for (int i = blockIdx.x * NTHREADS + tid; i < 96 * 128; i += gridDim.x * NTHREADS) ((u32x4*)(WT_IN + (size_t)1440 * 1024))[i] = (u32x4){0u, 0u, 0u, 0u};
}

__device__ __forceinline__ void ph_xn(const P& p) {
    const int tid = threadIdx.x, lane = tid & 63, wave = tid >> 6;
    const int gw = blockIdx.x * 8 + wave, NGW = gridDim.x * 8;
    const float* mod = (const float*)(p.ws + WS_MOD);
    bf16_t* XN = (bf16_t*)(p.ws + WS_XN); float* COS = (float*)(p.ws + WS_COS); float* SIN = (float*)(p.ws + WS_SIN);
    f32x4 pg[4], psc[4], psh[4]; int pb = -1;
    for (int m = gw; m < MTOK; m += NGW) {
        const int b = m >> 13;
        const f32x4* xr = (const f32x4*)(p.x + (size_t)m * DM);
        f32x4 v[4]; float s = 0.f;
#pragma unroll
        for (int j = 0; j < 4; ++j) v[j] = xr[lane + 64 * j];
        if (b != pb) { pb = b;
#pragma unroll
            for (int j = 0; j < 4; ++j) { const int col = 4 * lane + 256 * j; pg[j] = *(const f32x4*)(p.norm_mix + col); psc[j] = *(const f32x4*)(mod + b * 6144 + 1024 + col); psh[j] = *(const f32x4*)(mod + b * 6144 + col); } }
#pragma unroll
        for (int j = 0; j < 4; ++j) s += v[j].x * v[j].x + v[j].y * v[j].y + v[j].z * v[j].z + v[j].w * v[j].w;
        s = wave_sum(s);
        const float rstd = rsqrtf(s * (1.f / DM) + EPS);
#pragma unroll
        for (int j = 0; j < 4; ++j) { const int col = 4 * lane + 256 * j;
            const f32x4 g = pg[j], sc = psc[j], sh = psh[j];
            const f32x4 h = v[j] * rstd * g * (sc + 1.0f) + sh;
            u32x2 o; o.x = pk2(h.x, h.y); o.y = pk2(h.z, h.w); *(u32x2*)(XN + (size_t)m * DM + col) = o;
            *(unsigned*)(p.ws + WS_XN8 + (size_t)m * DM + col) = pk4_fp8(h.x, h.y, h.z, h.w); }
        if (lane < 16) {
            const float freq = exp2f(-(float)lane * 0.8304820237218406f);
            const float ang = (float)p.pos[m] * freq;
            double t = (double)ang * 0.15915494309189535; t -= rint(t);
            const float fr = (float)t;
            COS[m * 16 + lane] = __builtin_amdgcn_cosf(fr); SIN[m * 16 + lane] = __builtin_amdgcn_sinf(fr);
        }
    }
}

namespace pg8 {
#define PG8_LAS __attribute__((address_space(3)))
constexpr int BM = 256, BK = 64, HALF = 128, HTB = HALF * BK * 2, STAGE_BYTES = 8 * HTB, NXCD = 8, WGM = 8;
__device__ __forceinline__ int lds_byte(int r, int c) { const int st = (r >> 4) * 2 + (c >> 5), rr = r & 15, cc = c & 31, ob = rr * 64 + cc * 2; return st * 1024 + (ob ^ (((ob >> 9) & 1) << 5)); }
__device__ __forceinline__ void stage_rc(int b, int& R, int& C) { const int st = b / 1024, sb = b % 1024, swz = sb ^ (((sb >> 9) & 1) << 5); R = (st >> 1) * 16 + swz / 64; C = (st & 1) * 32 + (swz % 64) / 2; }
__device__ __forceinline__ int perm32(int rho) { const int n = rho >> 4, i = rho & 15; return 8 * (i >> 2) + 4 * n + (i & 3); }
struct GUnit { const char* a; const char* b; int pm, pn, e, cnt, tile, pad_; };
typedef float f32x2_t __attribute__((ext_vector_type(2))); typedef __bf16 bf16x2_t __attribute__((ext_vector_type(2)));
__device__ __forceinline__ unsigned cvt_pk_bf16(float lo, float hi) { f32x2_t v = {lo, hi}; bf16x2_t b = __builtin_convertvector(v, bf16x2_t); return __builtin_bit_cast(unsigned, b); }

struct DenseOrder {
    const char* A; const char* Bt; int K, nM, nN, nwg, G, c;
    __device__ void init(const void* A_, const void* Bt_, int M, int N, int K_, int G_, int c_) { A = (const char*)A_; Bt = (const char*)Bt_; K = K_; nM = M / BM; nN = N / BM; nwg = nM * nN; G = G_; c = c_; }
    __device__ bool next(int i, GUnit& u) const {
        const long L = (long)i * G + c; if (L >= nwg) return false;
        int wgid = (int)L; { const int q = nwg / NXCD, r = nwg % NXCD, xcd = wgid % NXCD, off = wgid / NXCD; wgid = (xcd < r ? xcd * (q + 1) : r * (q + 1) + (xcd - r) * q) + off; }
        const int nig = WGM * nN, gid = wgid / nig, fm = gid * WGM, gsz = (nM - fm) < WGM ? (nM - fm) : WGM;
        u.pm = fm + ((wgid % nig) % gsz); u.pn = (wgid % nig) / gsz; u.e = 0; u.cnt = 0; u.tile = 0; u.pad_ = 0;
        u.a = A + (size_t)u.pm * BM * K * 2; u.b = Bt + (size_t)u.pn * BM * K * 2; return true;
    }
    __device__ __forceinline__ unsigned a_rowoff(const GUnit&, int) const { return 0u; }
};

typedef int v8i32 __attribute__((ext_vector_type(8)));
typedef int v4i32 __attribute__((ext_vector_type(4)));
template <class Epi, class Sched, bool ALIGN_EPI, bool GATHER, bool FP8 = false>
__device__ __forceinline__ void gemm_phase(PG8_LAS unsigned char* lds, const int K, const Sched& S, const Epi& E) {
    int tid_ = threadIdx.x; asm volatile("" : "+v"(tid_));
    const int tid = tid_, wid = __builtin_amdgcn_readfirstlane(tid >> 6), lane = tid & 63, wr = wid >> 2, wc = wid & 3, fr = lane & 15, fq = lane >> 4;
    const int nt = K / BK;
    int RA[2]; unsigned CA[2], voffB[2];
#pragma unroll
    for (int i = 0; i < 2; ++i) { int R, C; stage_rc(tid * 16 + i * 8192, R, C); const int Rb = Epi::PERM ? ((R & ~31) + perm32(R & 31)) : R;
        RA[i] = R; CA[i] = (unsigned)C * 2u; voffB[i] = (unsigned)(Rb * K + C) * 2u; }
    const size_t kstep = (size_t)(BK * 2);
    const size_t hstep = (size_t)HALF * K * 2;
    const unsigned ldsw = (unsigned)wid * 1024u;
    const int aoff = lds_byte(wr * 64 + fr, FP8 ? fq * 16 : fq * 8), boff = lds_byte(wc * 32 + fr, FP8 ? fq * 16 : fq * 8);
#define PG8_SA(b, h) (((b) * 2 + (h)) * HTB)
#define PG8_SB(b, h) ((4 + (b) * 2 + (h)) * HTB)
#define PG8_STAGE(bufoff, gbase, voff) do { _Pragma("unroll") for (int _i = 0; _i < 2; ++_i) { unsigned o_ = (voff)[_i]; asm volatile("" : "+v"(o_));     \
        __builtin_amdgcn_global_load_lds((const unsigned*)((const char*)(gbase) + o_), (PG8_LAS unsigned*)(lds + (bufoff) + ldsw + _i * 8192), 16, 0, 0); } } while (0)
#define PG8_LD16(p) (*(const PG8_LAS v4i32*)(p))
#define PG8_LDA(dst, b, h) do { if constexpr (FP8) { _Pragma("unroll") for (int m = 0; m < 4; ++m) { const PG8_LAS unsigned char* p_ = lds + PG8_SA(b, h) + aoff + m * 2048; \
            dst##8[m] = __builtin_shufflevector(PG8_LD16(p_), PG8_LD16(p_ + 16), 0, 1, 2, 3, 4, 5, 6, 7); } } \
        else { _Pragma("unroll") for (int m = 0; m < 4; ++m) _Pragma("unroll") for (int k = 0; k < 2; ++k) dst[m][k] = *(const PG8_LAS bf16x8*)(lds + PG8_SA(b, h) + aoff + m * 2048 + k * 1024); } } while (0)
#define PG8_LDB(dst, b, h) do { if constexpr (FP8) { _Pragma("unroll") for (int n = 0; n < 2; ++n) { const PG8_LAS unsigned char* p_ = lds + PG8_SB(b, h) + boff + n * 2048; \
            dst##8[n] = __builtin_shufflevector(PG8_LD16(p_), PG8_LD16(p_ + 16), 0, 1, 2, 3, 4, 5, 6, 7); } } \
        else { _Pragma("unroll") for (int n = 0; n < 2; ++n) _Pragma("unroll") for (int k = 0; k < 2; ++k) dst[n][k] = *(const PG8_LAS bf16x8*)(lds + PG8_SB(b, h) + boff + n * 2048 + k * 1024); } } while (0)
#define PG8_MMA(ai, bj, At, Bt) do { __builtin_amdgcn_s_setprio(1); \
        if constexpr (FP8) { _Pragma("unroll") for (int m = 0; m < 4; ++m) _Pragma("unroll") for (int n = 0; n < 2; ++n) \
                asm volatile("v_mfma_scale_f32_16x16x128_f8f6f4 %0, %1, %2, %0, %3, %3 op_sel_hi:[0,0,0]" : "+v"(acc[ai][bj][m][n]) : "v"(Bt##8[n]), "v"(At##8[m]), "v"(scl8)); } \
        else { _Pragma("unroll") for (int m = 0; m < 4; ++m) _Pragma("unroll") for (int n = 0; n < 2; ++n) _Pragma("unroll") for (int k = 0; k < 2; ++k) \
                acc[ai][bj][m][n] = __builtin_amdgcn_mfma_f32_16x16x32_bf16(Bt[n][k], At[m][k], acc[ai][bj][m][n], 0, 0, 0); } \
        __builtin_amdgcn_s_setprio(0); } while (0)
#define PG8_WAIT_V(n) asm volatile("s_waitcnt vmcnt(" #n ")" ::: "memory")
#define PG8_WAIT_L(n) asm volatile("s_waitcnt lgkmcnt(" #n ")" ::: "memory")
#define PG8_BAR __builtin_amdgcn_s_barrier()
#define PG8_SCHED __builtin_amdgcn_sched_barrier(0)
#define PG8_VOFF(u, v) do { _Pragma("unroll") for (int _i = 0; _i < 2; ++_i) { int r_ = RA[_i]; if (GATHER) asm volatile("" : "+v"(r_));     \
        _Pragma("unroll") for (int _h = 0; _h < 2; ++_h) v[_h][_i] = GATHER ? (S.a_rowoff(u, _h * HALF + r_) + CA[_i]) : ((unsigned)((_h * HALF + r_) * K) * 2u + CA[_i]); } } while (0)
    GUnit cur, nxt; int ui = 0;
    if (!S.next(0, cur)) return;
    f32x4 acc[2][2][4][2];
#pragma unroll
    for (int a = 0; a < 2; ++a)
#pragma unroll
        for (int b = 0; b < 2; ++b)
#pragma unroll
            for (int m = 0; m < 4; ++m)
#pragma unroll
                for (int n = 0; n < 2; ++n) acc[a][b][m][n] = (f32x4){0.f, 0.f, 0.f, 0.f};
    bf16x8 At[4][2], B0[2][2], B1[2][2];
    v8i32 At8[4], B08[2], B18[2];
    const int scl8 = 0x7f7f7f7f;
    unsigned vAc[2][2], vAn[2][2];
    PG8_VOFF(cur, vAc);
    if (GATHER) { asm volatile("s_waitcnt vmcnt(0)" : "+v"(vAc[0][0]), "+v"(vAc[0][1]), "+v"(vAc[1][0]), "+v"(vAc[1][1]) :: "memory"); }
    const char* cA = cur.a; const char* cB = cur.b;
    PG8_STAGE(PG8_SB(0, 0), cB, voffB); PG8_STAGE(PG8_SB(0, 1), cB + hstep, voffB); PG8_STAGE(PG8_SA(0, 0), cA, vAc[0]); PG8_STAGE(PG8_SA(0, 1), cA, vAc[1]);
    if (wr == 1) PG8_BAR;
    PG8_WAIT_V(2); PG8_BAR;
    PG8_STAGE(PG8_SB(1, 0), cB + kstep, voffB); PG8_STAGE(PG8_SA(1, 0), cA + kstep, vAc[0]); PG8_STAGE(PG8_SB(1, 1), cB + hstep + kstep, voffB);
    PG8_WAIT_V(6); PG8_BAR;
    for (;;) {
        const bool has_next = S.next(ui + 1, nxt);
        const char* nA = has_next ? nxt.a : cA; const char* nB = has_next ? nxt.b : cB;
        if (GATHER) {
            if (has_next) { PG8_VOFF(nxt, vAn); }
            else {
#pragma unroll
                for (int h = 0; h < 2; ++h)
#pragma unroll
                    for (int i = 0; i < 2; ++i) vAn[h][i] = vAc[h][i]; }
            asm volatile("s_waitcnt vmcnt(0)" : "+v"(vAn[0][0]), "+v"(vAn[0][1]), "+v"(vAn[1][0]), "+v"(vAn[1][1]) :: "memory");
        }
#pragma unroll 1
        for (int t = 0; t < nt; t += 2) {
            const bool last = (t == nt - 2);
            if constexpr (Epi::HAS_MID) { if (t == (nt >> 1)) { int t_ = threadIdx.x; asm volatile("" : "+v"(t_)); E.mid(acc, cur, wr, wc, t_ & 15, (t_ >> 4) & 3); } }
            const char* a1 = cA + (size_t)(t + 1) * kstep;
            const char* a2 = last ? nA : cA + (size_t)(t + 2) * kstep; const char* b2 = last ? nB : cB + (size_t)(t + 2) * kstep;
            const char* a3 = a2 + kstep; const char* b3 = b2 + kstep;
            unsigned v2[2][2];
#pragma unroll
            for (int h = 0; h < 2; ++h)
#pragma unroll
                for (int i = 0; i < 2; ++i) v2[h][i] = (GATHER && last) ? vAn[h][i] : vAc[h][i];
            PG8_LDB(B0, 0, 0); PG8_LDB(B1, 0, 1); PG8_SCHED; PG8_LDA(At, 0, 0); PG8_STAGE(PG8_SA(1, 1), a1, vAc[1]);
            PG8_WAIT_V(8); PG8_WAIT_L(0); PG8_BAR; PG8_MMA(0, 0, At, B0); PG8_MMA(0, 1, At, B1); PG8_BAR; PG8_SCHED;
            PG8_LDA(At, 0, 1); PG8_STAGE(PG8_SB(0, 0), b2, voffB); PG8_STAGE(PG8_SB(0, 1), b2 + hstep, voffB); PG8_STAGE(PG8_SA(0, 0), a2, v2[0]);
            PG8_WAIT_V(8); PG8_WAIT_L(0); PG8_BAR; PG8_MMA(1, 0, At, B0); PG8_MMA(1, 1, At, B1); PG8_BAR; PG8_SCHED;
            PG8_LDB(B0, 1, 0); PG8_LDB(B1, 1, 1); PG8_SCHED; PG8_LDA(At, 1, 0); PG8_STAGE(PG8_SA(0, 1), a2, v2[1]);
            PG8_WAIT_V(8); PG8_WAIT_L(0); PG8_BAR; PG8_MMA(0, 0, At, B0); PG8_MMA(0, 1, At, B1); PG8_BAR; PG8_SCHED;
            PG8_LDA(At, 1, 1); PG8_STAGE(PG8_SB(1, 0), b3, voffB); PG8_STAGE(PG8_SB(1, 1), b3 + hstep, voffB); PG8_STAGE(PG8_SA(1, 0), a3, v2[0]);
            PG8_WAIT_V(8); PG8_WAIT_L(0); PG8_BAR; PG8_MMA(1, 0, At, B0); PG8_MMA(1, 1, At, B1); PG8_BAR; PG8_SCHED;
        }
        if constexpr (FP8) {
            asm volatile("s_nop 15\n\ts_nop 15" ::: "memory");
#pragma unroll
            for (int a = 0; a < 2; ++a)
#pragma unroll
                for (int b = 0; b < 2; ++b)
#pragma unroll
                    for (int m = 0; m < 4; ++m) asm volatile("" : "+v"(acc[a][b][m][0]), "+v"(acc[a][b][m][1]));
        }
        if constexpr (ALIGN_EPI) { if (wr == 0) PG8_BAR; }
        { int t_ = threadIdx.x; asm volatile("" : "+v"(t_));
          E(acc, cur, wr, wc, t_ & 15, (t_ >> 4) & 3); }
        if (!has_next) break;
#pragma unroll
        for (int a = 0; a < 2; ++a)
#pragma unroll
            for (int b = 0; b < 2; ++b)
#pragma unroll
                for (int m = 0; m < 4; ++m)
#pragma unroll
                    for (int n = 0; n < 2; ++n) acc[a][b][m][n] = (f32x4){0.f, 0.f, 0.f, 0.f};
        cur = nxt; cA = nA; cB = nB; ++ui;
#pragma unroll
        for (int h = 0; h < 2; ++h)
#pragma unroll
            for (int i = 0; i < 2; ++i) vAc[h][i] = vAn[h][i];
        if constexpr (ALIGN_EPI) { if (wr == 1) PG8_BAR; }
    }
    PG8_WAIT_V(0);
    if constexpr (!ALIGN_EPI) { if (wr == 0) PG8_BAR; }
    PG8_BAR;
#undef PG8_SA
#undef PG8_SB
#undef PG8_STAGE
#undef PG8_LDA
#undef PG8_LDB
#undef PG8_MMA
#undef PG8_LD16
#undef PG8_WAIT_V
#undef PG8_WAIT_L
#undef PG8_BAR
#undef PG8_SCHED
#undef PG8_VOFF
}
}
#define LAS __attribute__((address_space(3)))
__device__ __forceinline__ u32x4 pack8(const f32x4& v0, const f32x4& v1) { u32x4 w; w.x = pg8::cvt_pk_bf16(v0[0], v0[1]); w.y = pg8::cvt_pk_bf16(v0[2], v0[3]); w.z = pg8::cvt_pk_bf16(v1[0], v1[1]); w.w = pg8::cvt_pk_bf16(v1[2], v1[3]); return w; }
__device__ __forceinline__ void unpack8(const u32x4& w, f32x4& v0, f32x4& v1) { v0 = (f32x4){bf2f(w.x & 0xffffu), bf2f(w.x >> 16), bf2f(w.y & 0xffffu), bf2f(w.y >> 16)}; v1 = (f32x4){bf2f(w.z & 0xffffu), bf2f(w.z >> 16), bf2f(w.w & 0xffffu), bf2f(w.w >> 16)}; }
__device__ __forceinline__ float sigs_(float a) { return __builtin_amdgcn_rcpf(1.f + __builtin_amdgcn_exp2f(a * (-LOG2E * W8_INV))); }
__device__ __forceinline__ f32x4 sig4s(const f32x4& v) { return (f32x4){sigs_(v[0]), sigs_(v[1]), sigs_(v[2]), sigs_(v[3])}; }
__device__ __forceinline__ f32x4 sig4(const f32x4& v) { return (f32x4){sigmoidf_(v[0]), sigmoidf_(v[1]), sigmoidf_(v[2]), sigmoidf_(v[3])}; }

struct EpiProj {
    static constexpr bool PERM = true, HAS_MID = false;
    unsigned char* ws;
    __device__ __forceinline__ void operator()(const f32x4 (&acc)[2][2][4][2], const pg8::GUnit& u, int wr, int wc, int fr, int fq) const {
        const int row0 = u.pm * 256 + wr * 64 + fr;
#pragma unroll
        for (int bj = 0; bj < 2; ++bj) {
            const int cl = bj * 128 + wc * 32 + 8 * fq;
            bf16_t* base; int ld, c; float sc = 1.f; bool sg = false;
            const int pn = u.pn;
            if (pn < 2) { base = (bf16_t*)(ws + WS_QA); ld = 512; c = pn * 256 + cl; sc = 0.125f * LOG2E; }
            else if (pn == 2) { base = (bf16_t*)(ws + (bj == 0 ? WS_KA : WS_VA)); ld = 128; c = wc * 32 + 8 * fq; }
            else if (pn == 3) { base = (bf16_t*)(ws + WS_CKV); ld = 256; c = cl; }
            else if (pn == 4) { base = (bf16_t*)(ws + WS_CQ); ld = 384; c = cl; }
            else if (pn == 5) { if (bj == 0) { base = (bf16_t*)(ws + WS_CQ); ld = 384; c = 256 + wc * 32 + 8 * fq; } else { if (wc != 0) continue; base = (bf16_t*)(ws + WS_KR); ld = 32; c = 8 * fq; } }
            else if (pn < 10) { base = (bf16_t*)(ws + WS_GA); ld = 1024; c = (pn - 6) * 256 + cl; sg = true; }
            else { base = (bf16_t*)(ws + WS_GB); ld = 1024; c = (pn - 10) * 256 + cl; sg = true; }
            const bool is_kr = pn == 5 && bj == 1;
#pragma unroll
            for (int ai = 0; ai < 2; ++ai) {
                f32x4 cs[4], sn[4];
                if (is_kr) {
#pragma unroll
                    for (int m = 0; m < 4; ++m) { const int row = row0 + ai * 128 + m * 16; cs[m] = *(const f32x4*)((const float*)(ws + WS_COS) + row * 16 + 4 * fq); sn[m] = *(const f32x4*)((const float*)(ws + WS_SIN) + row * 16 + 4 * fq); }
                    asm volatile("" : "+v"(cs[0]), "+v"(cs[1]), "+v"(cs[2]), "+v"(cs[3]), "+v"(sn[0]), "+v"(sn[1]), "+v"(sn[2]), "+v"(sn[3]) :: "memory");
                }
#pragma unroll
                for (int m = 0; m < 4; ++m) { f32x4 v0 = acc[ai][bj][m][0], v1 = acc[ai][bj][m][1]; const int row = row0 + ai * 128 + m * 16;
                    if (is_kr) { const f32x4 o1 = v0 * cs[m] - v1 * sn[m], o2 = v1 * cs[m] + v0 * sn[m]; v0 = o1; v1 = o2; }
                    else if (sg) { v0 = sig4(v0); v1 = sig4(v1); } else { v0 = v0 * sc; v1 = v1 * sc; }
                    *(u32x4*)(base + (size_t)row * ld + c) = pack8(v0, v1); }
            }
        }
        if (u.pn >= 3 && u.pn <= 5) {
            float* SSQ = (float*)(ws + WS_SSQ);
#pragma unroll
            for (int ai = 0; ai < 2; ++ai)
#pragma unroll
                for (int m = 0; m < 4; ++m) { float q = 0.f;
#pragma unroll
                    for (int bj = 0; bj < 2; ++bj) { if (u.pn == 5 && bj == 1) continue;
#pragma unroll
                        for (int n = 0; n < 2; ++n) { const f32x4 v = acc[ai][bj][m][n]; q += (v[0] * v[0] + v[1] * v[1]) + (v[2] * v[2] + v[3] * v[3]); } }
                    q += __shfl_xor(q, 16); q += __shfl_xor(q, 32);
                    const int slot = u.pn == 3 ? 8 + wc : u.pn == 4 ? wc : 4 + wc;
                    if (fq == 0) SSQ[slot * MTOK + row0 + ai * 128 + m * 16] = q; }
        }
    }
};
struct EpiUpQ {
    static constexpr bool PERM = true, HAS_MID = false;
    unsigned char* ws;
    __device__ __forceinline__ void operator()(const f32x4 (&acc)[2][2][4][2], const pg8::GUnit& u, int wr, int wc, int fr, int fq) const {
        const float qs0 = 0.10206207261596577f * LOG2E;
        const int row0 = u.pm * 256 + wr * 64 + fr;
        const float* COS = (const float*)(ws + WS_COS); const float* SIN = (const float*)(ws + WS_SIN); const float* SSQ = (const float*)(ws + WS_SSQ);
        float rq[2][4];
#pragma unroll
        for (int ai = 0; ai < 2; ++ai)
#pragma unroll
            for (int m = 0; m < 4; ++m) { const int row = row0 + ai * 128 + m * 16; float q = 0.f;
#pragma unroll
                for (int sl = 0; sl < 8; ++sl) q += SSQ[sl * MTOK + row];
                rq[ai][m] = rsqrtf(q * (1.f / 384.f) + EPS); }
        asm volatile("" : "+v"(rq[0][0]), "+v"(rq[0][1]), "+v"(rq[0][2]), "+v"(rq[0][3]), "+v"(rq[1][0]), "+v"(rq[1][1]), "+v"(rq[1][2]), "+v"(rq[1][3]) :: "memory");
#pragma unroll
        for (int ai = 0; ai < 2; ++ai) { f32x4 cs[4], sn[4];
            if (u.pn >= 2) {
#pragma unroll
                for (int m = 0; m < 4; ++m) { const int row = row0 + ai * 128 + m * 16; cs[m] = *(const f32x4*)(COS + row * 16 + 4 * fq); sn[m] = *(const f32x4*)(SIN + row * 16 + 4 * fq); }
                asm volatile("" : "+v"(cs[0]), "+v"(cs[1]), "+v"(cs[2]), "+v"(cs[3]), "+v"(sn[0]), "+v"(sn[1]), "+v"(sn[2]), "+v"(sn[3]) :: "memory");
            }
#pragma unroll
            for (int bj = 0; bj < 2; ++bj) { const int cl = bj * 128 + wc * 32 + 8 * fq;
#pragma unroll
                for (int m = 0; m < 4; ++m) { const int row = row0 + ai * 128 + m * 16; const float qs = qs0 * rq[ai][m];
                    const f32x4 v0 = acc[ai][bj][m][0], v1 = acc[ai][bj][m][1];
                    if (u.pn < 2) { *(u32x4*)((bf16_t*)(ws + WS_QN) + (size_t)row * 512 + u.pn * 256 + cl) = pack8(v0 * qs, v1 * qs); }
                    else { const f32x4 o1 = (v0 * cs[m] - v1 * sn[m]) * qs, o2 = (v1 * cs[m] + v0 * sn[m]) * qs;
                        *(u32x4*)((bf16_t*)(ws + WS_QR) + (size_t)row * 256 + cl) = pack8(o1, o2); }
                }
                asm volatile("" ::: "memory"); }
        }
    }
};
struct EpiUpKV {
    static constexpr bool PERM = true, HAS_MID = false;
    unsigned char* ws;
    __device__ __forceinline__ void operator()(const f32x4 (&acc)[2][2][4][2], const pg8::GUnit& u, int wr, int wc, int fr, int fq) const {
        const int row0 = u.pm * 256 + wr * 64 + fr;
        bf16_t* base = (bf16_t*)(ws + (u.pn < 2 ? WS_KN : WS_VB)); const float* SSQ = (const float*)(ws + WS_SSQ);
        float rk[2][4];
#pragma unroll
        for (int ai = 0; ai < 2; ++ai)
#pragma unroll
            for (int m = 0; m < 4; ++m) { const int row = row0 + ai * 128 + m * 16;
                const float q = (SSQ[8 * MTOK + row] + SSQ[9 * MTOK + row]) + (SSQ[10 * MTOK + row] + SSQ[11 * MTOK + row]);
                rk[ai][m] = rsqrtf(q * (1.f / 256.f) + EPS); }
#pragma unroll
        for (int bj = 0; bj < 2; ++bj) { const int c = (u.pn & 1) * 256 + bj * 128 + wc * 32 + 8 * fq;
#pragma unroll
            for (int ai = 0; ai < 2; ++ai)
#pragma unroll
                for (int m = 0; m < 4; ++m) *(u32x4*)(base + (size_t)(row0 + ai * 128 + m * 16) * 512 + c) = pack8(acc[ai][bj][m][0] * rk[ai][m], acc[ai][bj][m][1] * rk[ai][m]); }
    }
};
struct EpiMixF {
    static constexpr bool PERM = true, HAS_MID = true;
    unsigned char* ws;
    __device__ __forceinline__ void mid(f32x4 (&acc)[2][2][4][2], const pg8::GUnit& u, int wr, int wc, int fr, int fq) const {
        const int row0 = u.pm * 256 + wr * 64 + fr;
        const bf16_t* GA = (const bf16_t*)(ws + WS_GA); const bf16_t* GB = (const bf16_t*)(ws + WS_GB);
#pragma unroll
        for (int bj = 0; bj < 2; ++bj) { const int c = u.pn * 256 + bj * 128 + wc * 32 + 8 * fq;
#pragma unroll
            for (int ai = 0; ai < 2; ++ai)
#pragma unroll
                for (int mh = 0; mh < 4; mh += 2) { u32x4 ga[2], gb[2];
#pragma unroll
                    for (int m = 0; m < 2; ++m) { const size_t idx = (size_t)(row0 + ai * 128 + (mh + m) * 16) * 1024 + c; ga[m] = *(const u32x4*)(GA + idx); gb[m] = *(const u32x4*)(GB + idx); }
                    asm volatile("" : "+v"(ga[0]), "+v"(ga[1]), "+v"(gb[0]), "+v"(gb[1]) :: "memory");
#pragma unroll
                    for (int m = 0; m < 2; ++m) { f32x4 a0, a1, b0, b1; unpack8(ga[m], a0, a1); unpack8(gb[m], b0, b1);
#pragma unroll
                        for (int i = 0; i < 4; ++i) { acc[ai][bj][mh + m][0][i] *= a0[i] * __builtin_amdgcn_rcpf(fmaxf(b0[i], 1e-30f)); acc[ai][bj][mh + m][1][i] *= a1[i] * __builtin_amdgcn_rcpf(fmaxf(b1[i], 1e-30f)); } } } }
    }
    __device__ __forceinline__ void operator()(const f32x4 (&acc)[2][2][4][2], const pg8::GUnit& u, int wr, int wc, int fr, int fq) const {
        const int row0 = u.pm * 256 + wr * 64 + fr;
        const bf16_t* GB = (const bf16_t*)(ws + WS_GB); bf16_t* MIX = (bf16_t*)(ws + WS_MIX);
#pragma unroll
        for (int bj = 0; bj < 2; ++bj) { const int c = u.pn * 256 + bj * 128 + wc * 32 + 8 * fq;
#pragma unroll
            for (int ai = 0; ai < 2; ++ai) { u32x4 gb[4];
#pragma unroll
                for (int m = 0; m < 4; ++m) gb[m] = *(const u32x4*)(GB + (size_t)(row0 + ai * 128 + m * 16) * 1024 + c);
                asm volatile("" : "+v"(gb[0]), "+v"(gb[1]), "+v"(gb[2]), "+v"(gb[3]) :: "memory");
#pragma unroll
                for (int m = 0; m < 4; ++m) { const size_t idx = (size_t)(row0 + ai * 128 + m * 16) * 1024 + c;
                    f32x4 g0, g1; unpack8(gb[m], g0, g1);
                    const f32x4 y0 = g0 * acc[ai][bj][m][0] * MIX8_SCALE, y1 = g1 * acc[ai][bj][m][1] * MIX8_SCALE;
                    u32x2 o8; o8.x = pk4_fp8(y0[0], y0[1], y0[2], y0[3]); o8.y = pk4_fp8(y1[0], y1[1], y1[2], y1[3]);
                    *(u32x2*)((unsigned char*)MIX + idx) = o8; } } }
    }
};
struct EpiOut {
    static constexpr bool PERM = true, HAS_MID = false;
    unsigned char* ws; const float* x;
    __device__ __forceinline__ void operator()(const f32x4 (&acc)[2][2][4][2], const pg8::GUnit& u, int wr, int wc, int fr, int fq) const {
        const int row0 = u.pm * 256 + wr * 64 + fr; const int b = (u.pm * 256) >> 13;
        const float* mod = (const float*)(ws + WS_MOD); bf16_t* X1 = (bf16_t*)(ws + WS_X1);
#pragma unroll
        for (int bj = 0; bj < 2; ++bj) { const int c = u.pn * 256 + bj * 128 + wc * 32 + 8 * fq;
            const f32x4 g0 = *(const f32x4*)(mod + b * 6144 + 2048 + c) * OUT8_INV, g1 = *(const f32x4*)(mod + b * 6144 + 2048 + c + 4) * OUT8_INV;
#pragma unroll
            for (int ai = 0; ai < 2; ++ai) { f32x4 x0[4], x1[4];
#pragma unroll
                for (int m = 0; m < 4; ++m) { const size_t idx = (size_t)(row0 + ai * 128 + m * 16) * 1024 + c; x0[m] = *(const f32x4*)(x + idx); x1[m] = *(const f32x4*)(x + idx + 4); }
                asm volatile("" : "+v"(x0[0]), "+v"(x0[1]), "+v"(x0[2]), "+v"(x0[3]), "+v"(x1[0]), "+v"(x1[1]), "+v"(x1[2]), "+v"(x1[3]) :: "memory");
#pragma unroll
                for (int m = 0; m < 4; ++m) { const size_t idx = (size_t)(row0 + ai * 128 + m * 16) * 1024 + c;
                    *(u32x4*)(X1 + idx) = pack8(x0[m] + g0 * acc[ai][bj][m][0], x1[m] + g1 * acc[ai][bj][m][1]); } } }
    }
};

constexpr int RT_LD = 1028;
__device__ __forceinline__ void ph_route(const P& p, unsigned char* lds, bool commit = true) {
    const int tid = threadIdx.x, lane = tid & 63, wave = tid >> 6, e = lane & 31, hf = lane >> 5;
    const int RPW = MTOK / gridDim.x;
    float* h2s = (float*)lds;
    unsigned* lcnt = (unsigned*)(lds + 132096); unsigned* lbase = lcnt + 32; unsigned* lent = lcnt + 64; float* lw = (float*)(lcnt + 64 + 256);
    float* lg = (float*)(lcnt + 64 + 512) + wave * 128 + hf * 64;
    if (tid < NEXP) lcnt[tid] = 0u;
    const float* mod = (const float*)(p.ws + WS_MOD); const bf16_t* X1 = (const bf16_t*)(p.ws + WS_X1); unsigned char* H2 = p.ws + WS_XN;
    unsigned* cnt = (unsigned*)(p.ws + WS_CTL); unsigned* LIST = (unsigned*)(p.ws + WS_LIST); float* LISTW = (float*)(p.ws + WS_LISTW);
    u32x4 wh[8], wl[8];
    { const float* wrt = (const float*)(p.ws + WS_WRT) + e * 1028 + 128 * wave + 8 * hf;
#pragma unroll
      for (int ks = 0; ks < 8; ++ks) { const f32x4 a = *(const f32x4*)(wrt + 16 * ks), b = *(const f32x4*)(wrt + 16 * ks + 4); f32x4 ha, hb;
          wh[ks] = pack8(a, b); unpack8(wh[ks], ha, hb); wl[ks] = pack8(a - ha, b - hb); } }
    const float brt = p.b_router[e];
    for (int pass = 0; pass * 32 < RPW; ++pass) {
        u32x2 xw[4][4];
#pragma unroll
        for (int rr = 0; rr < 4; ++rr) { const u32x2* xr = (const u32x2*)(X1 + (size_t)(blockIdx.x * RPW + pass * 32 + 4 * wave + rr) * DM);
#pragma unroll
            for (int j = 0; j < 4; ++j) xw[rr][j] = xr[lane + 64 * j]; }
        f32x4 rg[4], rsc[4], rsh[4];
        { const int b0 = (blockIdx.x * RPW + pass * 32) >> 13;
#pragma unroll
          for (int j = 0; j < 4; ++j) { const int col = 4 * lane + 256 * j; rg[j] = *(const f32x4*)(p.norm_ffn + col); rsc[j] = *(const f32x4*)(mod + b0 * 6144 + 4096 + col); rsh[j] = *(const f32x4*)(mod + b0 * 6144 + 3072 + col); } }
#pragma unroll
        for (int rr = 0; rr < 4; ++rr) {
            const int rl = 4 * wave + rr, m = blockIdx.x * RPW + pass * 32 + rl;
            f32x4 v[4]; float s = 0.f;
#pragma unroll
            for (int j = 0; j < 4; ++j) { const u32x2 w = xw[rr][j]; v[j] = (f32x4){bf2f(w.x & 0xffffu), bf2f(w.x >> 16), bf2f(w.y & 0xffffu), bf2f(w.y >> 16)};
                s += v[j].x * v[j].x + v[j].y * v[j].y + v[j].z * v[j].z + v[j].w * v[j].w; }
            s = wave_sum(s);
            const float rstd = rsqrtf(s * (1.f / DM) + EPS);
#pragma unroll
            for (int j = 0; j < 4; ++j) { const int col = 4 * lane + 256 * j;
                const f32x4 g = rg[j], sc = rsc[j], sh = rsh[j];
                v[j] = v[j] * rstd * g * (sc + 1.0f) + sh;
                *(unsigned*)(H2 + (size_t)m * DM + col) = pk4_fp8(v[j].x, v[j].y, v[j].z, v[j].w);
                *(f32x4*)(h2s + rl * RT_LD + col) = v[j]; }
        }
        __syncthreads();
        typedef float f32x16r __attribute__((ext_vector_type(16)));
        f32x16r acc, acc1, acc2;
#pragma unroll
        for (int r = 0; r < 16; ++r) { acc[r] = 0.f; acc1[r] = 0.f; acc2[r] = 0.f; }
        const float* ap = h2s + e * RT_LD + 128 * wave + 8 * hf;
#pragma unroll
        for (int ks = 0; ks < 8; ++ks) { const f32x4 a = *(const f32x4*)(ap + 16 * ks), b = *(const f32x4*)(ap + 16 * ks + 4); f32x4 ha, hb;
            const u32x4 ah = pack8(a, b); unpack8(ah, ha, hb); const u32x4 al = pack8(a - ha, b - hb);
            acc  = __builtin_amdgcn_mfma_f32_32x32x16_bf16(__builtin_bit_cast(bf16x8, ah), __builtin_bit_cast(bf16x8, wh[ks]), acc, 0, 0, 0);
            acc1 = __builtin_amdgcn_mfma_f32_32x32x16_bf16(__builtin_bit_cast(bf16x8, ah), __builtin_bit_cast(bf16x8, wl[ks]), acc1, 0, 0, 0);
            acc2 = __builtin_amdgcn_mfma_f32_32x32x16_bf16(__builtin_bit_cast(bf16x8, al), __builtin_bit_cast(bf16x8, wh[ks]), acc2, 0, 0, 0); }
#pragma unroll
        for (int r = 0; r < 16; ++r) acc[r] += acc1[r] + acc2[r];
        __syncthreads();
#pragma unroll
        for (int r = 0; r < 16; ++r) h2s[(wave * 32 + ((r & 3) + 8 * (r >> 2) + 4 * hf)) * 32 + e] = acc[r];
        __syncthreads();
#pragma unroll 1
        for (int it = 0; it < 2; ++it) {
            const int rl = 4 * wave + 2 * it + hf, ri = pass * 32 + rl;
            float val = brt;
#pragma unroll
            for (int w8 = 0; w8 < 8; ++w8) val += h2s[(w8 * 32 + rl) * 32 + e];
            lg[e] = val;
            int rank = 0;
#pragma unroll
            for (int e4 = 0; e4 < 8; ++e4) { const f32x4 o = *(const f32x4*)(lg + 4 * e4);
#pragma unroll
                for (int i = 0; i < 4; ++i) { const int ee = 4 * e4 + i; rank += (o[i] > val || (o[i] == val && ee < e)) ? 1 : 0; } }
            if (rank < 4) { lg[32 + rank] = val; lg[36 + rank] = __int_as_float(e); }
            const f32x4 tvv = *(const f32x4*)(lg + 32), tiv = *(const f32x4*)(lg + 36);
            const float e1 = __expf(tvv[1] - tvv[0]), e2 = __expf(tvv[2] - tvv[0]), e3 = __expf(tvv[3] - tvv[0]);
            const float inv = 1.f / (1.f + e1 + e2 + e3);
            if (e < 4) {
                const int ex = __float_as_int(e == 0 ? tiv[0] : e == 1 ? tiv[1] : e == 2 ? tiv[2] : tiv[3]);
                const float w = (e == 0 ? 1.f : e == 1 ? e1 : e == 2 ? e2 : e3) * inv;
                const unsigned lr = atomicAdd(&lcnt[ex], 1u);
                lent[ri * 4 + e] = (unsigned)ex | (lr << 8); lw[ri * 4 + e] = w;
            }
        }
        __syncthreads();
    }
    if (!commit) return;
    if (tid < NEXP) lbase[tid] = atomicAdd(&cnt[tid * 64], lcnt[tid]);
    __syncthreads();
    for (int a = tid; a < RPW * 4; a += NTHREADS) {
        const unsigned en = lent[a]; const int ex = (int)(en & 255u); const unsigned pos = lbase[ex] + (en >> 8);
        LIST[(size_t)ex * LISTCAP + pos] = (unsigned)((blockIdx.x * RPW + (a >> 2)) * 4 + (a & 3));
        ((float*)(p.ws + WS_TOPW))[(size_t)blockIdx.x * RPW * 4 + a] = lw[a];
    }
}
__device__ __forceinline__ void ph_final(const P& p) {
    const int tid = threadIdx.x, lane = tid & 63, wave = tid >> 6;
    const int gw = blockIdx.x * 8 + wave, NGW = gridDim.x * 8;
    const float* mod = (const float*)(p.ws + WS_MOD); const bf16_t* X1 = (const bf16_t*)(p.ws + WS_X1); const unsigned char* Y = (const unsigned char*)(p.ws + WS_Y);
    f32x4 fg[4], g2v[4]; int pb = -1;
#pragma unroll
    for (int j = 0; j < 4; ++j) fg[j] = *(const f32x4*)(p.fnorm + 4 * lane + 256 * j);
    for (int m = gw; m < MTOK; m += NGW) {
        const int b = m >> 13;
        if (b != pb) { pb = b;
#pragma unroll
            for (int j = 0; j < 4; ++j) g2v[j] = *(const f32x4*)(mod + b * 6144 + 5120 + 4 * lane + 256 * j); }
        const u32x2* xr = (const u32x2*)(X1 + (size_t)m * DM);
        f32x4 v[4]; float s = 0.f;
        const f32x4 tw = *(const f32x4*)((const float*)(p.ws + WS_TOPW) + (size_t)m * 4);
#pragma unroll
        for (int j = 0; j < 4; ++j) { const int col = 4 * lane + 256 * j;
            f32x4 y = (f32x4){0.f, 0.f, 0.f, 0.f};
#pragma unroll
            for (int k = 0; k < 4; ++k) { const int w = (int)__builtin_nontemporal_load((const unsigned*)(Y + ((size_t)m * 4 + k) * 1024 + col));
                y.x += tw[k] * __builtin_amdgcn_cvt_f32_fp8(w, 0); y.y += tw[k] * __builtin_amdgcn_cvt_f32_fp8(w, 1); y.z += tw[k] * __builtin_amdgcn_cvt_f32_fp8(w, 2); y.w += tw[k] * __builtin_amdgcn_cvt_f32_fp8(w, 3); }
            const f32x4 g2 = g2v[j];
            const u32x2 xw = xr[lane + 64 * j];
            v[j] = (f32x4){bf2f(xw.x & 0xffffu), bf2f(xw.x >> 16), bf2f(xw.y & 0xffffu), bf2f(xw.y >> 16)} + g2 * y;
            s += v[j].x * v[j].x + v[j].y * v[j].y + v[j].z * v[j].z + v[j].w * v[j].w; }
        s = wave_sum(s);
        const float rstd = rsqrtf(s * (1.f / DM) + EPS);
#pragma unroll
        for (int j = 0; j < 4; ++j) { const int col = 4 * lane + 256 * j; const f32x4 g = fg[j];
            *(f32x4*)(p.out + (size_t)m * DM + col) = v[j] * rstd * g; }
    }
}


struct EpiGate {
    static constexpr bool PERM = true, HAS_MID = false;
    unsigned char* ws;
    __device__ __forceinline__ void operator()(const f32x4 (&acc)[2][2][4][2], const pg8::GUnit& u, int wr, int wc, int fr, int fq) const {
        const int row0 = u.pm * 256 + wr * 64 + fr;
        bf16_t* base = (bf16_t*)(ws + (u.pn < 4 ? WS_GA : WS_GB));
#pragma unroll
        for (int bj = 0; bj < 2; ++bj) { const int c = (u.pn & 3) * 256 + bj * 128 + wc * 32 + 8 * fq;
#pragma unroll
            for (int ai = 0; ai < 2; ++ai)
#pragma unroll
                for (int m = 0; m < 4; ++m) *(u32x4*)(base + (size_t)(row0 + ai * 128 + m * 16) * 1024 + c) = pack8(sig4s(acc[ai][bj][m][0]), sig4s(acc[ai][bj][m][1])); }
    }
};
struct GateOrder {
    const char* A; const char* Bt; int G, c;
    __device__ __forceinline__ bool next(int i, pg8::GUnit& u) const {
        int un;
        if (G == 256) { if (c < 128) { if (i > 0) return false; un = c; } else { if (i > 2) return false; un = 128 + 3 * (c - 128) + i; } }
        else { un = i * G + c; if (un >= 512) return false; }
        u.pm = un >> 3; u.pn = un & 7; u.e = 0; u.cnt = 0; u.tile = 0; u.pad_ = 0;
        u.a = A + (size_t)u.pm * 256 * 1024; u.b = Bt + (size_t)u.pn * 256 * 1024; return true;
    }
    __device__ __forceinline__ unsigned a_rowoff(const pg8::GUnit&, int) const { return 0u; }
};
__device__ __forceinline__ void ph_proj2(const P& p, unsigned char* lds) {
    { pg8::DenseOrder S; S.init(p.ws + WS_XN, p.ws + WS_WT_IN, MTOK, 1536, 1024, gridDim.x, blockIdx.x);
      EpiProj E{p.ws};
      pg8::gemm_phase<EpiProj, pg8::DenseOrder, true, false>((LAS unsigned char*)lds, 1024, S, E); }
    { GateOrder S{(const char*)(p.ws + WS_XN8), (const char*)(p.ws + WS_WT_G8), (int)gridDim.x, (int)blockIdx.x};
      EpiGate E{p.ws};
      pg8::gemm_phase<EpiGate, GateOrder, true, false, true>((LAS unsigned char*)lds, 512, S, E); }
}
__device__ __forceinline__ void ph_up2(const P& p, unsigned char* lds) {
    { pg8::DenseOrder S; S.init(p.ws + WS_CQ, p.ws + WS_WT_UQ, MTOK, 768, 384, gridDim.x, blockIdx.x); EpiUpQ E{p.ws};
      pg8::gemm_phase<EpiUpQ, pg8::DenseOrder, false, false>((LAS unsigned char*)lds, 384, S, E); }
    { pg8::DenseOrder S; S.init(p.ws + WS_CKV, p.ws + WS_WT_UKV, MTOK, 1024, 256, gridDim.x, blockIdx.x); EpiUpKV E{p.ws};
      pg8::gemm_phase<EpiUpKV, pg8::DenseOrder, false, false>((LAS unsigned char*)lds, 256, S, E); }
}
__device__ __forceinline__ void ph_mix2(const P& p, unsigned char* lds) {
    pg8::DenseOrder S; S.init(p.ws + WS_AO, p.ws + WS_WT_A, MTOK, 1024, 1024, gridDim.x, blockIdx.x); EpiMixF E{p.ws};
    pg8::gemm_phase<EpiMixF, pg8::DenseOrder, false, false>((LAS unsigned char*)lds, 1024, S, E);
}
__device__ __forceinline__ void ph_out2(const P& p, unsigned char* lds) {
    pg8::DenseOrder S; S.init(p.ws + WS_MIX, p.ws + WS_WT_OUT, MTOK, 1024, 512, gridDim.x, blockIdx.x); EpiOut E{p.ws, p.x};
    pg8::gemm_phase<EpiOut, pg8::DenseOrder, false, false, true>((LAS unsigned char*)lds, 512, S, E);
}


constexpr int MOE_TAB_OFF = 135168;
__device__ __forceinline__ void moe_build_tab(const P& p, unsigned char* lds) {
    LAS int* tab = (LAS int*)((LAS unsigned char*)lds + MOE_TAB_OFF);
    const unsigned* cnt = (const unsigned*)(p.ws + WS_CTL);
    const int tid = threadIdx.x;
    if (tid < 64) {
        const int c = tid < NEXP ? (int)cnt[tid * 64] : 0, n = (c + 255) >> 8;
        int incl = n;
#pragma unroll
        for (int o = 1; o < 32; o <<= 1) { const int t = __shfl_up(incl, o); if (tid >= o) incl += t; }
        const int s = incl - n;
        if (tid < NEXP) { tab[tid] = c; tab[32 + tid] = s; for (int j = 0; j < n; ++j) tab[128 + s + j] = tid; if (tid == NEXP - 1) tab[64] = incl; }
    }
    __syncthreads();
}
template <bool GATHER> struct MoeOrder {
    const LAS int* tab; const char* Abase; const char* Bbase; const unsigned* LIST; int K, NCT, G, c;
    __device__ __forceinline__ bool next(int i, pg8::GUnit& u) const {
        const int vc = (G % 8 == 0) ? (c % 8) * (G / 8) + c / 8 : c;
        const int L = i * G + vc; const int ntile = __builtin_amdgcn_readfirstlane(tab[64]); if (L >= ntile * NCT) return false;
        const int tile = L / NCT, pn = L - tile * NCT, e = __builtin_amdgcn_readfirstlane(tab[128 + tile]);
        u.e = e; u.cnt = __builtin_amdgcn_readfirstlane(tab[e]); u.pm = tile - __builtin_amdgcn_readfirstlane(tab[32 + e]); u.pn = pn; u.tile = tile; u.pad_ = 0;
        u.b = Bbase + ((size_t)e * NCT + pn) * 256 * K * 2;
        u.a = GATHER ? Abase : Abase + (size_t)tile * 256 * K * 2;
        return true;
    }
    __device__ __forceinline__ unsigned a_rowoff(const pg8::GUnit& u, int r) const {
        const int row = u.pm * 256 + r; const unsigned ent = row < u.cnt ? LIST[(size_t)u.e * LISTCAP + row] : 0u; return (ent >> 2) * (unsigned)(K * 2);
    }
};
struct EpiMoe1 {
    static constexpr bool PERM = true, HAS_MID = false;
    unsigned char* ws; const float* b1;
    __device__ __forceinline__ void operator()(const f32x4 (&acc)[2][2][4][2], const pg8::GUnit& u, int wr, int wc, int fr, int fq) const {
        bf16_t* HID = (bf16_t*)(ws + WS_HID);
        const int row0 = u.tile * 256 + wr * 64 + fr, col = u.pn * 128 + wc * 32 + 8 * fq;
        constexpr float CG = -1.702f * LOG2E, CGI = 1.f / CG;
        f32x4 bg[2], bl[2];
#pragma unroll
        for (int n = 0; n < 2; ++n) { bg[n] = *(const f32x4*)(b1 + u.e * 2048 + col + 4 * n) * CG; bl[n] = (*(const f32x4*)(b1 + u.e * 2048 + 1024 + col + 4 * n) + 1.f) * CGI; }
#pragma unroll
        for (int ai = 0; ai < 2; ++ai)
#pragma unroll
            for (int m = 0; m < 4; ++m) { f32x4 h[2];
#pragma unroll
                for (int n = 0; n < 2; ++n) { const f32x4 gv = acc[ai][0][m][n] * (W8_INV * CG) + bg[n], lv = acc[ai][1][m][n] * (W8_INV * CGI) + bl[n];
#pragma unroll
                    for (int i = 0; i < 4; ++i) { const float t = fmaxf(gv[i], 7.f * CG), L = __builtin_amdgcn_fmed3f(lv[i], 8.f * CGI, -6.f * CGI);
                        h[n][i] = t * __builtin_amdgcn_rcpf(1.f + __builtin_amdgcn_exp2f(t)) * L; } }
                u32x2 o8; o8.x = pk4_fp8(h[0][0], h[0][1], h[0][2], h[0][3]); o8.y = pk4_fp8(h[1][0], h[1][1], h[1][2], h[1][3]);
                *(u32x2*)((unsigned char*)HID + (size_t)(row0 + ai * 128 + m * 16) * 1024 + col) = o8; }
    }
};
struct EpiMoe2 {
    static constexpr bool PERM = true, HAS_MID = false;
    unsigned char* ws; const float* b2;
    __device__ __forceinline__ void operator()(const f32x4 (&acc)[2][2][4][2], const pg8::GUnit& u, int wr, int wc, int fr, int fq) const {
        unsigned char* Y = ws + WS_Y; const unsigned* LIST = (const unsigned*)(ws + WS_LIST) + (size_t)u.e * LISTCAP;
        f32x4 bv[2][2]; unsigned ent[2][4];
#pragma unroll
        for (int bj = 0; bj < 2; ++bj)
#pragma unroll
            for (int n = 0; n < 2; ++n) bv[bj][n] = *(const f32x4*)(b2 + u.e * 1024 + u.pn * 256 + bj * 128 + wc * 32 + 8 * fq + 4 * n);
#pragma unroll
        for (int ai = 0; ai < 2; ++ai)
#pragma unroll
            for (int m = 0; m < 4; ++m) { const int rr = u.pm * 256 + ai * 128 + wr * 64 + m * 16 + fr, rc = rr < u.cnt ? rr : u.cnt - 1; ent[ai][m] = LIST[rc]; }
        asm volatile("" : "+v"(bv[0][0]), "+v"(bv[0][1]), "+v"(bv[1][0]), "+v"(bv[1][1]));
#pragma unroll
        for (int ai = 0; ai < 2; ++ai)
#pragma unroll
            for (int m = 0; m < 4; ++m) asm volatile("" : "+v"(ent[ai][m]));
#pragma unroll
        for (int ai = 0; ai < 2; ++ai)
#pragma unroll
            for (int m = 0; m < 4; ++m) { const int rr = u.pm * 256 + ai * 128 + wr * 64 + m * 16 + fr;
                if (rr < u.cnt) {
#pragma unroll
                    for (int bj = 0; bj < 2; ++bj) { const int c = u.pn * 256 + bj * 128 + wc * 32 + 8 * fq;
                        const f32x4 y0 = acc[ai][bj][m][0] * W8_INV + bv[bj][0], y1 = acc[ai][bj][m][1] * W8_INV + bv[bj][1];
                        u32x2 o8; o8.x = pk4_fp8(y0[0], y0[1], y0[2], y0[3]); o8.y = pk4_fp8(y1[0], y1[1], y1[2], y1[3]);
                        *(u32x2*)(Y + (size_t)ent[ai][m] * 1024 + c) = o8; } } }
    }
};
__device__ __forceinline__ void ph_moe1_2(const P& p, unsigned char* lds) {
    moe_build_tab(p, lds);
    MoeOrder<true> S{(const LAS int*)((LAS unsigned char*)lds + MOE_TAB_OFF), (const char*)(p.ws + WS_XN), (const char*)(p.ws + WS_WT_M1), (const unsigned*)(p.ws + WS_LIST), 512, 8, (int)gridDim.x, (int)blockIdx.x};
    EpiMoe1 E{p.ws, p.b_m1};
    pg8::gemm_phase<EpiMoe1, MoeOrder<true>, true, true, true>((LAS unsigned char*)lds, 512, S, E);
}
__device__ __forceinline__ void ph_moe2_2(const P& p, unsigned char* lds) {
    MoeOrder<false> S{(const LAS int*)((LAS unsigned char*)lds + MOE_TAB_OFF), (const char*)(p.ws + WS_HID), (const char*)(p.ws + WS_WT_M2), (const unsigned*)(p.ws + WS_LIST), 512, 4, (int)gridDim.x, (int)blockIdx.x};
    EpiMoe2 E{p.ws, p.b_m2};
    pg8::gemm_phase<EpiMoe2, MoeOrder<false>, true, false, true>((LAS unsigned char*)lds, 512, S, E);
}


namespace att {
typedef float f32x16 __attribute__((ext_vector_type(16)));
typedef short s16x4 __attribute__((ext_vector_type(4)));
typedef short v4i16_t __attribute__((ext_vector_type(4)));
typedef LAS const unsigned char* lds_cptr;
constexpr int KROW = 208;
constexpr int KBUF = 64 * KROW, VBUF = 8192;
constexpr int OFF_K = 0, OFF_V = 2 * KBUF, OFF_WS = 2 * KBUF + 2 * VBUF, LDS_BYTES_ATT = OFF_WS + 8 * 256;
__device__ __forceinline__ int crow(int r, int hi) { return (r & 3) + 8 * (r >> 2) + 4 * hi; }
__device__ __forceinline__ s16x4 vtr(lds_cptr p) { return __builtin_bit_cast(s16x4, __builtin_amdgcn_ds_read_tr16_b64_v4i16((LAS v4i16_t*)p)); }
__device__ __forceinline__ float vmax3(float a, float b, float c) { float d; asm("v_max3_f32 %0, %1, %2, %3" : "=v"(d) : "v"(a), "v"(b), "v"(c)); return d; }
__device__ __forceinline__ float half_swap_max(float m) { auto rr = __builtin_amdgcn_permlane32_swap(__float_as_uint(m), __float_as_uint(m), false, false); return fmaxf(__uint_as_float(rr[0]), __uint_as_float(rr[1])); }
__device__ __forceinline__ float half_swap_sum(float m) { auto rr = __builtin_amdgcn_permlane32_swap(__float_as_uint(m), __float_as_uint(m), false, false); return __uint_as_float(rr[0]) + __uint_as_float(rr[1]); }

constexpr int BG_SCR_OFF = 49152;
#define ATT_BARRIER() asm volatile("s_waitcnt lgkmcnt(0)\n\ts_barrier" ::: "memory")
template <bool MLA>
__device__ __forceinline__ void attn_unit(const P& p, LAS unsigned char* lds, int b, int hk, int q0, BgConv& bg, float* bgscr) {
    int tid_ = threadIdx.x; asm volatile("" : "+v"(tid_));
    const int tid = tid_, lane = tid & 63, r32 = lane & 31, hi = lane >> 5, wid = __builtin_amdgcn_readfirstlane(tid >> 6);
    constexpr int NKS = MLA ? 6 : 4;
    const int head = MLA ? hk : hk * 4 + (wid >> 1);
    const int qw0 = MLA ? q0 + 32 * wid : q0 + 32 * (wid & 1);
    const size_t rb = (size_t)b * SEQ;
    bf16x8 qf[NKS];
    if (MLA) {
        const bf16_t* qn = (const bf16_t*)(p.ws + WS_QN) + (rb + qw0 + r32) * 512 + head * 64 + 8 * hi;
        const bf16_t* qr = (const bf16_t*)(p.ws + WS_QR) + (rb + qw0 + r32) * 256 + head * 32 + 8 * hi;
#pragma unroll
        for (int ks = 0; ks < 4; ++ks) qf[ks] = *(const bf16x8*)(qn + 16 * ks);
#pragma unroll
        for (int ks = 4; ks < NKS; ++ks) qf[ks] = *(const bf16x8*)(qr + 16 * (ks - 4));
    } else {
        const bf16_t* qa = (const bf16_t*)(p.ws + WS_QA) + (rb + qw0 + r32) * 512 + head * 64 + 8 * hi;
#pragma unroll
        for (int ks = 0; ks < NKS; ++ks) qf[ks] = *(const bf16x8*)(qa + 16 * ks);
    }
    const int t_lo = MLA ? 0 : (q0 >= 128 ? (q0 - 128) >> 6 : 0), t_hi = MLA ? ((q0 + 256) >> 6) - 1 : (q0 >> 6);
    const int skey = tid >> 3, sc = tid & 7;
    const bf16_t* kg; const bf16_t* vg; const bf16_t* rg = nullptr;
    if (MLA) { kg = (const bf16_t*)(p.ws + WS_KN) + (rb + skey) * 512 + hk * 64 + 8 * sc; vg = (const bf16_t*)(p.ws + WS_VB) + (rb + skey) * 512 + hk * 64 + 8 * sc;
               rg = (const bf16_t*)(p.ws + WS_KR) + (rb + (tid >> 2)) * 32 + 8 * (tid & 3); }
    else { kg = (const bf16_t*)(p.ws + WS_KA) + (rb + skey) * 128 + hk * 64 + 8 * sc; vg = (const bf16_t*)(p.ws + WS_VA) + (rb + skey) * 128 + hk * 64 + 8 * sc; }
    const int kpitch = MLA ? 512 : 128;
    const int kst = skey * KROW + sc * 16;
    const int rst = (tid >> 2) * KROW + 128 + (tid & 3) * 16;
    const int vst = ((8 * sc) >> 5) * 4096 + (skey >> 4) * 1024 + (skey & 15) * 64 + ((8 * sc) & 31) * 2;
    u32x4 kreg, vreg, rreg = (u32x4){0u, 0u, 0u, 0u};
#define ATT_LOAD(t) do { kreg = *(const u32x4*)(kg + (size_t)(t) * 64 * kpitch); vreg = *(const u32x4*)(vg + (size_t)(t) * 64 * kpitch); \
        if (MLA && tid < 256) rreg = *(const u32x4*)(rg + (size_t)(t) * 64 * 32); } while (0)
#define ATT_WRITE(buf) do { *(LAS u32x4*)(lds + OFF_K + (buf) * KBUF + kst) = kreg; *(LAS u32x4*)(lds + OFF_V + (buf) * VBUF + vst) = vreg; \
        if (MLA && tid < 256) *(LAS u32x4*)(lds + OFF_K + (buf) * KBUF + rst) = rreg; } while (0)
    LAS float* wsf = (LAS float*)(lds + OFF_WS) + wid * 64;
    float m, l; f32x16 o[2];
#pragma unroll
    for (int r = 0; r < 16; ++r) { o[0][r] = 0.f; o[1][r] = 0.f; }
    float slope2 = 0.f;
    if (MLA) { m = -INFINITY; l = 0.f; }
    else { m = p.sinks[head] * LOG2E; l = hi == 0 ? 1.f : 0.f; slope2 = exp2f(-(float)(head + 1)) * LOG2E; }
    const lds_cptr kp0 = (lds_cptr)lds + OFF_K + r32 * KROW + hi * 16;
    const lds_cptr vp0 = (lds_cptr)lds + OFF_V + ((lane >> 4) & 1) * 32 + (lane & 3) * 8 + (4 * hi + ((lane & 15) >> 2)) * 64;
    ATT_LOAD(t_lo); ATT_WRITE(0);
    ATT_BARRIER();
    for (int t = t_lo; t <= t_hi; ++t) {
        const int cur = (t - t_lo) & 1, s0 = t * 64;
        if (t < t_hi) ATT_LOAD(t + 1);
        if (BG_CONV) bg_step(p, bg, bgscr, lane);
        const bool active = MLA ? (s0 <= qw0 + 31) : (s0 <= qw0 + 31 && s0 + 63 >= qw0 - 127);
        if (active) {
            f32x16 p0, p1;
#pragma unroll
            for (int r = 0; r < 16; ++r) { p0[r] = 0.f; p1[r] = 0.f; }
            const lds_cptr kp = kp0 + cur * KBUF;
#pragma unroll
            for (int ks = 0; ks < NKS; ++ks) {
                const bf16x8 a0 = *(const LAS bf16x8*)(kp + ks * 32), a1 = *(const LAS bf16x8*)(kp + 32 * KROW + ks * 32);
                p0 = __builtin_amdgcn_mfma_f32_32x32x16_bf16(a0, qf[ks], p0, 0, 0, 0);
                p1 = __builtin_amdgcn_mfma_f32_32x32x16_bf16(a1, qf[ks], p1, 0, 0, 0);
            }
            const int q = qw0 + r32;
            if (MLA) {
                if (s0 + 63 > qw0) {
#pragma unroll
                    for (int r = 0; r < 16; ++r) { const int key = s0 + crow(r, hi); if (key > q) p0[r] = -INFINITY; if (key + 32 > q) p1[r] = -INFINITY; }
                }
            } else {
#pragma unroll
                for (int r = 0; r < 16; ++r) { const int d0 = q - (s0 + crow(r, hi)), d1 = d0 - 32;
                    p0[r] = (d0 >= 0 && d0 < 128) ? p0[r] - slope2 * (float)d0 : -INFINITY;
                    p1[r] = (d1 >= 0 && d1 < 128) ? p1[r] - slope2 * (float)d1 : -INFINITY; }
            }
            float mx = fmaxf(p0[0], p1[0]);
#pragma unroll
            for (int r = 1; r < 16; ++r) mx = fmaxf(mx, fmaxf(p0[r], p1[r]));
            mx = half_swap_max(mx);
            if (__any(mx > m + 8.f)) {
                const float mn = fmaxf(m, mx), alpha = __builtin_amdgcn_exp2f(m - mn);
                m = mn; l *= alpha;
                if (hi == 0) wsf[r32] = alpha;
#pragma unroll
                for (int r = 0; r < 16; ++r) { const float a = wsf[crow(r, hi)]; o[0][r] *= a; o[1][r] *= a; }
            }
            float ps = 0.f;
#pragma unroll
            for (int r = 0; r < 16; ++r) { p0[r] = __builtin_amdgcn_exp2f(p0[r] - m); p1[r] = __builtin_amdgcn_exp2f(p1[r] - m); ps += p0[r] + p1[r]; }
            l += ps;
            u32x4 pw[4];
#pragma unroll
            for (int i = 0; i < 4; ++i) { pw[0][i] = pg8::cvt_pk_bf16(p0[2 * i], p0[2 * i + 1]); pw[1][i] = pg8::cvt_pk_bf16(p0[8 + 2 * i], p0[8 + 2 * i + 1]);
                                          pw[2][i] = pg8::cvt_pk_bf16(p1[2 * i], p1[2 * i + 1]); pw[3][i] = pg8::cvt_pk_bf16(p1[8 + 2 * i], p1[8 + 2 * i + 1]); }
            const lds_cptr vp = vp0 + cur * VBUF;
#pragma unroll
            for (int d0 = 0; d0 < 2; ++d0)
#pragma unroll
                for (int ks = 0; ks < 4; ++ks) {
                    const s16x4 lo = vtr(vp + d0 * 4096 + ks * 1024), hh = vtr(vp + d0 * 4096 + ks * 1024 + 512);
                    const bf16x8 vf = (bf16x8){lo[0], lo[1], lo[2], lo[3], hh[0], hh[1], hh[2], hh[3]};
                    o[d0] = __builtin_amdgcn_mfma_f32_32x32x16_bf16(__builtin_bit_cast(bf16x8, pw[ks]), vf, o[d0], 0, 0, 0);
                }
        }
        if (t < t_hi) ATT_WRITE(cur ^ 1);
        ATT_BARRIER();
    }
    l = half_swap_sum(l);
    if (hi == 0) wsf[32 + r32] = 1.f / l;
    bf16_t* Ob = (bf16_t*)(p.ws + WS_AO) + (rb + qw0) * 1024 + (MLA ? 512 : 0) + head * 64 + r32;
#pragma unroll
    for (int r = 0; r < 16; ++r) { const int qr = crow(r, hi); const float rl = wsf[32 + qr];
        Ob[(size_t)qr * 1024] = (bf16_t)f2bf(o[0][r] * rl); Ob[(size_t)qr * 1024 + 32] = (bf16_t)f2bf(o[1][r] * rl); }
#undef ATT_LOAD
#undef ATT_WRITE
}
constexpr int PP_AHEAD = 4;
constexpr int PP_OFF_V = 3 * KBUF, PP_OFF_WS = 3 * KBUF + 3 * VBUF;
#define ATT_PBAR() do { __builtin_amdgcn_sched_barrier(0); asm volatile("s_waitcnt lgkmcnt(0)\n\ts_barrier" ::: "memory"); __builtin_amdgcn_sched_barrier(0); } while (0)
template <bool MLA>
__device__ __forceinline__ void attn_unit_pp(const P& p, LAS unsigned char* lds, int b, int hk, int q0, BgConv& bg) {
    int tid_ = threadIdx.x; asm volatile("" : "+v"(tid_));
    const int tid = tid_, lane = tid & 63, r32 = lane & 31, hi = lane >> 5, wid = __builtin_amdgcn_readfirstlane(tid >> 6);
    const int grp = wid >> 2;
    constexpr int NKS = MLA ? 6 : 4;
    const int head = MLA ? hk : hk * 4 + (wid >> 1);
    const int qw0 = MLA ? q0 + 32 * wid : q0 + 32 * (wid & 1);
    const size_t rb = (size_t)b * SEQ;
    bf16x8 qf[NKS];
    if (MLA) {
        const bf16_t* qn = (const bf16_t*)(p.ws + WS_QN) + (rb + qw0 + r32) * 512 + head * 64 + 8 * hi;
        const bf16_t* qr = (const bf16_t*)(p.ws + WS_QR) + (rb + qw0 + r32) * 256 + head * 32 + 8 * hi;
#pragma unroll
        for (int ks = 0; ks < 4; ++ks) qf[ks] = *(const bf16x8*)(qn + 16 * ks);
#pragma unroll
        for (int ks = 4; ks < NKS; ++ks) qf[ks] = *(const bf16x8*)(qr + 16 * (ks - 4));
    } else {
        const bf16_t* qa = (const bf16_t*)(p.ws + WS_QA) + (rb + qw0 + r32) * 512 + head * 64 + 8 * hi;
#pragma unroll
        for (int ks = 0; ks < NKS; ++ks) qf[ks] = *(const bf16x8*)(qa + 16 * ks);
    }
    const int t_lo = MLA ? 0 : (q0 >= 128 ? (q0 - 128) >> 6 : 0), t_hi = MLA ? ((q0 + 256) >> 6) - 1 : (q0 >> 6);
    const int skey = tid >> 3, sc = tid & 7;
    const bf16_t* kg; const bf16_t* vg; const bf16_t* rg = nullptr;
    if (MLA) { kg = (const bf16_t*)(p.ws + WS_KN) + (rb + skey) * 512 + hk * 64 + 8 * sc; vg = (const bf16_t*)(p.ws + WS_VB) + (rb + skey) * 512 + hk * 64 + 8 * sc;
               rg = (const bf16_t*)(p.ws + WS_KR) + (rb + (tid >> 2)) * 32 + 8 * (tid & 3); }
    else { kg = (const bf16_t*)(p.ws + WS_KA) + (rb + skey) * 128 + hk * 64 + 8 * sc; vg = (const bf16_t*)(p.ws + WS_VA) + (rb + skey) * 128 + hk * 64 + 8 * sc; }
    const int kpitch = MLA ? 512 : 128;
    const int kst = skey * KROW + sc * 16;
    const int rst = (tid >> 2) * KROW + 128 + (tid & 3) * 16;
    const int vst = ((8 * sc) >> 5) * 4096 + (skey >> 4) * 1024 + (skey & 15) * 64 + ((8 * sc) & 31) * 2;
    u32x4 kreg, vreg, rreg = (u32x4){0u, 0u, 0u, 0u};
#define PP_LOAD(t) do { kreg = *(const u32x4*)(kg + (size_t)(t) * 64 * kpitch); vreg = *(const u32x4*)(vg + (size_t)(t) * 64 * kpitch); \
        if (MLA && tid < 256) rreg = *(const u32x4*)(rg + (size_t)(t) * 64 * 32); } while (0)
#define PP_WRITE(kb, vb) do { *(LAS u32x4*)(lds + (kb) + kst) = kreg; *(LAS u32x4*)(lds + PP_OFF_V + (vb) + vst) = vreg; \
        if (MLA && tid < 256) *(LAS u32x4*)(lds + (kb) + rst) = rreg; } while (0)
    LAS float* wsf = (LAS float*)(lds + PP_OFF_WS) + wid * 64;
    float m, l; f32x16 o[2];
#pragma unroll
    for (int r = 0; r < 16; ++r) { o[0][r] = 0.f; o[1][r] = 0.f; }
    float slope2 = 0.f;
    if (MLA) { m = -INFINITY; l = 0.f; }
    else { m = p.sinks[head] * LOG2E; l = hi == 0 ? 1.f : 0.f; slope2 = exp2f(-(float)(head + 1)) * LOG2E; }
    const lds_cptr kp0 = (lds_cptr)lds + r32 * KROW + hi * 16;
    const lds_cptr vp0 = (lds_cptr)lds + PP_OFF_V + ((lane >> 4) & 1) * 32 + (lane & 3) * 8 + (4 * hi + ((lane & 15) >> 2)) * 64;
    int kbP = 2 * KBUF, kbC = 0, kbN = KBUF, vbP = 2 * VBUF, vbC = 0, vbN = VBUF;
    PP_LOAD(t_lo); PP_WRITE(kbC, vbC);
    if (t_lo < t_hi) PP_LOAD(t_lo + 1);
    ATT_PBAR();
    if (grp) ATT_PBAR();
    u32x4 pw[4];
#pragma unroll
    for (int i = 0; i < 4; ++i) pw[i] = (u32x4){0u, 0u, 0u, 0u};
    f32x16 p0, p1;
#pragma unroll
    for (int r = 0; r < 16; ++r) { p0[r] = 0.f; p1[r] = 0.f; }
    bool act_prev = false;
    for (int t = t_lo; t <= t_hi + 1; ++t) {
        const int s0 = t * 64;
        const bool active = t <= t_hi && (MLA ? (s0 <= qw0 + 31) : (s0 <= qw0 + 31 && s0 + 63 >= qw0 - 127));
        __builtin_amdgcn_s_setprio(1);
        if (active) {
#pragma unroll
            for (int r = 0; r < 16; ++r) { p0[r] = 0.f; p1[r] = 0.f; }
            const lds_cptr kp = kp0 + kbC;
            bf16x8 ka[2 * NKS];
#pragma unroll
            for (int ks = 0; ks < NKS; ++ks) { ka[2 * ks] = *(const LAS bf16x8*)(kp + ks * 32); ka[2 * ks + 1] = *(const LAS bf16x8*)(kp + 32 * KROW + ks * 32); }
#pragma unroll
            for (int ks = 0; ks < NKS; ++ks) {
                p0 = __builtin_amdgcn_mfma_f32_32x32x16_bf16(ka[2 * ks], qf[ks], p0, 0, 0, 0);
                p1 = __builtin_amdgcn_mfma_f32_32x32x16_bf16(ka[2 * ks + 1], qf[ks], p1, 0, 0, 0);
            }
            __builtin_amdgcn_sched_group_barrier(0x100, PP_AHEAD, 0);
#pragma unroll
            for (int i = 0; i < 2 * NKS - PP_AHEAD; ++i) { __builtin_amdgcn_sched_group_barrier(0x008, 1, 0); __builtin_amdgcn_sched_group_barrier(0x100, 1, 0); }
            __builtin_amdgcn_sched_group_barrier(0x008, PP_AHEAD, 0);
        }
        __builtin_amdgcn_sched_barrier(0);
        if (act_prev) {
            const lds_cptr vp = vp0 + vbP;
            bf16x8 vf[8];
#pragma unroll
            for (int ks = 0; ks < 4; ++ks)
#pragma unroll
                for (int d0 = 0; d0 < 2; ++d0) {
                    const s16x4 lo = vtr(vp + d0 * 4096 + ks * 1024), hh = vtr(vp + d0 * 4096 + ks * 1024 + 512);
                    vf[2 * ks + d0] = (bf16x8){lo[0], lo[1], lo[2], lo[3], hh[0], hh[1], hh[2], hh[3]};
                }
#pragma unroll
            for (int ks = 0; ks < 4; ++ks) {
                o[0] = __builtin_amdgcn_mfma_f32_32x32x16_bf16(__builtin_bit_cast(bf16x8, pw[ks]), vf[2 * ks], o[0], 0, 0, 0);
                o[1] = __builtin_amdgcn_mfma_f32_32x32x16_bf16(__builtin_bit_cast(bf16x8, pw[ks]), vf[2 * ks + 1], o[1], 0, 0, 0);
            }
            __builtin_amdgcn_sched_group_barrier(0x100, 6, 0);
#pragma unroll
            for (int i = 0; i < 5; ++i) { __builtin_amdgcn_sched_group_barrier(0x008, 1, 0); __builtin_amdgcn_sched_group_barrier(0x100, 2, 0); }
            __builtin_amdgcn_sched_group_barrier(0x008, 3, 0);
        }
        __builtin_amdgcn_sched_barrier(0);
        __builtin_amdgcn_s_setprio(0);
        if (t < t_hi) PP_WRITE(kbN, vbN);
        if (BG_CONV) bg_step_fin(p, bg, lane);
        if (t + 1 < t_hi) PP_LOAD(t + 2);
        if (BG_CONV) bg_step_iss(p, bg, lane);
        ATT_PBAR();
        if (active) {
            const int q = qw0 + r32;
            if (MLA) {
                if (s0 + 63 > qw0) {
#pragma unroll
                    for (int r = 0; r < 16; ++r) { const int key = s0 + crow(r, hi); if (key > q) p0[r] = -INFINITY; if (key + 32 > q) p1[r] = -INFINITY; }
                }
            } else {
#pragma unroll
                for (int r = 0; r < 16; ++r) { const int d0 = q - (s0 + crow(r, hi)), d1 = d0 - 32;
                    p0[r] = (d0 >= 0 && d0 < 128) ? p0[r] - slope2 * (float)d0 : -INFINITY;
                    p1[r] = (d1 >= 0 && d1 < 128) ? p1[r] - slope2 * (float)d1 : -INFINITY; }
            }
            float mxa = fmaxf(p0[0], p1[0]), mxb = fmaxf(p0[1], p1[1]);
#pragma unroll
            for (int r = 2; r < 16; r += 2) { mxa = vmax3(mxa, p0[r], p1[r]); mxb = vmax3(mxb, p0[r + 1], p1[r + 1]); }
            float mx = half_swap_max(fmaxf(mxa, mxb));
            if (__any(mx > m + 8.f)) {
                const float mn = fmaxf(m, mx), alpha = __builtin_amdgcn_exp2f(m - mn);
                m = mn; l *= alpha;
                if (hi == 0) wsf[r32] = alpha;
#pragma unroll
                for (int r = 0; r < 16; ++r) { const float a = wsf[crow(r, hi)]; o[0][r] *= a; o[1][r] *= a; }
            }
#pragma unroll
            for (int r = 0; r < 16; ++r) { p0[r] -= m; p1[r] -= m; }
            __builtin_amdgcn_sched_barrier(0);
#pragma unroll
            for (int r = 0; r < 16; ++r) { p0[r] = __builtin_amdgcn_exp2f(p0[r]); p1[r] = __builtin_amdgcn_exp2f(p1[r]); }
            __builtin_amdgcn_sched_barrier(0);
            { typedef float f32x2 __attribute__((ext_vector_type(2)));
              f32x2 sa = (f32x2){p0[0], p0[1]} + (f32x2){p1[0], p1[1]}, sb = (f32x2){p0[2], p0[3]} + (f32x2){p1[2], p1[3]};
#pragma unroll
              for (int r = 4; r < 16; r += 4) { sa += (f32x2){p0[r], p0[r + 1]} + (f32x2){p1[r], p1[r + 1]}; sb += (f32x2){p0[r + 2], p0[r + 3]} + (f32x2){p1[r + 2], p1[r + 3]}; }
              sa += sb; l += sa[0] + sa[1]; }
#pragma unroll
            for (int i = 0; i < 4; ++i) { pw[0][i] = pg8::cvt_pk_bf16(p0[2 * i], p0[2 * i + 1]); pw[1][i] = pg8::cvt_pk_bf16(p0[8 + 2 * i], p0[8 + 2 * i + 1]);
                                          pw[2][i] = pg8::cvt_pk_bf16(p1[2 * i], p1[2 * i + 1]); pw[3][i] = pg8::cvt_pk_bf16(p1[8 + 2 * i], p1[8 + 2 * i + 1]); }
        }
        act_prev = active;
        ATT_PBAR();
        { const int tk = kbP; kbP = kbC; kbC = kbN; kbN = tk; const int tv = vbP; vbP = vbC; vbC = vbN; vbN = tv; }
    }
    if (!grp) ATT_PBAR();
    l = half_swap_sum(l);
    if (hi == 0) wsf[32 + r32] = 1.f / l;
    bf16_t* Ob = (bf16_t*)(p.ws + WS_AO) + (rb + qw0) * 1024 + (MLA ? 512 : 0) + head * 64 + r32;
#pragma unroll
    for (int r = 0; r < 16; ++r) { const int qr = crow(r, hi); const float rl = wsf[32 + qr];
        Ob[(size_t)qr * 1024] = (bf16_t)f2bf(o[0][r] * rl); Ob[(size_t)qr * 1024 + 32] = (bf16_t)f2bf(o[1][r] * rl); }
#undef PP_LOAD
#undef PP_WRITE
}
}
__device__ __forceinline__ void ph_attn2(const P& p, unsigned char* lds_) {
    LAS unsigned char* lds = (LAS unsigned char*)lds_;
    const int G = gridDim.x, bx = blockIdx.x;
    const int vcu = (G % 8 == 0) ? (bx % 8) * (G / 8) + bx / 8 : bx;
    const int lane_ = threadIdx.x & 63, wave_ = threadIdx.x >> 6;
    BgConv bg; bg.item = bx * 8 + wave_; bg.it = 0; bg.ngw = G * 8; bg.pend = false;
#pragma unroll
    for (int i = 0; i < 32; ++i) bg.r[i] = 0.f;
    float* bgscr = (float*)(lds_ + att::BG_SCR_OFF + wave_ * 8704);
    for (int pi = vcu; pi < 256; pi += G) {
        const int bh = pi >> 4, sidx = pi & 15;
        att::attn_unit_pp<true>(p, lds, bh >> 3, bh & 7, (31 - sidx) * 256, bg);
        att::attn_unit_pp<true>(p, lds, bh >> 3, bh & 7, sidx * 256, bg);
    }
    for (int u = vcu; u < 512; u += G) {
        const int bk = u >> 7, qb = u & 127;
        att::attn_unit_pp<false>(p, lds, bk >> 1, bk & 1, qb * 64, bg);
    }
    if (BG_CONV) bg_drain(p, bg, bgscr, lane_);
}

#define XB_TMO      128
#define XB_XCNT(j)  (256  + 64 * (j))
#define XB_XSUB(j)  (1280 + 64 * (j))
#define XB_XGEN(j)  (2304 + 64 * (j))
#define XB_TOP      3328
#define XB_TOPGEN   3392
#define XCD_BAR_WORDS 3456
#define XB_SPIN_CAP (1u << 18)
__device__ __forceinline__ unsigned xb_ld(unsigned* p)              { return __hip_atomic_load(p, __ATOMIC_RELAXED, __HIP_MEMORY_SCOPE_AGENT); }
__device__ __forceinline__ unsigned xb_add(unsigned* p, unsigned v) { return __hip_atomic_fetch_add(p, v, __ATOMIC_RELAXED, __HIP_MEMORY_SCOPE_AGENT); }
__device__ __forceinline__ unsigned xb_xcc_id() { return (unsigned)__builtin_amdgcn_s_getreg((3 << 11) | 20) & 0xFu; }
#define XB_SPIN(cond, bar) do { unsigned _sp = 0; while (cond) { __builtin_amdgcn_s_sleep(1); \
    if ((++_sp & 255u) == 0u) { if (xb_ld(&(bar)[XB_TMO])) break; if (_sp > XB_SPIN_CAP) { atomicAdd(&(bar)[XB_TMO], 1u); break; } } } } while (0)
struct XcdBarrier { unsigned* bar; unsigned x; volatile LAS unsigned* st; };
__device__ __forceinline__ XcdBarrier xcd_barrier_post(unsigned* bar, volatile LAS unsigned* st) {
    XcdBarrier b; b.bar = bar; b.x = xb_xcc_id(); b.st = st;
    if (threadIdx.x == 0) (void)xb_add(&bar[XB_XCNT(b.x)], 1u);
    return b;
}
__device__ __forceinline__ void xcd_barrier_complete(unsigned* bar, unsigned x, unsigned& nloc, unsigned& nx) {
    const unsigned G = gridDim.x * gridDim.y * gridDim.z;
    unsigned sum, cnt, mine, sp = 0u;
    for (;;) {
        sum = 0u; cnt = 0u; mine = 0u;
#pragma unroll
        for (unsigned j = 0; j < 16; ++j) { const unsigned c = xb_ld(&bar[XB_XCNT(j)]); sum += c; cnt += (c > 0u) ? 1u : 0u; mine = (j == x) ? c : mine; }
        if (sum == G) break;
        __builtin_amdgcn_s_sleep(1);
        if ((++sp & 255u) == 0u) { if (xb_ld(&bar[XB_TMO])) break; if (sp > XB_SPIN_CAP) { atomicAdd(&bar[XB_TMO], 1u); break; } }
    }
    nloc = mine > 0u ? mine : 1u; nx = cnt > 0u ? cnt : 1u;
}
__device__ __forceinline__ void xcd_barrier(const XcdBarrier& b) {
    asm volatile("s_waitcnt vmcnt(0)" ::: "memory");
    __syncthreads();
    if (threadIdx.x == 0) {
        unsigned* bar = b.bar;
        __builtin_amdgcn_s_waitcnt(0);
        unsigned nloc = b.st[0], nx = b.st[1];
        if (nloc == 0u) { xcd_barrier_complete(bar, b.x, nloc, nx); b.st[0] = nloc; b.st[1] = nx; }
        const unsigned old = xb_add(&bar[XB_XSUB(b.x)], 1u);
        const unsigned gen = old / nloc;
        if (old + 1u == (gen + 1u) * nloc) {
            __builtin_amdgcn_fence(__ATOMIC_RELEASE, "agent");
            asm volatile("s_waitcnt vmcnt(0)" ::: "memory");
            const unsigned og = xb_add(&bar[XB_TOP], 1u);
            const unsigned tg = og / nx;
            if (og + 1u == (tg + 1u) * nx) xb_add(&bar[XB_TOPGEN], 1u);
            else XB_SPIN(xb_ld(&bar[XB_TOPGEN]) == tg, bar);
            __builtin_amdgcn_fence(__ATOMIC_ACQUIRE, "agent");
            xb_add(&bar[XB_XGEN(b.x)], 1u);
            asm volatile("s_waitcnt vmcnt(0)" ::: "memory");
        } else {
            XB_SPIN(xb_ld(&bar[XB_XGEN(b.x)]) == gen, bar);
            __builtin_amdgcn_fence(__ATOMIC_ACQUIRE, "agent");
            asm volatile("s_waitcnt vmcnt(0)" ::: "memory");
        }
    }
    __syncthreads();
}
constexpr int LDSCTL_OFF = 139264;
constexpr int CW_BAR = 4096;
constexpr size_t CTL_ZERO_BYTES = 65536;

__global__ void __launch_bounds__(NTHREADS, 2) mega_fwd(P p) {
    extern __shared__ __attribute__((aligned(16))) unsigned char lds[];
    if (threadIdx.x < 32) ((LAS unsigned*)((LAS unsigned char*)lds + LDSCTL_OFF))[threadIdx.x] = 0u;
    __syncthreads();
    const XcdBarrier bar = xcd_barrier_post((unsigned*)(p.ws + WS_CTL) + CW_BAR, (volatile LAS unsigned*)((LAS unsigned char*)lds + LDSCTL_OFF));
#ifndef PH_MASK
#define PH_MASK 0xFFFF
#endif
#ifndef PH_DUP
#define PH_DUP 0
#endif
#define RUN_PH(bit, call) do { if (PH_MASK & (bit)) { call; if (PH_DUP & (bit)) { __syncthreads(); call; } } } while (0)
#define GSYNC() do { xcd_barrier(bar); if (PH_DUP & 0x10000) xcd_barrier(bar); } while (0)
    RUN_PH(1, (ph_mod(p, lds), ph_convert(p, lds)));
    GSYNC();
    RUN_PH(2, ph_xn(p));
    GSYNC();
    RUN_PH(4, ph_proj2(p, lds));
    GSYNC();
    RUN_PH(16, ph_up2(p, lds));
    GSYNC();
    RUN_PH(32, ph_attn2(p, lds));
    GSYNC();
    RUN_PH(64, ph_mix2(p, lds));
    GSYNC();
    RUN_PH(128, ph_out2(p, lds));
    GSYNC();
    if (PH_DUP & 256) { ph_route(p, lds, false); __syncthreads(); }
    if (PH_MASK & 256) ph_route(p, lds, true);
    GSYNC();
    RUN_PH(512, ph_moe1_2(p, lds));
    GSYNC();
    RUN_PH(1024, ph_moe2_2(p, lds));
    GSYNC();
    RUN_PH(2048, ph_final(p));
}

extern "C" void kernel_launch(void* const* d_in, const int* in_sizes, int n_in, void* d_out, int out_size, void* d_ws, size_t ws_size, hipStream_t stream) {
    static int grid_blocks = 0;
    if (!grid_blocks) {
        int dev = 0, cus = 0, per_cu = 0;
        (void)hipGetDevice(&dev);
        (void)hipDeviceGetAttribute(&cus, hipDeviceAttributeMultiprocessorCount, dev);
        (void)hipFuncSetAttribute((const void*)mega_fwd, hipFuncAttributeMaxDynamicSharedMemorySize, LDS_BYTES);
        (void)hipOccupancyMaxActiveBlocksPerMultiprocessor(&per_cu, (const void*)mega_fwd, NTHREADS, LDS_BYTES);
        if (per_cu < 1) per_cu = 1;
        grid_blocks = cus * per_cu;
        if (grid_blocks > 256) grid_blocks = 256;
        if (grid_blocks < 256 || MTOK % grid_blocks != 0) { fprintf(stderr, "kernel_launch: grid %d unsupported (needs >= 256 workgroups dividing %d)\n", grid_blocks, MTOK); grid_blocks = -1; }
        else if (ws_size < WS_END || n_in != 24) { fprintf(stderr, "kernel_launch: ws %zu < %zu or n_in %d != 24\n", ws_size, (size_t)WS_END, n_in); grid_blocks = -1; }
    }
    if (grid_blocks < 0) return;
    P p{};
    p.x = (const float*)d_in[0]; p.c = (const float*)d_in[1]; p.pos = (const int*)d_in[2]; p.w_ada = (const float*)d_in[3]; p.b_ada = (const float*)d_in[4];
    p.norm_mix = (const float*)d_in[5]; p.norm_ffn = (const float*)d_in[6]; p.w_in = (const float*)d_in[7]; p.sinks = (const float*)d_in[8];
    p.q_norm = (const float*)d_in[9]; p.kv_norm = (const float*)d_in[10]; p.w_uq = (const float*)d_in[11]; p.w_uk = (const float*)d_in[12]; p.w_uv = (const float*)d_in[13];
    p.w_a = (const float*)d_in[14]; p.w_b = (const float*)d_in[15]; p.w_out = (const float*)d_in[16]; p.w_router = (const float*)d_in[17]; p.b_router = (const float*)d_in[18];
    p.w_m1 = (const float*)d_in[19]; p.b_m1 = (const float*)d_in[20]; p.w_m2 = (const float*)d_in[21]; p.b_m2 = (const float*)d_in[22]; p.fnorm = (const float*)d_in[23];
    p.out = (float*)d_out; p.ws = (unsigned char*)d_ws;
    if (hipMemsetAsync((char*)d_ws + WS_CTL, 0, CTL_ZERO_BYTES, stream) != hipSuccess) { fprintf(stderr, "kernel_launch: memset failed\n"); return; }
    hipLaunchKernelGGL(mega_fwd, dim3(grid_blocks), dim3(NTHREADS), LDS_BYTES, stream, p);
    const hipError_t e = hipPeekAtLastError();
    if (e != hipSuccess) fprintf(stderr, "launch failed: %s (grid %d)\n", hipGetErrorString(e), grid_blocks);
}
```

```cpp
#include <hip/hip_runtime.h>
#include <cstdio>
#include <cstdint>

typedef unsigned short bf16_t;
typedef short bf16x8 __attribute__((ext_vector_type(8)));
typedef float f32x4 __attribute__((ext_vector_type(4)));
typedef unsigned u32x4 __attribute__((ext_vector_type(4)));
typedef unsigned u32x2 __attribute__((ext_vector_type(2)));

constexpr int NTHREADS = 512;
constexpr int LDS_BYTES = 147456;
constexpr int BATCH = 2, SEQ = 8192, DM = 1024, MTOK = BATCH * SEQ;
constexpr int NEXP = 32, LISTCAP = 16384;
constexpr float EPS = 1e-6f;
constexpr float LOG2E = 1.4426950408889634f;

constexpr size_t MiB = 1u << 20;
constexpr size_t WS_CTL = 0;
constexpr size_t WS_MOD = 1 * MiB;
constexpr size_t WS_WT_IN = 2 * MiB;
constexpr size_t WS_WT_UQ = 9 * MiB;
constexpr size_t WS_WT_UKV = 10 * MiB;
constexpr size_t WS_WT_A = 11 * MiB;
constexpr size_t WS_WT_B = 12 * MiB;
constexpr size_t WS_WT_OUT = 13 * MiB;
constexpr size_t WS_WRT = 1 * MiB + 524288;
constexpr size_t WS_COS = 15 * MiB;
constexpr size_t WS_SIN = 16 * MiB;
constexpr size_t WS_SSQ = 17 * MiB;
constexpr size_t WS_LIST = 18 * MiB;
constexpr size_t WS_TOPW = 1835008;
constexpr size_t WS_LISTW = 809 * MiB;
constexpr size_t WS_WT_M1 = 20 * MiB;
constexpr size_t WS_WT_M2 = 148 * MiB;
constexpr size_t WS_XN = 212 * MiB;
constexpr size_t WS_QA = 244 * MiB;
constexpr size_t WS_KA = 260 * MiB;
constexpr size_t WS_VA = 264 * MiB;
constexpr size_t WS_CQ = 268 * MiB;
constexpr size_t WS_CKV = 280 * MiB;
constexpr size_t WS_KR = 288 * MiB;
constexpr size_t WS_GA = 289 * MiB;
constexpr size_t WS_GB = 321 * MiB;
constexpr size_t WS_QN = 353 * MiB;
constexpr size_t WS_QR = 369 * MiB;
constexpr size_t WS_KN = 377 * MiB;
constexpr size_t WS_VB = 393 * MiB;
constexpr size_t WS_AO = 409 * MiB;
constexpr size_t WS_BO = 425 * MiB;
constexpr size_t WS_MIX = 441 * MiB;
constexpr size_t WS_X1 = 473 * MiB;
constexpr size_t WS_HID = 537 * MiB;
constexpr size_t WS_Y = 681 * MiB;
constexpr size_t WS_XN8 = 811 * MiB;
constexpr size_t WS_WT_G8 = 827 * MiB;
constexpr size_t WS_END = 829 * MiB;

struct P {
    const float *x, *c; const int* pos;
    const float *w_ada, *b_ada, *norm_mix, *norm_ffn, *w_in, *sinks, *q_norm, *kv_norm, *w_uq, *w_uk, *w_uv, *w_a, *w_b, *w_out,
        *w_router, *b_router, *w_m1, *b_m1, *w_m2, *b_m2, *fnorm;
    float* out; unsigned char* ws;
};

__device__ __forceinline__ unsigned f2bf(float f) { unsigned u = __float_as_uint(f); return (u + 0x7fffu + ((u >> 16) & 1u)) >> 16; }
__device__ __forceinline__ unsigned pk2(float lo, float hi) { return f2bf(lo) | (f2bf(hi) << 16); }
__device__ __forceinline__ float bf2f(unsigned h) { return __uint_as_float(h << 16); }
__device__ __forceinline__ unsigned pk4_fp8(float a, float b, float c, float d) { int r = __builtin_amdgcn_cvt_pk_fp8_f32(a, b, 0, false); r = __builtin_amdgcn_cvt_pk_fp8_f32(c, d, r, true); return (unsigned)r; }
constexpr float W8_SCALE = 32.f, W8_INV = 0.03125f;
constexpr float MIX8_SCALE = 8.f, OUT8_INV = 1.f / (8.f * 32.f);
__device__ __forceinline__ float wave_sum(float v) {
#pragma unroll
    for (int o = 1; o < 64; o <<= 1) v += __shfl_xor(v, o);
    return v;
}
__device__ __forceinline__ float sigmoidf_(float v) { return __builtin_amdgcn_rcpf(1.f + __builtin_amdgcn_exp2f(-LOG2E * v)); }

__device__ __forceinline__ void ph_mod(const P& p, unsigned char* lds) {
    const int tid = threadIdx.x, lane = tid & 63, wave = tid >> 6;
    float* red = (float*)lds;
    float* mod = (float*)(p.ws + WS_MOD);
    for (int item = blockIdx.x; item < 192; item += gridDim.x) {
        const int n0 = item * 32, cn = lane & 31, kq = lane >> 5;
        float a0 = 0.f, a1 = 0.f;
#pragma unroll 1
        for (int i0 = 0; i0 < 64; i0 += 16) {
            float wv[16];
#pragma unroll
            for (int i = 0; i < 16; ++i) wv[i] = __builtin_nontemporal_load(p.w_ada + (size_t)(wave * 128 + 2 * (i0 + i) + kq) * 6144 + n0 + cn);
#pragma unroll
            for (int i = 0; i < 16; ++i) { const int k = wave * 128 + 2 * (i0 + i) + kq; const float c0 = p.c[k], c1 = p.c[1024 + k];
                a0 += c0 * sigmoidf_(c0) * wv[i]; a1 += c1 * sigmoidf_(c1) * wv[i]; }
        }
        a0 += __shfl_xor(a0, 32); a1 += __shfl_xor(a1, 32);
        if (lane < 32) { red[(wave * 2 + 0) * 32 + cn] = a0; red[(wave * 2 + 1) * 32 + cn] = a1; }
        __syncthreads();
        if (tid < 64) { const int b = tid >> 5, cc = tid & 31; float s = 0.f;
            for (int w = 0; w < 8; ++w) s += red[(w * 2 + b) * 32 + cc];
            mod[b * 6144 + n0 + cc] = s + p.b_ada[n0 + cc]; }
        __syncthreads();
    }
}
__device__ __forceinline__ int ropeperm(int d) { return d < 16 ? 8 * (d >> 2) + (d & 3) : 8 * ((d - 16) >> 2) + 4 + (d & 3); }
__device__ __forceinline__ void transpose_item(const float* W, int N, int K, bf16_t* WT, int k0, int n0, int dst_row0, const float* kscale, float* scr, int lane, bool rperm = false) {
    float tv[32];
#pragma unroll
    for (int i = 0; i < 32; ++i) tv[i] = W[(size_t)(k0 + 2 * i + (lane >> 5)) * N + n0 + (lane & 31)];
#pragma unroll
    for (int i = 0; i < 32; ++i) { const int kk = 2 * i + (lane >> 5); float v = tv[i]; if (kscale) v *= kscale[k0 + kk]; scr[kk * 33 + (lane & 31)] = v; }
    __builtin_amdgcn_s_waitcnt(0); __builtin_amdgcn_wave_barrier();
    const int c = lane & 7;
#pragma unroll
    for (int j = 0; j < 4; ++j) { const int n = (lane >> 3) + 8 * j; const float* s = scr + (8 * c) * 33 + n;
        u32x4 o; o.x = pk2(s[0 * 33], s[1 * 33]); o.y = pk2(s[2 * 33], s[3 * 33]); o.z = pk2(s[4 * 33], s[5 * 33]); o.w = pk2(s[6 * 33], s[7 * 33]);
        *(u32x4*)(WT + (size_t)(dst_row0 + (rperm ? ropeperm(n) : n)) * K + k0 + 8 * c) = o; }
    __builtin_amdgcn_s_waitcnt(0); __builtin_amdgcn_wave_barrier();
}
__device__ __forceinline__ void transpose_item_fp8(const float* W, int N, int K, unsigned char* WT, int k0, int n0, int dst_row0, float* scr, int lane) {
    float tv[32];
#pragma unroll
    for (int i = 0; i < 32; ++i) tv[i] = W[(size_t)(k0 + 2 * i + (lane >> 5)) * N + n0 + (lane & 31)];
#pragma unroll
    for (int i = 0; i < 32; ++i) { const int kk = 2 * i + (lane >> 5); scr[kk * 33 + (lane & 31)] = tv[i] * W8_SCALE; }
    __builtin_amdgcn_s_waitcnt(0); __builtin_amdgcn_wave_barrier();
    const int c = lane & 3;
#pragma unroll
    for (int j = 0; j < 2; ++j) { const int n = (lane >> 2) + 16 * j; const float* sp = scr + (16 * c) * 33 + n;
        u32x4 o; o.x = pk4_fp8(sp[0 * 33], sp[1 * 33], sp[2 * 33], sp[3 * 33]); o.y = pk4_fp8(sp[4 * 33], sp[5 * 33], sp[6 * 33], sp[7 * 33]);
        o.z = pk4_fp8(sp[8 * 33], sp[9 * 33], sp[10 * 33], sp[11 * 33]); o.w = pk4_fp8(sp[12 * 33], sp[13 * 33], sp[14 * 33], sp[15 * 33]);
        *(u32x4*)(WT + (size_t)(dst_row0 + n) * K + k0 + 16 * c) = o; }
    __builtin_amdgcn_s_waitcnt(0); __builtin_amdgcn_wave_barrier();
}
__device__ __forceinline__ int in_colmap(int s) {
    if (s < 768) return s;
    if (s < 1152) return 1024 + (s - 768);
    if (s < 1408) return 768 + (s - 1152);
    if (s < 1440) return s;
    if (s < 2464) return 1536 + (s - 1440);
    return 2560 + (s - 2464);
}
#ifndef BG_CONV
#define BG_CONV 1
#endif
constexpr int BG_I_M1 = 32 * 16 * 64, BG_I_M2 = 32 * 16 * 32, BG_TOTAL = BG_I_M1 + BG_I_M2;
struct BgConv { float r[32]; int item, it, ngw; bool pend; };
__device__ __forceinline__ void bg_decode(const P& p, int item, const float*& W, int& N, unsigned char*& WT, int& k0, int& n0, int& dst) {
    if (item < BG_I_M1) { const int e = item >> 10, q = item & 1023, kb = q >> 6, nb = q & 63; n0 = nb * 32; const int j = n0 & 1023, lin = n0 >> 10;
        dst = (j >> 7) * 256 + lin * 128 + (j & 127); W = p.w_m1 + (size_t)e * 1024 * 2048; N = 2048; WT = p.ws + WS_WT_M1 + (size_t)e * 2048 * 1024; k0 = kb * 64; }
    else { const int r = item - BG_I_M1, e = r >> 9, q = r & 511, kb = q >> 5, nb = q & 31; n0 = nb * 32; dst = n0;
        W = p.w_m2 + (size_t)e * 1024 * 1024; N = 1024; WT = p.ws + WS_WT_M2 + (size_t)e * 1024 * 1024; k0 = kb * 64; }
}
__device__ __forceinline__ void bg_issue(const P& p, BgConv& g, int lane) {
    const float* W; int N, k0, n0, dst; unsigned char* WT; bg_decode(p, g.item, W, N, WT, k0, n0, dst);
    const float* src = W + (size_t)(k0 + (lane >> 5)) * N + n0 + (lane & 31);
#pragma unroll
    for (int i = 0; i < 32; ++i) g.r[i] = __builtin_nontemporal_load(src + (size_t)(2 * i) * N);
}
__device__ __forceinline__ void bg_finish(const P& p, BgConv& g, float* scr, int lane) {
    const float* W; int N, k0, n0, dst; unsigned char* WT; bg_decode(p, g.item, W, N, WT, k0, n0, dst);
    unsigned w[8];
#pragma unroll
    for (int i = 0; i < 16; i += 2) {
        const auto s0 = __builtin_amdgcn_permlane32_swap(__float_as_uint(g.r[i] * W8_SCALE), __float_as_uint(g.r[i + 16] * W8_SCALE), false, false);
        const auto s1 = __builtin_amdgcn_permlane32_swap(__float_as_uint(g.r[i + 1] * W8_SCALE), __float_as_uint(g.r[i + 17] * W8_SCALE), false, false);
        w[i >> 1] = pk4_fp8(__uint_as_float(s0[0]), __uint_as_float(s0[1]), __uint_as_float(s1[0]), __uint_as_float(s1[1]));
    }
    unsigned char* o = WT + (size_t)(dst + (lane & 31)) * 1024 + k0 + 32 * (lane >> 5);
    __builtin_nontemporal_store((u32x4){w[0], w[1], w[2], w[3]}, (u32x4*)o); __builtin_nontemporal_store((u32x4){w[4], w[5], w[6], w[7]}, (u32x4*)(o + 16));
}
__device__ __forceinline__ void bg_step(const P& p, BgConv& g, float* scr, int lane) {
    if ((g.it & 3) == 2 && g.pend) { bg_finish(p, g, scr, lane); g.item += g.ngw; g.pend = false; }
    if ((g.it & 3) == 0 && g.item < BG_TOTAL) { bg_issue(p, g, lane); g.pend = true; }
    ++g.it;
}
__device__ __forceinline__ void bg_step_fin(const P& p, BgConv& g, int lane) { if ((g.it & 3) == 2 && g.pend) { bg_finish(p, g, nullptr, lane); g.item += g.ngw; g.pend = false; } }
__device__ __forceinline__ void bg_step_iss(const P& p, BgConv& g, int lane) { if ((g.it & 3) == 0 && g.item < BG_TOTAL) { bg_issue(p, g, lane); g.pend = true; } ++g.it; }
__device__ __forceinline__ void bg_drain(const P& p, BgConv& g, float* scr, int lane) {
    if (g.pend) { bg_finish(p, g, scr, lane); g.item += g.ngw; g.pend = false; }
    while (g.item < BG_TOTAL) { bg_issue(p, g, lane); bg_finish(p, g, scr, lane); g.item += g.ngw; }
}
__device__ __forceinline__ void ph_convert(const P& p, unsigned char* lds) {
    const int tid = threadIdx.x, lane = tid & 63, wave = tid >> 6;
    const int gw = blockIdx.x * 8 + wave, NGW = gridDim.x * 8;
    float* scr = (float*)(lds + wave * 8704);
    bf16_t* WT_IN = (bf16_t*)(p.ws + WS_WT_IN); bf16_t* WT_UQ = (bf16_t*)(p.ws + WS_WT_UQ); bf16_t* WT_UKV = (bf16_t*)(p.ws + WS_WT_UKV);
    bf16_t* WT_A = (bf16_t*)(p.ws + WS_WT_A); bf16_t* WT_B = (bf16_t*)(p.ws + WS_WT_B); bf16_t* WT_OUT = (bf16_t*)(p.ws + WS_WT_OUT);
    bf16_t* WT_M1 = (bf16_t*)(p.ws + WS_WT_M1); bf16_t* WT_M2 = (bf16_t*)(p.ws + WS_WT_M2);
    constexpr int I_IN = 16 * 109, I_UQ = 6 * 24, I_UK = 4 * 16, I_A = 8 * 32, I_OUT = 16 * 32, I_M1 = 32 * 16 * 64, I_M2 = 32 * 16 * 32;
    constexpr int TOTAL = I_IN + I_UQ + 2 * I_UK + 2 * I_A + I_OUT + (BG_CONV ? 0 : I_M1 + I_M2);
    for (int it = gw; it < TOTAL; it += NGW) {
        int r = it;
        if (r < I_IN) { const int kb = r / 109, nb = r % 109;
            if (nb * 32 < 1440) transpose_item(p.w_in, 3488, 1024, WT_IN, kb * 64, nb * 32, in_colmap(nb * 32), nullptr, scr, lane, nb * 32 == 1408);
            else transpose_item_fp8(p.w_in, 3488, 1024, p.ws + WS_WT_G8, kb * 64, nb * 32, nb * 32 - 1440, scr, lane);
            continue; } r -= I_IN;
        if (r < I_UQ) { const int kb = r / 24, nb = r % 24; const int n0 = nb * 32, hh = n0 / 96, d = n0 % 96;
            const int dst = d < 64 ? hh * 64 + d : 512 + hh * 32; transpose_item(p.w_uq, 768, 384, WT_UQ, kb * 64, n0, dst, p.q_norm, scr, lane, d >= 64); continue; } r -= I_UQ;
        if (r < I_UK) { const int kb = r / 16, nb = r % 16; transpose_item(p.w_uk, 512, 256, WT_UKV, kb * 64, nb * 32, nb * 32, p.kv_norm, scr, lane); continue; } r -= I_UK;
        if (r < I_UK) { const int kb = r / 16, nb = r % 16; transpose_item(p.w_uv, 512, 256, WT_UKV, kb * 64, nb * 32, 512 + nb * 32, p.kv_norm, scr, lane); continue; } r -= I_UK;
        if (r < I_A) { const int kb = r / 32, nb = r % 32; transpose_item(p.w_a, 1024, 1024, WT_A, kb * 64, nb * 32, nb * 32, nullptr, scr, lane); continue; } r -= I_A;
        if (r < I_A) { const int kb = r / 32, nb = r % 32; transpose_item(p.w_b, 1024, 1024, WT_A + 512, kb * 64, nb * 32, nb * 32, nullptr, scr, lane); continue; } r -= I_A;
        if (r < I_OUT) { const int kb = r / 32, nb = r % 32; transpose_item_fp8(p.w_out, 1024, 1024, (unsigned char*)WT_OUT, kb * 64, nb * 32, nb * 32, scr, lane); continue; } r -= I_OUT;
        if (r < I_M1) { const int e = r / 1024, q = r % 1024, kb = q / 64, nb = q % 64; const int n0 = nb * 32, j = n0 & 1023, lin = n0 >> 10;
            const int dst = (j >> 7) * 256 + lin * 128 + (j & 127);
            transpose_item_fp8(p.w_m1 + (size_t)e * 1024 * 2048, 2048, 1024, (unsigned char*)WT_M1 + (size_t)e * 2048 * 1024, kb * 64, n0, dst, scr, lane); continue; } r -= I_M1;
        { const int e = r / 512, q = r % 512, kb = q / 32, nb = q % 32;
            transpose_item_fp8(p.w_m2 + (size_t)e * 1024 * 1024, 1024, 1024, (unsigned char*)WT_M2 + (size_t)e * 1024 * 1024, kb * 64, nb * 32, nb * 32, scr, lane); }
    }
    for (int i = blockIdx.x * NTHREADS + tid; i < 1024 * 32; i += gridDim.x * NTHREADS) { const int k = i >> 5, e = i & 31; ((float*)(p.ws + WS_WRT))[e * 1028 + k] = p.w_router[i]; }
    for (int i = blockIdx.x * NTHREADS + tid; i < 96 * 128; i += gridDim.x * NTHREADS) ((u32x4*)(WT_IN + (size_t)1440 * 1024))[i] = (u32x4){0u, 0u, 0u, 0u};
}

__device__ __forceinline__ void ph_xn(const P& p) {
    const int tid = threadIdx.x, lane = tid & 63, wave = tid >> 6;
    const int gw = blockIdx.x * 8 + wave, NGW = gridDim.x * 8;
    const float* mod = (const float*)(p.ws + WS_MOD);
    bf16_t* XN = (bf16_t*)(p.ws + WS_XN); float* COS = (float*)(p.ws + WS_COS); float* SIN = (float*)(p.ws + WS_SIN);
    f32x4 pg[4], psc[4], psh[4]; int pb = -1;
    for (int m = gw; m < MTOK; m += NGW) {
        const int b = m >> 13;
        const f32x4* xr = (const f32x4*)(p.x + (size_t)m * DM);
        f32x4 v[4]; float s = 0.f;
#pragma unroll
        for (int j = 0; j < 4; ++j) v[j] = xr[lane + 64 * j];
        if (b != pb) { pb = b;
#pragma unroll
            for (int j = 0; j < 4; ++j) { const int col = 4 * lane + 256 * j; pg[j] = *(const f32x4*)(p.norm_mix + col); psc[j] = *(const f32x4*)(mod + b * 6144 + 1024 + col); psh[j] = *(const f32x4*)(mod + b * 6144 + col); } }
#pragma unroll
        for (int j = 0; j < 4; ++j) s += v[j].x * v[j].x + v[j].y * v[j].y + v[j].z * v[j].z + v[j].w * v[j].w;
        s = wave_sum(s);
        const float rstd = rsqrtf(s * (1.f / DM) + EPS);
#pragma unroll
        for (int j = 0; j < 4; ++j) { const int col = 4 * lane + 256 * j;
            const f32x4 g = pg[j], sc = psc[j], sh = psh[j];
            const f32x4 h = v[j] * rstd * g * (sc + 1.0f) + sh;
            u32x2 o; o.x = pk2(h.x, h.y); o.y = pk2(h.z, h.w); *(u32x2*)(XN + (size_t)m * DM + col) = o;
            *(unsigned*)(p.ws + WS_XN8 + (size_t)m * DM + col) = pk4_fp8(h.x, h.y, h.z, h.w); }
        if (lane < 16) {
            const float freq = exp2f(-(float)lane * 0.8304820237218406f);
            const float ang = (float)p.pos[m] * freq;
            double t = (double)ang * 0.15915494309189535; t -= rint(t);
            const float fr = (float)t;
            COS[m * 16 + lane] = __builtin_amdgcn_cosf(fr); SIN[m * 16 + lane] = __builtin_amdgcn_sinf(fr);
        }
    }
}

namespace pg8 {
#define PG8_LAS __attribute__((address_space(3)))
constexpr int BM = 256, BK = 64, HALF = 128, HTB = HALF * BK * 2, STAGE_BYTES = 8 * HTB, NXCD = 8, WGM = 8;
__device__ __forceinline__ int lds_byte(int r, int c) { const int st = (r >> 4) * 2 + (c >> 5), rr = r & 15, cc = c & 31, ob = rr * 64 + cc * 2; return st * 1024 + (ob ^ (((ob >> 9) & 1) << 5)); }
__device__ __forceinline__ void stage_rc(int b, int& R, int& C) { const int st = b / 1024, sb = b % 1024, swz = sb ^ (((sb >> 9) & 1) << 5); R = (st >> 1) * 16 + swz / 64; C = (st & 1) * 32 + (swz % 64) / 2; }
__device__ __forceinline__ int perm32(int rho) { const int n = rho >> 4, i = rho & 15; return 8 * (i >> 2) + 4 * n + (i & 3); }
struct GUnit { const char* a; const char* b; int pm, pn, e, cnt, tile, pad_; };
typedef float f32x2_t __attribute__((ext_vector_type(2))); typedef __bf16 bf16x2_t __attribute__((ext_vector_type(2)));
__device__ __forceinline__ unsigned cvt_pk_bf16(float lo, float hi) { f32x2_t v = {lo, hi}; bf16x2_t b = __builtin_convertvector(v, bf16x2_t); return __builtin_bit_cast(unsigned, b); }

struct DenseOrder {
    const char* A; const char* Bt; int K, nM, nN, nwg, G, c;
    __device__ void init(const void* A_, const void* Bt_, int M, int N, int K_, int G_, int c_) { A = (const char*)A_; Bt = (const char*)Bt_; K = K_; nM = M / BM; nN = N / BM; nwg = nM * nN; G = G_; c = c_; }
    __device__ bool next(int i, GUnit& u) const {
        const long L = (long)i * G + c; if (L >= nwg) return false;
        int wgid = (int)L; { const int q = nwg / NXCD, r = nwg % NXCD, xcd = wgid % NXCD, off = wgid / NXCD; wgid = (xcd < r ? xcd * (q + 1) : r * (q + 1) + (xcd - r) * q) + off; }
        const int nig = WGM * nN, gid = wgid / nig, fm = gid * WGM, gsz = (nM - fm) < WGM ? (nM - fm) : WGM;
        u.pm = fm + ((wgid % nig) % gsz); u.pn = (wgid % nig) / gsz; u.e = 0; u.cnt = 0; u.tile = 0; u.pad_ = 0;
        u.a = A + (size_t)u.pm * BM * K * 2; u.b = Bt + (size_t)u.pn * BM * K * 2; return true;
    }
    __device__ __forceinline__ unsigned a_rowoff(const GUnit&, int) const { return 0u; }
};

typedef int v8i32 __attribute__((ext_vector_type(8)));
typedef int v4i32 __attribute__((ext_vector_type(4)));
template <class Epi, class Sched, bool ALIGN_EPI, bool GATHER, bool FP8 = false>
__device__ __forceinline__ void gemm_phase(PG8_LAS unsigned char* lds, const int K, const Sched& S, const Epi& E) {
    int tid_ = threadIdx.x; asm volatile("" : "+v"(tid_));
    const int tid = tid_, wid = __builtin_amdgcn_readfirstlane(tid >> 6), lane = tid & 63, wr = wid >> 2, wc = wid & 3, fr = lane & 15, fq = lane >> 4;
    const int nt = K / BK;
    int RA[2]; unsigned CA[2], voffB[2];
#pragma unroll
    for (int i = 0; i < 2; ++i) { int R, C; stage_rc(tid * 16 + i * 8192, R, C); const int Rb = Epi::PERM ? ((R & ~31) + perm32(R & 31)) : R;
        RA[i] = R; CA[i] = (unsigned)C * 2u; voffB[i] = (unsigned)(Rb * K + C) * 2u; }
    const size_t kstep = (size_t)(BK * 2);
    const size_t hstep = (size_t)HALF * K * 2;
    const unsigned ldsw = (unsigned)wid * 1024u;
    const int aoff = lds_byte(wr * 64 + fr, FP8 ? fq * 16 : fq * 8), boff = lds_byte(wc * 32 + fr, FP8 ? fq * 16 : fq * 8);
#define PG8_SA(b, h) (((b) * 2 + (h)) * HTB)
#define PG8_SB(b, h) ((4 + (b) * 2 + (h)) * HTB)
#define PG8_STAGE(bufoff, gbase, voff) do { _Pragma("unroll") for (int _i = 0; _i < 2; ++_i) { unsigned o_ = (voff)[_i]; asm volatile("" : "+v"(o_));     \
        __builtin_amdgcn_global_load_lds((const unsigned*)((const char*)(gbase) + o_), (PG8_LAS unsigned*)(lds + (bufoff) + ldsw + _i * 8192), 16, 0, 0); } } while (0)
#define PG8_LD16(p) (*(const PG8_LAS v4i32*)(p))
#define PG8_LDA(dst, b, h) do { if constexpr (FP8) { _Pragma("unroll") for (int m = 0; m < 4; ++m) { const PG8_LAS unsigned char* p_ = lds + PG8_SA(b, h) + aoff + m * 2048; \
            dst##8[m] = __builtin_shufflevector(PG8_LD16(p_), PG8_LD16(p_ + 16), 0, 1, 2, 3, 4, 5, 6, 7); } } \
        else { _Pragma("unroll") for (int m = 0; m < 4; ++m) _Pragma("unroll") for (int k = 0; k < 2; ++k) dst[m][k] = *(const PG8_LAS bf16x8*)(lds + PG8_SA(b, h) + aoff + m * 2048 + k * 1024); } } while (0)
#define PG8_LDB(dst, b, h) do { if constexpr (FP8) { _Pragma("unroll") for (int n = 0; n < 2; ++n) { const PG8_LAS unsigned char* p_ = lds + PG8_SB(b, h) + boff + n * 2048; \
            dst##8[n] = __builtin_shufflevector(PG8_LD16(p_), PG8_LD16(p_ + 16), 0, 1, 2, 3, 4, 5, 6, 7); } } \
        else { _Pragma("unroll") for (int n = 0; n < 2; ++n) _Pragma("unroll") for (int k = 0; k < 2; ++k) dst[n][k] = *(const PG8_LAS bf16x8*)(lds + PG8_SB(b, h) + boff + n * 2048 + k * 1024); } } while (0)
#define PG8_MMA(ai, bj, At, Bt) do { __builtin_amdgcn_s_setprio(1); \
        if constexpr (FP8) { _Pragma("unroll") for (int m = 0; m < 4; ++m) _Pragma("unroll") for (int n = 0; n < 2; ++n) \
                asm volatile("v_mfma_scale_f32_16x16x128_f8f6f4 %0, %1, %2, %0, %3, %3 op_sel_hi:[0,0,0]" : "+v"(acc[ai][bj][m][n]) : "v"(Bt##8[n]), "v"(At##8[m]), "v"(scl8)); } \
        else { _Pragma("unroll") for (int m = 0; m < 4; ++m) _Pragma("unroll") for (int n = 0; n < 2; ++n) _Pragma("unroll") for (int k = 0; k < 2; ++k) \
                acc[ai][bj][m][n] = __builtin_amdgcn_mfma_f32_16x16x32_bf16(Bt[n][k], At[m][k], acc[ai][bj][m][n], 0, 0, 0); } \
        __builtin_amdgcn_s_setprio(0); } while (0)
#define PG8_WAIT_V(n) asm volatile("s_waitcnt vmcnt(" #n ")" ::: "memory")
#define PG8_WAIT_L(n) asm volatile("s_waitcnt lgkmcnt(" #n ")" ::: "memory")
#define PG8_BAR __builtin_amdgcn_s_barrier()
#define PG8_SCHED __builtin_amdgcn_sched_barrier(0)
#define PG8_VOFF(u, v) do { _Pragma("unroll") for (int _i = 0; _i < 2; ++_i) { int r_ = RA[_i]; if (GATHER) asm volatile("" : "+v"(r_));     \
        _Pragma("unroll") for (int _h = 0; _h < 2; ++_h) v[_h][_i] = GATHER ? (S.a_rowoff(u, _h * HALF + r_) + CA[_i]) : ((unsigned)((_h * HALF + r_) * K) * 2u + CA[_i]); } } while (0)
    GUnit cur, nxt; int ui = 0;
    if (!S.next(0, cur)) return;
    f32x4 acc[2][2][4][2];
#pragma unroll
    for (int a = 0; a < 2; ++a)
#pragma unroll
        for (int b = 0; b < 2; ++b)
#pragma unroll
            for (int m = 0; m < 4; ++m)
#pragma unroll
                for (int n = 0; n < 2; ++n) acc[a][b][m][n] = (f32x4){0.f, 0.f, 0.f, 0.f};
    bf16x8 At[4][2], B0[2][2], B1[2][2];
    v8i32 At8[4], B08[2], B18[2];
    const int scl8 = 0x7f7f7f7f;
    unsigned vAc[2][2], vAn[2][2];
    PG8_VOFF(cur, vAc);
    if (GATHER) { asm volatile("s_waitcnt vmcnt(0)" : "+v"(vAc[0][0]), "+v"(vAc[0][1]), "+v"(vAc[1][0]), "+v"(vAc[1][1]) :: "memory"); }
    const char* cA = cur.a; const char* cB = cur.b;
    PG8_STAGE(PG8_SB(0, 0), cB, voffB); PG8_STAGE(PG8_SB(0, 1), cB + hstep, voffB); PG8_STAGE(PG8_SA(0, 0), cA, vAc[0]); PG8_STAGE(PG8_SA(0, 1), cA, vAc[1]);
    if (wr == 1) PG8_BAR;
    PG8_WAIT_V(2); PG8_BAR;
    PG8_STAGE(PG8_SB(1, 0), cB + kstep, voffB); PG8_STAGE(PG8_SA(1, 0), cA + kstep, vAc[0]); PG8_STAGE(PG8_SB(1, 1), cB + hstep + kstep, voffB);
    PG8_WAIT_V(6); PG8_BAR;
    for (;;) {
        const bool has_next = S.next(ui + 1, nxt);
        const char* nA = has_next ? nxt.a : cA; const char* nB = has_next ? nxt.b : cB;
        if (GATHER) {
            if (has_next) { PG8_VOFF(nxt, vAn); }
            else {
#pragma unroll
                for (int h = 0; h < 2; ++h)
#pragma unroll
                    for (int i = 0; i < 2; ++i) vAn[h][i] = vAc[h][i]; }
            asm volatile("s_waitcnt vmcnt(0)" : "+v"(vAn[0][0]), "+v"(vAn[0][1]), "+v"(vAn[1][0]), "+v"(vAn[1][1]) :: "memory");
        }
#pragma unroll 1
        for (int t = 0; t < nt; t += 2) {
            const bool last = (t == nt - 2);
            if constexpr (Epi::HAS_MID) { if (t == (nt >> 1)) { int t_ = threadIdx.x; asm volatile("" : "+v"(t_)); E.mid(acc, cur, wr, wc, t_ & 15, (t_ >> 4) & 3); } }
            const char* a1 = cA + (size_t)(t + 1) * kstep;
            const char* a2 = last ? nA : cA + (size_t)(t + 2) * kstep; const char* b2 = last ? nB : cB + (size_t)(t + 2) * kstep;
            const char* a3 = a2 + kstep; const char* b3 = b2 + kstep;
            unsigned v2[2][2];
#pragma unroll
            for (int h = 0; h < 2; ++h)
#pragma unroll
                for (int i = 0; i < 2; ++i) v2[h][i] = (GATHER && last) ? vAn[h][i] : vAc[h][i];
            PG8_LDB(B0, 0, 0); PG8_LDB(B1, 0, 1); PG8_SCHED; PG8_LDA(At, 0, 0); PG8_STAGE(PG8_SA(1, 1), a1, vAc[1]);
            PG8_WAIT_V(8); PG8_WAIT_L(0); PG8_BAR; PG8_MMA(0, 0, At, B0); PG8_MMA(0, 1, At, B1); PG8_BAR; PG8_SCHED;
            PG8_LDA(At, 0, 1); PG8_STAGE(PG8_SB(0, 0), b2, voffB); PG8_STAGE(PG8_SB(0, 1), b2 + hstep, voffB); PG8_STAGE(PG8_SA(0, 0), a2, v2[0]);
            PG8_WAIT_V(8); PG8_WAIT_L(0); PG8_BAR; PG8_MMA(1, 0, At, B0); PG8_MMA(1, 1, At, B1); PG8_BAR; PG8_SCHED;
            PG8_LDB(B0, 1, 0); PG8_LDB(B1, 1, 1); PG8_SCHED; PG8_LDA(At, 1, 0); PG8_STAGE(PG8_SA(0, 1), a2, v2[1]);
            PG8_WAIT_V(8); PG8_WAIT_L(0); PG8_BAR; PG8_MMA(0, 0, At, B0); PG8_MMA(0, 1, At, B1); PG8_BAR; PG8_SCHED;
            PG8_LDA(At, 1, 1); PG8_STAGE(PG8_SB(1, 0), b3, voffB); PG8_STAGE(PG8_SB(1, 1), b3 + hstep, voffB); PG8_STAGE(PG8_SA(1, 0), a3, v2[0]);
            PG8_WAIT_V(8); PG8_WAIT_L(0); PG8_BAR; PG8_MMA(1, 0, At, B0); PG8_MMA(1, 1, At, B1); PG8_BAR; PG8_SCHED;
        }
        if constexpr (FP8) {
            asm volatile("s_nop 15\n\ts_nop 15" ::: "memory");
#pragma unroll
            for (int a = 0; a < 2; ++a)
#pragma unroll
                for (int b = 0; b < 2; ++b)
#pragma unroll
                    for (int m = 0; m < 4; ++m) asm volatile("" : "+v"(acc[a][b][m][0]), "+v"(acc[a][b][m][1]));
        }
        if constexpr (ALIGN_EPI) { if (wr == 0) PG8_BAR; }
        { int t_ = threadIdx.x; asm volatile("" : "+v"(t_));
          E(acc, cur, wr, wc, t_ & 15, (t_ >> 4) & 3); }
        if (!has_next) break;
#pragma unroll
        for (int a = 0; a < 2; ++a)
#pragma unroll
            for (int b = 0; b < 2; ++b)
#pragma unroll
                for (int m = 0; m < 4; ++m)
#pragma unroll
                    for (int n = 0; n < 2; ++n) acc[a][b][m][n] = (f32x4){0.f, 0.f, 0.f, 0.f};
        cur = nxt; cA = nA; cB = nB; ++ui;
#pragma unroll
        for (int h = 0; h < 2; ++h)
#pragma unroll
            for (int i = 0; i < 2; ++i) vAc[h][i] = vAn[h][i];
        if constexpr (ALIGN_EPI) { if (wr == 1) PG8_BAR; }
    }
    PG8_WAIT_V(0);
    if constexpr (!ALIGN_EPI) { if (wr == 0) PG8_BAR; }
    PG8_BAR;
#undef PG8_SA
#undef PG8_SB
#undef PG8_STAGE
#undef PG8_LDA
#undef PG8_LDB
#undef PG8_MMA
#undef PG8_LD16
#undef PG8_WAIT_V
#undef PG8_WAIT_L
#undef PG8_BAR
#undef PG8_SCHED
#undef PG8_VOFF
}
}
#define LAS __attribute__((address_space(3)))
__device__ __forceinline__ u32x4 pack8(const f32x4& v0, const f32x4& v1) { u32x4 w; w.x = pg8::cvt_pk_bf16(v0[0], v0[1]); w.y = pg8::cvt_pk_bf16(v0[2], v0[3]); w.z = pg8::cvt_pk_bf16(v1[0], v1[1]); w.w = pg8::cvt_pk_bf16(v1[2], v1[3]); return w; }
__device__ __forceinline__ void unpack8(const u32x4& w, f32x4& v0, f32x4& v1) { v0 = (f32x4){bf2f(w.x & 0xffffu), bf2f(w.x >> 16), bf2f(w.y & 0xffffu), bf2f(w.y >> 16)}; v1 = (f32x4){bf2f(w.z & 0xffffu), bf2f(w.z >> 16), bf2f(w.w & 0xffffu), bf2f(w.w >> 16)}; }
__device__ __forceinline__ float sigs_(float a) { return __builtin_amdgcn_rcpf(1.f + __builtin_amdgcn_exp2f(a * (-LOG2E * W8_INV))); }
__device__ __forceinline__ f32x4 sig4s(const f32x4& v) { return (f32x4){sigs_(v[0]), sigs_(v[1]), sigs_(v[2]), sigs_(v[3])}; }
__device__ __forceinline__ f32x4 sig4(const f32x4& v) { return (f32x4){sigmoidf_(v[0]), sigmoidf_(v[1]), sigmoidf_(v[2]), sigmoidf_(v[3])}; }

struct EpiProj {
    static constexpr bool PERM = true, HAS_MID = false;
    unsigned char* ws;
    __device__ __forceinline__ void operator()(const f32x4 (&acc)[2][2][4][2], const pg8::GUnit& u, int wr, int wc, int fr, int fq) const {
        const int row0 = u.pm * 256 + wr * 64 + fr;
#pragma unroll
        for (int bj = 0; bj < 2; ++bj) {
            const int cl = bj * 128 + wc * 32 + 8 * fq;
            bf16_t* base; int ld, c; float sc = 1.f; bool sg = false;
            const int pn = u.pn;
            if (pn < 2) { base = (bf16_t*)(ws + WS_QA); ld = 512; c = pn * 256 + cl; sc = 0.125f * LOG2E; }
            else if (pn == 2) { base = (bf16_t*)(ws + (bj == 0 ? WS_KA : WS_VA)); ld = 128; c = wc * 32 + 8 * fq; }
            else if (pn == 3) { base = (bf16_t*)(ws + WS_CKV); ld = 256; c = cl; }
            else if (pn == 4) { base = (bf16_t*)(ws + WS_CQ); ld = 384; c = cl; }
            else if (pn == 5) { if (bj == 0) { base = (bf16_t*)(ws + WS_CQ); ld = 384; c = 256 + wc * 32 + 8 * fq; } else { if (wc != 0) continue; base = (bf16_t*)(ws + WS_KR); ld = 32; c = 8 * fq; } }
            else if (pn < 10) { base = (bf16_t*)(ws + WS_GA); ld = 1024; c = (pn - 6) * 256 + cl; sg = true; }
            else { base = (bf16_t*)(ws + WS_GB); ld = 1024; c = (pn - 10) * 256 + cl; sg = true; }
            const bool is_kr = pn == 5 && bj == 1;
#pragma unroll
            for (int ai = 0; ai < 2; ++ai) {
                f32x4 cs[4], sn[4];
                if (is_kr) {
#pragma unroll
                    for (int m = 0; m < 4; ++m) { const int row = row0 + ai * 128 + m * 16; cs[m] = *(const f32x4*)((const float*)(ws + WS_COS) + row * 16 + 4 * fq); sn[m] = *(const f32x4*)((const float*)(ws + WS_SIN) + row * 16 + 4 * fq); }
                    asm volatile("" : "+v"(cs[0]), "+v"(cs[1]), "+v"(cs[2]), "+v"(cs[3]), "+v"(sn[0]), "+v"(sn[1]), "+v"(sn[2]), "+v"(sn[3]) :: "memory");
                }
#pragma unroll
                for (int m = 0; m < 4; ++m) { f32x4 v0 = acc[ai][bj][m][0], v1 = acc[ai][bj][m][1]; const int row = row0 + ai * 128 + m * 16;
                    if (is_kr) { const f32x4 o1 = v0 * cs[m] - v1 * sn[m], o2 = v1 * cs[m] + v0 * sn[m]; v0 = o1; v1 = o2; }
                    else if (sg) { v0 = sig4(v0); v1 = sig4(v1); } else { v0 = v0 * sc; v1 = v1 * sc; }
                    *(u32x4*)(base + (size_t)row * ld + c) = pack8(v0, v1); }
            }
        }
        if (u.pn >= 3 && u.pn <= 5) {
            float* SSQ = (float*)(ws + WS_SSQ);
#pragma unroll
            for (int ai = 0; ai < 2; ++ai)
#pragma unroll
                for (int m = 0; m < 4; ++m) { float q = 0.f;
#pragma unroll
                    for (int bj = 0; bj < 2; ++bj) { if (u.pn == 5 && bj == 1) continue;
#pragma unroll
                        for (int n = 0; n < 2; ++n) { const f32x4 v = acc[ai][bj][m][n]; q += (v[0] * v[0] + v[1] * v[1]) + (v[2] * v[2] + v[3] * v[3]); } }
                    q += __shfl_xor(q, 16); q += __shfl_xor(q, 32);
                    const int slot = u.pn == 3 ? 8 + wc : u.pn == 4 ? wc : 4 + wc;
                    if (fq == 0) SSQ[slot * MTOK + row0 + ai * 128 + m * 16] = q; }
        }
    }
};
struct EpiUpQ {
    static constexpr bool PERM = true, HAS_MID = false;
    unsigned char* ws;
    __device__ __forceinline__ void operator()(const f32x4 (&acc)[2][2][4][2], const pg8::GUnit& u, int wr, int wc, int fr, int fq) const {
        const float qs0 = 0.10206207261596577f * LOG2E;
        const int row0 = u.pm * 256 + wr * 64 + fr;
        const float* COS = (const float*)(ws + WS_COS); const float* SIN = (const float*)(ws + WS_SIN); const float* SSQ = (const float*)(ws + WS_SSQ);
        float rq[2][4];
#pragma unroll
        for (int ai = 0; ai < 2; ++ai)
#pragma unroll
            for (int m = 0; m < 4; ++m) { const int row = row0 + ai * 128 + m * 16; float q = 0.f;
#pragma unroll
                for (int sl = 0; sl < 8; ++sl) q += SSQ[sl * MTOK + row];
                rq[ai][m] = rsqrtf(q * (1.f / 384.f) + EPS); }
        asm volatile("" : "+v"(rq[0][0]), "+v"(rq[0][1]), "+v"(rq[0][2]), "+v"(rq[0][3]), "+v"(rq[1][0]), "+v"(rq[1][1]), "+v"(rq[1][2]), "+v"(rq[1][3]) :: "memory");
#pragma unroll
        for (int ai = 0; ai < 2; ++ai) { f32x4 cs[4], sn[4];
            if (u.pn >= 2) {
#pragma unroll
                for (int m = 0; m < 4; ++m) { const int row = row0 + ai * 128 + m * 16; cs[m] = *(const f32x4*)(COS + row * 16 + 4 * fq); sn[m] = *(const f32x4*)(SIN + row * 16 + 4 * fq); }
                asm volatile("" : "+v"(cs[0]), "+v"(cs[1]), "+v"(cs[2]), "+v"(cs[3]), "+v"(sn[0]), "+v"(sn[1]), "+v"(sn[2]), "+v"(sn[3]) :: "memory");
            }
#pragma unroll
            for (int bj = 0; bj < 2; ++bj) { const int cl = bj * 128 + wc * 32 + 8 * fq;
#pragma unroll
                for (int m = 0; m < 4; ++m) { const int row = row0 + ai * 128 + m * 16; const float qs = qs0 * rq[ai][m];
                    const f32x4 v0 = acc[ai][bj][m][0], v1 = acc[ai][bj][m][1];
                    if (u.pn < 2) { *(u32x4*)((bf16_t*)(ws + WS_QN) + (size_t)row * 512 + u.pn * 256 + cl) = pack8(v0 * qs, v1 * qs); }
                    else { const f32x4 o1 = (v0 * cs[m] - v1 * sn[m]) * qs, o2 = (v1 * cs[m] + v0 * sn[m]) * qs;
                        *(u32x4*)((bf16_t*)(ws + WS_QR) + (size_t)row * 256 + cl) = pack8(o1, o2); }
                }
                asm volatile("" ::: "memory"); }
        }
    }
};
struct EpiUpKV {
    static constexpr bool PERM = true, HAS_MID = false;
    unsigned char* ws;
    __device__ __forceinline__ void operator()(const f32x4 (&acc)[2][2][4][2], const pg8::GUnit& u, int wr, int wc, int fr, int fq) const {
        const int row0 = u.pm * 256 + wr * 64 + fr;
        bf16_t* base = (bf16_t*)(ws + (u.pn < 2 ? WS_KN : WS_VB)); const float* SSQ = (const float*)(ws + WS_SSQ);
        float rk[2][4];
#pragma unroll
        for (int ai = 0; ai < 2; ++ai)
#pragma unroll
            for (int m = 0; m < 4; ++m) { const int row = row0 + ai * 128 + m * 16;
                const float q = (SSQ[8 * MTOK + row] + SSQ[9 * MTOK + row]) + (SSQ[10 * MTOK + row] + SSQ[11 * MTOK + row]);
                rk[ai][m] = rsqrtf(q * (1.f / 256.f) + EPS); }
#pragma unroll
        for (int bj = 0; bj < 2; ++bj) { const int c = (u.pn & 1) * 256 + bj * 128 + wc * 32 + 8 * fq;
#pragma unroll
            for (int ai = 0; ai < 2; ++ai)
#pragma unroll
                for (int m = 0; m < 4; ++m) *(u32x4*)(base + (size_t)(row0 + ai * 128 + m * 16) * 512 + c) = pack8(acc[ai][bj][m][0] * rk[ai][m], acc[ai][bj][m][1] * rk[ai][m]); }
    }
};
struct EpiMixF {
    static constexpr bool PERM = true, HAS_MID = true;
    unsigned char* ws;
    __device__ __forceinline__ void mid(f32x4 (&acc)[2][2][4][2], const pg8::GUnit& u, int wr, int wc, int fr, int fq) const {
        const int row0 = u.pm * 256 + wr * 64 + fr;
        const bf16_t* GA = (const bf16_t*)(ws + WS_GA); const bf16_t* GB = (const bf16_t*)(ws + WS_GB);
#pragma unroll
        for (int bj = 0; bj < 2; ++bj) { const int c = u.pn * 256 + bj * 128 + wc * 32 + 8 * fq;
#pragma unroll
            for (int ai = 0; ai < 2; ++ai) { u32x4 ga[4], gb[4];
#pragma unroll
                for (int m = 0; m < 4; ++m) { const size_t idx = (size_t)(row0 + ai * 128 + m * 16) * 1024 + c; ga[m] = *(const u32x4*)(GA + idx); gb[m] = *(const u32x4*)(GB + idx); }
                asm volatile("" : "+v"(ga[0]), "+v"(ga[1]), "+v"(ga[2]), "+v"(ga[3]), "+v"(gb[0]), "+v"(gb[1]), "+v"(gb[2]), "+v"(gb[3]) :: "memory");
#pragma unroll
                for (int m = 0; m < 4; ++m) { f32x4 a0, a1, b0, b1; unpack8(ga[m], a0, a1); unpack8(gb[m], b0, b1);
#pragma unroll
                    for (int i = 0; i < 4; ++i) { acc[ai][bj][m][0][i] *= a0[i] * __builtin_amdgcn_rcpf(fmaxf(b0[i], 1e-30f)); acc[ai][bj][m][1][i] *= a1[i] * __builtin_amdgcn_rcpf(fmaxf(b1[i], 1e-30f)); } } } }
    }
    __device__ __forceinline__ void operator()(const f32x4 (&acc)[2][2][4][2], const pg8::GUnit& u, int wr, int wc, int fr, int fq) const {
        const int row0 = u.pm * 256 + wr * 64 + fr;
        const bf16_t* GB = (const bf16_t*)(ws + WS_GB); bf16_t* MIX = (bf16_t*)(ws + WS_MIX);
#pragma unroll
        for (int bj = 0; bj < 2; ++bj) { const int c = u.pn * 256 + bj * 128 + wc * 32 + 8 * fq;
            u32x4 gb[2][4];
#pragma unroll
            for (int ai = 0; ai < 2; ++ai)
#pragma unroll
                for (int m = 0; m < 4; ++m) gb[ai][m] = *(const u32x4*)(GB + (size_t)(row0 + ai * 128 + m * 16) * 1024 + c);
            asm volatile("" : "+v"(gb[0][0]), "+v"(gb[0][1]), "+v"(gb[0][2]), "+v"(gb[0][3]), "+v"(gb[1][0]), "+v"(gb[1][1]), "+v"(gb[1][2]), "+v"(gb[1][3]) :: "memory");
#pragma unroll
            for (int ai = 0; ai < 2; ++ai) {
#pragma unroll
                for (int m = 0; m < 4; ++m) { const size_t idx = (size_t)(row0 + ai * 128 + m * 16) * 1024 + c;
                    f32x4 g0, g1; unpack8(gb[ai][m], g0, g1);
                    const f32x4 y0 = g0 * acc[ai][bj][m][0] * MIX8_SCALE, y1 = g1 * acc[ai][bj][m][1] * MIX8_SCALE;
                    u32x2 o8; o8.x = pk4_fp8(y0[0], y0[1], y0[2], y0[3]); o8.y = pk4_fp8(y1[0], y1[1], y1[2], y1[3]);
                    *(u32x2*)((unsigned char*)MIX + idx) = o8; } } }
    }
};
struct EpiOut {
    static constexpr bool PERM = true, HAS_MID = false;
    unsigned char* ws; const float* x;
    __device__ __forceinline__ void operator()(const f32x4 (&acc)[2][2][4][2], const pg8::GUnit& u, int wr, int wc, int fr, int fq) const {
        const int row0 = u.pm * 256 + wr * 64 + fr; const int b = (u.pm * 256) >> 13;
        const float* mod = (const float*)(ws + WS_MOD); bf16_t* X1 = (bf16_t*)(ws + WS_X1);
#pragma unroll
        for (int bj = 0; bj < 2; ++bj) { const int c = u.pn * 256 + bj * 128 + wc * 32 + 8 * fq;
            const f32x4 g0 = *(const f32x4*)(mod + b * 6144 + 2048 + c) * OUT8_INV, g1 = *(const f32x4*)(mod + b * 6144 + 2048 + c + 4) * OUT8_INV;
#pragma unroll
            for (int ai = 0; ai < 2; ++ai) { f32x4 x0[4], x1[4];
#pragma unroll
                for (int m = 0; m < 4; ++m) { const size_t idx = (size_t)(row0 + ai * 128 + m * 16) * 1024 + c; x0[m] = *(const f32x4*)(x + idx); x1[m] = *(const f32x4*)(x + idx + 4); }
                asm volatile("" : "+v"(x0[0]), "+v"(x0[1]), "+v"(x0[2]), "+v"(x0[3]), "+v"(x1[0]), "+v"(x1[1]), "+v"(x1[2]), "+v"(x1[3]) :: "memory");
#pragma unroll
                for (int m = 0; m < 4; ++m) { const size_t idx = (size_t)(row0 + ai * 128 + m * 16) * 1024 + c;
                    *(u32x4*)(X1 + idx) = pack8(x0[m] + g0 * acc[ai][bj][m][0], x1[m] + g1 * acc[ai][bj][m][1]); } } }
    }
};

constexpr int RT_LD = 1028;
__device__ __forceinline__ void ph_route(const P& p, unsigned char* lds, bool commit = true) {
    const int tid = threadIdx.x, lane = tid & 63, wave = tid >> 6, e = lane & 31, hf = lane >> 5;
    const int RPW = MTOK / gridDim.x;
    float* h2s = (float*)lds;
    unsigned* lcnt = (unsigned*)(lds + 132096); unsigned* lbase = lcnt + 32; unsigned* lent = lcnt + 64; float* lw = (float*)(lcnt + 64 + 256);
    float* lg = (float*)(lcnt + 64 + 512) + wave * 128 + hf * 64;
    if (tid < NEXP) lcnt[tid] = 0u;
    const float* mod = (const float*)(p.ws + WS_MOD); const bf16_t* X1 = (const bf16_t*)(p.ws + WS_X1); unsigned char* H2 = p.ws + WS_XN;
    unsigned* cnt = (unsigned*)(p.ws + WS_CTL); unsigned* LIST = (unsigned*)(p.ws + WS_LIST); float* LISTW = (float*)(p.ws + WS_LISTW);
    u32x4 wh[8], wl[8];
    { const float* wrt = (const float*)(p.ws + WS_WRT) + e * 1028 + 128 * wave + 8 * hf;
#pragma unroll
      for (int ks = 0; ks < 8; ++ks) { const f32x4 a = *(const f32x4*)(wrt + 16 * ks), b = *(const f32x4*)(wrt + 16 * ks + 4); f32x4 ha, hb;
          wh[ks] = pack8(a, b); unpack8(wh[ks], ha, hb); wl[ks] = pack8(a - ha, b - hb); } }
    const float brt = p.b_router[e];
    for (int pass = 0; pass * 32 < RPW; ++pass) {
        u32x2 xw[4][4];
#pragma unroll
        for (int rr = 0; rr < 4; ++rr) { const u32x2* xr = (const u32x2*)(X1 + (size_t)(blockIdx.x * RPW + pass * 32 + 4 * wave + rr) * DM);
#pragma unroll
            for (int j = 0; j < 4; ++j) xw[rr][j] = xr[lane + 64 * j]; }
        f32x4 rg[4], rsc[4], rsh[4];
        { const int b0 = (blockIdx.x * RPW + pass * 32) >> 13;
#pragma unroll
          for (int j = 0; j < 4; ++j) { const int col = 4 * lane + 256 * j; rg[j] = *(const f32x4*)(p.norm_ffn + col); rsc[j] = *(const f32x4*)(mod + b0 * 6144 + 4096 + col); rsh[j] = *(const f32x4*)(mod + b0 * 6144 + 3072 + col); } }
#pragma unroll
        for (int rr = 0; rr < 4; ++rr) {
            const int rl = 4 * wave + rr, m = blockIdx.x * RPW + pass * 32 + rl;
            f32x4 v[4]; float s = 0.f;
#pragma unroll
            for (int j = 0; j < 4; ++j) { const u32x2 w = xw[rr][j]; v[j] = (f32x4){bf2f(w.x & 0xffffu), bf2f(w.x >> 16), bf2f(w.y & 0xffffu), bf2f(w.y >> 16)};
                s += v[j].x * v[j].x + v[j].y * v[j].y + v[j].z * v[j].z + v[j].w * v[j].w; }
            s = wave_sum(s);
            const float rstd = rsqrtf(s * (1.f / DM) + EPS);
#pragma unroll
            for (int j = 0; j < 4; ++j) { const int col = 4 * lane + 256 * j;
                const f32x4 g = rg[j], sc = rsc[j], sh = rsh[j];
                v[j] = v[j] * rstd * g * (sc + 1.0f) + sh;
                *(unsigned*)(H2 + (size_t)m * DM + col) = pk4_fp8(v[j].x, v[j].y, v[j].z, v[j].w);
                *(f32x4*)(h2s + rl * RT_LD + col) = v[j]; }
        }
        __syncthreads();
        typedef float f32x16r __attribute__((ext_vector_type(16)));
        f32x16r acc, acc1, acc2;
#pragma unroll
        for (int r = 0; r < 16; ++r) { acc[r] = 0.f; acc1[r] = 0.f; acc2[r] = 0.f; }
        const float* ap = h2s + e * RT_LD + 128 * wave + 8 * hf;
#pragma unroll
        for (int ks = 0; ks < 8; ++ks) { const f32x4 a = *(const f32x4*)(ap + 16 * ks), b = *(const f32x4*)(ap + 16 * ks + 4); f32x4 ha, hb;
            const u32x4 ah = pack8(a, b); unpack8(ah, ha, hb); const u32x4 al = pack8(a - ha, b - hb);
            acc  = __builtin_amdgcn_mfma_f32_32x32x16_bf16(__builtin_bit_cast(bf16x8, ah), __builtin_bit_cast(bf16x8, wh[ks]), acc, 0, 0, 0);
            acc1 = __builtin_amdgcn_mfma_f32_32x32x16_bf16(__builtin_bit_cast(bf16x8, ah), __builtin_bit_cast(bf16x8, wl[ks]), acc1, 0, 0, 0);
            acc2 = __builtin_amdgcn_mfma_f32_32x32x16_bf16(__builtin_bit_cast(bf16x8, al), __builtin_bit_cast(bf16x8, wh[ks]), acc2, 0, 0, 0); }
#pragma unroll
        for (int r = 0; r < 16; ++r) acc[r] += acc1[r] + acc2[r];
        __syncthreads();
#pragma unroll
        for (int r = 0; r < 16; ++r) h2s[(wave * 32 + ((r & 3) + 8 * (r >> 2) + 4 * hf)) * 32 + e] = acc[r];
        __syncthreads();
#pragma unroll 1
        for (int it = 0; it < 2; ++it) {
            const int rl = 4 * wave + 2 * it + hf, ri = pass * 32 + rl;
            float val = brt;
#pragma unroll
            for (int w8 = 0; w8 < 8; ++w8) val += h2s[(w8 * 32 + rl) * 32 + e];
            lg[e] = val;
            int rank = 0;
#pragma unroll
            for (int e4 = 0; e4 < 8; ++e4) { const f32x4 o = *(const f32x4*)(lg + 4 * e4);
#pragma unroll
                for (int i = 0; i < 4; ++i) { const int ee = 4 * e4 + i; rank += (o[i] > val || (o[i] == val && ee < e)) ? 1 : 0; } }
            if (rank < 4) { lg[32 + rank] = val; lg[36 + rank] = __int_as_float(e); }
            const f32x4 tvv = *(const f32x4*)(lg + 32), tiv = *(const f32x4*)(lg + 36);
            const float e1 = __expf(tvv[1] - tvv[0]), e2 = __expf(tvv[2] - tvv[0]), e3 = __expf(tvv[3] - tvv[0]);
            const float inv = 1.f / (1.f + e1 + e2 + e3);
            if (e < 4) {
                const int ex = __float_as_int(e == 0 ? tiv[0] : e == 1 ? tiv[1] : e == 2 ? tiv[2] : tiv[3]);
                const float w = (e == 0 ? 1.f : e == 1 ? e1 : e == 2 ? e2 : e3) * inv;
                const unsigned lr = atomicAdd(&lcnt[ex], 1u);
                lent[ri * 4 + e] = (unsigned)ex | (lr << 8); lw[ri * 4 + e] = w;
            }
        }
        __syncthreads();
    }
    if (!commit) return;
    if (tid < NEXP) lbase[tid] = atomicAdd(&cnt[tid * 64], lcnt[tid]);
    __syncthreads();
    for (int a = tid; a < RPW * 4; a += NTHREADS) {
        const unsigned en = lent[a]; const int ex = (int)(en & 255u); const unsigned pos = lbase[ex] + (en >> 8);
        LIST[(size_t)ex * LISTCAP + pos] = (unsigned)((blockIdx.x * RPW + (a >> 2)) * 4 + (a & 3));
        ((float*)(p.ws + WS_TOPW))[(size_t)blockIdx.x * RPW * 4 + a] = lw[a];
    }
}
__device__ __forceinline__ void ph_final(const P& p) {
    const int tid = threadIdx.x, lane = tid & 63, wave = tid >> 6;
    const int gw = blockIdx.x * 8 + wave, NGW = gridDim.x * 8;
    const float* mod = (const float*)(p.ws + WS_MOD); const bf16_t* X1 = (const bf16_t*)(p.ws + WS_X1); const unsigned char* Y = (const unsigned char*)(p.ws + WS_Y);
    f32x4 fg[4], g2v[4]; int pb = -1;
#pragma unroll
    for (int j = 0; j < 4; ++j) fg[j] = *(const f32x4*)(p.fnorm + 4 * lane + 256 * j);
    for (int m = gw; m < MTOK; m += NGW) {
        const int b = m >> 13;
        if (b != pb) { pb = b;
#pragma unroll
            for (int j = 0; j < 4; ++j) g2v[j] = *(const f32x4*)(mod + b * 6144 + 5120 + 4 * lane + 256 * j); }
        const u32x2* xr = (const u32x2*)(X1 + (size_t)m * DM);
        f32x4 v[4]; float s = 0.f;
        const f32x4 tw = *(const f32x4*)((const float*)(p.ws + WS_TOPW) + (size_t)m * 4);
#pragma unroll
        for (int j = 0; j < 4; ++j) { const int col = 4 * lane + 256 * j;
            f32x4 y = (f32x4){0.f, 0.f, 0.f, 0.f};
#pragma unroll
            for (int k = 0; k < 4; ++k) { const int w = (int)__builtin_nontemporal_load((const unsigned*)(Y + ((size_t)m * 4 + k) * 1024 + col));
                y.x += tw[k] * __builtin_amdgcn_cvt_f32_fp8(w, 0); y.y += tw[k] * __builtin_amdgcn_cvt_f32_fp8(w, 1); y.z += tw[k] * __builtin_amdgcn_cvt_f32_fp8(w, 2); y.w += tw[k] * __builtin_amdgcn_cvt_f32_fp8(w, 3); }
            const f32x4 g2 = g2v[j];
            const u32x2 xw = xr[lane + 64 * j];
            v[j] = (f32x4){bf2f(xw.x & 0xffffu), bf2f(xw.x >> 16), bf2f(xw.y & 0xffffu), bf2f(xw.y >> 16)} + g2 * y;
            s += v[j].x * v[j].x + v[j].y * v[j].y + v[j].z * v[j].z + v[j].w * v[j].w; }
        s = wave_sum(s);
        const float rstd = rsqrtf(s * (1.f / DM) + EPS);
#pragma unroll
        for (int j = 0; j < 4; ++j) { const int col = 4 * lane + 256 * j; const f32x4 g = fg[j];
            *(f32x4*)(p.out + (size_t)m * DM + col) = v[j] * rstd * g; }
    }
}


struct EpiGate {
    static constexpr bool PERM = true, HAS_MID = false;
    unsigned char* ws;
    __device__ __forceinline__ void operator()(const f32x4 (&acc)[2][2][4][2], const pg8::GUnit& u, int wr, int wc, int fr, int fq) const {
        const int row0 = u.pm * 256 + wr * 64 + fr;
        bf16_t* base = (bf16_t*)(ws + (u.pn < 4 ? WS_GA : WS_GB));
#pragma unroll
        for (int bj = 0; bj < 2; ++bj) { const int c = (u.pn & 3) * 256 + bj * 128 + wc * 32 + 8 * fq;
#pragma unroll
            for (int ai = 0; ai < 2; ++ai)
#pragma unroll
                for (int m = 0; m < 4; ++m) *(u32x4*)(base + (size_t)(row0 + ai * 128 + m * 16) * 1024 + c) = pack8(sig4s(acc[ai][bj][m][0]), sig4s(acc[ai][bj][m][1])); }
    }
};
struct GateOrder {
    const char* A; const char* Bt; int G, c;
    __device__ __forceinline__ bool next(int i, pg8::GUnit& u) const {
        int un;
        if (G == 256) { if (c < 128) { if (i > 0) return false; un = c; } else { if (i > 2) return false; un = 128 + 3 * (c - 128) + i; } }
        else { un = i * G + c; if (un >= 512) return false; }
        u.pm = un >> 3; u.pn = un & 7; u.e = 0; u.cnt = 0; u.tile = 0; u.pad_ = 0;
        u.a = A + (size_t)u.pm * 256 * 1024; u.b = Bt + (size_t)u.pn * 256 * 1024; return true;
    }
    __device__ __forceinline__ unsigned a_rowoff(const pg8::GUnit&, int) const { return 0u; }
};
__device__ __forceinline__ void ph_proj2(const P& p, unsigned char* lds) {
    { pg8::DenseOrder S; S.init(p.ws + WS_XN, p.ws + WS_WT_IN, MTOK, 1536, 1024, gridDim.x, blockIdx.x);
      EpiProj E{p.ws};
      pg8::gemm_phase<EpiProj, pg8::DenseOrder, true, false>((LAS unsigned char*)lds, 1024, S, E); }
    { GateOrder S{(const char*)(p.ws + WS_XN8), (const char*)(p.ws + WS_WT_G8), (int)gridDim.x, (int)blockIdx.x};
      EpiGate E{p.ws};
      pg8::gemm_phase<EpiGate, GateOrder, true, false, true>((LAS unsigned char*)lds, 512, S, E); }
}
__device__ __forceinline__ void ph_up2(const P& p, unsigned char* lds) {
    { pg8::DenseOrder S; S.init(p.ws + WS_CQ, p.ws + WS_WT_UQ, MTOK, 768, 384, gridDim.x, blockIdx.x); EpiUpQ E{p.ws};
      pg8::gemm_phase<EpiUpQ, pg8::DenseOrder, false, false>((LAS unsigned char*)lds, 384, S, E); }
    { pg8::DenseOrder S; S.init(p.ws + WS_CKV, p.ws + WS_WT_UKV, MTOK, 1024, 256, gridDim.x, blockIdx.x); EpiUpKV E{p.ws};
      pg8::gemm_phase<EpiUpKV, pg8::DenseOrder, false, false>((LAS unsigned char*)lds, 256, S, E); }
}
__device__ __forceinline__ void ph_mix2(const P& p, unsigned char* lds) {
    pg8::DenseOrder S; S.init(p.ws + WS_AO, p.ws + WS_WT_A, MTOK, 1024, 1024, gridDim.x, blockIdx.x); EpiMixF E{p.ws};
    pg8::gemm_phase<EpiMixF, pg8::DenseOrder, false, false>((LAS unsigned char*)lds, 1024, S, E);
}
__device__ __forceinline__ void ph_out2(const P& p, unsigned char* lds) {
    pg8::DenseOrder S; S.init(p.ws + WS_MIX, p.ws + WS_WT_OUT, MTOK, 1024, 512, gridDim.x, blockIdx.x); EpiOut E{p.ws, p.x};
    pg8::gemm_phase<EpiOut, pg8::DenseOrder, false, false, true>((LAS unsigned char*)lds, 512, S, E);
}


constexpr int MOE_TAB_OFF = 135168;
__device__ __forceinline__ void moe_build_tab(const P& p, unsigned char* lds) {
    LAS int* tab = (LAS int*)((LAS unsigned char*)lds + MOE_TAB_OFF);
    const unsigned* cnt = (const unsigned*)(p.ws + WS_CTL);
    const int tid = threadIdx.x;
    if (tid < 64) {
        const int c = tid < NEXP ? (int)cnt[tid * 64] : 0, n = (c + 255) >> 8;
        int incl = n;
#pragma unroll
        for (int o = 1; o < 32; o <<= 1) { const int t = __shfl_up(incl, o); if (tid >= o) incl += t; }
        const int s = incl - n;
        if (tid < NEXP) { tab[tid] = c; tab[32 + tid] = s; for (int j = 0; j < n; ++j) tab[128 + s + j] = tid; if (tid == NEXP - 1) tab[64] = incl; }
    }
    __syncthreads();
}
template <bool GATHER> struct MoeOrder {
    const LAS int* tab; const char* Abase; const char* Bbase; const unsigned* LIST; int K, NCT, G, c;
    __device__ __forceinline__ bool next(int i, pg8::GUnit& u) const {
        const int vc = (G % 8 == 0) ? (c % 8) * (G / 8) + c / 8 : c;
        const int L = i * G + vc; const int ntile = __builtin_amdgcn_readfirstlane(tab[64]); if (L >= ntile * NCT) return false;
        const int tile = L / NCT, pn = L - tile * NCT, e = __builtin_amdgcn_readfirstlane(tab[128 + tile]);
        u.e = e; u.cnt = __builtin_amdgcn_readfirstlane(tab[e]); u.pm = tile - __builtin_amdgcn_readfirstlane(tab[32 + e]); u.pn = pn; u.tile = tile; u.pad_ = 0;
        u.b = Bbase + ((size_t)e * NCT + pn) * 256 * K * 2;
        u.a = GATHER ? Abase : Abase + (size_t)tile * 256 * K * 2;
        return true;
    }
    __device__ __forceinline__ unsigned a_rowoff(const pg8::GUnit& u, int r) const {
        const int row = u.pm * 256 + r; const unsigned ent = row < u.cnt ? LIST[(size_t)u.e * LISTCAP + row] : 0u; return (ent >> 2) * (unsigned)(K * 2);
    }
};
struct EpiMoe1 {
    static constexpr bool PERM = true, HAS_MID = false;
    unsigned char* ws; const float* b1;
    __device__ __forceinline__ void operator()(const f32x4 (&acc)[2][2][4][2], const pg8::GUnit& u, int wr, int wc, int fr, int fq) const {
        bf16_t* HID = (bf16_t*)(ws + WS_HID);
        const int row0 = u.tile * 256 + wr * 64 + fr, col = u.pn * 128 + wc * 32 + 8 * fq;
        constexpr float CG = -1.702f * LOG2E, CGI = 1.f / CG;
        f32x4 bg[2], bl[2];
#pragma unroll
        for (int n = 0; n < 2; ++n) { bg[n] = *(const f32x4*)(b1 + u.e * 2048 + col + 4 * n) * CG; bl[n] = (*(const f32x4*)(b1 + u.e * 2048 + 1024 + col + 4 * n) + 1.f) * CGI; }
#pragma unroll
        for (int ai = 0; ai < 2; ++ai)
#pragma unroll
            for (int m = 0; m < 4; ++m) { f32x4 h[2];
#pragma unroll
                for (int n = 0; n < 2; ++n) { const f32x4 gv = acc[ai][0][m][n] * (W8_INV * CG) + bg[n], lv = acc[ai][1][m][n] * (W8_INV * CGI) + bl[n];
#pragma unroll
                    for (int i = 0; i < 4; ++i) { const float t = fmaxf(gv[i], 7.f * CG), L = __builtin_amdgcn_fmed3f(lv[i], 8.f * CGI, -6.f * CGI);
                        h[n][i] = t * __builtin_amdgcn_rcpf(1.f + __builtin_amdgcn_exp2f(t)) * L; } }
                u32x2 o8; o8.x = pk4_fp8(h[0][0], h[0][1], h[0][2], h[0][3]); o8.y = pk4_fp8(h[1][0], h[1][1], h[1][2], h[1][3]);
                *(u32x2*)((unsigned char*)HID + (size_t)(row0 + ai * 128 + m * 16) * 1024 + col) = o8; }
    }
};
struct EpiMoe2 {
    static constexpr bool PERM = true, HAS_MID = false;
    unsigned char* ws; const float* b2;
    __device__ __forceinline__ void operator()(const f32x4 (&acc)[2][2][4][2], const pg8::GUnit& u, int wr, int wc, int fr, int fq) const {
        unsigned char* Y = ws + WS_Y; const unsigned* LIST = (const unsigned*)(ws + WS_LIST) + (size_t)u.e * LISTCAP;
        f32x4 bv[2][2]; unsigned ent[2][4];
#pragma unroll
        for (int bj = 0; bj < 2; ++bj)
#pragma unroll
            for (int n = 0; n < 2; ++n) bv[bj][n] = *(const f32x4*)(b2 + u.e * 1024 + u.pn * 256 + bj * 128 + wc * 32 + 8 * fq + 4 * n);
#pragma unroll
        for (int ai = 0; ai < 2; ++ai)
#pragma unroll
            for (int m = 0; m < 4; ++m) { const int rr = u.pm * 256 + ai * 128 + wr * 64 + m * 16 + fr, rc = rr < u.cnt ? rr : u.cnt - 1; ent[ai][m] = LIST[rc]; }
        asm volatile("" : "+v"(bv[0][0]), "+v"(bv[0][1]), "+v"(bv[1][0]), "+v"(bv[1][1]));
#pragma unroll
        for (int ai = 0; ai < 2; ++ai)
#pragma unroll
            for (int m = 0; m < 4; ++m) asm volatile("" : "+v"(ent[ai][m]));
#pragma unroll
        for (int ai = 0; ai < 2; ++ai)
#pragma unroll
            for (int m = 0; m < 4; ++m) { const int rr = u.pm * 256 + ai * 128 + wr * 64 + m * 16 + fr;
                if (rr < u.cnt) {
#pragma unroll
                    for (int bj = 0; bj < 2; ++bj) { const int c = u.pn * 256 + bj * 128 + wc * 32 + 8 * fq;
                        const f32x4 y0 = acc[ai][bj][m][0] * W8_INV + bv[bj][0], y1 = acc[ai][bj][m][1] * W8_INV + bv[bj][1];
                        u32x2 o8; o8.x = pk4_fp8(y0[0], y0[1], y0[2], y0[3]); o8.y = pk4_fp8(y1[0], y1[1], y1[2], y1[3]);
                        *(u32x2*)(Y + (size_t)ent[ai][m] * 1024 + c) = o8; } } }
    }
};
__device__ __forceinline__ void ph_moe1_2(const P& p, unsigned char* lds) {
    moe_build_tab(p, lds);
    MoeOrder<true> S{(const LAS int*)((LAS unsigned char*)lds + MOE_TAB_OFF), (const char*)(p.ws + WS_XN), (const char*)(p.ws + WS_WT_M1), (const unsigned*)(p.ws + WS_LIST), 512, 8, (int)gridDim.x, (int)blockIdx.x};
    EpiMoe1 E{p.ws, p.b_m1};
    pg8::gemm_phase<EpiMoe1, MoeOrder<true>, true, true, true>((LAS unsigned char*)lds, 512, S, E);
}
__device__ __forceinline__ void ph_moe2_2(const P& p, unsigned char* lds) {
    MoeOrder<false> S{(const LAS int*)((LAS unsigned char*)lds + MOE_TAB_OFF), (const char*)(p.ws + WS_HID), (const char*)(p.ws + WS_WT_M2), (const unsigned*)(p.ws + WS_LIST), 512, 4, (int)gridDim.x, (int)blockIdx.x};
    EpiMoe2 E{p.ws, p.b_m2};
    pg8::gemm_phase<EpiMoe2, MoeOrder<false>, true, false, true>((LAS unsigned char*)lds, 512, S, E);
}


namespace att {
typedef float f32x16 __attribute__((ext_vector_type(16)));
typedef short s16x4 __attribute__((ext_vector_type(4)));
typedef short v4i16_t __attribute__((ext_vector_type(4)));
typedef LAS const unsigned char* lds_cptr;
constexpr int KROW = 208;
constexpr int KBUF = 64 * KROW, VBUF = 8192;
constexpr int OFF_K = 0, OFF_V = 2 * KBUF, OFF_WS = 2 * KBUF + 2 * VBUF, LDS_BYTES_ATT = OFF_WS + 8 * 256;
__device__ __forceinline__ int crow(int r, int hi) { return (r & 3) + 8 * (r >> 2) + 4 * hi; }
__device__ __forceinline__ s16x4 vtr(lds_cptr p) { return __builtin_bit_cast(s16x4, __builtin_amdgcn_ds_read_tr16_b64_v4i16((LAS v4i16_t*)p)); }
__device__ __forceinline__ float vmax3(float a, float b, float c) { float d; asm("v_max3_f32 %0, %1, %2, %3" : "=v"(d) : "v"(a), "v"(b), "v"(c)); return d; }
__device__ __forceinline__ float half_swap_max(float m) { auto rr = __builtin_amdgcn_permlane32_swap(__float_as_uint(m), __float_as_uint(m), false, false); return fmaxf(__uint_as_float(rr[0]), __uint_as_float(rr[1])); }
__device__ __forceinline__ float half_swap_sum(float m) { auto rr = __builtin_amdgcn_permlane32_swap(__float_as_uint(m), __float_as_uint(m), false, false); return __uint_as_float(rr[0]) + __uint_as_float(rr[1]); }

constexpr int BG_SCR_OFF = 49152;
#define ATT_BARRIER() asm volatile("s_waitcnt lgkmcnt(0)\n\ts_barrier" ::: "memory")
template <bool MLA>
__device__ __forceinline__ void attn_unit(const P& p, LAS unsigned char* lds, int b, int hk, int q0, BgConv& bg, float* bgscr) {
    int tid_ = threadIdx.x; asm volatile("" : "+v"(tid_));
    const int tid = tid_, lane = tid & 63, r32 = lane & 31, hi = lane >> 5, wid = __builtin_amdgcn_readfirstlane(tid >> 6);
    constexpr int NKS = MLA ? 6 : 4;
    const int head = MLA ? hk : hk * 4 + (wid >> 1);
    const int qw0 = MLA ? q0 + 32 * wid : q0 + 32 * (wid & 1);
    const size_t rb = (size_t)b * SEQ;
    bf16x8 qf[NKS];
    if (MLA) {
        const bf16_t* qn = (const bf16_t*)(p.ws + WS_QN) + (rb + qw0 + r32) * 512 + head * 64 + 8 * hi;
        const bf16_t* qr = (const bf16_t*)(p.ws + WS_QR) + (rb + qw0 + r32) * 256 + head * 32 + 8 * hi;
#pragma unroll
        for (int ks = 0; ks < 4; ++ks) qf[ks] = *(const bf16x8*)(qn + 16 * ks);
#pragma unroll
        for (int ks = 4; ks < NKS; ++ks) qf[ks] = *(const bf16x8*)(qr + 16 * (ks - 4));
    } else {
        const bf16_t* qa = (const bf16_t*)(p.ws + WS_QA) + (rb + qw0 + r32) * 512 + head * 64 + 8 * hi;
#pragma unroll
        for (int ks = 0; ks < NKS; ++ks) qf[ks] = *(const bf16x8*)(qa + 16 * ks);
    }
    const int t_lo = MLA ? 0 : (q0 >= 128 ? (q0 - 128) >> 6 : 0), t_hi = MLA ? ((q0 + 256) >> 6) - 1 : (q0 >> 6);
    const int skey = tid >> 3, sc = tid & 7;
    const bf16_t* kg; const bf16_t* vg; const bf16_t* rg = nullptr;
    if (MLA) { kg = (const bf16_t*)(p.ws + WS_KN) + (rb + skey) * 512 + hk * 64 + 8 * sc; vg = (const bf16_t*)(p.ws + WS_VB) + (rb + skey) * 512 + hk * 64 + 8 * sc;
               rg = (const bf16_t*)(p.ws + WS_KR) + (rb + (tid >> 2)) * 32 + 8 * (tid & 3); }
    else { kg = (const bf16_t*)(p.ws + WS_KA) + (rb + skey) * 128 + hk * 64 + 8 * sc; vg = (const bf16_t*)(p.ws + WS_VA) + (rb + skey) * 128 + hk * 64 + 8 * sc; }
    const int kpitch = MLA ? 512 : 128;
    const int kst = skey * KROW + sc * 16;
    const int rst = (tid >> 2) * KROW + 128 + (tid & 3) * 16;
    const int vst = ((8 * sc) >> 5) * 4096 + (skey >> 4) * 1024 + (skey & 15) * 64 + ((8 * sc) & 31) * 2;
    u32x4 kreg, vreg, rreg = (u32x4){0u, 0u, 0u, 0u};
#define ATT_LOAD(t) do { kreg = *(const u32x4*)(kg + (size_t)(t) * 64 * kpitch); vreg = *(const u32x4*)(vg + (size_t)(t) * 64 * kpitch); \
        if (MLA && tid < 256) rreg = *(const u32x4*)(rg + (size_t)(t) * 64 * 32); } while (0)
#define ATT_WRITE(buf) do { *(LAS u32x4*)(lds + OFF_K + (buf) * KBUF + kst) = kreg; *(LAS u32x4*)(lds + OFF_V + (buf) * VBUF + vst) = vreg; \
        if (MLA && tid < 256) *(LAS u32x4*)(lds + OFF_K + (buf) * KBUF + rst) = rreg; } while (0)
    LAS float* wsf = (LAS float*)(lds + OFF_WS) + wid * 64;
    float m, l; f32x16 o[2];
#pragma unroll
    for (int r = 0; r < 16; ++r) { o[0][r] = 0.f; o[1][r] = 0.f; }
    float slope2 = 0.f;
    if (MLA) { m = -INFINITY; l = 0.f; }
    else { m = p.sinks[head] * LOG2E; l = hi == 0 ? 1.f : 0.f; slope2 = exp2f(-(float)(head + 1)) * LOG2E; }
    const lds_cptr kp0 = (lds_cptr)lds + OFF_K + r32 * KROW + hi * 16;
    const lds_cptr vp0 = (lds_cptr)lds + OFF_V + ((lane >> 4) & 1) * 32 + (lane & 3) * 8 + (4 * hi + ((lane & 15) >> 2)) * 64;
    ATT_LOAD(t_lo); ATT_WRITE(0);
    ATT_BARRIER();
    for (int t = t_lo; t <= t_hi; ++t) {
        const int cur = (t - t_lo) & 1, s0 = t * 64;
        if (t < t_hi) ATT_LOAD(t + 1);
        if (BG_CONV) bg_step(p, bg, bgscr, lane);
        const bool active = MLA ? (s0 <= qw0 + 31) : (s0 <= qw0 + 31 && s0 + 63 >= qw0 - 127);
        if (active) {
            f32x16 p0, p1;
#pragma unroll
            for (int r = 0; r < 16; ++r) { p0[r] = 0.f; p1[r] = 0.f; }
            const lds_cptr kp = kp0 + cur * KBUF;
#pragma unroll
            for (int ks = 0; ks < NKS; ++ks) {
                const bf16x8 a0 = *(const LAS bf16x8*)(kp + ks * 32), a1 = *(const LAS bf16x8*)(kp + 32 * KROW + ks * 32);
                p0 = __builtin_amdgcn_mfma_f32_32x32x16_bf16(a0, qf[ks], p0, 0, 0, 0);
                p1 = __builtin_amdgcn_mfma_f32_32x32x16_bf16(a1, qf[ks], p1, 0, 0, 0);
            }
            const int q = qw0 + r32;
            if (MLA) {
                if (s0 + 63 > qw0) {
#pragma unroll
                    for (int r = 0; r < 16; ++r) { const int key = s0 + crow(r, hi); if (key > q) p0[r] = -INFINITY; if (key + 32 > q) p1[r] = -INFINITY; }
                }
            } else {
#pragma unroll
                for (int r = 0; r < 16; ++r) { const int d0 = q - (s0 + crow(r, hi)), d1 = d0 - 32;
                    p0[r] = (d0 >= 0 && d0 < 128) ? p0[r] - slope2 * (float)d0 : -INFINITY;
                    p1[r] = (d1 >= 0 && d1 < 128) ? p1[r] - slope2 * (float)d1 : -INFINITY; }
            }
            float mx = fmaxf(p0[0], p1[0]);
#pragma unroll
            for (int r = 1; r < 16; ++r) mx = fmaxf(mx, fmaxf(p0[r], p1[r]));
            mx = half_swap_max(mx);
            if (__any(mx > m + 8.f)) {
                const float mn = fmaxf(m, mx), alpha = __builtin_amdgcn_exp2f(m - mn);
                m = mn; l *= alpha;
                if (hi == 0) wsf[r32] = alpha;
#pragma unroll
                for (int r = 0; r < 16; ++r) { const float a = wsf[crow(r, hi)]; o[0][r] *= a; o[1][r] *= a; }
            }
            float ps = 0.f;
#pragma unroll
            for (int r = 0; r < 16; ++r) { p0[r] = __builtin_amdgcn_exp2f(p0[r] - m); p1[r] = __builtin_amdgcn_exp2f(p1[r] - m); ps += p0[r] + p1[r]; }
            l += ps;
            u32x4 pw[4];
#pragma unroll
            for (int i = 0; i < 4; ++i) { pw[0][i] = pg8::cvt_pk_bf16(p0[2 * i], p0[2 * i + 1]); pw[1][i] = pg8::cvt_pk_bf16(p0[8 + 2 * i], p0[8 + 2 * i + 1]);
                                          pw[2][i] = pg8::cvt_pk_bf16(p1[2 * i], p1[2 * i + 1]); pw[3][i] = pg8::cvt_pk_bf16(p1[8 + 2 * i], p1[8 + 2 * i + 1]); }
            const lds_cptr vp = vp0 + cur * VBUF;
#pragma unroll
            for (int d0 = 0; d0 < 2; ++d0)
#pragma unroll
                for (int ks = 0; ks < 4; ++ks) {
                    const s16x4 lo = vtr(vp + d0 * 4096 + ks * 1024), hh = vtr(vp + d0 * 4096 + ks * 1024 + 512);
                    const bf16x8 vf = (bf16x8){lo[0], lo[1], lo[2], lo[3], hh[0], hh[1], hh[2], hh[3]};
                    o[d0] = __builtin_amdgcn_mfma_f32_32x32x16_bf16(__builtin_bit_cast(bf16x8, pw[ks]), vf, o[d0], 0, 0, 0);
                }
        }
        if (t < t_hi) ATT_WRITE(cur ^ 1);
        ATT_BARRIER();
    }
    l = half_swap_sum(l);
    if (hi == 0) wsf[32 + r32] = 1.f / l;
    bf16_t* Ob = (bf16_t*)(p.ws + WS_AO) + (rb + qw0) * 1024 + (MLA ? 512 : 0) + head * 64 + r32;
#pragma unroll
    for (int r = 0; r < 16; ++r) { const int qr = crow(r, hi); const float rl = wsf[32 + qr];
        Ob[(size_t)qr * 1024] = (bf16_t)f2bf(o[0][r] * rl); Ob[(size_t)qr * 1024 + 32] = (bf16_t)f2bf(o[1][r] * rl); }
#undef ATT_LOAD
#undef ATT_WRITE
}
constexpr int PP_AHEAD = 4;
constexpr int PP_OFF_V = 3 * KBUF, PP_OFF_WS = 3 * KBUF + 3 * VBUF;
#define ATT_PBAR() do { __builtin_amdgcn_sched_barrier(0); asm volatile("s_waitcnt lgkmcnt(0)\n\ts_barrier" ::: "memory"); __builtin_amdgcn_sched_barrier(0); } while (0)
template <bool MLA>
__device__ __forceinline__ void attn_unit_pp(const P& p, LAS unsigned char* lds, int b, int hk, int q0, BgConv& bg) {
    int tid_ = threadIdx.x; asm volatile("" : "+v"(tid_));
    const int tid = tid_, lane = tid & 63, r32 = lane & 31, hi = lane >> 5, wid = __builtin_amdgcn_readfirstlane(tid >> 6);
    const int grp = wid >> 2;
    constexpr int NKS = MLA ? 6 : 4;
    const int head = MLA ? hk : hk * 4 + (wid >> 1);
    const int qw0 = MLA ? q0 + 32 * wid : q0 + 32 * (wid & 1);
    const size_t rb = (size_t)b * SEQ;
    bf16x8 qf[NKS];
    if (MLA) {
        const bf16_t* qn = (const bf16_t*)(p.ws + WS_QN) + (rb + qw0 + r32) * 512 + head * 64 + 8 * hi;
        const bf16_t* qr = (const bf16_t*)(p.ws + WS_QR) + (rb + qw0 + r32) * 256 + head * 32 + 8 * hi;
#pragma unroll
        for (int ks = 0; ks < 4; ++ks) qf[ks] = *(const bf16x8*)(qn + 16 * ks);
#pragma unroll
        for (int ks = 4; ks < NKS; ++ks) qf[ks] = *(const bf16x8*)(qr + 16 * (ks - 4));
    } else {
        const bf16_t* qa = (const bf16_t*)(p.ws + WS_QA) + (rb + qw0 + r32) * 512 + head * 64 + 8 * hi;
#pragma unroll
        for (int ks = 0; ks < NKS; ++ks) qf[ks] = *(const bf16x8*)(qa + 16 * ks);
    }
    const int t_lo = MLA ? 0 : (q0 >= 128 ? (q0 - 128) >> 6 : 0), t_hi = MLA ? ((q0 + 256) >> 6) - 1 : (q0 >> 6);
    const int skey = tid >> 3, sc = tid & 7;
    const bf16_t* kg; const bf16_t* vg; const bf16_t* rg = nullptr;
    if (MLA) { kg = (const bf16_t*)(p.ws + WS_KN) + (rb + skey) * 512 + hk * 64 + 8 * sc; vg = (const bf16_t*)(p.ws + WS_VB) + (rb + skey) * 512 + hk * 64 + 8 * sc;
               rg = (const bf16_t*)(p.ws + WS_KR) + (rb + (tid >> 2)) * 32 + 8 * (tid & 3); }
    else { kg = (const bf16_t*)(p.ws + WS_KA) + (rb + skey) * 128 + hk * 64 + 8 * sc; vg = (const bf16_t*)(p.ws + WS_VA) + (rb + skey) * 128 + hk * 64 + 8 * sc; }
    const int kpitch = MLA ? 512 : 128;
    const int kst = skey * KROW + sc * 16;
    const int rst = (tid >> 2) * KROW + 128 + (tid & 3) * 16;
    const int vst = ((8 * sc) >> 5) * 4096 + (skey >> 4) * 1024 + (skey & 15) * 64 + ((8 * sc) & 31) * 2;
    u32x4 kreg, vreg, rreg = (u32x4){0u, 0u, 0u, 0u};
#define PP_LOAD(t) do { kreg = *(const u32x4*)(kg + (size_t)(t) * 64 * kpitch); vreg = *(const u32x4*)(vg + (size_t)(t) * 64 * kpitch); \
        if (MLA && tid < 256) rreg = *(const u32x4*)(rg + (size_t)(t) * 64 * 32); } while (0)
#define PP_WRITE(kb, vb) do { *(LAS u32x4*)(lds + (kb) + kst) = kreg; *(LAS u32x4*)(lds + PP_OFF_V + (vb) + vst) = vreg; \
        if (MLA && tid < 256) *(LAS u32x4*)(lds + (kb) + rst) = rreg; } while (0)
    LAS float* wsf = (LAS float*)(lds + PP_OFF_WS) + wid * 64;
    float m, l; f32x16 o[2];
#pragma unroll
    for (int r = 0; r < 16; ++r) { o[0][r] = 0.f; o[1][r] = 0.f; }
    float slope2 = 0.f;
    if (MLA) { m = -INFINITY; l = 0.f; }
    else { m = p.sinks[head] * LOG2E; l = hi == 0 ? 1.f : 0.f; slope2 = exp2f(-(float)(head + 1)) * LOG2E; }
    const lds_cptr kp0 = (lds_cptr)lds + r32 * KROW + hi * 16;
    const lds_cptr vp0 = (lds_cptr)lds + PP_OFF_V + ((lane >> 4) & 1) * 32 + (lane & 3) * 8 + (4 * hi + ((lane & 15) >> 2)) * 64;
    int kbP = 2 * KBUF, kbC = 0, kbN = KBUF, vbP = 2 * VBUF, vbC = 0, vbN = VBUF;
    PP_LOAD(t_lo); PP_WRITE(kbC, vbC);
    if (t_lo < t_hi) PP_LOAD(t_lo + 1);
    ATT_PBAR();
    if (grp) ATT_PBAR();
    u32x4 pw[4];
#pragma unroll
    for (int i = 0; i < 4; ++i) pw[i] = (u32x4){0u, 0u, 0u, 0u};
    f32x16 p0, p1;
#pragma unroll
    for (int r = 0; r < 16; ++r) { p0[r] = 0.f; p1[r] = 0.f; }
    bool act_prev = false;
    for (int t = t_lo; t <= t_hi + 1; ++t) {
        const int s0 = t * 64;
        const bool active = t <= t_hi && (MLA ? (s0 <= qw0 + 31) : (s0 <= qw0 + 31 && s0 + 63 >= qw0 - 127));
        __builtin_amdgcn_s_setprio(1);
        if (active) {
#pragma unroll
            for (int r = 0; r < 16; ++r) { p0[r] = 0.f; p1[r] = 0.f; }
            const lds_cptr kp = kp0 + kbC;
            bf16x8 ka[2 * NKS];
#pragma unroll
            for (int ks = 0; ks < NKS; ++ks) { ka[2 * ks] = *(const LAS bf16x8*)(kp + ks * 32); ka[2 * ks + 1] = *(const LAS bf16x8*)(kp + 32 * KROW + ks * 32); }
#pragma unroll
            for (int ks = 0; ks < NKS; ++ks) {
                p0 = __builtin_amdgcn_mfma_f32_32x32x16_bf16(ka[2 * ks], qf[ks], p0, 0, 0, 0);
                p1 = __builtin_amdgcn_mfma_f32_32x32x16_bf16(ka[2 * ks + 1], qf[ks], p1, 0, 0, 0);
            }
            __builtin_amdgcn_sched_group_barrier(0x100, PP_AHEAD, 0);
#pragma unroll
            for (int i = 0; i < 2 * NKS - PP_AHEAD; ++i) { __builtin_amdgcn_sched_group_barrier(0x008, 1, 0); __builtin_amdgcn_sched_group_barrier(0x100, 1, 0); }
            __builtin_amdgcn_sched_group_barrier(0x008, PP_AHEAD, 0);
        }
        __builtin_amdgcn_sched_barrier(0);
        if (act_prev) {
            const lds_cptr vp = vp0 + vbP;
            bf16x8 vf[8];
#pragma unroll
            for (int ks = 0; ks < 4; ++ks)
#pragma unroll
                for (int d0 = 0; d0 < 2; ++d0) {
                    const s16x4 lo = vtr(vp + d0 * 4096 + ks * 1024), hh = vtr(vp + d0 * 4096 + ks * 1024 + 512);
                    vf[2 * ks + d0] = (bf16x8){lo[0], lo[1], lo[2], lo[3], hh[0], hh[1], hh[2], hh[3]};
                }
#pragma unroll
            for (int ks = 0; ks < 4; ++ks) {
                o[0] = __builtin_amdgcn_mfma_f32_32x32x16_bf16(__builtin_bit_cast(bf16x8, pw[ks]), vf[2 * ks], o[0], 0, 0, 0);
                o[1] = __builtin_amdgcn_mfma_f32_32x32x16_bf16(__builtin_bit_cast(bf16x8, pw[ks]), vf[2 * ks + 1], o[1], 0, 0, 0);
            }
            __builtin_amdgcn_sched_group_barrier(0x100, 6, 0);
#pragma unroll
            for (int i = 0; i < 5; ++i) { __builtin_amdgcn_sched_group_barrier(0x008, 1, 0); __builtin_amdgcn_sched_group_barrier(0x100, 2, 0); }
            __builtin_amdgcn_sched_group_barrier(0x008, 3, 0);
        }
        __builtin_amdgcn_sched_barrier(0);
        __builtin_amdgcn_s_setprio(0);
        if (t < t_hi) PP_WRITE(kbN, vbN);
        if (BG_CONV) bg_step_fin(p, bg, lane);
        if (t + 1 < t_hi) PP_LOAD(t + 2);
        if (BG_CONV) bg_step_iss(p, bg, lane);
        ATT_PBAR();
        if (active) {
            const int q = qw0 + r32;
            if (MLA) {
                if (s0 + 63 > qw0) {
#pragma unroll
                    for (int r = 0; r < 16; ++r) { const int key = s0 + crow(r, hi); if (key > q) p0[r] = -INFINITY; if (key + 32 > q) p1[r] = -INFINITY; }
                }
            } else {
#pragma unroll
                for (int r = 0; r < 16; ++r) { const int d0 = q - (s0 + crow(r, hi)), d1 = d0 - 32;
                    p0[r] = (d0 >= 0 && d0 < 128) ? p0[r] - slope2 * (float)d0 : -INFINITY;
                    p1[r] = (d1 >= 0 && d1 < 128) ? p1[r] - slope2 * (float)d1 : -INFINITY; }
            }
            float mxa = fmaxf(p0[0], p1[0]), mxb = fmaxf(p0[1], p1[1]);
#pragma unroll
            for (int r = 2; r < 16; r += 2) { mxa = vmax3(mxa, p0[r], p1[r]); mxb = vmax3(mxb, p0[r + 1], p1[r + 1]); }
            float mx = half_swap_max(fmaxf(mxa, mxb));
            if (__any(mx > m + 8.f)) {
                const float mn = fmaxf(m, mx), alpha = __builtin_amdgcn_exp2f(m - mn);
                m = mn; l *= alpha;
                if (hi == 0) wsf[r32] = alpha;
#pragma unroll
                for (int r = 0; r < 16; ++r) { const float a = wsf[crow(r, hi)]; o[0][r] *= a; o[1][r] *= a; }
            }
#pragma unroll
            for (int r = 0; r < 16; ++r) { p0[r] -= m; p1[r] -= m; }
            __builtin_amdgcn_sched_barrier(0);
#pragma unroll
            for (int r = 0; r < 16; ++r) { p0[r] = __builtin_amdgcn_exp2f(p0[r]); p1[r] = __builtin_amdgcn_exp2f(p1[r]); }
            __builtin_amdgcn_sched_barrier(0);
            { typedef float f32x2 __attribute__((ext_vector_type(2)));
              f32x2 sa = (f32x2){p0[0], p0[1]} + (f32x2){p1[0], p1[1]}, sb = (f32x2){p0[2], p0[3]} + (f32x2){p1[2], p1[3]};
#pragma unroll
              for (int r = 4; r < 16; r += 4) { sa += (f32x2){p0[r], p0[r + 1]} + (f32x2){p1[r], p1[r + 1]}; sb += (f32x2){p0[r + 2], p0[r + 3]} + (f32x2){p1[r + 2], p1[r + 3]}; }
              sa += sb; l += sa[0] + sa[1]; }
#pragma unroll
            for (int i = 0; i < 4; ++i) { pw[0][i] = pg8::cvt_pk_bf16(p0[2 * i], p0[2 * i + 1]); pw[1][i] = pg8::cvt_pk_bf16(p0[8 + 2 * i], p0[8 + 2 * i + 1]);
                                          pw[2][i] = pg8::cvt_pk_bf16(p1[2 * i], p1[2 * i + 1]); pw[3][i] = pg8::cvt_pk_bf16(p1[8 + 2 * i], p1[8 + 2 * i + 1]); }
        }
        act_prev = active;
        ATT_PBAR();
        { const int tk = kbP; kbP = kbC; kbC = kbN; kbN = tk; const int tv = vbP; vbP = vbC; vbC = vbN; vbN = tv; }
    }
    if (!grp) ATT_PBAR();
    l = half_swap_sum(l);
    if (hi == 0) wsf[32 + r32] = 1.f / l;
    bf16_t* Ob = (bf16_t*)(p.ws + WS_AO) + (rb + qw0) * 1024 + (MLA ? 512 : 0) + head * 64 + r32;
#pragma unroll
    for (int r = 0; r < 16; ++r) { const int qr = crow(r, hi); const float rl = wsf[32 + qr];
        Ob[(size_t)qr * 1024] = (bf16_t)f2bf(o[0][r] * rl); Ob[(size_t)qr * 1024 + 32] = (bf16_t)f2bf(o[1][r] * rl); }
#undef PP_LOAD
#undef PP_WRITE
}
}
__device__ __forceinline__ void ph_attn2(const P& p, unsigned char* lds_) {
    LAS unsigned char* lds = (LAS unsigned char*)lds_;
    const int G = gridDim.x, bx = blockIdx.x;
    const int vcu = (G % 8 == 0) ? (bx % 8) * (G / 8) + bx / 8 : bx;
    const int lane_ = threadIdx.x & 63, wave_ = threadIdx.x >> 6;
    BgConv bg; bg.item = bx * 8 + wave_; bg.it = 0; bg.ngw = G * 8; bg.pend = false;
#pragma unroll
    for (int i = 0; i < 32; ++i) bg.r[i] = 0.f;
    float* bgscr = (float*)(lds_ + att::BG_SCR_OFF + wave_ * 8704);
    for (int pi = vcu; pi < 256; pi += G) {
        const int bh = pi >> 4, sidx = pi & 15;
        att::attn_unit_pp<true>(p, lds, bh >> 3, bh & 7, (31 - sidx) * 256, bg);
        att::attn_unit_pp<true>(p, lds, bh >> 3, bh & 7, sidx * 256, bg);
    }
    for (int u = vcu; u < 512; u += G) {
        const int bk = u >> 7, qb = u & 127;
        att::attn_unit_pp<false>(p, lds, bk >> 1, bk & 1, qb * 64, bg);
    }
    if (BG_CONV) bg_drain(p, bg, bgscr, lane_);
}

#define XB_TMO      128
#define XB_XCNT(j)  (256  + 64 * (j))
#define XB_XSUB(j)  (1280 + 64 * (j))
#define XB_XGEN(j)  (2304 + 64 * (j))
#define XB_TOP      3328
#define XB_TOPGEN   3392
#define XCD_BAR_WORDS 3456
#define XB_SPIN_CAP (1u << 18)
__device__ __forceinline__ unsigned xb_ld(unsigned* p)              { return __hip_atomic_load(p, __ATOMIC_RELAXED, __HIP_MEMORY_SCOPE_AGENT); }
__device__ __forceinline__ unsigned xb_add(unsigned* p, unsigned v) { return __hip_atomic_fetch_add(p, v, __ATOMIC_RELAXED, __HIP_MEMORY_SCOPE_AGENT); }
__device__ __forceinline__ unsigned xb_xcc_id() { return (unsigned)__builtin_amdgcn_s_getreg((3 << 11) | 20) & 0xFu; }
#define XB_SPIN(cond, bar) do { unsigned _sp = 0; while (cond) { __builtin_amdgcn_s_sleep(1); \
    if ((++_sp & 255u) == 0u) { if (xb_ld(&(bar)[XB_TMO])) break; if (_sp > XB_SPIN_CAP) { atomicAdd(&(bar)[XB_TMO], 1u); break; } } } } while (0)
struct XcdBarrier { unsigned* bar; unsigned x; volatile LAS unsigned* st; };
__device__ __forceinline__ XcdBarrier xcd_barrier_post(unsigned* bar, volatile LAS unsigned* st) {
    XcdBarrier b; b.bar = bar; b.x = xb_xcc_id(); b.st = st;
    if (threadIdx.x == 0) (void)xb_add(&bar[XB_XCNT(b.x)], 1u);
    return b;
}
__device__ __forceinline__ void xcd_barrier_complete(unsigned* bar, unsigned x, unsigned& nloc, unsigned& nx) {
    const unsigned G = gridDim.x * gridDim.y * gridDim.z;
    unsigned sum, cnt, mine, sp = 0u;
    for (;;) {
        sum = 0u; cnt = 0u; mine = 0u;
#pragma unroll
        for (unsigned j = 0; j < 16; ++j) { const unsigned c = xb_ld(&bar[XB_XCNT(j)]); sum += c; cnt += (c > 0u) ? 1u : 0u; mine = (j == x) ? c : mine; }
        if (sum == G) break;
        __builtin_amdgcn_s_sleep(1);
        if ((++sp & 255u) == 0u) { if (xb_ld(&bar[XB_TMO])) break; if (sp > XB_SPIN_CAP) { atomicAdd(&bar[XB_TMO], 1u); break; } }
    }
    nloc = mine > 0u ? mine : 1u; nx = cnt > 0u ? cnt : 1u;
}
__device__ __forceinline__ void xcd_barrier(const XcdBarrier& b) {
    asm volatile("s_waitcnt vmcnt(0)" ::: "memory");
    __syncthreads();
    if (threadIdx.x == 0) {
        unsigned* bar = b.bar;
        __builtin_amdgcn_s_waitcnt(0);
        unsigned nloc = b.st[0], nx = b.st[1];
        if (nloc == 0u) { xcd_barrier_complete(bar, b.x, nloc, nx); b.st[0] = nloc; b.st[1] = nx; }
        const unsigned old = xb_add(&bar[XB_XSUB(b.x)], 1u);
        const unsigned gen = old / nloc;
        if (old + 1u == (gen + 1u) * nloc) {
            __builtin_amdgcn_fence(__ATOMIC_RELEASE, "agent");
            asm volatile("s_waitcnt vmcnt(0)" ::: "memory");
            const unsigned og = xb_add(&bar[XB_TOP], 1u);
            const unsigned tg = og / nx;
            if (og + 1u == (tg + 1u) * nx) xb_add(&bar[XB_TOPGEN], 1u);
            else XB_SPIN(xb_ld(&bar[XB_TOPGEN]) == tg, bar);
            __builtin_amdgcn_fence(__ATOMIC_ACQUIRE, "agent");
            xb_add(&bar[XB_XGEN(b.x)], 1u);
            asm volatile("s_waitcnt vmcnt(0)" ::: "memory");
        } else {
            XB_SPIN(xb_ld(&bar[XB_XGEN(b.x)]) == gen, bar);
            __builtin_amdgcn_fence(__ATOMIC_ACQUIRE, "agent");
            asm volatile("s_waitcnt vmcnt(0)" ::: "memory");
        }
    }
    __syncthreads();
}
constexpr int LDSCTL_OFF = 139264;
constexpr int CW_BAR = 4096;
constexpr size_t CTL_ZERO_BYTES = 65536;

__global__ void __launch_bounds__(NTHREADS, 2) mega_fwd(P p) {
    extern __shared__ __attribute__((aligned(16))) unsigned char lds[];
    if (threadIdx.x < 32) ((LAS unsigned*)((LAS unsigned char*)lds + LDSCTL_OFF))[threadIdx.x] = 0u;
    __syncthreads();
    const XcdBarrier bar = xcd_barrier_post((unsigned*)(p.ws + WS_CTL) + CW_BAR, (volatile LAS unsigned*)((LAS unsigned char*)lds + LDSCTL_OFF));
#ifndef PH_MASK
#define PH_MASK 0xFFFF
#endif
#ifndef PH_DUP
#define PH_DUP 0
#endif
#define RUN_PH(bit, call) do { if (PH_MASK & (bit)) { call; if (PH_DUP & (bit)) { __syncthreads(); call; } } } while (0)
#define GSYNC() do { xcd_barrier(bar); if (PH_DUP & 0x10000) xcd_barrier(bar); } while (0)
    RUN_PH(1, (ph_mod(p, lds), ph_convert(p, lds)));
    GSYNC();
    RUN_PH(2, ph_xn(p));
    GSYNC();
    RUN_PH(4, ph_proj2(p, lds));
    GSYNC();
    RUN_PH(16, ph_up2(p, lds));
    GSYNC();
    RUN_PH(32, ph_attn2(p, lds));
    GSYNC();
    RUN_PH(64, ph_mix2(p, lds));
    GSYNC();
    RUN_PH(128, ph_out2(p, lds));
    GSYNC();
    if (PH_DUP & 256) { ph_route(p, lds, false); __syncthreads(); }
    if (PH_MASK & 256) ph_route(p, lds, true);
    GSYNC();
    RUN_PH(512, ph_moe1_2(p, lds));
    GSYNC();
    RUN_PH(1024, ph_moe2_2(p, lds));
    GSYNC();
    RUN_PH(2048, ph_final(p));
}

extern "C" void kernel_launch(void* const* d_in, const int* in_sizes, int n_in, void* d_out, int out_size, void* d_ws, size_t ws_size, hipStream_t stream) {
    static int grid_blocks = 0;
    if (!grid_blocks) {
        int dev = 0, cus = 0, per_cu = 0;
        (void)hipGetDevice(&dev);
        (void)hipDeviceGetAttribute(&cus, hipDeviceAttributeMultiprocessorCount, dev);
        (void)hipFuncSetAttribute((const void*)mega_fwd, hipFuncAttributeMaxDynamicSharedMemorySize, LDS_BYTES);
        (void)hipOccupancyMaxActiveBlocksPerMultiprocessor(&per_cu, (const void*)mega_fwd, NTHREADS, LDS_BYTES);
        if (per_cu < 1) per_cu = 1;
        grid_blocks = cus * per_cu;
        if (grid_blocks > 256) grid_blocks = 256;
        if (grid_blocks < 256 || MTOK % grid_blocks != 0) { fprintf(stderr, "kernel_launch: grid %d unsupported (needs >= 256 workgroups dividing %d)\n", grid_blocks, MTOK); grid_blocks = -1; }
        else if (ws_size < WS_END || n_in != 24) { fprintf(stderr, "kernel_launch: ws %zu < %zu or n_in %d != 24\n", ws_size, (size_t)WS_END, n_in); grid_blocks = -1; }
    }
    if (grid_blocks < 0) return;
    P p{};
    p.x = (const float*)d_in[0]; p.c = (const float*)d_in[1]; p.pos = (const int*)d_in[2]; p.w_ada = (const float*)d_in[3]; p.b_ada = (const float*)d_in[4];
    p.norm_mix = (const float*)d_in[5]; p.norm_ffn = (const float*)d_in[6]; p.w_in = (const float*)d_in[7]; p.sinks = (const float*)d_in[8];
    p.q_norm = (const float*)d_in[9]; p.kv_norm = (const float*)d_in[10]; p.w_uq = (const float*)d_in[11]; p.w_uk = (const float*)d_in[12]; p.w_uv = (const float*)d_in[13];
    p.w_a = (const float*)d_in[14]; p.w_b = (const float*)d_in[15]; p.w_out = (const float*)d_in[16]; p.w_router = (const float*)d_in[17]; p.b_router = (const float*)d_in[18];
    p.w_m1 = (const float*)d_in[19]; p.b_m1 = (const float*)d_in[20]; p.w_m2 = (const float*)d_in[21]; p.b_m2 = (const float*)d_in[22]; p.fnorm = (const float*)d_in[23];
    p.out = (float*)d_out; p.ws = (unsigned char*)d_ws;
    if (hipMemsetAsync((char*)d_ws + WS_CTL, 0, CTL_ZERO_BYTES, stream) != hipSuccess) { fprintf(stderr, "kernel_launch: memset failed\n"); return; }
    hipLaunchKernelGGL(mega_fwd, dim3(grid_blocks), dim3(NTHREADS), LDS_BYTES, stream, p);
    const hipError_t e = hipPeekAtLastError();
    if (e != hipSuccess) fprintf(stderr, "launch failed: %s (grid %d)\n", hipGetErrorString(e), grid_blocks);
}
```
